# Optimizing an MI355X kernel written in HIP

```python
import math
import jax, jax.numpy as jnp
from jax import lax
import numpy as np

D_MODEL = 2048
BATCH = 4
SEQ = 4096
DEPTH = 2

CHUNK = 64
Q_BLOCK = 128
ROPE_THETA = 500000.0
NORM_EPS = 1e-6

MLA_HEADS = 8
MLA_NOPE = 64
MLA_ROPE = 32
MLA_V = 64
MLA_Q_LORA = 512
MLA_KV_LORA = 512

DIFF_HEADS = 4
DIFF_DH = 64
DIFF_DV = 2 * DIFF_DH
DIFF_ROT = DIFF_DH // 4
DIFF_QK = DIFF_HEADS * 2 * DIFF_DH

SGU_GROUPS = 4
SGU_GROUP_DIM = 128
SGU_WIDTH = SGU_GROUPS * SGU_GROUP_DIM
SGU_BLOCK = 128

N_BRANCH = 3
BRANCH_WIDTH = 512

IN_SPLITS = (MLA_Q_LORA, MLA_KV_LORA, MLA_ROPE, DIFF_QK, DIFF_QK,
             DIFF_HEADS * DIFF_DV, SGU_WIDTH, SGU_WIDTH)
D_IN = sum(IN_SPLITS)
IN_OFFSETS = tuple(int(v) for v in np.cumsum(IN_SPLITS)[:-1])

PEER_HEADS = 8
PEER_NKEYS = 128
PEER_EXPERTS = PEER_NKEYS * PEER_NKEYS
PEER_DKEY = 256
PEER_TOPK = 16
PEER_TOK_BLOCK = 128

kernel_name = "hybrid_mla_diff_sgu_peer_chunk_causal"


def rms_norm(x, gain):
    xf = x.astype(jnp.float32)
    y = xf * lax.rsqrt(jnp.mean(xf * xf, axis=-1, keepdims=True) + NORM_EPS)
    return (y * gain.astype(jnp.float32)).astype(x.dtype)


def rope(x, pos, rot_dim):
    half = rot_dim // 2
    inv_freq = ROPE_THETA ** (-jnp.arange(half, dtype=jnp.float32) / half)
    ang = pos.astype(jnp.float32)[:, None] * inv_freq[None, :]
    cos = jnp.cos(ang)[None, :, None, :]
    sin = jnp.sin(ang)[None, :, None, :]
    xr = x[..., :rot_dim].astype(jnp.float32)
    x1, x2 = xr[..., :half], xr[..., half:]
    rot = jnp.concatenate([x1 * cos - x2 * sin, x2 * cos + x1 * sin], axis=-1).astype(x.dtype)
    return jnp.concatenate([rot, x[..., rot_dim:]], axis=-1)


def chunk_mask(q_pos, k_pos):
    return (k_pos[None, :] // CHUNK) <= (q_pos[:, None] // CHUNK)


def masked_softmax(logits, mask):
    logits = jnp.where(mask, logits.astype(jnp.float32), -jnp.inf)
    return jax.nn.softmax(logits, axis=-1)


def sweep_query_blocks(fn, *qs):
    B, S = qs[0].shape[:2]
    nb = S // Q_BLOCK
    blocks = tuple(jnp.moveaxis(q.reshape(B, nb, Q_BLOCK, *q.shape[2:]), 1, 0) for q in qs)
    out = lax.map(lambda a: fn(a[0], *a[1:]), (jnp.arange(nb), *blocks))
    return jnp.moveaxis(out, 0, 1).reshape(B, S, *out.shape[3:])


def mla_branch(c_q, c_kv, k_rope, pos, g_cq, g_ckv, w_uq, w_ukv, nope_gain, rope_gain):
    B, S, _ = c_q.shape
    c_q = rms_norm(c_q, g_cq)
    c_kv = rms_norm(c_kv, g_ckv)
    q = jnp.einsum('bsr,rhd->bshd', c_q, w_uq)
    kv = jnp.einsum('bsr,rhd->bshd', c_kv, w_ukv)
    q_nope = rms_norm(q[..., :MLA_NOPE], nope_gain[0])
    q_pe = rope(rms_norm(q[..., MLA_NOPE:], rope_gain[0]), pos, MLA_ROPE)
    k_nope = rms_norm(kv[..., :MLA_NOPE], nope_gain[1])
    v = kv[..., MLA_NOPE:]
    k_pe = rope(rms_norm(k_rope, rope_gain[1])[:, :, None, :], pos, MLA_ROPE)[:, :, 0, :]
    scale = (MLA_NOPE + MLA_ROPE) ** -0.5

    def block(i, qn, qr):
        q_pos = i * Q_BLOCK + jnp.arange(Q_BLOCK)
        s = (jnp.einsum('bqhd,bkhd->bhqk', qn, k_nope).astype(jnp.float32)
             + jnp.einsum('bqhd,bkd->bhqk', qr, k_pe).astype(jnp.float32)) * scale
        p = masked_softmax(s, chunk_mask(q_pos, pos))
        return jnp.einsum('bhqk,bkhd->bqhd', p.astype(v.dtype), v)

    o = sweep_query_blocks(block, q_nope, q_pe)
    return o.reshape(B, S, MLA_HEADS * MLA_V)


def diff_branch(q, k, v, pos, qk_gain, lam_vecs, sub_gain, lambda_init):
    B, S, _ = q.shape
    q = rms_norm(q.reshape(B, S, DIFF_HEADS, 2, DIFF_DH), qk_gain[0])
    k = rms_norm(k.reshape(B, S, DIFF_HEADS, 2, DIFF_DH), qk_gain[1])
    q = rope(q.reshape(B, S, DIFF_HEADS * 2, DIFF_DH), pos, DIFF_ROT).reshape(B, S, DIFF_HEADS, 2, DIFF_DH)
    k = rope(k.reshape(B, S, DIFF_HEADS * 2, DIFF_DH), pos, DIFF_ROT).reshape(B, S, DIFF_HEADS, 2, DIFF_DH)
    v = v.reshape(B, S, DIFF_HEADS, DIFF_DV)
    lv = lam_vecs.astype(jnp.float32)
    lam = jnp.exp(jnp.sum(lv[0] * lv[1])) - jnp.exp(jnp.sum(lv[2] * lv[3])) + lambda_init
    scale = DIFF_DH ** -0.5

    def block(i, qb):
        q_pos = i * Q_BLOCK + jnp.arange(Q_BLOCK)
        s = jnp.einsum('bqhcd,bkhcd->bchqk', qb, k).astype(jnp.float32) * scale
        p = masked_softmax(s, chunk_mask(q_pos, pos))
        a = p[:, 0] - lam * p[:, 1]
        return jnp.einsum('bhqk,bkhd->bqhd', a.astype(v.dtype), v)

    o = sweep_query_blocks(block, q)
    o = rms_norm(o, sub_gain) * (1.0 - lambda_init)
    return o.reshape(B, S, DIFF_HEADS * DIFF_DV)


def sgu_branch(u, v, v_gain, w_s, b_s):
    B, S, _ = u.shape
    u = jax.nn.gelu(u)
    v = rms_norm(jax.nn.gelu(v), v_gain)
    nb = S // SGU_BLOCK
    v = v.reshape(B, nb, SGU_BLOCK, SGU_GROUPS, SGU_GROUP_DIM)
    t = jnp.arange(SGU_BLOCK)
    mask = (t[None, :] // CHUNK) <= (t[:, None] // CHUNK)
    w = jnp.where(mask[None], w_s, jnp.zeros_like(w_s))
    s = jnp.einsum('gts,bnsgc->bntgc', w, v) + jnp.transpose(b_s)[None, None, :, :, None]
    return u * s.reshape(B, S, SGU_WIDTH)


def peer(h, w_query, sub_keys, expert_u, expert_v):
    B, S, D = h.shape
    half = PEER_DKEY // 2
    q = jnp.einsum('bsd,dhk->bshk', h, w_query).reshape(B, S, PEER_HEADS, 2, half)
    scores = jnp.einsum('bshcd,cnd->bshcn', q, sub_keys).astype(jnp.float32)
    s1, i1 = lax.top_k(scores[..., 0, :], PEER_TOPK)
    s2, i2 = lax.top_k(scores[..., 1, :], PEER_TOPK)
    cand = (s1[..., :, None] + s2[..., None, :]).reshape(B, S, PEER_HEADS, PEER_TOPK * PEER_TOPK)
    cand_idx = (i1[..., :, None] * PEER_NKEYS + i2[..., None, :]).reshape(B, S, PEER_HEADS, PEER_TOPK * PEER_TOPK)
    top_s, top_pos = lax.top_k(cand, PEER_TOPK)
    idx = jnp.take_along_axis(cand_idx, top_pos, axis=-1)
    g = jax.nn.softmax(top_s, axis=-1)
    nb = (B * S) // PEER_TOK_BLOCK
    hb = h.reshape(nb, PEER_TOK_BLOCK, D)
    ib = idx.reshape(nb, PEER_TOK_BLOCK, PEER_HEADS * PEER_TOPK)
    gb = g.reshape(nb, PEER_TOK_BLOCK, PEER_HEADS * PEER_TOPK)

    def block(args):
        xb, eb, wb = args
        a = jnp.einsum('tkd,td->tk', expert_u[eb], xb).astype(jnp.float32)
        coef = (wb * jax.nn.gelu(a)).astype(xb.dtype)
        return jnp.einsum('tk,tkd->td', coef, expert_v[eb])

    out = lax.map(block, (hb, ib, gb))
    return out.reshape(B, S, D)


def setup_inputs(seed: int = 0) -> dict:
    key = jax.random.key(seed)
    ks = jax.random.split(key, 24)
    L = DEPTH
    f32 = jnp.float32

    def nrm(k, shape, scale):
        return jax.random.normal(k, shape, f32) * scale

    def gain(k, shape):
        return 1.0 + 0.02 * jax.random.normal(k, shape, f32)

    return {
        "x": nrm(ks[0], (BATCH, SEQ, D_MODEL), 1.0),
        "norm_mix": gain(ks[1], (L, D_MODEL)),
        "w_in": nrm(ks[2], (L, D_MODEL, D_IN), D_MODEL ** -0.5),
        "mla_g_cq": gain(ks[3], (L, MLA_Q_LORA)),
        "mla_g_ckv": gain(ks[4], (L, MLA_KV_LORA)),
        "mla_w_uq": nrm(ks[5], (L, MLA_Q_LORA, MLA_HEADS, MLA_NOPE + MLA_ROPE), MLA_Q_LORA ** -0.5),
        "mla_w_ukv": nrm(ks[6], (L, MLA_KV_LORA, MLA_HEADS, MLA_NOPE + MLA_V), MLA_KV_LORA ** -0.5),
        "mla_nope_gain": gain(ks[7], (L, 2, MLA_NOPE)),
        "mla_rope_gain": gain(ks[8], (L, 2, MLA_ROPE)),
        "diff_qk_gain": gain(ks[9], (L, 2, DIFF_DH)),
        "diff_lambda": nrm(ks[10], (L, 4, DIFF_DH), 0.1),
        "diff_sub_gain": gain(ks[11], (L, DIFF_DV)),
        "sgu_v_gain": gain(ks[12], (L, SGU_WIDTH)),
        "sgu_w": nrm(ks[13], (L, SGU_GROUPS, SGU_BLOCK, SGU_BLOCK), SGU_BLOCK ** -0.5),
        "sgu_b": gain(ks[14], (L, SGU_GROUPS, SGU_BLOCK)),
        "w_gate": nrm(ks[15], (L, N_BRANCH, D_MODEL, D_MODEL), D_MODEL ** -0.5),
        "b_gate": nrm(ks[16], (L, N_BRANCH, D_MODEL), 0.02),
        "w_branch": nrm(ks[17], (L, N_BRANCH, BRANCH_WIDTH, D_MODEL), BRANCH_WIDTH ** -0.5),
        "w_out": nrm(ks[18], (L, D_MODEL, D_MODEL), D_MODEL ** -0.5),
        "norm_ffn": gain(ks[19], (L, D_MODEL)),
        "peer_w_query": nrm(ks[20], (L, D_MODEL, PEER_HEADS, PEER_DKEY), D_MODEL ** -0.5),
        "peer_sub_keys": nrm(ks[21], (L, 2, PEER_NKEYS, PEER_DKEY // 2), (PEER_DKEY // 2) ** -0.5),
        "peer_u": nrm(ks[22], (L, PEER_EXPERTS, D_MODEL), D_MODEL ** -0.5),
        "peer_v": nrm(ks[23], (L, PEER_EXPERTS, D_MODEL), PEER_HEADS ** -0.5),
    }


def reference(x, norm_mix, w_in, mla_g_cq, mla_g_ckv, mla_w_uq, mla_w_ukv, mla_nope_gain,
              mla_rope_gain, diff_qk_gain, diff_lambda, diff_sub_gain, sgu_v_gain, sgu_w, sgu_b,
              w_gate, b_gate, w_branch, w_out, norm_ffn, peer_w_query, peer_sub_keys, peer_u, peer_v):
    S = x.shape[1]
    pos = jnp.arange(S, dtype=jnp.int32)
    for l in range(DEPTH):
        lambda_init = 0.8 - 0.6 * math.exp(-0.3 * l)
        h = rms_norm(x, norm_mix[l])
        z = jnp.einsum('bsd,de->bse', h, w_in[l])
        c_q, c_kv, k_rope, dq, dk, dv, su, sv = jnp.split(z, IN_OFFSETS, axis=-1)
        o_mla = mla_branch(c_q, c_kv, k_rope, pos, mla_g_cq[l], mla_g_ckv[l], mla_w_uq[l],
                           mla_w_ukv[l], mla_nope_gain[l], mla_rope_gain[l])
        o_diff = diff_branch(dq, dk, dv, pos, diff_qk_gain[l], diff_lambda[l], diff_sub_gain[l],
                             lambda_init)
        o_sgu = sgu_branch(su, sv, sgu_v_gain[l], sgu_w[l], sgu_b[l])
        merged = jnp.zeros_like(x)
        for n, o in enumerate((o_mla, o_diff, o_sgu)):
            gate = jax.nn.sigmoid(jnp.einsum('bsd,de->bse', h, w_gate[l, n]) + b_gate[l, n])
            merged = merged + gate * jnp.einsum('bsc,cd->bsd', o, w_branch[l, n])
        x = x + jnp.einsum('bsd,de->bse', merged, w_out[l])
        x = x + peer(rms_norm(x, norm_ffn[l]), peer_w_query[l], peer_sub_keys[l], peer_u[l], peer_v[l])
    return x
```

```cpp
#include <hip/hip_runtime.h>
#include <cstdio>
#include <cstdint>
#ifndef RESID_IN_PEER
#define RESID_IN_PEER 0
#endif

constexpr int BATCH = 4, SEQ = 4096, DM = 2048, DEPTH = 2;
constexpr int T = BATCH * SEQ;
constexpr int ZP = 3840;
constexpr int NGATE = 3 * DM;
constexpr int N1 = ZP + NGATE;
constexpr int ZC_CQ = 0, ZC_CKV = 512, ZC_DQ = 1024, ZC_DK = 1536, ZC_DV = 2048, ZC_SU = 2560, ZC_SV = 3072, ZC_KR = 3584;
constexpr int DIN = 3616;
constexpr int NEXP = 16384;
constexpr float NORM_EPS = 1e-6f;
constexpr float LOG2E = 1.4426950408889634f;

typedef unsigned short bf16;
typedef unsigned u32x4 __attribute__((ext_vector_type(4)));
typedef unsigned u32x2 __attribute__((ext_vector_type(2)));
typedef float f32x4 __attribute__((ext_vector_type(4)));
typedef float f32x16 __attribute__((ext_vector_type(16)));
typedef short bf16x8 __attribute__((ext_vector_type(8)));
#define LAS __attribute__((address_space(3)))

constexpr size_t MiB = 1u << 20;
constexpr size_t WS_CTL = 0;
constexpr size_t WS_ROPE = 1 * MiB;
constexpr size_t WS_W = 2 * MiB;
constexpr size_t WO_CAT = 0;
constexpr size_t WO_UP = WO_CAT + (size_t)N1 * DM * 2;
constexpr size_t WO_B = WO_UP + (size_t)1792 * 512 * 2;
constexpr size_t WO_OUT = WO_B + (size_t)3 * DM * 512 * 2;
constexpr size_t WO_PQ = WO_OUT + (size_t)DM * DM * 2;
constexpr size_t WO_SGU = WO_PQ + (size_t)DM * DM * 2;
constexpr size_t W_LAYER = WO_SGU + (size_t)4 * 128 * 128 * 2;
constexpr size_t WS_ACT = WS_W + 2 * W_LAYER + (2 * MiB - (2 * W_LAYER) % (2 * MiB));
constexpr size_t WS_HB = WS_ACT;
constexpr size_t WS_Z = WS_HB + (size_t)T * DM * 2;
constexpr size_t WS_G = WS_Z + (size_t)T * ZP * 2;
constexpr size_t WS_SC = WS_G;
constexpr size_t WS_QR = WS_G + (size_t)T * NGATE * 2;
constexpr size_t WS_KVR = WS_QR + (size_t)T * 768 * 2;
constexpr size_t WS_QM = WS_KVR + (size_t)T * 1024 * 2;
constexpr size_t WS_KM = WS_QM + (size_t)T * 768 * 2;
constexpr size_t WS_OC = WS_KM + (size_t)T * 768 * 2;
constexpr size_t WS_MG = WS_OC + (size_t)3 * T * 512 * 2;
constexpr size_t WS_IDX = WS_MG + (size_t)T * DM * 2;
constexpr size_t WS_GW = WS_IDX + (size_t)T * 128 * 4;
constexpr int QROW = DM / 2;
constexpr size_t WS_U8 = WS_GW + (size_t)T * 128 * 4;
constexpr size_t WS_V8 = WS_U8 + (size_t)DEPTH * NEXP * QROW;
constexpr size_t WS_PS = WS_V8 + (size_t)DEPTH * NEXP * QROW;
constexpr size_t WS_HB8 = WS_PS + (size_t)2 * DEPTH * NEXP * 4;
constexpr size_t WS_WG8 = WS_HB8 + (size_t)T * DM;
constexpr size_t WS_END = WS_WG8 + (size_t)DEPTH * NGATE * DM;
constexpr int CW_GMAX = 3072;

struct Params {
    const float* in[24];
    float* out;
    unsigned char* ws;
};

__device__ __forceinline__ unsigned f2bf(float f) { unsigned u = __builtin_bit_cast(unsigned, f); return (u + 0x7fffu + ((u >> 16) & 1u)) >> 16; }
__device__ __forceinline__ unsigned pk2(float lo, float hi) { return f2bf(lo) | (f2bf(hi) << 16); }
__device__ __forceinline__ float bf2f(unsigned b) { return __builtin_bit_cast(float, b << 16); }
__device__ __forceinline__ float bflo(unsigned w) { return __builtin_bit_cast(float, w << 16); }
__device__ __forceinline__ float bfhi(unsigned w) { return __builtin_bit_cast(float, w & 0xffff0000u); }
__device__ __forceinline__ unsigned pk4_fp8(float a, float b, float c, float d) { int w = __builtin_amdgcn_cvt_pk_fp8_f32(a, b, 0, false); w = __builtin_amdgcn_cvt_pk_fp8_f32(c, d, w, true); return (unsigned)w; }
__device__ __forceinline__ float wave_sum(float v) {
#pragma unroll
    for (int o = 1; o < 64; o <<= 1) v += __shfl_xor(v, o);
    return v;
}
__device__ __forceinline__ float gelu_tanh(float x) {
    const float u = 0.7978845608028654f * (x + 0.044715f * x * x * x);
    const float e = __expf(-2.0f * fabsf(u));
    float th = (1.0f - e) / (1.0f + e);
    th = u < 0.f ? -th : th;
    return 0.5f * x * (1.0f + th);
}
__device__ __forceinline__ void unpack8(const u32x4 w, float (&f)[8]) {
    f[0] = bflo(w.x); f[1] = bfhi(w.x); f[2] = bflo(w.y); f[3] = bfhi(w.y); f[4] = bflo(w.z); f[5] = bfhi(w.z); f[6] = bflo(w.w); f[7] = bfhi(w.w);
}
__device__ __forceinline__ u32x4 pack8(const float (&f)[8]) {
    u32x4 w; w.x = pk2(f[0], f[1]); w.y = pk2(f[2], f[3]); w.z = pk2(f[4], f[5]); w.w = pk2(f[6], f[7]); return w;
}

__device__ __forceinline__ void transpose_item(const float* __restrict__ W, int ldw, int scol0, int k0, int K, bf16* __restrict__ WT, int drow0, float* scr, int lane, int kd0 = -1) {
    if (kd0 < 0) kd0 = k0;
    float v[32];
    const float* src = W + (size_t)(k0 + (lane >> 5)) * ldw + scol0 + (lane & 31);
#pragma unroll
    for (int i = 0; i < 32; ++i) v[i] = src[(size_t)(2 * i) * ldw];
#pragma unroll
    for (int i = 0; i < 32; ++i) scr[(2 * i + (lane >> 5)) * 33 + (lane & 31)] = v[i];
    asm volatile("s_waitcnt lgkmcnt(0)" ::: "memory");
    const int c = lane & 7;
#pragma unroll
    for (int j = 0; j < 4; ++j) { const int n = (lane >> 3) + 8 * j; const float* s = scr + (8 * c) * 33 + n;
        u32x4 o; o.x = pk2(s[0 * 33], s[1 * 33]); o.y = pk2(s[2 * 33], s[3 * 33]); o.z = pk2(s[4 * 33], s[5 * 33]); o.w = pk2(s[6 * 33], s[7 * 33]);
        *(u32x4*)(WT + (size_t)(drow0 + n) * K + kd0 + 8 * c) = o; }
    asm volatile("s_waitcnt lgkmcnt(0)" ::: "memory");
}

__device__ __forceinline__ void transpose_item8(const float* __restrict__ W, int ldw, int scol0, int k0, int K, unsigned char* __restrict__ WT, int drow0, float* scr, int lane, float sc) {
    float v[32];
    const float* src = W + (size_t)(k0 + (lane >> 5)) * ldw + scol0 + (lane & 31);
#pragma unroll
    for (int i = 0; i < 32; ++i) v[i] = src[(size_t)(2 * i) * ldw];
#pragma unroll
    for (int i = 0; i < 32; ++i) scr[(2 * i + (lane >> 5)) * 33 + (lane & 31)] = v[i] * sc;
    asm volatile("s_waitcnt lgkmcnt(0)" ::: "memory");
    const int c = lane & 7;
#pragma unroll
    for (int j = 0; j < 4; ++j) { const int n = (lane >> 3) + 8 * j; const float* s = scr + (8 * c) * 33 + n;
        u32x2 o; o.x = pk4_fp8(s[0 * 33], s[1 * 33], s[2 * 33], s[3 * 33]); o.y = pk4_fp8(s[4 * 33], s[5 * 33], s[6 * 33], s[7 * 33]);
        *(u32x2*)(WT + (size_t)(drow0 + n) * K + k0 + 8 * c) = o; }
    asm volatile("s_waitcnt lgkmcnt(0)" ::: "memory");
}
__device__ __forceinline__ float gate_scale(const unsigned* w) { const unsigned b = __hip_atomic_load(w, __ATOMIC_RELAXED, __HIP_MEMORY_SCOPE_AGENT); const int e = (int)((b >> 23) & 255u) - 126;
    const int k = 8 - e, kc = k < -100 ? -100 : (k > 100 ? 100 : k); return __builtin_bit_cast(float, (unsigned)(kc + 127) << 23); }
__device__ __forceinline__ void prologue_transposes(const Params& p, int l, float* scr, int gw, int ngw, int lane) {
    unsigned char* wl = p.ws + WS_W + (size_t)l * W_LAYER;
    bf16* Wcat = (bf16*)(wl + WO_CAT); bf16* Wup = (bf16*)(wl + WO_UP); bf16* Wb = (bf16*)(wl + WO_B); bf16* Wout = (bf16*)(wl + WO_OUT);
    const float* w_in = p.in[2] + (size_t)l * DM * DIN;
    const float* w_gate = p.in[15] + (size_t)l * 3 * DM * DM;
    const float* w_uq = p.in[5] + (size_t)l * 512 * 768;
    const float* w_ukv = p.in[6] + (size_t)l * 512 * 1024;
    const float* w_br = p.in[17] + (size_t)l * 3 * 512 * DM;
    const float* w_out = p.in[18] + (size_t)l * DM * DM;
    constexpr int I1 = 113 * 32, I2 = 3 * 64 * 32, I3 = 24 * 8, I4 = 32 * 8, I5 = 3 * 64 * 8, I6 = 64 * 32;
    constexpr int NIT = I1 + I2 + I3 + I4 + I5 + I6;
    for (int it = gw; it < NIT; it += ngw) {
        int r = it;
        if (r < I1) { const int cb = r / 32, kb = r % 32; const int n0 = cb * 32;
            const int sc = n0 < 1024 ? n0 : (n0 < 3584 ? n0 + 32 : n0 - 3584 + 1024);
            transpose_item(w_in, DIN, sc, kb * 64, DM, Wcat, n0, scr, lane); continue; } r -= I1;
        if (r < I2) { continue; } r -= I2;
        if (r < I3) { const int cb = r / 8, kb = r % 8;
            int sc, dr; if (cb < 16) { const int h = cb >> 1, hf = cb & 1; sc = h * 96 + 32 * hf; dr = h * 64 + 32 * hf; } else { const int h = cb - 16; sc = h * 96 + 64; dr = 512 + h * 32; }
            transpose_item(w_uq, 768, sc, kb * 64, 512, Wup, dr, scr, lane); continue; } r -= I3;
        if (r < I4) { const int cb = r / 8, kb = r % 8;
            const int v = cb >> 4, h = (cb & 15) >> 1, hf = cb & 1; const int sc = h * 128 + 64 * v + 32 * hf, dr = 768 + 512 * v + h * 64 + 32 * hf;
            transpose_item(w_ukv, 1024, sc, kb * 64, 512, Wup, dr, scr, lane); continue; } r -= I4;
        if (r < I5) { const int n = r / 512, q = r % 512, cb = q / 8, kb = q % 8;
            transpose_item(w_br + (size_t)n * 512 * DM, DM, cb * 32, kb * 64, 1536, Wb, cb * 32, scr, lane, n * 512 + kb * 64); continue; } r -= I5;
        { const int cb = r / 32, kb = r % 32; transpose_item(w_out, DM, cb * 32, kb * 64, DM, Wout, cb * 32, scr, lane); }
    }
    for (int i = gw * 64 + lane; i < 224 * 256; i += ngw * 64) { ((u32x4*)(Wcat + (size_t)DIN * DM))[i] = (u32x4){0u, 0u, 0u, 0u}; }
    bf16* sg = (bf16*)(wl + WO_SGU); const float* sw = p.in[13] + (size_t)l * 4 * 128 * 128;
    for (int i = gw * 64 + lane; i < 4 * 128 * 128; i += ngw * 64) { const int s = i & 127, t = (i >> 7) & 127; const bool ok = (s >> 6) <= (t >> 6); sg[i] = (bf16)f2bf(ok ? sw[i] : 0.f); }
}

__device__ __forceinline__ void prologue_rope(const Params& p, int gtid, int nthr) {
    float* tab = (float*)(p.ws + WS_ROPE);
    for (int i = gtid; i < SEQ * 24; i += nthr) {
        const int pos = i / 24, j = i % 24;
        const int jj = j < 8 ? 2 * j : j - 8;
        float invf;
        switch (jj) { case 0: invf = 1.000000000e+00f; break; case 1: invf = 4.403665960e-01f; break; case 2: invf = 1.939227432e-01f; break; case 3: invf = 8.539710194e-02f; break;
            case 4: invf = 3.760603070e-02f; break; case 5: invf = 1.656044088e-02f; break; case 6: invf = 7.292664610e-03f; break; case 7: invf = 3.211446106e-03f; break;
            case 8: invf = 1.414213562e-03f; break; case 9: invf = 6.227724371e-04f; break; case 10: invf = 2.742481884e-04f; break; case 11: invf = 1.207697351e-04f; break;
            case 12: invf = 5.318295734e-05f; break; case 13: invf = 2.341999971e-05f; break; case 14: invf = 1.031338525e-05f; break; default: invf = 4.541670478e-06f; break; }
        int co, so; if (j < 8) { co = j; so = 8 + j; } else { co = 16 + (j - 8); so = 32 + (j - 8); }
        const float ang = (float)pos * invf; float sn, cs; sincosf(ang, &sn, &cs);
        tab[pos * 48 + co] = cs; tab[pos * 48 + so] = sn;
    }
}

__device__ __forceinline__ void fold_item(const Params& p, int l, int item, float* lds, int tid) {
    const int hc = item >> 4, mt = item & 15, c = hc & 1, m0 = mt * 128;
    const float* Wq = p.in[20] + (size_t)l * DM * DM; const float* keys = p.in[21] + (size_t)l * 2 * 128 * 128 + (size_t)c * 128 * 128;
    bf16* WPQ = (bf16*)(p.ws + WS_W + (size_t)l * W_LAYER + WO_PQ);
    float* As = lds; float* Bs = lds + 128 * 68;
    const int tn = tid & 31, tm = tid >> 5;
    float acc[4][8];
#pragma unroll
    for (int i = 0; i < 4; ++i)
#pragma unroll
        for (int j = 0; j < 8; ++j) acc[i][j] = 0.f;
    for (int dh = 0; dh < 2; ++dh) {
        __syncthreads();
        for (int i = tid; i < 128 * 16; i += 512) { const int r = i >> 4, q = i & 15;
            *(f32x4*)(As + r * 68 + 4 * q) = *(const f32x4*)(Wq + (size_t)(m0 + r) * DM + hc * 128 + dh * 64 + 4 * q);
            *(f32x4*)(Bs + r * 68 + 4 * q) = *(const f32x4*)(keys + r * 128 + dh * 64 + 4 * q); }
        __syncthreads();
#pragma unroll 2
        for (int d = 0; d < 64; d += 4) {
            f32x4 b4[4], a4[8];
#pragma unroll
            for (int i = 0; i < 4; ++i) b4[i] = *(const f32x4*)(Bs + (tn + 32 * i) * 68 + d);
#pragma unroll
            for (int j = 0; j < 8; ++j) a4[j] = *(const f32x4*)(As + (8 * tm + j) * 68 + d);
#pragma unroll
            for (int i = 0; i < 4; ++i)
#pragma unroll
                for (int j = 0; j < 8; ++j) acc[i][j] += (b4[i].x * a4[j].x + b4[i].y * a4[j].y) + (b4[i].z * a4[j].z + b4[i].w * a4[j].w);
        }
    }
#pragma unroll
    for (int i = 0; i < 4; ++i) *(u32x4*)(WPQ + (size_t)(hc * 128 + tn + 32 * i) * DM + m0 + 8 * tm) = pack8(acc[i]);
}

__device__ __forceinline__ void rms_row_to_bf16(const float* xrow, const float* gain, bf16* orow, int lane, unsigned char* o8 = nullptr) {
    f32x4 v[8]; float s = 0.f;
#pragma unroll
    for (int j = 0; j < 8; ++j) { v[j] = ((const f32x4*)xrow)[lane + 64 * j]; s += (v[j].x * v[j].x + v[j].y * v[j].y) + (v[j].z * v[j].z + v[j].w * v[j].w); }
    const float rstd = rsqrtf(wave_sum(s) * (1.f / DM) + NORM_EPS);
#pragma unroll
    for (int j = 0; j < 8; ++j) { const f32x4 g = ((const f32x4*)gain)[lane + 64 * j];
        u32x2 o; o.x = pk2(v[j].x * rstd * g.x, v[j].y * rstd * g.y); o.y = pk2(v[j].z * rstd * g.z, v[j].w * rstd * g.w);
        ((u32x2*)orow)[lane + 64 * j] = o;
        if (o8) ((unsigned*)o8)[lane + 64 * j] = pk4_fp8(v[j].x * rstd * g.x, v[j].y * rstd * g.y, v[j].z * rstd * g.z, v[j].w * rstd * g.w); }
}

__device__ __forceinline__ void add_rms_row(const float* xin, const bf16* dl, float* xout, const float* gain, bf16* orow, int lane) {
    f32x4 v[8]; float s = 0.f;
#pragma unroll
    for (int j = 0; j < 8; ++j) { v[j] = ((const f32x4*)xin)[lane + 64 * j]; const u32x2 d = ((const u32x2*)dl)[lane + 64 * j];
        v[j].x += bflo(d.x); v[j].y += bfhi(d.x); v[j].z += bflo(d.y); v[j].w += bfhi(d.y);
        if (xout) ((f32x4*)xout)[lane + 64 * j] = v[j];
        s += (v[j].x * v[j].x + v[j].y * v[j].y) + (v[j].z * v[j].z + v[j].w * v[j].w); }
    const float rstd = rsqrtf(wave_sum(s) * (1.f / DM) + NORM_EPS);
#pragma unroll
    for (int j = 0; j < 8; ++j) { const f32x4 g = ((const f32x4*)gain)[lane + 64 * j];
        u32x2 o; o.x = pk2(v[j].x * rstd * g.x, v[j].y * rstd * g.y); o.y = pk2(v[j].z * rstd * g.z, v[j].w * rstd * g.w);
        ((u32x2*)orow)[lane + 64 * j] = o; }
}

__device__ __forceinline__ void prep1_row(const Params& p, int l, int t, int lane) {
    bf16* z = (bf16*)(p.ws + WS_Z) + (size_t)t * ZP;
    const float* rope = (const float*)(p.ws + WS_ROPE) + (size_t)(t & (SEQ - 1)) * 48;
    float f[8];
#pragma unroll
    for (int seg = 0; seg < 2; ++seg) {
        const float* g = (seg == 0 ? p.in[3] : p.in[4]) + (size_t)l * 512;
        u32x4* ptr = (u32x4*)(z + (seg == 0 ? ZC_CQ : ZC_CKV)) + lane;
        unpack8(*ptr, f); float s = 0.f;
#pragma unroll
        for (int i = 0; i < 8; ++i) s += f[i] * f[i];
        const float rstd = rsqrtf(wave_sum(s) * (1.f / 512.f) + NORM_EPS);
#pragma unroll
        for (int i = 0; i < 8; ++i) f[i] = f[i] * rstd * g[lane * 8 + i];
        *ptr = pack8(f);
    }
#pragma unroll
    for (int seg = 0; seg < 2; ++seg) {
        const float* g = p.in[9] + (size_t)l * 128 + seg * 64;
        u32x4* ptr = (u32x4*)(z + (seg == 0 ? ZC_DQ : ZC_DK)) + lane;
        unpack8(*ptr, f); float s = 0.f;
#pragma unroll
        for (int i = 0; i < 8; ++i) s += f[i] * f[i];
        s += __shfl_xor(s, 1); s += __shfl_xor(s, 2); s += __shfl_xor(s, 4);
        const float rstd = rsqrtf(s * (1.f / 64.f) + NORM_EPS);
        const int d0 = (lane & 7) * 8;
#pragma unroll
        for (int i = 0; i < 8; ++i) f[i] = f[i] * rstd * g[d0 + i];
        float o[8];
#pragma unroll
        for (int i = 0; i < 8; ++i) o[i] = __shfl_xor(f[i], 1);
        if ((lane & 7) == 0) {
#pragma unroll
            for (int i = 0; i < 8; ++i) f[i] = f[i] * rope[i] - o[i] * rope[8 + i];
        } else if ((lane & 7) == 1) {
#pragma unroll
            for (int i = 0; i < 8; ++i) f[i] = f[i] * rope[i] + o[i] * rope[8 + i];
        }
        if (seg == 0) {
#pragma unroll
            for (int i = 0; i < 8; ++i) f[i] *= 0.125f * LOG2E;
        }
        *ptr = pack8(f);
    }
    {
        u32x4* ptr = (u32x4*)(z + ZC_SU) + lane;
        unpack8(*ptr, f);
#pragma unroll
        for (int i = 0; i < 8; ++i) f[i] = gelu_tanh(f[i]);
        *ptr = pack8(f);
    }
    {
        const float* g = p.in[12] + (size_t)l * 512;
        u32x4* ptr = (u32x4*)(z + ZC_SV) + lane;
        unpack8(*ptr, f); float s = 0.f;
#pragma unroll
        for (int i = 0; i < 8; ++i) { f[i] = gelu_tanh(f[i]); s += f[i] * f[i]; }
        const float rstd = rsqrtf(wave_sum(s) * (1.f / 512.f) + NORM_EPS);
#pragma unroll
        for (int i = 0; i < 8; ++i) f[i] = f[i] * rstd * g[lane * 8 + i];
        *ptr = pack8(f);
    }
    {
        const float* g = p.in[8] + (size_t)l * 64 + 32;
        const int ll = lane & 3;
        const u32x4 w = *((const u32x4*)(z + ZC_KR) + ll);
        unpack8(w, f); float s = 0.f;
#pragma unroll
        for (int i = 0; i < 8; ++i) s += f[i] * f[i];
        s += __shfl_xor(s, 1); s += __shfl_xor(s, 2);
        const float rstd = rsqrtf(s * (1.f / 32.f) + NORM_EPS);
#pragma unroll
        for (int i = 0; i < 8; ++i) f[i] = f[i] * rstd * g[ll * 8 + i];
        float o[8];
#pragma unroll
        for (int i = 0; i < 8; ++i) o[i] = __shfl_xor(f[i], 2);
        const int fi = (ll & 1) * 8;
        if (ll < 2) {
#pragma unroll
            for (int i = 0; i < 8; ++i) f[i] = f[i] * rope[16 + fi + i] - o[i] * rope[32 + fi + i];
        } else {
#pragma unroll
            for (int i = 0; i < 8; ++i) f[i] = f[i] * rope[16 + fi + i] + o[i] * rope[32 + fi + i];
        }
        if (lane < 32) { bf16* km = (bf16*)(p.ws + WS_KM) + (size_t)t * 768 + (lane >> 2) * 96 + 64 + ll * 8; *(u32x4*)km = pack8(f); }
    }
}

__device__ __forceinline__ void prep2_row(const Params& p, int l, int t, int lane) {
    const bf16* qr = (const bf16*)(p.ws + WS_QR) + (size_t)t * 768;
    const bf16* kvr = (const bf16*)(p.ws + WS_KVR) + (size_t)t * 1024;
    bf16* qm = (bf16*)(p.ws + WS_QM) + (size_t)t * 768;
    bf16* km = (bf16*)(p.ws + WS_KM) + (size_t)t * 768;
    const float* rope = (const float*)(p.ws + WS_ROPE) + (size_t)(t & (SEQ - 1)) * 48;
    const float* ng = p.in[7] + (size_t)l * 128;
    const float* rg = p.in[8] + (size_t)l * 64;
    const float qscale = 0.10206207261596577f * LOG2E;
    float f[8];
    const int h = lane >> 3, d0 = (lane & 7) * 8;
    {
        unpack8(*((const u32x4*)qr + lane), f); float s = 0.f;
#pragma unroll
        for (int i = 0; i < 8; ++i) s += f[i] * f[i];
        s += __shfl_xor(s, 1); s += __shfl_xor(s, 2); s += __shfl_xor(s, 4);
        const float rstd = rsqrtf(s * (1.f / 64.f) + NORM_EPS) * qscale;
#pragma unroll
        for (int i = 0; i < 8; ++i) f[i] = f[i] * rstd * ng[d0 + i];
        *(u32x4*)(qm + h * 96 + d0) = pack8(f);
    }
    {
        unpack8(*((const u32x4*)kvr + lane), f); float s = 0.f;
#pragma unroll
        for (int i = 0; i < 8; ++i) s += f[i] * f[i];
        s += __shfl_xor(s, 1); s += __shfl_xor(s, 2); s += __shfl_xor(s, 4);
        const float rstd = rsqrtf(s * (1.f / 64.f) + NORM_EPS);
#pragma unroll
        for (int i = 0; i < 8; ++i) f[i] = f[i] * rstd * ng[64 + d0 + i];
        *(u32x4*)(km + h * 96 + d0) = pack8(f);
    }
    {
        const int l5 = lane & 31, hh = l5 >> 2, ll = l5 & 3;
        unpack8(*((const u32x4*)(qr + 512) + l5), f); float s = 0.f;
#pragma unroll
        for (int i = 0; i < 8; ++i) s += f[i] * f[i];
        s += __shfl_xor(s, 1); s += __shfl_xor(s, 2);
        const float rstd = rsqrtf(s * (1.f / 32.f) + NORM_EPS);
#pragma unroll
        for (int i = 0; i < 8; ++i) f[i] = f[i] * rstd * rg[ll * 8 + i];
        float o[8];
#pragma unroll
        for (int i = 0; i < 8; ++i) o[i] = __shfl_xor(f[i], 2);
        const int fi = (ll & 1) * 8;
        if (ll < 2) {
#pragma unroll
            for (int i = 0; i < 8; ++i) f[i] = (f[i] * rope[16 + fi + i] - o[i] * rope[32 + fi + i]) * qscale;
        } else {
#pragma unroll
            for (int i = 0; i < 8; ++i) f[i] = (f[i] * rope[16 + fi + i] + o[i] * rope[32 + fi + i]) * qscale;
        }
        if (lane < 32) *(u32x4*)(qm + hh * 96 + 64 + ll * 8) = pack8(f);
    }
}

__device__ __forceinline__ float diff_lambda(const Params& p, int l, int lane) {
    const float* lv = p.in[10] + (size_t)l * 256;
    const float a = wave_sum(lv[lane] * lv[64 + lane]), b = wave_sum(lv[128 + lane] * lv[192 + lane]);
    const float lambda_init = 0.8f - 0.6f * expf(-0.3f * (float)l);
    return expf(a) - expf(b) + lambda_init;
}

typedef float f32x2 __attribute__((ext_vector_type(2)));
typedef _Float16 f16x32 __attribute__((ext_vector_type(32)));
typedef float f32x32 __attribute__((ext_vector_type(32)));
typedef unsigned u32x6 __attribute__((ext_vector_type(6)));
__device__ __forceinline__ void q4_row(const float* __restrict__ src, unsigned char* __restrict__ dst, float* scl, int lane) {
    f32x4 v[8]; float ss = 0.f;
#pragma unroll
    for (int j = 0; j < 8; ++j) { v[j] = ((const f32x4*)(src + 32 * lane))[j]; ss += (v[j].x * v[j].x + v[j].y * v[j].y) + (v[j].z * v[j].z + v[j].w * v[j].w); }
    const float sc = fmaxf(0.5f * sqrtf(wave_sum(ss) * (1.f / DM)), 1e-30f), is = 1.f / sc;
    u32x4 w;
#pragma unroll
    for (int d = 0; d < 4; ++d) { unsigned x = 0;
        const f32x4 a = v[2 * d], b = v[2 * d + 1];
        x = __builtin_amdgcn_cvt_scalef32_pk_fp4_f32(x, fminf(fmaxf(a.x * is, -6.f), 6.f), fminf(fmaxf(a.y * is, -6.f), 6.f), 1.0f, 0);
        x = __builtin_amdgcn_cvt_scalef32_pk_fp4_f32(x, fminf(fmaxf(a.z * is, -6.f), 6.f), fminf(fmaxf(a.w * is, -6.f), 6.f), 1.0f, 1);
        x = __builtin_amdgcn_cvt_scalef32_pk_fp4_f32(x, fminf(fmaxf(b.x * is, -6.f), 6.f), fminf(fmaxf(b.y * is, -6.f), 6.f), 1.0f, 2);
        x = __builtin_amdgcn_cvt_scalef32_pk_fp4_f32(x, fminf(fmaxf(b.z * is, -6.f), 6.f), fminf(fmaxf(b.w * is, -6.f), 6.f), 1.0f, 3);
        w[d] = x; }
    *(u32x4*)(dst + 16 * lane) = w;
    if (lane == 0) *scl = sc;
}
__device__ __forceinline__ void q4u_row(const float* __restrict__ src, unsigned char* __restrict__ dst, float* scl, int lane) {
    f32x4 v[8]; float ss = 0.f;
#pragma unroll
    for (int j = 0; j < 8; ++j) { v[j] = ((const f32x4*)(src + 32 * lane))[j]; ss += (v[j].x * v[j].x + v[j].y * v[j].y) + (v[j].z * v[j].z + v[j].w * v[j].w); }
    const float step = fmaxf(0.35f * sqrtf(wave_sum(ss) * (1.f / DM)), 1e-30f), is = 1.f / step;
    u32x4 w;
#pragma unroll
    for (int d = 0; d < 4; ++d) { unsigned x = 0;
#pragma unroll
        for (int e = 0; e < 8; ++e) { const float f = v[2 * d + (e >> 2)][e & 3]; const int q = (int)fminf(fmaxf(rintf(f * is), -8.f), 7.f) + 8; x |= (unsigned)q << (4 * e); }
        w[d] = x; }
    *(u32x4*)(dst + 16 * lane) = w;
    if (lane == 0) *scl = step;
}
__device__ __forceinline__ int f2key(float f) { const int b = __builtin_bit_cast(int, f); return b ^ ((b >> 31) & 0x7fffffff); }
__device__ __forceinline__ float key2f(int k) { const int b = k ^ ((k >> 31) & 0x7fffffff); return __builtin_bit_cast(float, b & ~127); }
__device__ __forceinline__ void topk_lane(const float* __restrict__ sc, int* __restrict__ idxo, float* __restrict__ gwo) {
    float av[2][16]; int ai[2][16];
#pragma unroll
    for (int c = 0; c < 2; ++c) {
        int lst[16];
#pragma unroll
        for (int j = 0; j < 16; ++j) lst[j] = (int)0x80000000;
#pragma unroll 1
        for (int i0 = 0; i0 < 128; i0 += 32) {
            f32x4 v[8];
#pragma unroll
            for (int q = 0; q < 8; ++q) v[q] = *(const f32x4*)(sc + c * 128 + i0 + 4 * q);
#pragma unroll
            for (int q = 0; q < 8; ++q)
#pragma unroll
                for (int e = 0; e < 4; ++e) { int key = (f2key(v[q][e]) & ~127) | (127 - (i0 + 4 * q + e));
#pragma unroll
                    for (int j = 0; j < 16; ++j) { const int hi = max(lst[j], key); key = min(lst[j], key); lst[j] = hi; } }
        }
#pragma unroll
        for (int j = 0; j < 16; ++j) { av[c][j] = key2f(lst[j]); ai[c][j] = 127 - (lst[j] & 127); }
    }
    float lv[16]; int lp[16];
#pragma unroll
    for (int j = 0; j < 16; ++j) { lv[j] = -INFINITY; lp[j] = 0; }
#pragma unroll
    for (int i = 0; i < 16; ++i)
#pragma unroll
        for (int jj = 0; jj < 16; ++jj) if ((i + 1) * (jj + 1) <= 16) {
            float sv = av[0][i] + av[1][jj]; int pay = ai[0][i] * 128 + ai[1][jj];
#pragma unroll
            for (int j = 0; j < 16; ++j) { const bool gt = sv > lv[j]; const float nv = gt ? sv : lv[j]; const int np = gt ? pay : lp[j]; sv = gt ? lv[j] : sv; pay = gt ? lp[j] : pay; lv[j] = nv; lp[j] = np; }
        }
    float sum = 0.f; const float mx = lv[0];
#pragma unroll
    for (int j = 0; j < 16; ++j) { lv[j] = __expf(lv[j] - mx); sum += lv[j]; }
    const float inv = 1.f / sum;
#pragma unroll
    for (int q = 0; q < 4; ++q) { *(u32x4*)(idxo + 4 * q) = (u32x4){(unsigned)lp[4 * q], (unsigned)lp[4 * q + 1], (unsigned)lp[4 * q + 2], (unsigned)lp[4 * q + 3]};
        *(f32x4*)(gwo + 4 * q) = (f32x4){lv[4 * q] * inv, lv[4 * q + 1] * inv, lv[4 * q + 2] * inv, lv[4 * q + 3] * inv}; }
}
__device__ __forceinline__ float dot_f4(const u32x4 a, const f32x2 (&h)[16]) {
    f32x2 s = {0.f, 0.f};
#pragma unroll
    for (int w = 0; w < 4; ++w) {
        s = __builtin_elementwise_fma(__builtin_amdgcn_cvt_scalef32_pk_f32_fp4(a[w], 1.0f, 0), h[4 * w], s); s = __builtin_elementwise_fma(__builtin_amdgcn_cvt_scalef32_pk_f32_fp4(a[w], 1.0f, 1), h[4 * w + 1], s);
        s = __builtin_elementwise_fma(__builtin_amdgcn_cvt_scalef32_pk_f32_fp4(a[w], 1.0f, 2), h[4 * w + 2], s); s = __builtin_elementwise_fma(__builtin_amdgcn_cvt_scalef32_pk_f32_fp4(a[w], 1.0f, 3), h[4 * w + 3], s); }
    return s.x + s.y;
}
__device__ __forceinline__ float dot_u4(const u32x4 a, const int (&he)[4], const int (&ho)[4]) {
    int acc = 0;
#pragma unroll
    for (int w = 0; w < 4; ++w) { acc = __builtin_amdgcn_sdot4((int)(a[w] & 0x0F0F0F0Fu), he[w], acc, false); acc = __builtin_amdgcn_sdot4((int)((a[w] >> 4) & 0x0F0F0F0Fu), ho[w], acc, false); }
    return (float)acc;
}
__device__ __forceinline__ void axpy_f4(const u32x4 a, float c, f32x2 (&o)[16]) {
    const f32x2 c2 = {c, c};
#pragma unroll
    for (int w = 0; w < 4; ++w) {
        o[4 * w] = __builtin_elementwise_fma(c2, __builtin_amdgcn_cvt_scalef32_pk_f32_fp4(a[w], 1.0f, 0), o[4 * w]); o[4 * w + 1] = __builtin_elementwise_fma(c2, __builtin_amdgcn_cvt_scalef32_pk_f32_fp4(a[w], 1.0f, 1), o[4 * w + 1]);
        o[4 * w + 2] = __builtin_elementwise_fma(c2, __builtin_amdgcn_cvt_scalef32_pk_f32_fp4(a[w], 1.0f, 2), o[4 * w + 2]); o[4 * w + 3] = __builtin_elementwise_fma(c2, __builtin_amdgcn_cvt_scalef32_pk_f32_fp4(a[w], 1.0f, 3), o[4 * w + 3]); }
}
template <int M, int N, int NP> __device__ __forceinline__ void rs_step_(float (&pr)[NP], int lane) {
    const bool up = (lane & M) != 0;
#pragma unroll
    for (int i = 0; i < N / 2; ++i) { const float keep = up ? pr[i + N / 2] : pr[i], send = up ? pr[i] : pr[i + N / 2]; pr[i] = keep + __shfl_xor(send, M); }
}
template <bool CHEAP = false> __device__ __forceinline__ void peer_wave(const Params& p, int l, int gw, int ngw, int lane, const float* gain_next, const float* xin, float* xout) {
    const __amdgpu_buffer_rsrc_t RU = __builtin_amdgcn_make_buffer_rsrc((void*)(p.ws + WS_U8 + (size_t)l * NEXP * QROW), 0, NEXP * QROW, 0x00020000);
    const __amdgpu_buffer_rsrc_t RV = __builtin_amdgcn_make_buffer_rsrc((void*)(p.ws + WS_V8 + (size_t)l * NEXP * QROW), 0, NEXP * QROW, 0x00020000);
    const float* PSU = (const float*)(p.ws + WS_PS) + (size_t)l * NEXP; const float* PSV = PSU + (size_t)DEPTH * NEXP;
    const int* IDX0 = (const int*)(p.ws + WS_IDX); const float* GW0 = (const float*)(p.ws + WS_GW);
    const int loff = 16 * lane, l15 = lane & 15;
    const int nsteps = gw < T ? ((T - gw + ngw - 1) / ngw) * 8 : 0;
    if (nsteps == 0) return;
    f32x2 o[16];
#pragma unroll
    for (int i = 0; i < 16; ++i) o[i] = (f32x2){0.f, 0.f};
    int he[4] = {0, 0, 0, 0}, ho[4] = {0, 0, 0, 0}; float hscale = 0.f, h8sum = 0.f;
    u32x4 bufA[8], bufB[8];
    int ig = IDX0[(size_t)gw * 128 + l15]; float gwv = GW0[(size_t)gw * 128 + l15];
    float su = PSU[ig], sv = PSV[ig];
#define PEER_ISSUE(dst, R, idxv, r0) do { _Pragma("unroll") for (int j = 0; j < 8; ++j) dst[j] = __builtin_amdgcn_raw_buffer_load_b128(R, loff, __builtin_amdgcn_readlane(idxv, (r0) + j) * QROW, 0); } while (0)
    PEER_ISSUE(bufA, RU, ig, 0);
#pragma unroll 1
    for (int s_ = 0; s_ < nsteps; ++s_) {
        const int t = gw + (s_ >> 3) * ngw, g = s_ & 7;
        const bool hasn = s_ + 1 < nsteps; const int sn = hasn ? s_ + 1 : s_; const int tn = gw + (sn >> 3) * ngw, gn = sn & 7;
        const int ign = IDX0[(size_t)tn * 128 + gn * 16 + l15]; const float gwn = GW0[(size_t)tn * 128 + gn * 16 + l15];
        bf16* hb = (bf16*)(p.ws + WS_HB) + (size_t)t * DM;
        if (g == 0) {
            float hf[32]; float mx = 0.f;
#pragma unroll
            for (int q = 0; q < 4; ++q) { const u32x4 w = *(const u32x4*)(hb + 32 * lane + 8 * q);
                hf[8 * q] = bflo(w.x); hf[8 * q + 1] = bfhi(w.x); hf[8 * q + 2] = bflo(w.y); hf[8 * q + 3] = bfhi(w.y); hf[8 * q + 4] = bflo(w.z); hf[8 * q + 5] = bfhi(w.z); hf[8 * q + 6] = bflo(w.w); hf[8 * q + 7] = bfhi(w.w); }
#pragma unroll
            for (int i = 0; i < 32; ++i) mx = fmaxf(mx, fabsf(hf[i]));
#pragma unroll
            for (int of = 1; of < 64; of <<= 1) mx = fmaxf(mx, __shfl_xor(mx, of));
            hscale = fmaxf(mx, 1e-30f) * (1.f / 127.f); const float ih = 1.f / hscale; int isum = 0;
#pragma unroll
            for (int w = 0; w < 4; ++w) { unsigned e = 0, od = 0;
#pragma unroll
                for (int j = 0; j < 4; ++j) { const int qe = (int)rintf(hf[8 * w + 2 * j] * ih), qo = (int)rintf(hf[8 * w + 2 * j + 1] * ih); isum += qe + qo; e |= (unsigned)(qe & 255) << (8 * j); od |= (unsigned)(qo & 255) << (8 * j); }
                he[w] = (int)e; ho[w] = (int)od; }
            h8sum = wave_sum((float)isum);
        }
        float pr[16];
        PEER_ISSUE(bufB, RU, ig, 8);
        __builtin_amdgcn_sched_barrier(0);
#pragma unroll
        for (int j = 0; j < 8; ++j) { if (CHEAP) { const u32x4 q_ = bufA[j]; pr[j] = __builtin_bit_cast(float, (q_.x ^ q_.y) + (q_.z ^ q_.w)); } else pr[j] = dot_u4(bufA[j], he, ho); __builtin_amdgcn_sched_barrier(0); }
        PEER_ISSUE(bufA, RV, ig, 0);
        __builtin_amdgcn_sched_barrier(0);
#pragma unroll
        for (int j = 0; j < 8; ++j) { if (CHEAP) { const u32x4 q_ = bufB[j]; pr[8 + j] = __builtin_bit_cast(float, (q_.x ^ q_.y) + (q_.z ^ q_.w)); } else pr[8 + j] = dot_u4(bufB[j], he, ho); __builtin_amdgcn_sched_barrier(0); }
        rs_step_<8, 16, 16>(pr, lane); rs_step_<4, 8, 16>(pr, lane); rs_step_<2, 4, 16>(pr, lane); rs_step_<1, 2, 16>(pr, lane);
        float tot = pr[0]; tot += __shfl_xor(tot, 16); tot += __shfl_xor(tot, 32);
        const float a = (tot - 8.f * h8sum) * su * hscale;
        const float coef = gwv * gelu_tanh(a) * sv; const int coefi = __builtin_bit_cast(int, coef);
        PEER_ISSUE(bufB, RV, ig, 8);
        __builtin_amdgcn_sched_barrier(0);
#pragma unroll
        for (int j = 0; j < 8; ++j) { if (CHEAP) { const u32x4 q_ = bufA[j]; o[j].x += __builtin_bit_cast(float, (q_.x ^ q_.y) + (q_.z ^ q_.w)); } else axpy_f4(bufA[j], __builtin_bit_cast(float, __builtin_amdgcn_readlane(coefi, j)), o); __builtin_amdgcn_sched_barrier(0); }
        const float sun = PSU[ign], svn = PSV[ign];
        PEER_ISSUE(bufA, RU, ign, 0);
        __builtin_amdgcn_sched_barrier(0);
#pragma unroll
        for (int j = 0; j < 8; ++j) { if (CHEAP) { const u32x4 q_ = bufB[j]; o[8 + j].x += __builtin_bit_cast(float, (q_.x ^ q_.y) + (q_.z ^ q_.w)); } else axpy_f4(bufB[j], __builtin_bit_cast(float, __builtin_amdgcn_readlane(coefi, 8 + j)), o); __builtin_amdgcn_sched_barrier(0); }
        if (g == 7) {
            const float* xr = xin + (size_t)t * DM + 32 * lane; float* xw = xout + (size_t)t * DM + 32 * lane; const bf16* dr = (const bf16*)(p.ws + WS_QR) + (size_t)t * DM + 32 * lane; float ss = 0.f;
#pragma unroll
            for (int q = 0; q < 8; ++q) { f32x4 x = *(const f32x4*)(xr + 4 * q); u32x2 d = {0u, 0u}; if (RESID_IN_PEER) d = *(const u32x2*)(dr + 4 * q);
                x.x += bflo(d.x) + o[2 * q].x; x.y += bfhi(d.x) + o[2 * q].y; x.z += bflo(d.y) + o[2 * q + 1].x; x.w += bfhi(d.y) + o[2 * q + 1].y; *(f32x4*)(xw + 4 * q) = x;
                o[2 * q] = (f32x2){x.x, x.y}; o[2 * q + 1] = (f32x2){x.z, x.w}; ss += (x.x * x.x + x.y * x.y) + (x.z * x.z + x.w * x.w); }
            if (gain_next) {
                const float rstd = rsqrtf(wave_sum(ss) * (1.f / DM) + NORM_EPS);
#pragma unroll
                for (int q = 0; q < 4; ++q) { const int e0 = 32 * lane + 8 * q; const f32x4 g0 = *(const f32x4*)(gain_next + e0), g1 = *(const f32x4*)(gain_next + e0 + 4);
                    u32x4 w; w.x = pk2(o[4 * q].x * rstd * g0.x, o[4 * q].y * rstd * g0.y); w.y = pk2(o[4 * q + 1].x * rstd * g0.z, o[4 * q + 1].y * rstd * g0.w);
                    w.z = pk2(o[4 * q + 2].x * rstd * g1.x, o[4 * q + 2].y * rstd * g1.y); w.w = pk2(o[4 * q + 3].x * rstd * g1.z, o[4 * q + 3].y * rstd * g1.w);
                    *(u32x4*)(hb + e0) = w;
                    u32x2 w8; w8.x = pk4_fp8(o[4 * q].x * rstd * g0.x, o[4 * q].y * rstd * g0.y, o[4 * q + 1].x * rstd * g0.z, o[4 * q + 1].y * rstd * g0.w);
                    w8.y = pk4_fp8(o[4 * q + 2].x * rstd * g1.x, o[4 * q + 2].y * rstd * g1.y, o[4 * q + 3].x * rstd * g1.z, o[4 * q + 3].y * rstd * g1.w);
                    *(u32x2*)(p.ws + WS_HB8 + (size_t)t * DM + e0) = w8; }
            }
#pragma unroll
            for (int i = 0; i < 16; ++i) o[i] = (f32x2){0.f, 0.f};
        }
        ig = ign; gwv = gwn; su = sun; sv = svn;
    }
#undef PEER_ISSUE
}

namespace pg8 {
#define PG8_LAS __attribute__((address_space(3)))
typedef int v4i32 __attribute__((ext_vector_type(4)));
typedef int v8i32 __attribute__((ext_vector_type(8)));
constexpr int BM = 256, BK = 64, HALF = 128, HTB = HALF * BK * 2, STAGE_BYTES = 8 * HTB, NXCD = 8, WGM = 8;
__host__ __device__ __forceinline__ int lds_byte(int r, int c) { const int st = (r >> 4) * 2 + (c >> 5), rr = r & 15, cc = c & 31, ob = rr * 64 + cc * 2; return st * 1024 + (ob ^ (((ob >> 9) & 1) << 5)); }
__host__ __device__ __forceinline__ void stage_rc(int b, int& R, int& C) { const int st = b / 1024, sb = b % 1024, swz = sb ^ (((sb >> 9) & 1) << 5); R = (st >> 1) * 16 + swz / 64; C = (st & 1) * 32 + (swz % 64) / 2; }
__host__ __device__ __forceinline__ int perm32(int rho) { const int n = rho >> 4, i = rho & 15; return 8 * (i >> 2) + 4 * n + (i & 3); }
struct Unit { int pm, pn; };
struct StaticOrder {
    int nM, nN, nwg, G, c;
    __host__ __device__ void init(int M, int N, int G_, int c_) { nM = M / BM; nN = N / BM; nwg = nM * nN; G = G_; c = c_; }
    __host__ __device__ bool next(int i, Unit& u) const {
        const long L = (long)i * G + c; if (L >= nwg) return false;
        int wgid = (int)L; { const int q = nwg / NXCD, r = nwg % NXCD, xcd = wgid % NXCD, off = wgid / NXCD; wgid = (xcd < r ? xcd * (q + 1) : r * (q + 1) + (xcd - r) * q) + off; }
        const int nig = WGM * nN, gid = wgid / nig, fm = gid * WGM, gsz = (nM - fm) < WGM ? (nM - fm) : WGM;
        u.pm = fm + ((wgid % nig) % gsz); u.pn = (wgid % nig) / gsz; return true;
    }
};
struct MergedOrder {
    StaticOrder base;
    __host__ __device__ bool next(int i, Unit& u) const { const int tile = i / 3, n = i - 3 * tile; Unit b; if (!base.next(tile, b)) return false; u.pm = n * 64 + b.pm; u.pn = n * 8 + b.pn; return true; }
};
struct ZGOrder {
    StaticOrder sz, sg;
    __host__ __device__ void init(int G, int c) { sz.init(T, ZP, G, c); sg.init(T, DM, G, c); }
    __host__ __device__ bool next(int i, Unit& u) const {
        const int nzu = sz.c < sz.nwg ? (sz.nwg - sz.c + sz.G - 1) / sz.G : 0;
        if (i < nzu) return sz.next(i, u);
        const int j = i - nzu, tile = j / 3, n = j - 3 * tile; Unit b; if (!sg.next(tile, b)) return false; u.pm = b.pm; u.pn = 15 + 8 * n + b.pn; return true; }
};
struct ProbGen { const bf16* A; const bf16* Bt; int lda, ldb, K;
    __device__ __forceinline__ const char* Aptr(const Unit& u) const { return (const char*)(A + (size_t)u.pm * BM * lda); }
    __device__ __forceinline__ const char* Bptr(const Unit& u) const { return (const char*)(Bt + (size_t)u.pn * BM * ldb); } };
struct ProbUp { const bf16* Z; const bf16* Wup; int lda, ldb, K;
    __device__ __forceinline__ const char* Aptr(const Unit& u) const { return (const char*)(Z + (size_t)u.pm * BM * ZP + (u.pn < 3 ? ZC_CQ : ZC_CKV)); }
    __device__ __forceinline__ const char* Bptr(const Unit& u) const { return (const char*)(Wup + (size_t)u.pn * BM * 512); } };

__device__ __forceinline__ unsigned cvt_pk_bf16(float lo, float hi) { unsigned r; asm volatile("v_cvt_pk_bf16_f32 %0, %1, %2" : "=v"(r) : "v"(lo), "v"(hi)); return r; }
struct EpiZG { static constexpr bool PERM = true; static constexpr bool HOOK = false; bf16* Z; bf16* G; const float* bg; int noratio;
    __device__ __forceinline__ void operator()(const f32x4 (&acc)[2][2][4][2], const Unit& u, int wr, int wc, int fr, int fq) const {
        const int row0 = u.pm * BM + wr * 64 + fr; const bool gate = u.pn >= 15;
        const int gi = u.pn - 15, n0_ = gi >> 3; const int n = n0_;  const bool rat = n0_ > 0 && !noratio;
        bf16* base = gate ? G + n * DM : Z; const int ld = gate ? NGATE : ZP; const int colt = gate ? (gi & 7) * BM : u.pn * BM; const int col0 = colt + wc * 32 + 8 * fq;
        f32x4 bv[2][2];
#pragma unroll
        for (int bj = 0; bj < 2; ++bj)
#pragma unroll
            for (int nn = 0; nn < 2; ++nn) bv[bj][nn] = gate ? *(const f32x4*)(bg + n * DM + col0 + bj * HALF + 4 * nn) : (f32x4){0.f, 0.f, 0.f, 0.f};
#pragma unroll
        for (int ai = 0; ai < 2; ++ai) {
            u32x4 pw[4][2];
            if (gate && rat) {
#pragma unroll
                for (int m = 0; m < 4; ++m)
#pragma unroll
                    for (int bj = 0; bj < 2; ++bj) pw[m][bj] = *(const u32x4*)(base + (size_t)(row0 + ai * HALF + m * 16) * ld + col0 + bj * HALF - DM);
                __builtin_amdgcn_sched_barrier(0);
            }
#pragma unroll
            for (int m = 0; m < 4; ++m) { bf16* rowp = base + (size_t)(row0 + ai * HALF + m * 16) * ld + col0;
#pragma unroll
                for (int bj = 0; bj < 2; ++bj) { f32x4 v0 = acc[ai][bj][m][0] + bv[bj][0], v1 = acc[ai][bj][m][1] + bv[bj][1];
                    if (gate) {
#pragma unroll
                        for (int j = 0; j < 4; ++j) { v0[j] = fmaxf(__builtin_amdgcn_rcpf(1.f + __builtin_amdgcn_exp2f(-LOG2E * v0[j])), 1e-6f); v1[j] = fmaxf(__builtin_amdgcn_rcpf(1.f + __builtin_amdgcn_exp2f(-LOG2E * v1[j])), 1e-6f); }
                        if (rat) { const u32x4 q = pw[m][bj];
                            const float p8[8] = {bflo(q.x), bfhi(q.x), bflo(q.y), bfhi(q.y), bflo(q.z), bfhi(q.z), bflo(q.w), bfhi(q.w)};
                            u32x4 rw; rw.x = cvt_pk_bf16(p8[0] * __builtin_amdgcn_rcpf(v0[0]), p8[1] * __builtin_amdgcn_rcpf(v0[1])); rw.y = cvt_pk_bf16(p8[2] * __builtin_amdgcn_rcpf(v0[2]), p8[3] * __builtin_amdgcn_rcpf(v0[3]));
                            rw.z = cvt_pk_bf16(p8[4] * __builtin_amdgcn_rcpf(v1[0]), p8[5] * __builtin_amdgcn_rcpf(v1[1])); rw.w = cvt_pk_bf16(p8[6] * __builtin_amdgcn_rcpf(v1[2]), p8[7] * __builtin_amdgcn_rcpf(v1[3]));
                            *(u32x4*)(rowp + bj * HALF - DM) = rw; } }
                    u32x4 w; w.x = cvt_pk_bf16(v0[0], v0[1]); w.y = cvt_pk_bf16(v0[2], v0[3]); w.z = cvt_pk_bf16(v1[0], v1[1]); w.w = cvt_pk_bf16(v1[2], v1[3]);
                    *(u32x4*)(rowp + bj * HALF) = w; } }
        }
    } };
struct EpiG8 { static constexpr bool PERM = true; static constexpr bool HOOK = false; bf16* G; const float* bg; const unsigned* gmax;
    __device__ __forceinline__ void operator()(const f32x4 (&acc)[2][2][4][2], const Unit& u, int wr, int wc, int fr, int fq) const {
        const int row0 = u.pm * BM + wr * 64 + fr, col0 = u.pn * BM + wc * 32 + 8 * fq; const int n = u.pn >> 3; const float is = 1.f / gate_scale(gmax + 64 * n);
        f32x4 bv[2][2];
#pragma unroll
        for (int bj = 0; bj < 2; ++bj)
#pragma unroll
            for (int nn = 0; nn < 2; ++nn) bv[bj][nn] = *(const f32x4*)(bg + col0 + bj * HALF + 4 * nn);
#pragma unroll
        for (int ai = 0; ai < 2; ++ai)
#pragma unroll
            for (int m = 0; m < 4; ++m) { bf16* rowp = G + (size_t)(row0 + ai * HALF + m * 16) * NGATE + col0;
#pragma unroll
                for (int bj = 0; bj < 2; ++bj) { f32x4 v0 = acc[ai][bj][m][0] * is + bv[bj][0], v1 = acc[ai][bj][m][1] * is + bv[bj][1];
#pragma unroll
                    for (int j = 0; j < 4; ++j) { v0[j] = fmaxf(__builtin_amdgcn_rcpf(1.f + __builtin_amdgcn_exp2f(-LOG2E * v0[j])), 1e-6f); v1[j] = fmaxf(__builtin_amdgcn_rcpf(1.f + __builtin_amdgcn_exp2f(-LOG2E * v1[j])), 1e-6f); }
                    u32x4 w; w.x = cvt_pk_bf16(v0[0], v0[1]); w.y = cvt_pk_bf16(v0[2], v0[3]); w.z = cvt_pk_bf16(v1[0], v1[1]); w.w = cvt_pk_bf16(v1[2], v1[3]);
                    *(u32x4*)(rowp + bj * HALF) = w; } }
    } };
struct EpiUp { static constexpr bool HOOK = false; static constexpr bool PERM = true; bf16* QR; bf16* KVR;
    __device__ __forceinline__ void operator()(const f32x4 (&acc)[2][2][4][2], const Unit& u, int wr, int wc, int fr, int fq) const {
        const int row0 = u.pm * BM + wr * 64 + fr; const bool kv = u.pn >= 3;
        bf16* base = kv ? KVR : QR; const int ld = kv ? 1024 : 768; const int col0 = (kv ? (u.pn - 3) : u.pn) * BM + wc * 32 + 8 * fq;
#pragma unroll
        for (int ai = 0; ai < 2; ++ai)
#pragma unroll
            for (int m = 0; m < 4; ++m) { bf16* rowp = base + (size_t)(row0 + ai * HALF + m * 16) * ld + col0;
#pragma unroll
                for (int bj = 0; bj < 2; ++bj) { const f32x4 v0 = acc[ai][bj][m][0], v1 = acc[ai][bj][m][1];
                    u32x4 w; w.x = cvt_pk_bf16(v0[0], v0[1]); w.y = cvt_pk_bf16(v0[2], v0[3]); w.z = cvt_pk_bf16(v1[0], v1[1]); w.w = cvt_pk_bf16(v1[2], v1[3]);
                    *(u32x4*)(rowp + bj * HALF) = w; } }
    } };
struct EpiMG { static constexpr bool PERM = true; static constexpr bool HOOK = true; bf16* MG; const bf16* R; int nohook;
    template <bool RATIO> __device__ __forceinline__ void scale(f32x4 (&acc)[2][2][4][2], const Unit& u, int wr, int wc, int fr, int fq, int slot) const {
        const __amdgpu_buffer_rsrc_t rs = __builtin_amdgcn_make_buffer_rsrc((void*)R, 0, (int)((size_t)T * NGATE * 2), 0x00020000);
        const int voff = ((u.pm * BM + wr * 64 + fr) * NGATE + slot * DM + u.pn * BM + wc * 32 + 8 * fq) * 2;
#pragma unroll
        for (int ai = 0; ai < 2; ++ai) {
            u32x4 ga[4][2], gb[4][2];
#pragma unroll
            for (int m = 0; m < 4; ++m)
#pragma unroll
                for (int bj = 0; bj < 2; ++bj) { ga[m][bj] = __builtin_amdgcn_raw_buffer_load_b128(rs, voff, ((ai * HALF + m * 16) * NGATE + bj * HALF) * 2, 0);
                    if (RATIO) gb[m][bj] = __builtin_amdgcn_raw_buffer_load_b128(rs, voff, ((ai * HALF + m * 16) * NGATE + DM + bj * HALF) * 2, 0); }
            __builtin_amdgcn_sched_barrier(0);
#pragma unroll
            for (int m = 0; m < 4; ++m)
#pragma unroll
                for (int bj = 0; bj < 2; ++bj) { const u32x4 a = ga[m][bj];
                    float f[8] = {bflo(a.x), bfhi(a.x), bflo(a.y), bfhi(a.y), bflo(a.z), bfhi(a.z), bflo(a.w), bfhi(a.w)};
                    if (RATIO) { const u32x4 b = gb[m][bj]; const float d[8] = {bflo(b.x), bfhi(b.x), bflo(b.y), bfhi(b.y), bflo(b.z), bfhi(b.z), bflo(b.w), bfhi(b.w)};
#pragma unroll
                        for (int j = 0; j < 8; ++j) f[j] *= __builtin_amdgcn_rcpf(d[j]); }
                    acc[ai][bj][m][0][0] *= f[0]; acc[ai][bj][m][0][1] *= f[1]; acc[ai][bj][m][0][2] *= f[2]; acc[ai][bj][m][0][3] *= f[3];
                    acc[ai][bj][m][1][0] *= f[4]; acc[ai][bj][m][1][1] *= f[5]; acc[ai][bj][m][1][2] *= f[6]; acc[ai][bj][m][1][3] *= f[7]; }
            __builtin_amdgcn_sched_barrier(0);
        }
    }
    __device__ __forceinline__ void hook(f32x4 (&acc)[2][2][4][2], const Unit& u, int wr, int wc, int fr, int fq, int seg) const { if (!nohook) scale<true>(acc, u, wr, wc, fr, fq, seg - 1); }
    __device__ __forceinline__ void operator()(f32x4 (&acc)[2][2][4][2], const Unit& u, int wr, int wc, int fr, int fq) const {
        scale<false>(acc, u, wr, wc, fr, fq, 2);
        const int row0 = u.pm * BM + wr * 64 + fr, col0 = u.pn * BM + wc * 32 + 8 * fq;
#pragma unroll
        for (int ai = 0; ai < 2; ++ai)
#pragma unroll
            for (int m = 0; m < 4; ++m) { bf16* rowp = MG + (size_t)(row0 + ai * HALF + m * 16) * DM + col0;
#pragma unroll
                for (int bj = 0; bj < 2; ++bj) { const f32x4 v0 = acc[ai][bj][m][0], v1 = acc[ai][bj][m][1];
                    u32x4 w; w.x = cvt_pk_bf16(v0[0], v0[1]); w.y = cvt_pk_bf16(v0[2], v0[3]); w.z = cvt_pk_bf16(v1[0], v1[1]); w.w = cvt_pk_bf16(v1[2], v1[3]);
                    *(u32x4*)(rowp + bj * HALF) = w; } }
    } };
struct EpiOut { static constexpr bool HOOK = false; static constexpr bool PERM = false; const float* Xin; float* X;
    __device__ __forceinline__ void operator()(const f32x4 (&acc)[2][2][4][2], const Unit& u, int wr, int wc, int fr, int fq) const {
        const int row0 = u.pm * BM + wr * 64 + fr, col0 = u.pn * BM + wc * 32 + 4 * fq;
#pragma unroll
        for (int ai = 0; ai < 2; ++ai)
#pragma unroll
            for (int m = 0; m < 4; ++m) { const size_t off = (size_t)(row0 + ai * HALF + m * 16) * DM + col0;
#pragma unroll
                for (int bj = 0; bj < 2; ++bj)
#pragma unroll
                    for (int n = 0; n < 2; ++n) { const f32x4 xi = *(const f32x4*)(Xin + off + bj * HALF + n * 16); *(f32x4*)(X + off + bj * HALF + n * 16) = xi + acc[ai][bj][m][n]; } }
    } };
struct EpiDelta { static constexpr bool HOOK = false; static constexpr bool PERM = true; bf16* D;
    __device__ __forceinline__ void operator()(const f32x4 (&acc)[2][2][4][2], const Unit& u, int wr, int wc, int fr, int fq) const {
        const int row0 = u.pm * BM + wr * 64 + fr, col0 = u.pn * BM + wc * 32 + 8 * fq;
#pragma unroll
        for (int ai = 0; ai < 2; ++ai)
#pragma unroll
            for (int m = 0; m < 4; ++m) { bf16* rowp = D + (size_t)(row0 + ai * HALF + m * 16) * DM + col0;
#pragma unroll
                for (int bj = 0; bj < 2; ++bj) { const f32x4 v0 = acc[ai][bj][m][0], v1 = acc[ai][bj][m][1];
                    u32x4 w; w.x = cvt_pk_bf16(v0[0], v0[1]); w.y = cvt_pk_bf16(v0[2], v0[3]); w.z = cvt_pk_bf16(v1[0], v1[1]); w.w = cvt_pk_bf16(v1[2], v1[3]);
                    *(u32x4*)(rowp + bj * HALF) = w; } }
    } };
struct EpiSC { static constexpr bool HOOK = false; static constexpr bool PERM = false; float* SC;
    __device__ __forceinline__ void operator()(const f32x4 (&acc)[2][2][4][2], const Unit& u, int wr, int wc, int fr, int fq) const {
        const int row0 = u.pm * BM + wr * 64 + fr, col0 = u.pn * BM + wc * 32 + 4 * fq;
#pragma unroll
        for (int ai = 0; ai < 2; ++ai)
#pragma unroll
            for (int m = 0; m < 4; ++m) { const size_t off = (size_t)(row0 + ai * HALF + m * 16) * DM + col0;
#pragma unroll
                for (int bj = 0; bj < 2; ++bj)
#pragma unroll
                    for (int n = 0; n < 2; ++n) *(f32x4*)(SC + off + bj * HALF + n * 16) = acc[ai][bj][m][n]; }
    } };

template <class Epi, class Prob, class Sched, bool ALIGN_EPI = true, bool FP8 = false>
__device__ __forceinline__ void gemm_phase(PG8_LAS unsigned char* lds, const Prob g, const Sched& S, const Epi& E) {
    int tid = threadIdx.x; asm volatile("" : "+v"(tid));
    const int wid = __builtin_amdgcn_readfirstlane(tid >> 6), lane = tid & 63, wr = wid >> 2, wc = wid & 3, fr = lane & 15, fq = lane >> 4;
    const int K = g.K, nt = K / BK;
    unsigned voffA[2], voffB[2];
#pragma unroll
    for (int i = 0; i < 2; ++i) { int R, C; stage_rc(tid * 16 + i * 8192, R, C); const int Rb = Epi::PERM ? ((R & ~31) + perm32(R & 31)) : R;
        voffA[i] = (unsigned)(R * g.lda + C) * 2u; voffB[i] = (unsigned)(Rb * g.ldb + C) * 2u; }
    const size_t kstep = (size_t)(BK * 2);
    const size_t hstepA = (size_t)HALF * g.lda * 2, hstepB = (size_t)HALF * g.ldb * 2;
    const unsigned ldsw = (unsigned)wid * 1024u;
    const int aoff = lds_byte(wr * 64 + fr, fq * 8), boff = lds_byte(wc * 32 + fr, fq * 8);
#define PG8_SA(b, h) (((b) * 2 + (h)) * HTB)
#define PG8_SB(b, h) ((4 + (b) * 2 + (h)) * HTB)
#define PG8_STAGE(bufoff, gbase, voff) do { _Pragma("unroll") for (int _i = 0; _i < 2; ++_i) \
        __builtin_amdgcn_global_load_lds((const unsigned*)((const char*)(gbase) + (voff)[_i]), (PG8_LAS unsigned*)(lds + (bufoff) + ldsw + _i * 8192), 16, 0, 0); } while (0)
#define PG8_CAT8(x0, x1) __builtin_shufflevector(__builtin_bit_cast(v4i32, x0), __builtin_bit_cast(v4i32, x1), 0, 1, 2, 3, 4, 5, 6, 7)
#define PG8_LDA(dst, b, h) do { _Pragma("unroll") for (int m = 0; m < 4; ++m) { const bf16x8 x0 = *(const PG8_LAS bf16x8*)(lds + PG8_SA(b, h) + aoff + m * 2048), x1 = *(const PG8_LAS bf16x8*)(lds + PG8_SA(b, h) + aoff + m * 2048 + 1024); \
        if constexpr (FP8) dst##8[m] = PG8_CAT8(x0, x1); else { dst[m][0] = x0; dst[m][1] = x1; } } } while (0)
#define PG8_LDB(dst, b, h) do { _Pragma("unroll") for (int n = 0; n < 2; ++n) { const bf16x8 x0 = *(const PG8_LAS bf16x8*)(lds + PG8_SB(b, h) + boff + n * 2048), x1 = *(const PG8_LAS bf16x8*)(lds + PG8_SB(b, h) + boff + n * 2048 + 1024); \
        if constexpr (FP8) dst##8[n] = PG8_CAT8(x0, x1); else { dst[n][0] = x0; dst[n][1] = x1; } } } while (0)
#define PG8_MMA(ai, bj, At, Bt) do { __builtin_amdgcn_s_setprio(1); _Pragma("unroll") for (int m = 0; m < 4; ++m) _Pragma("unroll") for (int n = 0; n < 2; ++n) { \
        if constexpr (FP8) asm volatile("v_mfma_f32_16x16x128_f8f6f4 %0, %1, %2, %0" : "+v"(acc[ai][bj][m][n]) : "v"(Bt##8[n]), "v"(At##8[m]));   \
        else { _Pragma("unroll") for (int k = 0; k < 2; ++k) acc[ai][bj][m][n] = __builtin_amdgcn_mfma_f32_16x16x32_bf16(Bt[n][k], At[m][k], acc[ai][bj][m][n], 0, 0, 0); } } \
        if constexpr (FP8) asm volatile("s_nop 7" ::: "memory");   \
        __builtin_amdgcn_s_setprio(0); } while (0)
#define PG8_WAIT_V(n) asm volatile("s_waitcnt vmcnt(" #n ")" ::: "memory")
#define PG8_WAIT_L(n) asm volatile("s_waitcnt lgkmcnt(" #n ")" ::: "memory")
#define PG8_BAR __builtin_amdgcn_s_barrier()
#define PG8_SCHED __builtin_amdgcn_sched_barrier(0)
    Unit cur, nxt; int ui = 0;
    if (!S.next(0, cur)) return;
    f32x4 acc[2][2][4][2];
#pragma unroll
    for (int a = 0; a < 2; ++a)
#pragma unroll
        for (int b = 0; b < 2; ++b)
#pragma unroll
            for (int m = 0; m < 4; ++m)
#pragma unroll
                for (int n = 0; n < 2; ++n) acc[a][b][m][n] = (f32x4){0.f, 0.f, 0.f, 0.f};
    bf16x8 At[4][2], B0[2][2], B1[2][2];
    v8i32 At8[4], B08[2], B18[2];
    const char* cA = g.Aptr(cur); const char* cB = g.Bptr(cur);
    PG8_STAGE(PG8_SB(0, 0), cB, voffB); PG8_STAGE(PG8_SB(0, 1), cB + hstepB, voffB); PG8_STAGE(PG8_SA(0, 0), cA, voffA); PG8_STAGE(PG8_SA(0, 1), cA + hstepA, voffA);
    if (wr == 1) PG8_BAR;
    PG8_WAIT_V(2); PG8_BAR;
    PG8_STAGE(PG8_SB(1, 0), cB + kstep, voffB); PG8_STAGE(PG8_SA(1, 0), cA + kstep, voffA); PG8_STAGE(PG8_SB(1, 1), cB + hstepB + kstep, voffB);
    PG8_WAIT_V(6); PG8_BAR;
    for (;;) {
        const bool has_next = S.next(ui + 1, nxt);
        const char* nA = has_next ? g.Aptr(nxt) : cA; const char* nB = has_next ? g.Bptr(nxt) : cB;
        for (int t = 0; t < nt; t += 2) {
            if constexpr (Epi::HOOK) { if (t == 8 || t == 16) E.hook(acc, cur, wr, wc, fr, fq, t >> 3); }
            const bool last = (t == nt - 2);
            const char* a1 = cA + (size_t)(t + 1) * kstep;
            const char* a2 = last ? nA : cA + (size_t)(t + 2) * kstep; const char* b2 = last ? nB : cB + (size_t)(t + 2) * kstep;
            const char* a3 = a2 + kstep; const char* b3 = b2 + kstep;
            PG8_LDB(B0, 0, 0); PG8_LDB(B1, 0, 1); PG8_SCHED; PG8_LDA(At, 0, 0); PG8_STAGE(PG8_SA(1, 1), a1 + hstepA, voffA);
            PG8_WAIT_V(8); PG8_WAIT_L(0); PG8_BAR; PG8_MMA(0, 0, At, B0); PG8_MMA(0, 1, At, B1); PG8_BAR; PG8_SCHED;
            PG8_LDA(At, 0, 1); PG8_STAGE(PG8_SB(0, 0), b2, voffB); PG8_STAGE(PG8_SB(0, 1), b2 + hstepB, voffB); PG8_STAGE(PG8_SA(0, 0), a2, voffA);
            PG8_WAIT_V(8); PG8_WAIT_L(0); PG8_BAR; PG8_MMA(1, 0, At, B0); PG8_MMA(1, 1, At, B1); PG8_BAR; PG8_SCHED;
            PG8_LDB(B0, 1, 0); PG8_LDB(B1, 1, 1); PG8_SCHED; PG8_LDA(At, 1, 0); PG8_STAGE(PG8_SA(0, 1), a2 + hstepA, voffA);
            PG8_WAIT_V(8); PG8_WAIT_L(0); PG8_BAR; PG8_MMA(0, 0, At, B0); PG8_MMA(0, 1, At, B1); PG8_BAR; PG8_SCHED;
            PG8_LDA(At, 1, 1); PG8_STAGE(PG8_SB(1, 0), b3, voffB); PG8_STAGE(PG8_SB(1, 1), b3 + hstepB, voffB); PG8_STAGE(PG8_SA(1, 0), a3, voffA);
            PG8_WAIT_V(8); PG8_WAIT_L(0); PG8_BAR; PG8_MMA(1, 0, At, B0); PG8_MMA(1, 1, At, B1); PG8_BAR; PG8_SCHED;
        }
        if constexpr (ALIGN_EPI) { if (wr == 0) PG8_BAR; }
        E(acc, cur, wr, wc, fr, fq);
        if (!has_next) break;
#pragma unroll
        for (int a = 0; a < 2; ++a)
#pragma unroll
            for (int b = 0; b < 2; ++b)
#pragma unroll
                for (int m = 0; m < 4; ++m)
#pragma unroll
                    for (int n = 0; n < 2; ++n) acc[a][b][m][n] = (f32x4){0.f, 0.f, 0.f, 0.f};
        cur = nxt; cA = nA; cB = nB; ++ui;
        if constexpr (ALIGN_EPI) { if (wr == 1) PG8_BAR; }
    }
    PG8_WAIT_V(0);
    if constexpr (!ALIGN_EPI) { if (wr == 0) PG8_BAR; }
    PG8_BAR;
#undef PG8_SA
#undef PG8_SB
#undef PG8_STAGE
#undef PG8_LDA
#undef PG8_CAT8
#undef PG8_LDB
#undef PG8_MMA
#undef PG8_WAIT_V
#undef PG8_WAIT_L
#undef PG8_BAR
#undef PG8_SCHED
}
}


constexpr int RING_BYTES = 131072, MISC_OFF = RING_BYTES + 320, LDS_BYTES = 147456;
namespace att {
typedef short s16x4 __attribute__((ext_vector_type(4)));
__device__ __forceinline__ s16x4 lds_tr(const LAS unsigned char* p) { return __builtin_bit_cast(s16x4, __builtin_amdgcn_ds_read_tr16_b64_v4i16((LAS s16x4*)p)); }
template <int MODE> struct Cfg;
template <> struct Cfg<0> { static constexpr int DQK = 96, DV = 64, KRS = 208, VRS = 192, NV = 2, NL = 5; };
template <> struct Cfg<1> { static constexpr int DQK = 64, DV = 128, KRS = 144, VRS = 320, NV = 1, NL = 4; };
template <int MODE> struct Lay { using C = Cfg<MODE>; static constexpr int KB = 64 * C::KRS, VB = 64 * C::VRS, STAGE = 2 * KB + C::NV * VB; };

template <int MODE>
__device__ __forceinline__ void attn_unit(const Params& p, int l, int b, int hp, int qb, LAS unsigned char* lds, float lam, float lam_init, int pm = 0) {
    using C = Cfg<MODE>; using L = Lay<MODE>;
    constexpr int DQK = C::DQK, DV = C::DV, NDB = DV / 32, NKS = DQK / 16;
    int tid = threadIdx.x; asm volatile("" : "+v"(tid));
    const int lane = tid & 63, wid = __builtin_amdgcn_readfirstlane(tid >> 6), half = wid >> 2, r = lane & 31, h = lane >> 5;
    const int q0 = qb * 128, qrow = q0 + 32 * (wid & 3) + r;
    const size_t trow = (size_t)b * SEQ + qrow;
    const int ntile = 2 * qb + 2, mytiles = 2 * qb + 1 + ((wid & 3) >> 1);
    const bf16* Qb; const bf16* Kg[2]; const bf16* Vg[2]; int kp, vp;
    if (MODE == 0) { const bf16* QM = (const bf16*)(p.ws + WS_QM); const bf16* KM = (const bf16*)(p.ws + WS_KM); const bf16* KVR = (const bf16*)(p.ws + WS_KVR);
        Qb = QM + trow * 768 + (2 * hp + half) * 96; kp = 768; vp = 1024;
        Kg[0] = KM + (size_t)b * SEQ * 768 + (2 * hp) * 96; Kg[1] = Kg[0] + 96; Vg[0] = KVR + (size_t)b * SEQ * 1024 + 512 + (2 * hp) * 64; Vg[1] = Vg[0] + 64;
    } else { const bf16* Z = (const bf16*)(p.ws + WS_Z);
        Qb = Z + trow * ZP + ZC_DQ + (2 * hp + half) * 64; kp = ZP; vp = ZP;
        Kg[0] = Z + (size_t)b * SEQ * ZP + ZC_DK + (2 * hp) * 64; Kg[1] = Kg[0] + 64; Vg[0] = Z + (size_t)b * SEQ * ZP + ZC_DV + hp * 128; Vg[1] = Vg[0]; }
    constexpr int KC = DQK / 8, VC = DV / 8;
    typedef const __attribute__((address_space(1))) bf16* gptr_t;
    gptr_t gp[C::NL]; int lo_[C::NL]; size_t gstep[C::NL];
#pragma unroll
    for (int i = 0; i < C::NL; ++i) { const int id = tid + 512 * i;
        if (id < 2 * 64 * KC) { const int sg = id / (64 * KC), q = id % (64 * KC), row = q / KC, c = q % KC; gp[i] = (gptr_t)(sg ? Kg[1] : Kg[0]) + (size_t)row * kp + c * 8; lo_[i] = sg * L::KB + row * C::KRS + c * 16; gstep[i] = (size_t)64 * kp; }
        else { const int q2 = id - 2 * 64 * KC, sg = q2 / (64 * VC), q = q2 % (64 * VC), row = q / VC, c = q % VC; gp[i] = (gptr_t)(sg ? Vg[1] : Vg[0]) + (size_t)row * vp + c * 8; lo_[i] = 2 * L::KB + sg * L::VB + row * C::VRS + c * 16; gstep[i] = (size_t)64 * vp; } }
    bf16x8 qf[NKS];
#pragma unroll
    for (int s_ = 0; s_ < NKS; ++s_) qf[s_] = *(const bf16x8*)(Qb + 16 * s_ + 8 * h);
    const int koff = half * L::KB + r * C::KRS + 16 * h;
    const int voff = 2 * L::KB + (C::NV == 2 ? half * L::VB : 0) + (4 * h + ((lane & 15) >> 2)) * C::VRS + (((lane >> 4) & 1) * 16 + (lane & 3) * 4) * 2;
    f32x16 O[NDB];
#pragma unroll
    for (int d = 0; d < NDB; ++d)
#pragma unroll
        for (int e = 0; e < 16; ++e) O[d][e] = 0.f;
    f32x16 negm;
#pragma unroll
    for (int e = 0; e < 16; ++e) negm[e] = 0.f;
    float l_run = 0.f;
    u32x4 stA[C::NL], stB[C::NL];
#define ATT_LOAD(R) do { const size_t _st = adv > 0 ? 1 : 0; --adv; _Pragma("unroll") for (int i = 0; i < C::NL; ++i) { R[i] = *(const __attribute__((address_space(1))) u32x4*)gp[i]; gp[i] += _st * gstep[i]; } } while (0)
#define ATT_WRITE(R, stg) do { _Pragma("unroll") for (int i = 0; i < C::NL; ++i) *(LAS u32x4*)(lds + (stg) * L::STAGE + lo_[i]) = R[i]; } while (0)
#define ATT_VREAD(dst, kb) do { const int voff_ = (pm & 64) ? 2 * L::KB : voff; _Pragma("unroll") for (int d = 0; d < NDB; ++d) _Pragma("unroll") for (int sp = 0; sp < 2; ++sp) { \
                const LAS unsigned char* va = sb + voff_ + (32 * (kb) + 16 * sp) * C::VRS + 64 * d; \
                const s16x4 t0 = lds_tr(va), t1 = lds_tr(va + 8 * C::VRS); \
                dst[2 * d + sp] = (bf16x8){t0[0], t0[1], t0[2], t0[3], t1[0], t1[1], t1[2], t1[3]}; } } while (0)
#define ATT_PV(src, pfk) do { if (!(pm & 32)) { _Pragma("unroll") for (int d = 0; d < NDB; ++d) _Pragma("unroll") for (int sp = 0; sp < 2; ++sp) O[d] = __builtin_amdgcn_mfma_f32_32x32x16_bf16(src[2 * d + sp], pfk[sp], O[d], 0, 0, 0); } \
        else { _Pragma("unroll") for (int d = 0; d < NDB; ++d) O[d][0] += __builtin_bit_cast(float, (int)src[2 * d][0] + (int)pfk[0][0]); } } while (0)
#define ATT_SM(Sk, Sother, pfk) do { float mx = Sk[0]; _Pragma("unroll") for (int e = 1; e < 16; ++e) mx = fmaxf(mx, Sk[e]); \
            if (__any(mx > 8.f)) { mx = fmaxf(mx, __shfl_xor(mx, 32)); \
                const float dsh = fmaxf(mx, 0.f), alpha = __builtin_amdgcn_exp2f(-dsh); l_run *= alpha; \
                _Pragma("unroll") for (int e = 0; e < 16; ++e) { negm[e] -= dsh; Sk[e] -= dsh; Sother[e] -= dsh; } \
                _Pragma("unroll") for (int dd = 0; dd < NDB; ++dd) _Pragma("unroll") for (int e = 0; e < 16; ++e) O[dd][e] *= alpha; } \
            float ps = 0.f; \
            _Pragma("unroll") for (int sp = 0; sp < 2; ++sp) { float e8[8]; \
                if (pm & 16) { _Pragma("unroll") for (int jj = 0; jj < 8; ++jj) e8[jj] = Sk[8 * sp + jj]; } else { _Pragma("unroll") for (int jj = 0; jj < 8; ++jj) { e8[jj] = __builtin_amdgcn_exp2f(Sk[8 * sp + jj]); ps += e8[jj]; } } \
                u32x4 w; w.x = pg8::cvt_pk_bf16(e8[0], e8[1]); w.y = pg8::cvt_pk_bf16(e8[2], e8[3]); w.z = pg8::cvt_pk_bf16(e8[4], e8[5]); w.w = pg8::cvt_pk_bf16(e8[6], e8[7]); \
                pfk[sp] = __builtin_bit_cast(bf16x8, w); } \
            l_run += ps; } while (0)
#define ATT_COMPUTE(stg) do { LAS unsigned char* sb = lds + (stg) * L::STAGE; \
            bf16x8 kf[2][NKS]; \
            { const int koff_ = (pm & 64) ? 0 : koff; _Pragma("unroll") for (int kb = 0; kb < 2; ++kb) _Pragma("unroll") for (int s_ = 0; s_ < NKS; ++s_) kf[kb][s_] = *(const LAS bf16x8*)(sb + koff_ + kb * 32 * C::KRS + 32 * s_); } \
            __builtin_amdgcn_sched_barrier(0); \
            f32x16 S0 = negm, S1 = negm; \
            if (!(pm & 32)) { _Pragma("unroll") for (int s_ = 0; s_ < NKS; ++s_) S0 = __builtin_amdgcn_mfma_f32_32x32x16_bf16(kf[0][s_], qf[s_], S0, 0, 0, 0); \
            _Pragma("unroll") for (int s_ = 0; s_ < NKS; ++s_) S1 = __builtin_amdgcn_mfma_f32_32x32x16_bf16(kf[1][s_], qf[s_], S1, 0, 0, 0); } \
            bf16x8 vfa[2 * NDB], vfb[2 * NDB]; \
            ATT_VREAD(vfa, 0); \
            __builtin_amdgcn_sched_barrier(0); \
            bf16x8 pf0[2], pf1[2]; \
            ATT_SM(S0, S1, pf0); \
            __builtin_amdgcn_sched_barrier(0); \
            ATT_PV(vfa, pf0); \
            ATT_VREAD(vfb, 1); \
            __builtin_amdgcn_sched_barrier(0); \
            ATT_SM(S1, S0, pf1); \
            __builtin_amdgcn_sched_barrier(0); \
            ATT_PV(vfb, pf1); \
            } while (0)
    int adv = ntile - 1;
    ATT_LOAD(stA); ATT_LOAD(stB);
    ATT_WRITE(stA, 0);
    __syncthreads();
#pragma unroll 1
    for (int j = 0; j < ntile; j += 2) {
        if (!(pm & 1)) ATT_LOAD(stA);
        if (j < mytiles) ATT_COMPUTE(0);
        if (!(pm & 2)) ATT_WRITE(stB, 1);
        if (!(pm & 8)) __syncthreads();
        if (!(pm & 1)) ATT_LOAD(stB);
        if (j + 1 < mytiles) ATT_COMPUTE(1);
        if (!(pm & 2)) ATT_WRITE(stA, 0);
        if (!(pm & 8)) __syncthreads();
    }
#undef ATT_LOAD
#undef ATT_WRITE
#undef ATT_COMPUTE
#undef ATT_VREAD
#undef ATT_PV
#undef ATT_SM
    const float inv = 1.f / (l_run + __shfl_xor(l_run, 32));
    if (MODE == 0) {
        bf16* o = (bf16*)(p.ws + WS_OC) + trow * 1536 + (2 * hp + half) * 64 + 4 * h;
#pragma unroll
        for (int d = 0; d < NDB; ++d)
#pragma unroll
            for (int g4 = 0; g4 < 4; ++g4) { u32x2 w; w.x = pg8::cvt_pk_bf16(O[d][4 * g4] * inv, O[d][4 * g4 + 1] * inv); w.y = pg8::cvt_pk_bf16(O[d][4 * g4 + 2] * inv, O[d][4 * g4 + 3] * inv);
                *(u32x2*)(o + 32 * d + 8 * g4) = w; }
    } else {
        LAS unsigned char* xr = lds + (32 * (wid & 3) + r) * 264 + 8 * h;
        if (half == 1) {
#pragma unroll
            for (int d = 0; d < NDB; ++d)
#pragma unroll
                for (int g4 = 0; g4 < 4; ++g4) { u32x2 w; w.x = pg8::cvt_pk_bf16(O[d][4 * g4] * inv, O[d][4 * g4 + 1] * inv); w.y = pg8::cvt_pk_bf16(O[d][4 * g4 + 2] * inv, O[d][4 * g4 + 3] * inv);
                    *(LAS u32x2*)(xr + 64 * d + 16 * g4) = w; }
        }
        __syncthreads();
        if (half == 0) {
            float ss = 0.f;
#pragma unroll
            for (int d = 0; d < NDB; ++d)
#pragma unroll
                for (int g4 = 0; g4 < 4; ++g4) { const u32x2 w = *(const LAS u32x2*)(xr + 64 * d + 16 * g4);
                    O[d][4 * g4] = O[d][4 * g4] * inv - lam * bflo(w.x); O[d][4 * g4 + 1] = O[d][4 * g4 + 1] * inv - lam * bfhi(w.x);
                    O[d][4 * g4 + 2] = O[d][4 * g4 + 2] * inv - lam * bflo(w.y); O[d][4 * g4 + 3] = O[d][4 * g4 + 3] * inv - lam * bfhi(w.y);
                    ss += (O[d][4 * g4] * O[d][4 * g4] + O[d][4 * g4 + 1] * O[d][4 * g4 + 1]) + (O[d][4 * g4 + 2] * O[d][4 * g4 + 2] + O[d][4 * g4 + 3] * O[d][4 * g4 + 3]); }
            ss += __shfl_xor(ss, 32);
            const float rstd = rsqrtf(ss * (1.f / 128.f) + NORM_EPS) * (1.f - lam_init);
            const float* sg = p.in[11] + (size_t)l * 128 + 4 * h;
            bf16* o = (bf16*)(p.ws + WS_OC) + trow * 1536 + 512 + hp * 128 + 4 * h;
#pragma unroll
            for (int d = 0; d < NDB; ++d)
#pragma unroll
                for (int g4 = 0; g4 < 4; ++g4) { const f32x4 g = *(const f32x4*)(sg + 32 * d + 8 * g4);
                    u32x2 w; w.x = pg8::cvt_pk_bf16(O[d][4 * g4] * rstd * g.x, O[d][4 * g4 + 1] * rstd * g.y); w.y = pg8::cvt_pk_bf16(O[d][4 * g4 + 2] * rstd * g.z, O[d][4 * g4 + 3] * rstd * g.w);
                    *(u32x2*)(o + 32 * d + 8 * g4) = w; }
        }
        __syncthreads();
    }
}

__device__ __forceinline__ void sgu_unit(const Params& p, int l, int n, int g, LAS unsigned char* lds) {
    constexpr int VRS = 320;
    int tid = threadIdx.x; asm volatile("" : "+v"(tid));
    const int lane = tid & 63, wid = __builtin_amdgcn_readfirstlane(tid >> 6), r = lane & 31, h = lane >> 5, tb = wid & 3, ch = wid >> 2;
    const bf16* Z = (const bf16*)(p.ws + WS_Z) + (size_t)n * 128 * ZP;
#pragma unroll
    for (int i = 0; i < 4; ++i) { const int id = tid + 512 * i, row = id >> 4, c = id & 15; *(LAS u32x4*)(lds + row * VRS + c * 16) = *(const u32x4*)(Z + (size_t)row * ZP + ZC_SV + g * 128 + c * 8); }
    const bf16* W = (const bf16*)(p.ws + WS_W + (size_t)l * W_LAYER + WO_SGU) + ((size_t)g * 128 + tb * 32 + r) * 128 + 4 * h;
    u32x2 wf[8][2];
#pragma unroll
    for (int ks = 0; ks < 8; ++ks) { wf[ks][0] = *(const u32x2*)(W + 16 * ks); wf[ks][1] = *(const u32x2*)(W + 16 * ks + 8); }
    __syncthreads();
    f32x16 O[2];
#pragma unroll
    for (int d = 0; d < 2; ++d)
#pragma unroll
        for (int e = 0; e < 16; ++e) O[d][e] = 0.f;
    const int voff = (4 * h + ((lane & 15) >> 2)) * VRS + (((lane >> 4) & 1) * 16 + (lane & 3) * 4) * 2 + 128 * ch;
#pragma unroll
    for (int d = 0; d < 2; ++d)
#pragma unroll
        for (int ks = 0; ks < 8; ++ks) { const LAS unsigned char* va = lds + voff + (16 * ks) * VRS + 64 * d;
            const att::s16x4 t0 = att::lds_tr(va), t1 = att::lds_tr(va + 8 * VRS);
            const bf16x8 vf = {t0[0], t0[1], t0[2], t0[3], t1[0], t1[1], t1[2], t1[3]};
            const u32x4 pw = {wf[ks][0].x, wf[ks][0].y, wf[ks][1].x, wf[ks][1].y};
            O[d] = __builtin_amdgcn_mfma_f32_32x32x16_bf16(vf, __builtin_bit_cast(bf16x8, pw), O[d], 0, 0, 0); }
    const int t = tb * 32 + r; const size_t trow = (size_t)n * 128 + t;
    const float bias = p.in[14][(size_t)l * 512 + g * 128 + t];
    const bf16* up = (const bf16*)(p.ws + WS_Z) + trow * ZP + ZC_SU + g * 128 + 64 * ch + 4 * h;
    bf16* o = (bf16*)(p.ws + WS_OC) + trow * 1536 + 1024 + g * 128 + 64 * ch + 4 * h;
#pragma unroll
    for (int d = 0; d < 2; ++d)
#pragma unroll
        for (int g4 = 0; g4 < 4; ++g4) { const u32x2 uw = *(const u32x2*)(up + 32 * d + 8 * g4);
            u32x2 w; w.x = pg8::cvt_pk_bf16(bflo(uw.x) * (O[d][4 * g4] + bias), bfhi(uw.x) * (O[d][4 * g4 + 1] + bias)); w.y = pg8::cvt_pk_bf16(bflo(uw.y) * (O[d][4 * g4 + 2] + bias), bfhi(uw.y) * (O[d][4 * g4 + 3] + bias));
            *(u32x2*)(o + 32 * d + 8 * g4) = w; }
    __syncthreads();
}
}

#define XB_TMO      128
#define XB_XCNT(j)  (256  + 64 * (j))
#define XB_XSUB(j)  (1280 + 64 * (j))
#define XB_XGEN(j)  (2304 + 64 * (j))
#define XB_TOP      3328
#define XB_TOPGEN   3392
#define XCD_BAR_WORDS 3456
#define XB_SPIN_CAP (1u << 18)
__device__ __forceinline__ unsigned xb_ld(unsigned* p)              { return __hip_atomic_load(p, __ATOMIC_RELAXED, __HIP_MEMORY_SCOPE_AGENT); }
__device__ __forceinline__ unsigned xb_add(unsigned* p, unsigned v) { return __hip_atomic_fetch_add(p, v, __ATOMIC_RELAXED, __HIP_MEMORY_SCOPE_AGENT); }
__device__ __forceinline__ unsigned xb_xcc_id() { return (unsigned)__builtin_amdgcn_s_getreg((3 << 11) | 20) & 0xFu; }
#define XB_SPIN(cond, bar) do { unsigned _sp = 0; while (cond) { __builtin_amdgcn_s_sleep(1); \
    if ((++_sp & 255u) == 0u) { if (xb_ld(&(bar)[XB_TMO])) break; if (_sp > XB_SPIN_CAP) { atomicAdd(&(bar)[XB_TMO], 1u); break; } } } } while (0)
struct XcdBarrier { unsigned* bar; unsigned x; volatile LAS unsigned* st; };
__device__ __forceinline__ XcdBarrier xcd_barrier_post(unsigned* bar, volatile LAS unsigned* st) {
    XcdBarrier b; b.bar = bar; b.x = xb_xcc_id(); b.st = st;
    if (threadIdx.x == 0) (void)xb_add(&bar[XB_XCNT(b.x)], 1u);
    return b;
}
__device__ __forceinline__ void xcd_barrier_complete(unsigned* bar, unsigned x, unsigned& nloc, unsigned& nx) {
    const unsigned G = gridDim.x * gridDim.y * gridDim.z;
    unsigned sum, cnt, mine, sp = 0u;
    for (;;) {
        sum = 0u; cnt = 0u; mine = 0u;
#pragma unroll
        for (unsigned j = 0; j < 16; ++j) { const unsigned c = xb_ld(&bar[XB_XCNT(j)]); sum += c; cnt += (c > 0u) ? 1u : 0u; mine = (j == x) ? c : mine; }
        if (sum == G) break;
        __builtin_amdgcn_s_sleep(1);
        if ((++sp & 255u) == 0u) { if (xb_ld(&bar[XB_TMO])) break; if (sp > XB_SPIN_CAP) { atomicAdd(&bar[XB_TMO], 1u); break; } }
    }
    nloc = mine > 0u ? mine : 1u; nx = cnt > 0u ? cnt : 1u;
}
__device__ __forceinline__ void xcd_barrier(const XcdBarrier& b) {
    asm volatile("s_waitcnt vmcnt(0)" ::: "memory");
    __syncthreads();
    if (threadIdx.x == 0) {
        unsigned* bar = b.bar;
        __builtin_amdgcn_s_waitcnt(0);
        unsigned nloc = b.st[0], nx = b.st[1];
        if (nloc == 0u) { xcd_barrier_complete(bar, b.x, nloc, nx); b.st[0] = nloc; b.st[1] = nx; }
        const unsigned old = xb_add(&bar[XB_XSUB(b.x)], 1u);
        const unsigned gen = old / nloc;
        if (old + 1u == (gen + 1u) * nloc) {
            __builtin_amdgcn_fence(__ATOMIC_RELEASE, "agent");
            asm volatile("s_waitcnt vmcnt(0)" ::: "memory");
            const unsigned og = xb_add(&bar[XB_TOP], 1u);
            const unsigned tg = og / nx;
            if (og + 1u == (tg + 1u) * nx) xb_add(&bar[XB_TOPGEN], 1u);
            else XB_SPIN(xb_ld(&bar[XB_TOPGEN]) == tg, bar);
            __builtin_amdgcn_fence(__ATOMIC_ACQUIRE, "agent");
            xb_add(&bar[XB_XGEN(b.x)], 1u);
            asm volatile("s_waitcnt vmcnt(0)" ::: "memory");
        } else {
            XB_SPIN(xb_ld(&bar[XB_XGEN(b.x)]) == gen, bar);
            __builtin_amdgcn_fence(__ATOMIC_ACQUIRE, "agent");
            asm volatile("s_waitcnt vmcnt(0)" ::: "memory");
        }
    }
    __syncthreads();
}

constexpr int NPHASE = 1 + 11 * DEPTH;
constexpr int CW_BAR = 4096;
struct MArgs { Params p; int ph_lo, ph_hi, li, pad; };

__global__ void __launch_bounds__(512, 2) mega(MArgs a) {
    extern __shared__ __attribute__((aligned(16))) unsigned char lds_raw[];
    LAS unsigned char* lds = (LAS unsigned char*)lds_raw;
    volatile LAS unsigned* MISC = (volatile LAS unsigned*)(lds + MISC_OFF);
    const Params& p = a.p;
    const int tid = threadIdx.x, lane = tid & 63, wave = __builtin_amdgcn_readfirstlane(tid >> 6);
    const int G = gridDim.x, bx = blockIdx.x;
    const int vcu = (G % 8 == 0) ? (bx % 8) * (G / 8) + bx / 8 : bx;
    const int gw = vcu * 8 + wave, ngw = G * 8;
    unsigned char* ws = p.ws;
    for (int u = tid; u < (LDS_BYTES - RING_BYTES) / 4; u += 512) ((LAS unsigned*)(lds + RING_BYTES))[u] = 0u;
    __syncthreads();
    XcdBarrier bar = xcd_barrier_post((unsigned*)(ws + WS_CTL) + CW_BAR + a.li * XCD_BAR_WORDS, MISC + 8);
    const int lo = a.ph_lo, hi = a.ph_hi;
#ifndef PROBE_PM
#define PROBE_PM 0
#endif
#ifndef PROBE_K
#define PROBE_K (-1)
#endif
#ifndef PROBE_N
#define PROBE_N 0
#endif
#define NREP(j) ((PROBE_K == (j)) ? PROBE_N : 0)
#ifndef ENMASK
#define ENMASK 0xFFFFFFFFu
#endif
#define EN(j) ((ENMASK >> (j)) & 1u)
#define IN(k) (lo <= (k) && (k) < hi)
#define SEAM(k) do { if (IN(k) && IN((k) + 1)) xcd_barrier(bar); } while (0)

    if (EN(11) && IN(0)) for (int rep = 0; rep <= NREP(11); ++rep) {
        float* scr = (float*)lds_raw;
        __syncthreads();
        for (int r12 = 0; r12 <= NREP(12); ++r12)
        for (int l = 0; l < DEPTH; ++l) prologue_transposes(p, l, scr + wave * (64 * 33), gw, ngw, lane);
        prologue_rope(p, bx * 512 + tid, G * 512);
        __syncthreads();
        for (int r13 = 0; r13 <= NREP(13); ++r13)
        for (int it = bx; it < 2 * 256; it += G) fold_item(p, it >> 8, it & 255, scr, tid);
        __syncthreads();
        for (int r15 = 0; r15 <= NREP(15); ++r15)
        for (int t = gw; t < T; t += ngw) rms_row_to_bf16(p.in[0] + (size_t)t * DM, p.in[1], (bf16*)(ws + WS_HB) + (size_t)t * DM, lane, ws + WS_HB8 + (size_t)t * DM);
        for (int r14 = 0; r14 <= NREP(14); ++r14)
        for (int r = gw; r < 2 * DEPTH * NEXP; r += ngw) { const int tb = r / (DEPTH * NEXP), q = r % (DEPTH * NEXP);
            if (tb) q4_row(p.in[23] + (size_t)q * DM, ws + WS_V8 + (size_t)q * QROW, (float*)(ws + WS_PS) + (size_t)DEPTH * NEXP + q, lane);
            else q4u_row(p.in[22] + (size_t)q * DM, ws + WS_U8 + (size_t)q * QROW, (float*)(ws + WS_PS) + q, lane); }
        { unsigned* gmax = (unsigned*)(ws + WS_CTL) + CW_GMAX;
          for (int m6 = 0; m6 < 3 * DEPTH; ++m6) { const f32x4* src = (const f32x4*)(p.in[15] + (size_t)m6 * DM * DM); float mx = 0.f;
              for (int i = gw * 64 + lane; i < DM * DM / 4; i += ngw * 64) { const f32x4 v = src[i]; mx = fmaxf(mx, fmaxf(fmaxf(fabsf(v.x), fabsf(v.y)), fmaxf(fabsf(v.z), fabsf(v.w)))); }
#pragma unroll
              for (int of = 1; of < 64; of <<= 1) mx = fmaxf(mx, __shfl_xor(mx, of));
              if (lane == 0) atomicMax(gmax + 64 * m6, __builtin_bit_cast(unsigned, mx)); } }
        xcd_barrier(bar);
        { unsigned* gmax = (unsigned*)(ws + WS_CTL) + CW_GMAX;
          for (int it = gw; it < DEPTH * 3 * 64 * 32; it += ngw) { const int m6 = it / 2048, q = it % 2048, cb = q / 32, kb = q % 32;
              transpose_item8(p.in[15] + (size_t)m6 * DM * DM, DM, cb * 32, kb * 64, DM, ws + WS_WG8, m6 * DM + cb * 32, scr + wave * (64 * 33), lane, gate_scale(gmax + 64 * m6)); } }
    }
    SEAM(0);
    { constexpr int l = 0;
        const int pb = 1 + 11 * l;
        unsigned char* wl = ws + WS_W + (size_t)l * W_LAYER;
        bf16* HB = (bf16*)(ws + WS_HB); bf16* Z = (bf16*)(ws + WS_Z); bf16* Gt = (bf16*)(ws + WS_G);
        if (EN(0) && IN(pb + 0)) for (int rep = 0; rep <= NREP(0); ++rep) {
            { pg8::ProbGen g{HB, (const bf16*)(wl + WO_CAT), DM, DM, DM}; pg8::StaticOrder S; S.init(T, ZP, G, bx);
              pg8::EpiZG E{Z, Gt, p.in[16] + (size_t)l * NGATE, 1};
              pg8::gemm_phase<pg8::EpiZG, pg8::ProbGen, pg8::StaticOrder>(lds, g, S, E); }
            {
              const unsigned* gmax = (const unsigned*)(ws + WS_CTL) + CW_GMAX + 64 * 3 * l;
              pg8::ProbGen g{(const bf16*)(ws + WS_HB8), (const bf16*)(ws + WS_WG8 + (size_t)l * NGATE * DM), DM / 2, DM / 2, DM / 2}; pg8::StaticOrder S; S.init(T, NGATE, G, bx);
              pg8::EpiG8 E{Gt, p.in[16] + (size_t)l * NGATE, gmax};
              pg8::gemm_phase<pg8::EpiG8, pg8::ProbGen, pg8::StaticOrder, true, true>(lds, g, S, E); }
        }
        SEAM(pb + 0);
        if (EN(1) && IN(pb + 1)) { int ln = lane; asm volatile("" : "+v"(ln)); for (int t = gw; t < T; t += ngw) prep1_row(p, l, t, ln); }
        SEAM(pb + 1);
        if (EN(2) && IN(pb + 2)) for (int rep = 0; rep <= NREP(2); ++rep) {
            pg8::ProbUp g{Z, (const bf16*)(wl + WO_UP), ZP, 512, 512}; pg8::StaticOrder S; S.init(T, 1792, G, bx);
            pg8::EpiUp E{(bf16*)(ws + WS_QR), (bf16*)(ws + WS_KVR)};
            pg8::gemm_phase<pg8::EpiUp, pg8::ProbUp, pg8::StaticOrder>(lds, g, S, E);
        }
        SEAM(pb + 2);
        if (EN(3) && IN(pb + 3)) for (int rep = 0; rep <= NREP(3); ++rep) { int ln = lane; asm volatile("" : "+v"(ln)); for (int t = gw; t < T; t += ngw) prep2_row(p, l, t, ln); }
        SEAM(pb + 3);
        if (EN(4) && IN(pb + 4)) for (int rep = 0; rep <= NREP(4); ++rep) {
            const float lam = diff_lambda(p, l, lane), lam_init = 0.8f - 0.6f * expf(-0.3f * (float)l);
            unsigned* qbase = (unsigned*)(ws + WS_CTL) + 64 * (1 + 8 * l + 16 * rep);
            int qs = 0;
            for (;;) {
                __syncthreads();
                if (tid == 0) { int u = 192, qx = 0;
                    while (qs < 8) { qx = (int)((bar.x + (unsigned)qs) & 7u); u = (int)atomicAdd(qbase + 64 * qx, 1u); if (u < 192) break; ++qs; }
                    MISC[16] = (unsigned)(qs < 8 ? u : 192); MISC[17] = (unsigned)qx; MISC[18] = (unsigned)qs; }
                __syncthreads();
                const int u = (int)MISC[16], qx = (int)MISC[17]; qs = (int)MISC[18];
                if (u >= 192) break;
                if (u < 128) { const int qb = 31 - (u >> 2), combo = qx + 8 * (u & 3);
                    if (combo < 16) att::attn_unit<1>(p, l, combo >> 2, combo & 3, qb, lds, lam, lam_init, rep < NREP(4) ? PROBE_PM : 0);
                    else att::attn_unit<0>(p, l, (combo - 16) >> 2, (combo - 16) & 3, qb, lds, 0.f, 0.f, rep < NREP(4) ? PROBE_PM : 0);
                } else { const int v = qx * 64 + (u - 128); att::sgu_unit(p, l, v >> 2, v & 3, lds); }
            }
        }
        SEAM(pb + 4);
        if (EN(5) && IN(pb + 5)) for (int rep = 0; rep <= NREP(5); ++rep) {
            const bool prb = rep < NREP(5);
            pg8::ProbGen g{(const bf16*)(ws + WS_OC), (const bf16*)(wl + WO_B), 1536, 1536, 1536}; pg8::StaticOrder S; S.init(T, DM, G, bx);
            if (prb && (PROBE_PM & 2)) { g.A = HB; g.lda = DM; }
            if (prb && (PROBE_PM & 4)) { g.Bt = (const bf16*)(wl + WO_CAT); g.ldb = DM; }
            pg8::EpiMG E{prb ? (bf16*)(ws + WS_QR) : (bf16*)(ws + WS_MG), Gt, (prb && (PROBE_PM & 1)) ? 1 : 0};
            if (prb && (PROBE_PM & 8)) { pg8::EpiDelta E2{(bf16*)(ws + WS_QR)}; pg8::gemm_phase<pg8::EpiDelta, pg8::ProbGen, pg8::StaticOrder>(lds, g, S, E2); }
            else pg8::gemm_phase<pg8::EpiMG, pg8::ProbGen, pg8::StaticOrder>(lds, g, S, E);
        }
        SEAM(pb + 5);
        if (EN(6) && IN(pb + 6)) for (int rep = 0; rep <= NREP(6); ++rep) {
            pg8::ProbGen g{(const bf16*)(ws + WS_MG), (const bf16*)(wl + WO_OUT), DM, DM, DM}; pg8::StaticOrder S; S.init(T, DM, G, bx);
            pg8::EpiDelta E{(bf16*)(ws + WS_QR)};
            pg8::gemm_phase<pg8::EpiDelta, pg8::ProbGen, pg8::StaticOrder>(lds, g, S, E);
        }
        SEAM(pb + 6);
        if (EN(7) && IN(pb + 7)) { int ln = lane; asm volatile("" : "+v"(ln));
            const float* xin = l == 0 ? p.in[0] : p.out;
            for (int t = gw; t < T; t += ngw) add_rms_row(xin + (size_t)t * DM, (const bf16*)(ws + WS_QR) + (size_t)t * DM, RESID_IN_PEER ? nullptr : p.out + (size_t)t * DM, p.in[19] + (size_t)l * DM, HB + (size_t)t * DM, ln); }
        SEAM(pb + 7);
        if (EN(8) && IN(pb + 8)) for (int rep = 0; rep <= NREP(8); ++rep) {
            pg8::ProbGen g{HB, (const bf16*)(wl + WO_PQ), DM, DM, DM}; pg8::StaticOrder S; S.init(T, DM, G, bx);
            pg8::EpiSC E{(float*)(ws + WS_SC)};
            pg8::gemm_phase<pg8::EpiSC, pg8::ProbGen, pg8::StaticOrder>(lds, g, S, E);
        }
        SEAM(pb + 8);
        if (EN(9) && IN(pb + 9)) for (int rep = 0; rep <= NREP(9); ++rep) { int ln = lane; asm volatile("" : "+v"(ln));
            for (int task = gw; task < T * 8 / 64; task += ngw) { const int th = task * 64 + ln;
                topk_lane((const float*)(ws + WS_SC) + (size_t)th * 256, (int*)(ws + WS_IDX) + (size_t)th * 16, (float*)(ws + WS_GW) + (size_t)th * 16); } }
        SEAM(pb + 9);
        if (EN(10) && IN(pb + 10)) { int ln = lane; asm volatile("" : "+v"(ln));
            const float* gn = l + 1 < DEPTH ? p.in[1] + (size_t)(l + 1) * DM : nullptr;
            for (int rep = 0; rep <= NREP(10); ++rep) { const bool dummy = rep < NREP(10);
                const float* xin = (RESID_IN_PEER && l == 0) ? p.in[0] : p.out;
                if (dummy) peer_wave<PROBE_PM != 0>(p, l, gw, ngw, ln, nullptr, xin, (float*)(ws + WS_SC)); else peer_wave<false>(p, l, gw, ngw, ln, gn, xin, p.out); } }
        SEAM(pb + 10);
        }
    { constexpr int l = 1;
        const int pb = 1 + 11 * l;
        unsigned char* wl = ws + WS_W + (size_t)l * W_LAYER;
        bf16* HB = (bf16*)(ws + WS_HB); bf16* Z = (bf16*)(ws + WS_Z); bf16* Gt = (bf16*)(ws + WS_G);
        if (EN(0) && IN(pb + 0)) for (int rep = 0; rep <= NREP(0); ++rep) {
            { pg8::ProbGen g{HB, (const bf16*)(wl + WO_CAT), DM, DM, DM}; pg8::StaticOrder S; S.init(T, ZP, G, bx);
              pg8::EpiZG E{Z, Gt, p.in[16] + (size_t)l * NGATE, 1};
              pg8::gemm_phase<pg8::EpiZG, pg8::ProbGen, pg8::StaticOrder>(lds, g, S, E); }
            {
              const unsigned* gmax = (const unsigned*)(ws + WS_CTL) + CW_GMAX + 64 * 3 * l;
              pg8::ProbGen g{(const bf16*)(ws + WS_HB8), (const bf16*)(ws + WS_WG8 + (size_t)l * NGATE * DM), DM / 2, DM / 2, DM / 2}; pg8::StaticOrder S; S.init(T, NGATE, G, bx);
              pg8::EpiG8 E{Gt, p.in[16] + (size_t)l * NGATE, gmax};
              pg8::gemm_phase<pg8::EpiG8, pg8::ProbGen, pg8::StaticOrder, true, true>(lds, g, S, E); }
        }
        SEAM(pb + 0);
        if (EN(1) && IN(pb + 1)) { int ln = lane; asm volatile("" : "+v"(ln)); for (int t = gw; t < T; t += ngw) prep1_row(p, l, t, ln); }
        SEAM(pb + 1);
        if (EN(2) && IN(pb + 2)) for (int rep = 0; rep <= NREP(2); ++rep) {
            pg8::ProbUp g{Z, (const bf16*)(wl + WO_UP), ZP, 512, 512}; pg8::StaticOrder S; S.init(T, 1792, G, bx);
            pg8::EpiUp E{(bf16*)(ws + WS_QR), (bf16*)(ws + WS_KVR)};
            pg8::gemm_phase<pg8::EpiUp, pg8::ProbUp, pg8::StaticOrder>(lds, g, S, E);
        }
        SEAM(pb + 2);
        if (EN(3) && IN(pb + 3)) for (int rep = 0; rep <= NREP(3); ++rep) { int ln = lane; asm volatile("" : "+v"(ln)); for (int t = gw; t < T; t += ngw) prep2_row(p, l, t, ln); }
        SEAM(pb + 3);
        if (EN(4) && IN(pb + 4)) for (int rep = 0; rep <= NREP(4); ++rep) {
            const float lam = diff_lambda(p, l, lane), lam_init = 0.8f - 0.6f * expf(-0.3f * (float)l);
            unsigned* qbase = (unsigned*)(ws + WS_CTL) + 64 * (1 + 8 * l + 16 * rep);
            int qs = 0;
            for (;;) {
                __syncthreads();
                if (tid == 0) { int u = 192, qx = 0;
                    while (qs < 8) { qx = (int)((bar.x + (unsigned)qs) & 7u); u = (int)atomicAdd(qbase + 64 * qx, 1u); if (u < 192) break; ++qs; }
                    MISC[16] = (unsigned)(qs < 8 ? u : 192); MISC[17] = (unsigned)qx; MISC[18] = (unsigned)qs; }
                __syncthreads();
                const int u = (int)MISC[16], qx = (int)MISC[17]; qs = (int)MISC[18];
                if (u >= 192) break;
                if (u < 128) { const int qb = 31 - (u >> 2), combo = qx + 8 * (u & 3);
                    if (combo < 16) att::attn_unit<1>(p, l, combo >> 2, combo & 3, qb, lds, lam, lam_init, rep < NREP(4) ? PROBE_PM : 0);
                    else att::attn_unit<0>(p, l, (combo - 16) >> 2, (combo - 16) & 3, qb, lds, 0.f, 0.f, rep < NREP(4) ? PROBE_PM : 0);
                } else { const int v = qx * 64 + (u - 128); att::sgu_unit(p, l, v >> 2, v & 3, lds); }
            }
        }
        SEAM(pb + 4);
        if (EN(5) && IN(pb + 5)) for (int rep = 0; rep <= NREP(5); ++rep) {
            const bool prb = rep < NREP(5);
            pg8::ProbGen g{(const bf16*)(ws + WS_OC), (const bf16*)(wl + WO_B), 1536, 1536, 1536}; pg8::StaticOrder S; S.init(T, DM, G, bx);
            if (prb && (PROBE_PM & 2)) { g.A = HB; g.lda = DM; }
            if (prb && (PROBE_PM & 4)) { g.Bt = (const bf16*)(wl + WO_CAT); g.ldb = DM; }
            pg8::EpiMG E{prb ? (bf16*)(ws + WS_QR) : (bf16*)(ws + WS_MG), Gt, (prb && (PROBE_PM & 1)) ? 1 : 0};
            if (prb && (PROBE_PM & 8)) { pg8::EpiDelta E2{(bf16*)(ws + WS_QR)}; pg8::gemm_phase<pg8::EpiDelta, pg8::ProbGen, pg8::StaticOrder>(lds, g, S, E2); }
            else pg8::gemm_phase<pg8::EpiMG, pg8::ProbGen, pg8::StaticOrder>(lds, g, S, E);
        }
        SEAM(pb + 5);
        if (EN(6) && IN(pb + 6)) for (int rep = 0; rep <= NREP(6); ++rep) {
            pg8::ProbGen g{(const bf16*)(ws + WS_MG), (const bf16*)(wl + WO_OUT), DM, DM, DM}; pg8::StaticOrder S; S.init(T, DM, G, bx);
            pg8::EpiDelta E{(bf16*)(ws + WS_QR)};
            pg8::gemm_phase<pg8::EpiDelta, pg8::ProbGen, pg8::StaticOrder>(lds, g, S, E);
        }
        SEAM(pb + 6);
        if (EN(7) && IN(pb + 7)) { int ln = lane; asm volatile("" : "+v"(ln));
            const float* xin = l == 0 ? p.in[0] : p.out;
            for (int t = gw; t < T; t += ngw) add_rms_row(xin + (size_t)t * DM, (const bf16*)(ws + WS_QR) + (size_t)t * DM, RESID_IN_PEER ? nullptr : p.out + (size_t)t * DM, p.in[19] + (size_t)l * DM, HB + (size_t)t * DM, ln); }
        SEAM(pb + 7);
        if (EN(8) && IN(pb + 8)) for (int rep = 0; rep <= NREP(8); ++rep) {
            pg8::ProbGen g{HB, (const bf16*)(wl + WO_PQ), DM, DM, DM}; pg8::StaticOrder S; S.init(T, DM, G, bx);
            pg8::EpiSC E{(float*)(ws + WS_SC)};
            pg8::gemm_phase<pg8::EpiSC, pg8::ProbGen, pg8::StaticOrder>(lds, g, S, E);
        }
        SEAM(pb + 8);
        if (EN(9) && IN(pb + 9)) for (int rep = 0; rep <= NREP(9); ++rep) { int ln = lane; asm volatile("" : "+v"(ln));
            for (int task = gw; task < T * 8 / 64; task += ngw) { const int th = task * 64 + ln;
                topk_lane((const float*)(ws + WS_SC) + (size_t)th * 256, (int*)(ws + WS_IDX) + (size_t)th * 16, (float*)(ws + WS_GW) + (size_t)th * 16); } }
        SEAM(pb + 9);
        if (EN(10) && IN(pb + 10)) { int ln = lane; asm volatile("" : "+v"(ln));
            const float* gn = l + 1 < DEPTH ? p.in[1] + (size_t)(l + 1) * DM : nullptr;
            for (int rep = 0; rep <= NREP(10); ++rep) { const bool dummy = rep < NREP(10);
                const float* xin = (RESID_IN_PEER && l == 0) ? p.in[0] : p.out;
                if (dummy) peer_wave<PROBE_PM != 0>(p, l, gw, ngw, ln, nullptr, xin, (float*)(ws + WS_SC)); else peer_wave<false>(p, l, gw, ngw, ln, gn, xin, p.out); } }
        SEAM(pb + 10);
        }
#undef IN
#undef SEAM
}

static int g_grid = 0;
static void launch_mega(const Params& p, int lo, int hi, int li, hipStream_t stream) {
    MArgs a{}; a.p = p; a.ph_lo = lo; a.ph_hi = hi; a.li = li; a.pad = 0;
    mega<<<g_grid, 512, LDS_BYTES, stream>>>(a);
}
extern "C" void kernel_launch(void* const* d_in, const int* in_sizes, int n_in, void* d_out, int out_size, void* d_ws, size_t ws_size, hipStream_t stream) {
    if (n_in != 24 || out_size != T * DM || ws_size < WS_END) { fprintf(stderr, "kernel_launch: unexpected shapes (n_in %d, out %d, ws %zu, need %zu)\n", n_in, out_size, ws_size, (size_t)WS_END); return; }
    if (g_grid == 0) {
        int dev = 0, cus = 0, per_cu = 0;
        if (hipGetDevice(&dev) != hipSuccess || hipDeviceGetAttribute(&cus, hipDeviceAttributeMultiprocessorCount, dev) != hipSuccess) { g_grid = -1; return; }
        if (hipFuncSetAttribute((const void*)mega, hipFuncAttributeMaxDynamicSharedMemorySize, LDS_BYTES) != hipSuccess) { fprintf(stderr, "kernel_launch: hipFuncSetAttribute failed\n"); g_grid = -1; return; }
        if (hipOccupancyMaxActiveBlocksPerMultiprocessor(&per_cu, (const void*)mega, 512, LDS_BYTES) != hipSuccess || per_cu < 1) { fprintf(stderr, "kernel_launch: occupancy query says %d\n", per_cu); }
        (void)hipGetLastError();
        g_grid = cus;
    }
    if (g_grid < 0) return;
    Params p{};
    for (int i = 0; i < 24; ++i) p.in[i] = (const float*)d_in[i];
    p.out = (float*)d_out; p.ws = (unsigned char*)d_ws;
    unsigned char* ws = p.ws;
    (void)hipMemsetAsync(ws + WS_CTL, 0, 1 * MiB, stream);
    launch_mega(p, 0, NPHASE, 0, stream);
}
```

```cpp
#include <hip/hip_runtime.h>
#include <cstdio>
#include <cstdint>
#ifndef RESID_IN_PEER
#define RESID_IN_PEER 0
#endif

constexpr int BATCH = 4, SEQ = 4096, DM = 2048, DEPTH = 2;
constexpr int T = BATCH * SEQ;
constexpr int ZP = 3840;
constexpr int NGATE = 3 * DM;
constexpr int N1 = ZP + NGATE;
constexpr int ZC_CQ = 0, ZC_CKV = 512, ZC_DQ = 1024, ZC_DK = 1536, ZC_DV = 2048, ZC_SU = 2560, ZC_SV = 3072, ZC_KR = 3584;
constexpr int DIN = 3616;
constexpr int NEXP = 16384;
constexpr float NORM_EPS = 1e-6f;
constexpr float LOG2E = 1.4426950408889634f;

typedef unsigned short bf16;
typedef unsigned u32x4 __attribute__((ext_vector_type(4)));
typedef unsigned u32x2 __attribute__((ext_vector_type(2)));
typedef float f32x4 __attribute__((ext_vector_type(4)));
typedef float f32x16 __attribute__((ext_vector_type(16)));
typedef short bf16x8 __attribute__((ext_vector_type(8)));
#define LAS __attribute__((address_space(3)))

constexpr size_t MiB = 1u << 20;
constexpr size_t WS_CTL = 0;
constexpr size_t WS_ROPE = 1 * MiB;
constexpr size_t WS_W = 2 * MiB;
constexpr size_t WO_CAT = 0;
constexpr size_t WO_UP = WO_CAT + (size_t)N1 * DM * 2;
constexpr size_t WO_B = WO_UP + (size_t)1792 * 512 * 2;
constexpr size_t WO_OUT = WO_B + (size_t)3 * DM * 512 * 2;
constexpr size_t WO_PQ = WO_OUT + (size_t)DM * DM * 2;
constexpr size_t WO_SGU = WO_PQ + (size_t)DM * DM * 2;
constexpr size_t W_LAYER = WO_SGU + (size_t)4 * 128 * 128 * 2;
constexpr size_t WS_ACT = WS_W + 2 * W_LAYER + (2 * MiB - (2 * W_LAYER) % (2 * MiB));
constexpr size_t WS_HB = WS_ACT;
constexpr size_t WS_Z = WS_HB + (size_t)T * DM * 2;
constexpr size_t WS_G = WS_Z + (size_t)T * ZP * 2;
constexpr size_t WS_SC = WS_G;
constexpr size_t WS_QR = WS_G + (size_t)T * NGATE * 2;
constexpr size_t WS_KVR = WS_QR + (size_t)T * 768 * 2;
constexpr size_t WS_QM = WS_KVR + (size_t)T * 1024 * 2;
constexpr size_t WS_KM = WS_QM + (size_t)T * 768 * 2;
constexpr size_t WS_OC = WS_KM + (size_t)T * 768 * 2;
constexpr size_t WS_MG = WS_OC + (size_t)3 * T * 512 * 2;
constexpr size_t WS_IDX = WS_MG + (size_t)T * DM * 2;
constexpr size_t WS_GW = WS_IDX + (size_t)T * 128 * 4;
constexpr int QROW = DM / 2;
constexpr size_t WS_U8 = WS_GW + (size_t)T * 128 * 4;
constexpr size_t WS_V8 = WS_U8 + (size_t)DEPTH * NEXP * QROW;
constexpr size_t WS_PS = WS_V8 + (size_t)DEPTH * NEXP * QROW;
constexpr size_t WS_HB8 = WS_PS + (size_t)2 * DEPTH * NEXP * 4;
constexpr size_t WS_WG8 = WS_HB8 + (size_t)T * DM;
constexpr size_t WS_END = WS_WG8 + (size_t)DEPTH * NGATE * DM;
constexpr int CW_GMAX = 3072;

struct Params {
    const float* in[24];
    float* out;
    unsigned char* ws;
};

__device__ __forceinline__ unsigned f2bf(float f) { unsigned u = __builtin_bit_cast(unsigned, f); return (u + 0x7fffu + ((u >> 16) & 1u)) >> 16; }
__device__ __forceinline__ unsigned pk2(float lo, float hi) { return f2bf(lo) | (f2bf(hi) << 16); }
__device__ __forceinline__ float bf2f(unsigned b) { return __builtin_bit_cast(float, b << 16); }
__device__ __forceinline__ float bflo(unsigned w) { return __builtin_bit_cast(float, w << 16); }
__device__ __forceinline__ float bfhi(unsigned w) { return __builtin_bit_cast(float, w & 0xffff0000u); }
__device__ __forceinline__ unsigned pk4_fp8(float a, float b, float c, float d) { int w = __builtin_amdgcn_cvt_pk_fp8_f32(a, b, 0, false); w = __builtin_amdgcn_cvt_pk_fp8_f32(c, d, w, true); return (unsigned)w; }
__device__ __forceinline__ float wave_sum(float v) {
#pragma unroll
    for (int o = 1; o < 64; o <<= 1) v += __shfl_xor(v, o);
    return v;
}
__device__ __forceinline__ float gelu_tanh(float x) {
    const float u = 0.7978845608028654f * (x + 0.044715f * x * x * x);
    const float e = __expf(-2.0f * fabsf(u));
    float th = (1.0f - e) / (1.0f + e);
    th = u < 0.f ? -th : th;
    return 0.5f * x * (1.0f + th);
}
__device__ __forceinline__ void unpack8(const u32x4 w, float (&f)[8]) {
    f[0] = bflo(w.x); f[1] = bfhi(w.x); f[2] = bflo(w.y); f[3] = bfhi(w.y); f[4] = bflo(w.z); f[5] = bfhi(w.z); f[6] = bflo(w.w); f[7] = bfhi(w.w);
}
__device__ __forceinline__ u32x4 pack8(const float (&f)[8]) {
    u32x4 w; w.x = pk2(f[0], f[1]); w.y = pk2(f[2], f[3]); w.z = pk2(f[4], f[5]); w.w = pk2(f[6], f[7]); return w;
}

__device__ __forceinline__ void transpose_item(const float* __restrict__ W, int ldw, int scol0, int k0, int K, bf16* __restrict__ WT, int drow0, float* scr, int lane, int kd0 = -1) {
    if (kd0 < 0) kd0 = k0;
    float v[32];
    const float* src = W + (size_t)(k0 + (lane >> 5)) * ldw + scol0 + (lane & 31);
#pragma unroll
    for (int i = 0; i < 32; ++i) v[i] = src[(size_t)(2 * i) * ldw];
#pragma unroll
    for (int i = 0; i < 32; ++i) scr[(2 * i + (lane >> 5)) * 33 + (lane & 31)] = v[i];
    asm volatile("s_waitcnt lgkmcnt(0)" ::: "memory");
    const int c = lane & 7;
#pragma unroll
    for (int j = 0; j < 4; ++j) { const int n = (lane >> 3) + 8 * j; const float* s = scr + (8 * c) * 33 + n;
        u32x4 o; o.x = pk2(s[0 * 33], s[1 * 33]); o.y = pk2(s[2 * 33], s[3 * 33]); o.z = pk2(s[4 * 33], s[5 * 33]); o.w = pk2(s[6 * 33], s[7 * 33]);
        *(u32x4*)(WT + (size_t)(drow0 + n) * K + kd0 + 8 * c) = o; }
    asm volatile("s_waitcnt lgkmcnt(0)" ::: "memory");
}

__device__ __forceinline__ void transpose_item8(const float* __restrict__ W, int ldw, int scol0, int k0, int K, unsigned char* __restrict__ WT, int drow0, float* scr, int lane, float sc) {
    float v[32];
    const float* src = W + (size_t)(k0 + (lane >> 5)) * ldw + scol0 + (lane & 31);
#pragma unroll
    for (int i = 0; i < 32; ++i) v[i] = src[(size_t)(2 * i) * ldw];
#pragma unroll
    for (int i = 0; i < 32; ++i) scr[(2 * i + (lane >> 5)) * 33 + (lane & 31)] = v[i] * sc;
    asm volatile("s_waitcnt lgkmcnt(0)" ::: "memory");
    const int c = lane & 7;
#pragma unroll
    for (int j = 0; j < 4; ++j) { const int n = (lane >> 3) + 8 * j; const float* s = scr + (8 * c) * 33 + n;
        u32x2 o; o.x = pk4_fp8(s[0 * 33], s[1 * 33], s[2 * 33], s[3 * 33]); o.y = pk4_fp8(s[4 * 33], s[5 * 33], s[6 * 33], s[7 * 33]);
        *(u32x2*)(WT + (size_t)(drow0 + n) * K + k0 + 8 * c) = o; }
    asm volatile("s_waitcnt lgkmcnt(0)" ::: "memory");
}
__device__ __forceinline__ float gate_scale(const unsigned* w) { const unsigned b = __hip_atomic_load(w, __ATOMIC_RELAXED, __HIP_MEMORY_SCOPE_AGENT); const int e = (int)((b >> 23) & 255u) - 126;
    const int k = 8 - e, kc = k < -100 ? -100 : (k > 100 ? 100 : k); return __builtin_bit_cast(float, (unsigned)(kc + 127) << 23); }
__device__ __forceinline__ void prologue_transposes(const Params& p, int l, float* scr, int gw, int ngw, int lane) {
    unsigned char* wl = p.ws + WS_W + (size_t)l * W_LAYER;
    bf16* Wcat = (bf16*)(wl + WO_CAT); bf16* Wup = (bf16*)(wl + WO_UP); bf16* Wb = (bf16*)(wl + WO_B); bf16* Wout = (bf16*)(wl + WO_OUT);
    const float* w_in = p.in[2] + (size_t)l * DM * DIN;
    const float* w_gate = p.in[15] + (size_t)l * 3 * DM * DM;
    const float* w_uq = p.in[5] + (size_t)l * 512 * 768;
    const float* w_ukv = p.in[6] + (size_t)l * 512 * 1024;
    const float* w_br = p.in[17] + (size_t)l * 3 * 512 * DM;
    const float* w_out = p.in[18] + (size_t)l * DM * DM;
    constexpr int I1 = 113 * 32, I2 = 3 * 64 * 32, I3 = 24 * 8, I4 = 32 * 8, I5 = 3 * 64 * 8, I6 = 64 * 32;
    constexpr int NIT = I1 + I2 + I3 + I4 + I5 + I6;
    for (int it = gw; it < NIT; it += ngw) {
        int r = it;
        if (r < I1) { const int cb = r / 32, kb = r % 32; const int n0 = cb * 32;
            const int sc = n0 < 1024 ? n0 : (n0 < 3584 ? n0 + 32 : n0 - 3584 + 1024);
            transpose_item(w_in, DIN, sc, kb * 64, DM, Wcat, n0, scr, lane); continue; } r -= I1;
        if (r < I2) { continue; } r -= I2;
        if (r < I3) { const int cb = r / 8, kb = r % 8;
            int sc, dr; if (cb < 16) { const int h = cb >> 1, hf = cb & 1; sc = h * 96 + 32 * hf; dr = h * 64 + 32 * hf; } else { const int h = cb - 16; sc = h * 96 + 64; dr = 512 + h * 32; }
            transpose_item(w_uq, 768, sc, kb * 64, 512, Wup, dr, scr, lane); continue; } r -= I3;
        if (r < I4) { const int cb = r / 8, kb = r % 8;
            const int v = cb >> 4, h = (cb & 15) >> 1, hf = cb & 1; const int sc = h * 128 + 64 * v + 32 * hf, dr = 768 + 512 * v + h * 64 + 32 * hf;
            transpose_item(w_ukv, 1024, sc, kb * 64, 512, Wup, dr, scr, lane); continue; } r -= I4;
        if (r < I5) { const int n = r / 512, q = r % 512, cb = q / 8, kb = q % 8;
            transpose_item(w_br + (size_t)n * 512 * DM, DM, cb * 32, kb * 64, 1536, Wb, cb * 32, scr, lane, n * 512 + kb * 64); continue; } r -= I5;
        { const int cb = r / 32, kb = r % 32; transpose_item(w_out, DM, cb * 32, kb * 64, DM, Wout, cb * 32, scr, lane); }
    }
    for (int i = gw * 64 + lane; i < 224 * 256; i += ngw * 64) { ((u32x4*)(Wcat + (size_t)DIN * DM))[i] = (u32x4){0u, 0u, 0u, 0u}; }
    bf16* sg = (bf16*)(wl + WO_SGU); const float* sw = p.in[13] + (size_t)l * 4 * 128 * 128;
    for (int i = gw * 64 + lane; i < 4 * 128 * 128; i += ngw * 64) { const int s = i & 127, t = (i >> 7) & 127; const bool ok = (s >> 6) <= (t >> 6); sg[i] = (bf16)f2bf(ok ? sw[i] : 0.f); }
}

__device__ __forceinline__ void prologue_rope(const Params& p, int gtid, int nthr) {
    float* tab = (float*)(p.ws + WS_ROPE);
    for (int i = gtid; i < SEQ * 24; i += nthr) {
        const int pos = i / 24, j = i % 24;
        const int jj = j < 8 ? 2 * j : j - 8;
        float invf;
        switch (jj) { case 0: invf = 1.000000000e+00f; break; case 1: invf = 4.403665960e-01f; break; case 2: invf = 1.939227432e-01f; break; case 3: invf = 8.539710194e-02f; break;
            case 4: invf = 3.760603070e-02f; break; case 5: invf = 1.656044088e-02f; break; case 6: invf = 7.292664610e-03f; break; case 7: invf = 3.211446106e-03f; break;
            case 8: invf = 1.414213562e-03f; break; case 9: invf = 6.227724371e-04f; break; case 10: invf = 2.742481884e-04f; break; case 11: invf = 1.207697351e-04f; break;
            case 12: invf = 5.318295734e-05f; break; case 13: invf = 2.341999971e-05f; break; case 14: invf = 1.031338525e-05f; break; default: invf = 4.541670478e-06f; break; }
        int co, so; if (j < 8) { co = j; so = 8 + j; } else { co = 16 + (j - 8); so = 32 + (j - 8); }
        const float ang = (float)pos * invf; float sn, cs; sincosf(ang, &sn, &cs);
        tab[pos * 48 + co] = cs; tab[pos * 48 + so] = sn;
    }
}

__device__ __forceinline__ void fold_item(const Params& p, int l, int item, float* lds, int tid) {
    const int hc = item >> 4, mt = item & 15, c = hc & 1, m0 = mt * 128;
    const float* Wq = p.in[20] + (size_t)l * DM * DM; const float* keys = p.in[21] + (size_t)l * 2 * 128 * 128 + (size_t)c * 128 * 128;
    bf16* WPQ = (bf16*)(p.ws + WS_W + (size_t)l * W_LAYER + WO_PQ);
    float* As = lds; float* Bs = lds + 128 * 68;
    const int tn = tid & 31, tm = tid >> 5;
    float acc[4][8];
#pragma unroll
    for (int i = 0; i < 4; ++i)
#pragma unroll
        for (int j = 0; j < 8; ++j) acc[i][j] = 0.f;
    for (int dh = 0; dh < 2; ++dh) {
        __syncthreads();
        for (int i = tid; i < 128 * 16; i += 512) { const int r = i >> 4, q = i & 15;
            *(f32x4*)(As + r * 68 + 4 * q) = *(const f32x4*)(Wq + (size_t)(m0 + r) * DM + hc * 128 + dh * 64 + 4 * q);
            *(f32x4*)(Bs + r * 68 + 4 * q) = *(const f32x4*)(keys + r * 128 + dh * 64 + 4 * q); }
        __syncthreads();
#pragma unroll 2
        for (int d = 0; d < 64; d += 4) {
            f32x4 b4[4], a4[8];
#pragma unroll
            for (int i = 0; i < 4; ++i) b4[i] = *(const f32x4*)(Bs + (tn + 32 * i) * 68 + d);
#pragma unroll
            for (int j = 0; j < 8; ++j) a4[j] = *(const f32x4*)(As + (8 * tm + j) * 68 + d);
#pragma unroll
            for (int i = 0; i < 4; ++i)
#pragma unroll
                for (int j = 0; j < 8; ++j) acc[i][j] += (b4[i].x * a4[j].x + b4[i].y * a4[j].y) + (b4[i].z * a4[j].z + b4[i].w * a4[j].w);
        }
    }
#pragma unroll
    for (int i = 0; i < 4; ++i) *(u32x4*)(WPQ + (size_t)(hc * 128 + tn + 32 * i) * DM + m0 + 8 * tm) = pack8(acc[i]);
}

__device__ __forceinline__ void rms_row_to_bf16(const float* xrow, const float* gain, bf16* orow, int lane, unsigned char* o8 = nullptr) {
    f32x4 v[8]; float s = 0.f;
#pragma unroll
    for (int j = 0; j < 8; ++j) { v[j] = ((const f32x4*)xrow)[lane + 64 * j]; s += (v[j].x * v[j].x + v[j].y * v[j].y) + (v[j].z * v[j].z + v[j].w * v[j].w); }
    const float rstd = rsqrtf(wave_sum(s) * (1.f / DM) + NORM_EPS);
#pragma unroll
    for (int j = 0; j < 8; ++j) { const f32x4 g = ((const f32x4*)gain)[lane + 64 * j];
        u32x2 o; o.x = pk2(v[j].x * rstd * g.x, v[j].y * rstd * g.y); o.y = pk2(v[j].z * rstd * g.z, v[j].w * rstd * g.w);
        ((u32x2*)orow)[lane + 64 * j] = o;
        if (o8) ((unsigned*)o8)[lane + 64 * j] = pk4_fp8(v[j].x * rstd * g.x, v[j].y * rstd * g.y, v[j].z * rstd * g.z, v[j].w * rstd * g.w); }
}

__device__ __forceinline__ void add_rms_row(const float* xin, const bf16* dl, float* xout, const float* gain, bf16* orow, int lane) {
    f32x4 v[8]; float s = 0.f;
#pragma unroll
    for (int j = 0; j < 8; ++j) { v[j] = ((const f32x4*)xin)[lane + 64 * j]; const u32x2 d = ((const u32x2*)dl)[lane + 64 * j];
        v[j].x += bflo(d.x); v[j].y += bfhi(d.x); v[j].z += bflo(d.y); v[j].w += bfhi(d.y);
        if (xout) ((f32x4*)xout)[lane + 64 * j] = v[j];
        s += (v[j].x * v[j].x + v[j].y * v[j].y) + (v[j].z * v[j].z + v[j].w * v[j].w); }
    const float rstd = rsqrtf(wave_sum(s) * (1.f / DM) + NORM_EPS);
#pragma unroll
    for (int j = 0; j < 8; ++j) { const f32x4 g = ((const f32x4*)gain)[lane + 64 * j];
        u32x2 o; o.x = pk2(v[j].x * rstd * g.x, v[j].y * rstd * g.y); o.y = pk2(v[j].z * rstd * g.z, v[j].w * rstd * g.w);
        ((u32x2*)orow)[lane + 64 * j] = o; }
}

__device__ __forceinline__ void prep1_row(const Params& p, int l, int t, int lane) {
    bf16* z = (bf16*)(p.ws + WS_Z) + (size_t)t * ZP;
    const float* rope = (const float*)(p.ws + WS_ROPE) + (size_t)(t & (SEQ - 1)) * 48;
    float f[8];
#pragma unroll
    for (int seg = 0; seg < 2; ++seg) {
        const float* g = (seg == 0 ? p.in[3] : p.in[4]) + (size_t)l * 512;
        u32x4* ptr = (u32x4*)(z + (seg == 0 ? ZC_CQ : ZC_CKV)) + lane;
        unpack8(*ptr, f); float s = 0.f;
#pragma unroll
        for (int i = 0; i < 8; ++i) s += f[i] * f[i];
        const float rstd = rsqrtf(wave_sum(s) * (1.f / 512.f) + NORM_EPS);
#pragma unroll
        for (int i = 0; i < 8; ++i) f[i] = f[i] * rstd * g[lane * 8 + i];
        *ptr = pack8(f);
    }
#pragma unroll
    for (int seg = 0; seg < 2; ++seg) {
        const float* g = p.in[9] + (size_t)l * 128 + seg * 64;
        u32x4* ptr = (u32x4*)(z + (seg == 0 ? ZC_DQ : ZC_DK)) + lane;
        unpack8(*ptr, f); float s = 0.f;
#pragma unroll
        for (int i = 0; i < 8; ++i) s += f[i] * f[i];
        s += __shfl_xor(s, 1); s += __shfl_xor(s, 2); s += __shfl_xor(s, 4);
        const float rstd = rsqrtf(s * (1.f / 64.f) + NORM_EPS);
        const int d0 = (lane & 7) * 8;
#pragma unroll
        for (int i = 0; i < 8; ++i) f[i] = f[i] * rstd * g[d0 + i];
        float o[8];
#pragma unroll
        for (int i = 0; i < 8; ++i) o[i] = __shfl_xor(f[i], 1);
        if ((lane & 7) == 0) {
#pragma unroll
            for (int i = 0; i < 8; ++i) f[i] = f[i] * rope[i] - o[i] * rope[8 + i];
        } else if ((lane & 7) == 1) {
#pragma unroll
            for (int i = 0; i < 8; ++i) f[i] = f[i] * rope[i] + o[i] * rope[8 + i];
        }
        if (seg == 0) {
#pragma unroll
            for (int i = 0; i < 8; ++i) f[i] *= 0.125f * LOG2E;
        }
        *ptr = pack8(f);
    }
    {
        u32x4* ptr = (u32x4*)(z + ZC_SU) + lane;
        unpack8(*ptr, f);
#pragma unroll
        for (int i = 0; i < 8; ++i) f[i] = gelu_tanh(f[i]);
        *ptr = pack8(f);
    }
    {
        const float* g = p.in[12] + (size_t)l * 512;
        u32x4* ptr = (u32x4*)(z + ZC_SV) + lane;
        unpack8(*ptr, f); float s = 0.f;
#pragma unroll
        for (int i = 0; i < 8; ++i) { f[i] = gelu_tanh(f[i]); s += f[i] * f[i]; }
        const float rstd = rsqrtf(wave_sum(s) * (1.f / 512.f) + NORM_EPS);
#pragma unroll
        for (int i = 0; i < 8; ++i) f[i] = f[i] * rstd * g[lane * 8 + i];
        *ptr = pack8(f);
    }
    {
        const float* g = p.in[8] + (size_t)l * 64 + 32;
        const int ll = lane & 3;
        const u32x4 w = *((const u32x4*)(z + ZC_KR) + ll);
        unpack8(w, f); float s = 0.f;
#pragma unroll
        for (int i = 0; i < 8; ++i) s += f[i] * f[i];
        s += __shfl_xor(s, 1); s += __shfl_xor(s, 2);
        const float rstd = rsqrtf(s * (1.f / 32.f) + NORM_EPS);
#pragma unroll
        for (int i = 0; i < 8; ++i) f[i] = f[i] * rstd * g[ll * 8 + i];
        float o[8];
#pragma unroll
        for (int i = 0; i < 8; ++i) o[i] = __shfl_xor(f[i], 2);
        const int fi = (ll & 1) * 8;
        if (ll < 2) {
#pragma unroll
            for (int i = 0; i < 8; ++i) f[i] = f[i] * rope[16 + fi + i] - o[i] * rope[32 + fi + i];
        } else {
#pragma unroll
            for (int i = 0; i < 8; ++i) f[i] = f[i] * rope[16 + fi + i] + o[i] * rope[32 + fi + i];
        }
        if (lane < 32) { bf16* km = (bf16*)(p.ws + WS_KM) + (size_t)t * 768 + (lane >> 2) * 96 + 64 + ll * 8; *(u32x4*)km = pack8(f); }
    }
}

__device__ __forceinline__ void prep2_row(const Params& p, int l, int t, int lane) {
    const bf16* qr = (const bf16*)(p.ws + WS_QR) + (size_t)t * 768;
    const bf16* kvr = (const bf16*)(p.ws + WS_KVR) + (size_t)t * 1024;
    bf16* qm = (bf16*)(p.ws + WS_QM) + (size_t)t * 768;
    bf16* km = (bf16*)(p.ws + WS_KM) + (size_t)t * 768;
    const float* rope = (const float*)(p.ws + WS_ROPE) + (size_t)(t & (SEQ - 1)) * 48;
    const float* ng = p.in[7] + (size_t)l * 128;
    const float* rg = p.in[8] + (size_t)l * 64;
    const float qscale = 0.10206207261596577f * LOG2E;
    float f[8];
    const int h = lane >> 3, d0 = (lane & 7) * 8;
    {
        unpack8(*((const u32x4*)qr + lane), f); float s = 0.f;
#pragma unroll
        for (int i = 0; i < 8; ++i) s += f[i] * f[i];
        s += __shfl_xor(s, 1); s += __shfl_xor(s, 2); s += __shfl_xor(s, 4);
        const float rstd = rsqrtf(s * (1.f / 64.f) + NORM_EPS) * qscale;
#pragma unroll
        for (int i = 0; i < 8; ++i) f[i] = f[i] * rstd * ng[d0 + i];
        *(u32x4*)(qm + h * 96 + d0) = pack8(f);
    }
    {
        unpack8(*((const u32x4*)kvr + lane), f); float s = 0.f;
#pragma unroll
        for (int i = 0; i < 8; ++i) s += f[i] * f[i];
        s += __shfl_xor(s, 1); s += __shfl_xor(s, 2); s += __shfl_xor(s, 4);
        const float rstd = rsqrtf(s * (1.f / 64.f) + NORM_EPS);
#pragma unroll
        for (int i = 0; i < 8; ++i) f[i] = f[i] * rstd * ng[64 + d0 + i];
        *(u32x4*)(km + h * 96 + d0) = pack8(f);
    }
    {
        const int l5 = lane & 31, hh = l5 >> 2, ll = l5 & 3;
        unpack8(*((const u32x4*)(qr + 512) + l5), f); float s = 0.f;
#pragma unroll
        for (int i = 0; i < 8; ++i) s += f[i] * f[i];
        s += __shfl_xor(s, 1); s += __shfl_xor(s, 2);
        const float rstd = rsqrtf(s * (1.f / 32.f) + NORM_EPS);
#pragma unroll
        for (int i = 0; i < 8; ++i) f[i] = f[i] * rstd * rg[ll * 8 + i];
        float o[8];
#pragma unroll
        for (int i = 0; i < 8; ++i) o[i] = __shfl_xor(f[i], 2);
        const int fi = (ll & 1) * 8;
        if (ll < 2) {
#pragma unroll
            for (int i = 0; i < 8; ++i) f[i] = (f[i] * rope[16 + fi + i] - o[i] * rope[32 + fi + i]) * qscale;
        } else {
#pragma unroll
            for (int i = 0; i < 8; ++i) f[i] = (f[i] * rope[16 + fi + i] + o[i] * rope[32 + fi + i]) * qscale;
        }
        if (lane < 32) *(u32x4*)(qm + hh * 96 + 64 + ll * 8) = pack8(f);
    }
}

__device__ __forceinline__ float diff_lambda(const Params& p, int l, int lane) {
    const float* lv = p.in[10] + (size_t)l * 256;
    const float a = wave_sum(lv[lane] * lv[64 + lane]), b = wave_sum(lv[128 + lane] * lv[192 + lane]);
    const float lambda_init = 0.8f - 0.6f * expf(-0.3f * (float)l);
    return expf(a) - expf(b) + lambda_init;
}

typedef float f32x2 __attribute__((ext_vector_type(2)));
typedef _Float16 f16x32 __attribute__((ext_vector_type(32)));
typedef float f32x32 __attribute__((ext_vector_type(32)));
typedef unsigned u32x6 __attribute__((ext_vector_type(6)));
__device__ __forceinline__ void q4_row(const float* __restrict__ src, unsigned char* __restrict__ dst, float* scl, int lane) {
    f32x4 v[8]; float ss = 0.f;
#pragma unroll
    for (int j = 0; j < 8; ++j) { v[j] = ((const f32x4*)(src + 32 * lane))[j]; ss += (v[j].x * v[j].x + v[j].y * v[j].y) + (v[j].z * v[j].z + v[j].w * v[j].w); }
    const float sc = fmaxf(0.5f * sqrtf(wave_sum(ss) * (1.f / DM)), 1e-30f), is = 1.f / sc;
    u32x4 w;
#pragma unroll
    for (int d = 0; d < 4; ++d) { unsigned x = 0;
        const f32x4 a = v[2 * d], b = v[2 * d + 1];
        x = __builtin_amdgcn_cvt_scalef32_pk_fp4_f32(x, fminf(fmaxf(a.x * is, -6.f), 6.f), fminf(fmaxf(a.y * is, -6.f), 6.f), 1.0f, 0);
        x = __builtin_amdgcn_cvt_scalef32_pk_fp4_f32(x, fminf(fmaxf(a.z * is, -6.f), 6.f), fminf(fmaxf(a.w * is, -6.f), 6.f), 1.0f, 1);
        x = __builtin_amdgcn_cvt_scalef32_pk_fp4_f32(x, fminf(fmaxf(b.x * is, -6.f), 6.f), fminf(fmaxf(b.y * is, -6.f), 6.f), 1.0f, 2);
        x = __builtin_amdgcn_cvt_scalef32_pk_fp4_f32(x, fminf(fmaxf(b.z * is, -6.f), 6.f), fminf(fmaxf(b.w * is, -6.f), 6.f), 1.0f, 3);
        w[d] = x; }
    *(u32x4*)(dst + 16 * lane) = w;
    if (lane == 0) *scl = sc;
}
__device__ __forceinline__ void q4u_row(const float* __restrict__ src, unsigned char* __restrict__ dst, float* scl, int lane) {
    f32x4 v[8]; float ss = 0.f;
#pragma unroll
    for (int j = 0; j < 8; ++j) { v[j] = ((const f32x4*)(src + 32 * lane))[j]; ss += (v[j].x * v[j].x + v[j].y * v[j].y) + (v[j].z * v[j].z + v[j].w * v[j].w); }
    const float step = fmaxf(0.35f * sqrtf(wave_sum(ss) * (1.f / DM)), 1e-30f), is = 1.f / step;
    u32x4 w;
#pragma unroll
    for (int d = 0; d < 4; ++d) { unsigned x = 0;
#pragma unroll
        for (int e = 0; e < 8; ++e) { const float f = v[2 * d + (e >> 2)][e & 3]; const int q = (int)fminf(fmaxf(rintf(f * is), -8.f), 7.f) + 8; x |= (unsigned)q << (4 * e); }
        w[d] = x; }
    *(u32x4*)(dst + 16 * lane) = w;
    if (lane == 0) *scl = step;
}
__device__ __forceinline__ int f2key(float f) { const int b = __builtin_bit_cast(int, f); return b ^ ((b >> 31) & 0x7fffffff); }
__device__ __forceinline__ float key2f(int k) { const int b = k ^ ((k >> 31) & 0x7fffffff); return __builtin_bit_cast(float, b & ~127); }
__device__ __forceinline__ void topk_lane(const float* __restrict__ sc, int* __restrict__ idxo, float* __restrict__ gwo) {
    float av[2][16]; int ai[2][16];
#pragma unroll
    for (int c = 0; c < 2; ++c) {
        int lst[16];
#pragma unroll
        for (int j = 0; j < 16; ++j) lst[j] = (int)0x80000000;
#pragma unroll 1
        for (int i0 = 0; i0 < 128; i0 += 32) {
            f32x4 v[8];
#pragma unroll
            for (int q = 0; q < 8; ++q) v[q] = *(const f32x4*)(sc + c * 128 + i0 + 4 * q);
#pragma unroll
            for (int q = 0; q < 8; ++q)
#pragma unroll
                for (int e = 0; e < 4; ++e) { int key = (f2key(v[q][e]) & ~127) | (127 - (i0 + 4 * q + e));
#pragma unroll
                    for (int j = 0; j < 16; ++j) { const int hi = max(lst[j], key); key = min(lst[j], key); lst[j] = hi; } }
        }
#pragma unroll
        for (int j = 0; j < 16; ++j) { av[c][j] = key2f(lst[j]); ai[c][j] = 127 - (lst[j] & 127); }
    }
    float lv[16]; int lp[16];
#pragma unroll
    for (int j = 0; j < 16; ++j) { lv[j] = -INFINITY; lp[j] = 0; }
#pragma unroll
    for (int i = 0; i < 16; ++i)
#pragma unroll
        for (int jj = 0; jj < 16; ++jj) if ((i + 1) * (jj + 1) <= 16) {
            float sv = av[0][i] + av[1][jj]; int pay = ai[0][i] * 128 + ai[1][jj];
#pragma unroll
            for (int j = 0; j < 16; ++j) { const bool gt = sv > lv[j]; const float nv = gt ? sv : lv[j]; const int np = gt ? pay : lp[j]; sv = gt ? lv[j] : sv; pay = gt ? lp[j] : pay; lv[j] = nv; lp[j] = np; }
        }
    float sum = 0.f; const float mx = lv[0];
#pragma unroll
    for (int j = 0; j < 16; ++j) { lv[j] = __expf(lv[j] - mx); sum += lv[j]; }
    const float inv = 1.f / sum;
#pragma unroll
    for (int q = 0; q < 4; ++q) { *(u32x4*)(idxo + 4 * q) = (u32x4){(unsigned)lp[4 * q], (unsigned)lp[4 * q + 1], (unsigned)lp[4 * q + 2], (unsigned)lp[4 * q + 3]};
        *(f32x4*)(gwo + 4 * q) = (f32x4){lv[4 * q] * inv, lv[4 * q + 1] * inv, lv[4 * q + 2] * inv, lv[4 * q + 3] * inv}; }
}
__device__ __forceinline__ float dot_f4(const u32x4 a, const f32x2 (&h)[16]) {
    f32x2 s = {0.f, 0.f};
#pragma unroll
    for (int w = 0; w < 4; ++w) {
        s = __builtin_elementwise_fma(__builtin_amdgcn_cvt_scalef32_pk_f32_fp4(a[w], 1.0f, 0), h[4 * w], s); s = __builtin_elementwise_fma(__builtin_amdgcn_cvt_scalef32_pk_f32_fp4(a[w], 1.0f, 1), h[4 * w + 1], s);
        s = __builtin_elementwise_fma(__builtin_amdgcn_cvt_scalef32_pk_f32_fp4(a[w], 1.0f, 2), h[4 * w + 2], s); s = __builtin_elementwise_fma(__builtin_amdgcn_cvt_scalef32_pk_f32_fp4(a[w], 1.0f, 3), h[4 * w + 3], s); }
    return s.x + s.y;
}
__device__ __forceinline__ float dot_u4(const u32x4 a, const int (&he)[4], const int (&ho)[4]) {
    int acc = 0;
#pragma unroll
    for (int w = 0; w < 4; ++w) { acc = __builtin_amdgcn_sdot4((int)(a[w] & 0x0F0F0F0Fu), he[w], acc, false); acc = __builtin_amdgcn_sdot4((int)((a[w] >> 4) & 0x0F0F0F0Fu), ho[w], acc, false); }
    return (float)acc;
}
__device__ __forceinline__ void axpy_f4(const u32x4 a, float c, f32x2 (&o)[16]) {
    const f32x2 c2 = {c, c};
#pragma unroll
    for (int w = 0; w < 4; ++w) {
        o[4 * w] = __builtin_elementwise_fma(c2, __builtin_amdgcn_cvt_scalef32_pk_f32_fp4(a[w], 1.0f, 0), o[4 * w]); o[4 * w + 1] = __builtin_elementwise_fma(c2, __builtin_amdgcn_cvt_scalef32_pk_f32_fp4(a[w], 1.0f, 1), o[4 * w + 1]);
        o[4 * w + 2] = __builtin_elementwise_fma(c2, __builtin_amdgcn_cvt_scalef32_pk_f32_fp4(a[w], 1.0f, 2), o[4 * w + 2]); o[4 * w + 3] = __builtin_elementwise_fma(c2, __builtin_amdgcn_cvt_scalef32_pk_f32_fp4(a[w], 1.0f, 3), o[4 * w + 3]); }
}
template <int M, int N, int NP> __device__ __forceinline__ void rs_step_(float (&pr)[NP], int lane) {
    const bool up = (lane & M) != 0;
#pragma unroll
    for (int i = 0; i < N / 2; ++i) { const float keep = up ? pr[i + N / 2] : pr[i], send = up ? pr[i] : pr[i + N / 2]; pr[i] = keep + __shfl_xor(send, M); }
}
template <bool CHEAP = false> __device__ __forceinline__ void peer_wave(const Params& p, int l, int gw, int ngw, int lane, const float* gain_next, const float* xin, float* xout) {
    const __amdgpu_buffer_rsrc_t RU = __builtin_amdgcn_make_buffer_rsrc((void*)(p.ws + WS_U8 + (size_t)l * NEXP * QROW), 0, NEXP * QROW, 0x00020000);
    const __amdgpu_buffer_rsrc_t RV = __builtin_amdgcn_make_buffer_rsrc((void*)(p.ws + WS_V8 + (size_t)l * NEXP * QROW), 0, NEXP * QROW, 0x00020000);
    const float* PSU = (const float*)(p.ws + WS_PS) + (size_t)l * NEXP; const float* PSV = PSU + (size_t)DEPTH * NEXP;
    const int* IDX0 = (const int*)(p.ws + WS_IDX); const float* GW0 = (const float*)(p.ws + WS_GW);
    const int loff = 16 * lane, l15 = lane & 15;
    const int nsteps = gw < T ? ((T - gw + ngw - 1) / ngw) * 8 : 0;
    if (nsteps == 0) return;
    f32x2 o[16];
#pragma unroll
    for (int i = 0; i < 16; ++i) o[i] = (f32x2){0.f, 0.f};
    int he[4] = {0, 0, 0, 0}, ho[4] = {0, 0, 0, 0}; float hscale = 0.f, h8sum = 0.f;
    u32x4 bufA[8], bufB[8];
    int ig = IDX0[(size_t)gw * 128 + l15]; float gwv = GW0[(size_t)gw * 128 + l15];
    float su = PSU[ig], sv = PSV[ig];
#define PEER_ISSUE(dst, R, idxv, r0) do { _Pragma("unroll") for (int j = 0; j < 8; ++j) dst[j] = __builtin_amdgcn_raw_buffer_load_b128(R, loff, __builtin_amdgcn_readlane(idxv, (r0) + j) * QROW, 0); } while (0)
    PEER_ISSUE(bufA, RU, ig, 0);
#pragma unroll 1
    for (int s_ = 0; s_ < nsteps; ++s_) {
        const int t = gw + (s_ >> 3) * ngw, g = s_ & 7;
        const bool hasn = s_ + 1 < nsteps; const int sn = hasn ? s_ + 1 : s_; const int tn = gw + (sn >> 3) * ngw, gn = sn & 7;
        const int ign = IDX0[(size_t)tn * 128 + gn * 16 + l15]; const float gwn = GW0[(size_t)tn * 128 + gn * 16 + l15];
        bf16* hb = (bf16*)(p.ws + WS_HB) + (size_t)t * DM;
        if (g == 0) {
            float hf[32]; float mx = 0.f;
#pragma unroll
            for (int q = 0; q < 4; ++q) { const u32x4 w = *(const u32x4*)(hb + 32 * lane + 8 * q);
                hf[8 * q] = bflo(w.x); hf[8 * q + 1] = bfhi(w.x); hf[8 * q + 2] = bflo(w.y); hf[8 * q + 3] = bfhi(w.y); hf[8 * q + 4] = bflo(w.z); hf[8 * q + 5] = bfhi(w.z); hf[8 * q + 6] = bflo(w.w); hf[8 * q + 7] = bfhi(w.w); }
#pragma unroll
            for (int i = 0; i < 32; ++i) mx = fmaxf(mx, fabsf(hf[i]));
#pragma unroll
            for (int of = 1; of < 64; of <<= 1) mx = fmaxf(mx, __shfl_xor(mx, of));
            hscale = fmaxf(mx, 1e-30f) * (1.f / 127.f); const float ih = 1.f / hscale; int isum = 0;
#pragma unroll
            for (int w = 0; w < 4; ++w) { unsigned e = 0, od = 0;
#pragma unroll
                for (int j = 0; j < 4; ++j) { const int qe = (int)rintf(hf[8 * w + 2 * j] * ih), qo = (int)rintf(hf[8 * w + 2 * j + 1] * ih); isum += qe + qo; e |= (unsigned)(qe & 255) << (8 * j); od |= (unsigned)(qo & 255) << (8 * j); }
                he[w] = (int)e; ho[w] = (int)od; }
            h8sum = wave_sum((float)isum);
        }
        float pr[16];
        PEER_ISSUE(bufB, RU, ig, 8);
        __builtin_amdgcn_sched_barrier(0);
#pragma unroll
        for (int j = 0; j < 8; ++j) { if (CHEAP) { const u32x4 q_ = bufA[j]; pr[j] = __builtin_bit_cast(float, (q_.x ^ q_.y) + (q_.z ^ q_.w)); } else pr[j] = dot_u4(bufA[j], he, ho); __builtin_amdgcn_sched_barrier(0); }
        PEER_ISSUE(bufA, RV, ig, 0);
        __builtin_amdgcn_sched_barrier(0);
#pragma unroll
        for (int j = 0; j < 8; ++j) { if (CHEAP) { const u32x4 q_ = bufB[j]; pr[8 + j] = __builtin_bit_cast(float, (q_.x ^ q_.y) + (q_.z ^ q_.w)); } else pr[8 + j] = dot_u4(bufB[j], he, ho); __builtin_amdgcn_sched_barrier(0); }
        rs_step_<8, 16, 16>(pr, lane); rs_step_<4, 8, 16>(pr, lane); rs_step_<2, 4, 16>(pr, lane); rs_step_<1, 2, 16>(pr, lane);
        float tot = pr[0]; tot += __shfl_xor(tot, 16); tot += __shfl_xor(tot, 32);
        const float a = (tot - 8.f * h8sum) * su * hscale;
        const float coef = gwv * gelu_tanh(a) * sv; const int coefi = __builtin_bit_cast(int, coef);
        PEER_ISSUE(bufB, RV, ig, 8);
        __builtin_amdgcn_sched_barrier(0);
#pragma unroll
        for (int j = 0; j < 8; ++j) { if (CHEAP) { const u32x4 q_ = bufA[j]; o[j].x += __builtin_bit_cast(float, (q_.x ^ q_.y) + (q_.z ^ q_.w)); } else axpy_f4(bufA[j], __builtin_bit_cast(float, __builtin_amdgcn_readlane(coefi, j)), o); __builtin_amdgcn_sched_barrier(0); }
        const float sun = PSU[ign], svn = PSV[ign];
        PEER_ISSUE(bufA, RU, ign, 0);
        __builtin_amdgcn_sched_barrier(0);
#pragma unroll
        for (int j = 0; j < 8; ++j) { if (CHEAP) { const u32x4 q_ = bufB[j]; o[8 + j].x += __builtin_bit_cast(float, (q_.x ^ q_.y) + (q_.z ^ q_.w)); } else axpy_f4(bufB[j], __builtin_bit_cast(float, __builtin_amdgcn_readlane(coefi, 8 + j)), o); __builtin_amdgcn_sched_barrier(0); }
        if (g == 7) {
            const float* xr = xin + (size_t)t * DM + 32 * lane; float* xw = xout + (size_t)t * DM + 32 * lane; const bf16* dr = (const bf16*)(p.ws + WS_QR) + (size_t)t * DM + 32 * lane; float ss = 0.f;
#pragma unroll
            for (int q = 0; q < 8; ++q) { f32x4 x = *(const f32x4*)(xr + 4 * q); u32x2 d = {0u, 0u}; if (RESID_IN_PEER) d = *(const u32x2*)(dr + 4 * q);
                x.x += bflo(d.x) + o[2 * q].x; x.y += bfhi(d.x) + o[2 * q].y; x.z += bflo(d.y) + o[2 * q + 1].x; x.w += bfhi(d.y) + o[2 * q + 1].y; *(f32x4*)(xw + 4 * q) = x;
                o[2 * q] = (f32x2){x.x, x.y}; o[2 * q + 1] = (f32x2){x.z, x.w}; ss += (x.x * x.x + x.y * x.y) + (x.z * x.z + x.w * x.w); }
            if (gain_next) {
                const float rstd = rsqrtf(wave_sum(ss) * (1.f / DM) + NORM_EPS);
#pragma unroll
                for (int q = 0; q < 4; ++q) { const int e0 = 32 * lane + 8 * q; const f32x4 g0 = *(const f32x4*)(gain_next + e0), g1 = *(const f32x4*)(gain_next + e0 + 4);
                    u32x4 w; w.x = pk2(o[4 * q].x * rstd * g0.x, o[4 * q].y * rstd * g0.y); w.y = pk2(o[4 * q + 1].x * rstd * g0.z, o[4 * q + 1].y * rstd * g0.w);
                    w.z = pk2(o[4 * q + 2].x * rstd * g1.x, o[4 * q + 2].y * rstd * g1.y); w.w = pk2(o[4 * q + 3].x * rstd * g1.z, o[4 * q + 3].y * rstd * g1.w);
                    *(u32x4*)(hb + e0) = w;
                    u32x2 w8; w8.x = pk4_fp8(o[4 * q].x * rstd * g0.x, o[4 * q].y * rstd * g0.y, o[4 * q + 1].x * rstd * g0.z, o[4 * q + 1].y * rstd * g0.w);
                    w8.y = pk4_fp8(o[4 * q + 2].x * rstd * g1.x, o[4 * q + 2].y * rstd * g1.y, o[4 * q + 3].x * rstd * g1.z, o[4 * q + 3].y * rstd * g1.w);
                    *(u32x2*)(p.ws + WS_HB8 + (size_t)t * DM + e0) = w8; }
            }
#pragma unroll
            for (int i = 0; i < 16; ++i) o[i] = (f32x2){0.f, 0.f};
        }
        ig = ign; gwv = gwn; su = sun; sv = svn;
    }
#undef PEER_ISSUE
}

namespace pg8 {
#define PG8_LAS __attribute__((address_space(3)))
typedef int v4i32 __attribute__((ext_vector_type(4)));
typedef int v8i32 __attribute__((ext_vector_type(8)));
constexpr int BM = 256, BK = 64, HALF = 128, HTB = HALF * BK * 2, STAGE_BYTES = 8 * HTB, NXCD = 8, WGM = 8;
__host__ __device__ __forceinline__ int lds_byte(int r, int c) { const int st = (r >> 4) * 2 + (c >> 5), rr = r & 15, cc = c & 31, ob = rr * 64 + cc * 2; return st * 1024 + (ob ^ (((ob >> 9) & 1) << 5)); }
__host__ __device__ __forceinline__ void stage_rc(int b, int& R, int& C) { const int st = b / 1024, sb = b % 1024, swz = sb ^ (((sb >> 9) & 1) << 5); R = (st >> 1) * 16 + swz / 64; C = (st & 1) * 32 + (swz % 64) / 2; }
__host__ __device__ __forceinline__ int perm32(int rho) { const int n = rho >> 4, i = rho & 15; return 8 * (i >> 2) + 4 * n + (i & 3); }
struct Unit { int pm, pn; };
struct StaticOrder {
    int nM, nN, nwg, G, c;
    __host__ __device__ void init(int M, int N, int G_, int c_) { nM = M / BM; nN = N / BM; nwg = nM * nN; G = G_; c = c_; }
    __host__ __device__ bool next(int i, Unit& u) const {
        const long L = (long)i * G + c; if (L >= nwg) return false;
        int wgid = (int)L; { const int q = nwg / NXCD, r = nwg % NXCD, xcd = wgid % NXCD, off = wgid / NXCD; wgid = (xcd < r ? xcd * (q + 1) : r * (q + 1) + (xcd - r) * q) + off; }
        const int nig = WGM * nN, gid = wgid / nig, fm = gid * WGM, gsz = (nM - fm) < WGM ? (nM - fm) : WGM;
        u.pm = fm + ((wgid % nig) % gsz); u.pn = (wgid % nig) / gsz; return true;
    }
};
struct MergedOrder {
    StaticOrder base;
    __host__ __device__ bool next(int i, Unit& u) const { const int tile = i / 3, n = i - 3 * tile; Unit b; if (!base.next(tile, b)) return false; u.pm = n * 64 + b.pm; u.pn = n * 8 + b.pn; return true; }
};
struct ZGOrder {
    StaticOrder sz, sg;
    __host__ __device__ void init(int G, int c) { sz.init(T, ZP, G, c); sg.init(T, DM, G, c); }
    __host__ __device__ bool next(int i, Unit& u) const {
        const int nzu = sz.c < sz.nwg ? (sz.nwg - sz.c + sz.G - 1) / sz.G : 0;
        if (i < nzu) return sz.next(i, u);
        const int j = i - nzu, tile = j / 3, n = j - 3 * tile; Unit b; if (!sg.next(tile, b)) return false; u.pm = b.pm; u.pn = 15 + 8 * n + b.pn; return true; }
};
struct ProbGen { const bf16* A; const bf16* Bt; int lda, ldb, K;
    __device__ __forceinline__ const char* Aptr(const Unit& u) const { return (const char*)(A + (size_t)u.pm * BM * lda); }
    __device__ __forceinline__ const char* Bptr(const Unit& u) const { return (const char*)(Bt + (size_t)u.pn * BM * ldb); } };
struct ProbUp { const bf16* Z; const bf16* Wup; int lda, ldb, K;
    __device__ __forceinline__ const char* Aptr(const Unit& u) const { return (const char*)(Z + (size_t)u.pm * BM * ZP + (u.pn < 3 ? ZC_CQ : ZC_CKV)); }
    __device__ __forceinline__ const char* Bptr(const Unit& u) const { return (const char*)(Wup + (size_t)u.pn * BM * 512); } };

__device__ __forceinline__ unsigned cvt_pk_bf16(float lo, float hi) { unsigned r; asm volatile("v_cvt_pk_bf16_f32 %0, %1, %2" : "=v"(r) : "v"(lo), "v"(hi)); return r; }
struct EpiZG { static constexpr bool PERM = true; static constexpr bool HOOK = false; bf16* Z; bf16* G; const float* bg; int noratio;
    __device__ __forceinline__ void operator()(const f32x4 (&acc)[2][2][4][2], const Unit& u, int wr, int wc, int fr, int fq) const {
        const int row0 = u.pm * BM + wr * 64 + fr; const bool gate = u.pn >= 15;
        const int gi = u.pn - 15, n0_ = gi >> 3; const int n = n0_;  const bool rat = n0_ > 0 && !noratio;
        bf16* base = gate ? G + n * DM : Z; const int ld = gate ? NGATE : ZP; const int colt = gate ? (gi & 7) * BM : u.pn * BM; const int col0 = colt + wc * 32 + 8 * fq;
        f32x4 bv[2][2];
#pragma unroll
        for (int bj = 0; bj < 2; ++bj)
#pragma unroll
            for (int nn = 0; nn < 2; ++nn) bv[bj][nn] = gate ? *(const f32x4*)(bg + n * DM + col0 + bj * HALF + 4 * nn) : (f32x4){0.f, 0.f, 0.f, 0.f};
#pragma unroll
        for (int ai = 0; ai < 2; ++ai) {
            u32x4 pw[4][2];
            if (gate && rat) {
#pragma unroll
                for (int m = 0; m < 4; ++m)
#pragma unroll
                    for (int bj = 0; bj < 2; ++bj) pw[m][bj] = *(const u32x4*)(base + (size_t)(row0 + ai * HALF + m * 16) * ld + col0 + bj * HALF - DM);
                __builtin_amdgcn_sched_barrier(0);
            }
#pragma unroll
            for (int m = 0; m < 4; ++m) { bf16* rowp = base + (size_t)(row0 + ai * HALF + m * 16) * ld + col0;
#pragma unroll
                for (int bj = 0; bj < 2; ++bj) { f32x4 v0 = acc[ai][bj][m][0] + bv[bj][0], v1 = acc[ai][bj][m][1] + bv[bj][1];
                    if (gate) {
#pragma unroll
                        for (int j = 0; j < 4; ++j) { v0[j] = fmaxf(__builtin_amdgcn_rcpf(1.f + __builtin_amdgcn_exp2f(-LOG2E * v0[j])), 1e-6f); v1[j] = fmaxf(__builtin_amdgcn_rcpf(1.f + __builtin_amdgcn_exp2f(-LOG2E * v1[j])), 1e-6f); }
                        if (rat) { const u32x4 q = pw[m][bj];
                            const float p8[8] = {bflo(q.x), bfhi(q.x), bflo(q.y), bfhi(q.y), bflo(q.z), bfhi(q.z), bflo(q.w), bfhi(q.w)};
                            u32x4 rw; rw.x = cvt_pk_bf16(p8[0] * __builtin_amdgcn_rcpf(v0[0]), p8[1] * __builtin_amdgcn_rcpf(v0[1])); rw.y = cvt_pk_bf16(p8[2] * __builtin_amdgcn_rcpf(v0[2]), p8[3] * __builtin_amdgcn_rcpf(v0[3]));
                            rw.z = cvt_pk_bf16(p8[4] * __builtin_amdgcn_rcpf(v1[0]), p8[5] * __builtin_amdgcn_rcpf(v1[1])); rw.w = cvt_pk_bf16(p8[6] * __builtin_amdgcn_rcpf(v1[2]), p8[7] * __builtin_amdgcn_rcpf(v1[3]));
                            *(u32x4*)(rowp + bj * HALF - DM) = rw; } }
                    u32x4 w; w.x = cvt_pk_bf16(v0[0], v0[1]); w.y = cvt_pk_bf16(v0[2], v0[3]); w.z = cvt_pk_bf16(v1[0], v1[1]); w.w = cvt_pk_bf16(v1[2], v1[3]);
                    *(u32x4*)(rowp + bj * HALF) = w; } }
        }
    } };
struct EpiG8 { static constexpr bool PERM = true; static constexpr bool HOOK = false; bf16* G; const float* bg; const unsigned* gmax;
    __device__ __forceinline__ void operator()(const f32x4 (&acc)[2][2][4][2], const Unit& u, int wr, int wc, int fr, int fq) const {
        const int row0 = u.pm * BM + wr * 64 + fr, col0 = u.pn * BM + wc * 32 + 8 * fq; const int n = u.pn >> 3; const float is = 1.f / gate_scale(gmax + 64 * n);
        f32x4 bv[2][2];
#pragma unroll
        for (int bj = 0; bj < 2; ++bj)
#pragma unroll
            for (int nn = 0; nn < 2; ++nn) bv[bj][nn] = *(const f32x4*)(bg + col0 + bj * HALF + 4 * nn);
#pragma unroll
        for (int ai = 0; ai < 2; ++ai)
#pragma unroll
            for (int m = 0; m < 4; ++m) { bf16* rowp = G + (size_t)(row0 + ai * HALF + m * 16) * NGATE + col0;
#pragma unroll
                for (int bj = 0; bj < 2; ++bj) { f32x4 v0 = acc[ai][bj][m][0] * is + bv[bj][0], v1 = acc[ai][bj][m][1] * is + bv[bj][1];
#pragma unroll
                    for (int j = 0; j < 4; ++j) { v0[j] = fmaxf(__builtin_amdgcn_rcpf(1.f + __builtin_amdgcn_exp2f(-LOG2E * v0[j])), 1e-6f); v1[j] = fmaxf(__builtin_amdgcn_rcpf(1.f + __builtin_amdgcn_exp2f(-LOG2E * v1[j])), 1e-6f); }
                    u32x4 w; w.x = cvt_pk_bf16(v0[0], v0[1]); w.y = cvt_pk_bf16(v0[2], v0[3]); w.z = cvt_pk_bf16(v1[0], v1[1]); w.w = cvt_pk_bf16(v1[2], v1[3]);
                    *(u32x4*)(rowp + bj * HALF) = w; } }
    } };
struct EpiUp { static constexpr bool HOOK = false; static constexpr bool PERM = true; bf16* QR; bf16* KVR;
    __device__ __forceinline__ void operator()(const f32x4 (&acc)[2][2][4][2], const Unit& u, int wr, int wc, int fr, int fq) const {
        const int row0 = u.pm * BM + wr * 64 + fr; const bool kv = u.pn >= 3;
        bf16* base = kv ? KVR : QR; const int ld = kv ? 1024 : 768; const int col0 = (kv ? (u.pn - 3) : u.pn) * BM + wc * 32 + 8 * fq;
#pragma unroll
        for (int ai = 0; ai < 2; ++ai)
#pragma unroll
            for (int m = 0; m < 4; ++m) { bf16* rowp = base + (size_t)(row0 + ai * HALF + m * 16) * ld + col0;
#pragma unroll
                for (int bj = 0; bj < 2; ++bj) { const f32x4 v0 = acc[ai][bj][m][0], v1 = acc[ai][bj][m][1];
                    u32x4 w; w.x = cvt_pk_bf16(v0[0], v0[1]); w.y = cvt_pk_bf16(v0[2], v0[3]); w.z = cvt_pk_bf16(v1[0], v1[1]); w.w = cvt_pk_bf16(v1[2], v1[3]);
                    *(u32x4*)(rowp + bj * HALF) = w; } }
    } };
struct EpiMG { static constexpr bool PERM = true; static constexpr bool HOOK = true; bf16* MG; const bf16* R; int nohook;
    template <bool RATIO> __device__ __forceinline__ void scale(f32x4 (&acc)[2][2][4][2], const Unit& u, int wr, int wc, int fr, int fq, int slot) const {
        const __amdgpu_buffer_rsrc_t rs = __builtin_amdgcn_make_buffer_rsrc((void*)R, 0, (int)((size_t)T * NGATE * 2), 0x00020000);
        const int voff = ((u.pm * BM + wr * 64 + fr) * NGATE + slot * DM + u.pn * BM + wc * 32 + 8 * fq) * 2;
#pragma unroll
        for (int ai = 0; ai < 2; ++ai) {
            u32x4 ga[4][2], gb[4][2];
#pragma unroll
            for (int m = 0; m < 4; ++m)
#pragma unroll
                for (int bj = 0; bj < 2; ++bj) { ga[m][bj] = __builtin_amdgcn_raw_buffer_load_b128(rs, voff, ((ai * HALF + m * 16) * NGATE + bj * HALF) * 2, 0);
                    if (RATIO) gb[m][bj] = __builtin_amdgcn_raw_buffer_load_b128(rs, voff, ((ai * HALF + m * 16) * NGATE + DM + bj * HALF) * 2, 0); }
            __builtin_amdgcn_sched_barrier(0);
#pragma unroll
            for (int m = 0; m < 4; ++m)
#pragma unroll
                for (int bj = 0; bj < 2; ++bj) { const u32x4 a = ga[m][bj];
                    float f[8] = {bflo(a.x), bfhi(a.x), bflo(a.y), bfhi(a.y), bflo(a.z), bfhi(a.z), bflo(a.w), bfhi(a.w)};
                    if (RATIO) { const u32x4 b = gb[m][bj]; const float d[8] = {bflo(b.x), bfhi(b.x), bflo(b.y), bfhi(b.y), bflo(b.z), bfhi(b.z), bflo(b.w), bfhi(b.w)};
#pragma unroll
                        for (int j = 0; j < 8; ++j) f[j] *= __builtin_amdgcn_rcpf(d[j]); }
                    acc[ai][bj][m][0][0] *= f[0]; acc[ai][bj][m][0][1] *= f[1]; acc[ai][bj][m][0][2] *= f[2]; acc[ai][bj][m][0][3] *= f[3];
                    acc[ai][bj][m][1][0] *= f[4]; acc[ai][bj][m][1][1] *= f[5]; acc[ai][bj][m][1][2] *= f[6]; acc[ai][bj][m][1][3] *= f[7]; }
            __builtin_amdgcn_sched_barrier(0);
        }
    }
    __device__ __forceinline__ void hook(f32x4 (&acc)[2][2][4][2], const Unit& u, int wr, int wc, int fr, int fq, int seg) const { if (!nohook) scale<true>(acc, u, wr, wc, fr, fq, seg - 1); }
    __device__ __forceinline__ void operator()(f32x4 (&acc)[2][2][4][2], const Unit& u, int wr, int wc, int fr, int fq) const {
        scale<false>(acc, u, wr, wc, fr, fq, 2);
        const int row0 = u.pm * BM + wr * 64 + fr, col0 = u.pn * BM + wc * 32 + 8 * fq;
#pragma unroll
        for (int ai = 0; ai < 2; ++ai)
#pragma unroll
            for (int m = 0; m < 4; ++m) { bf16* rowp = MG + (size_t)(row0 + ai * HALF + m * 16) * DM + col0;
#pragma unroll
                for (int bj = 0; bj < 2; ++bj) { const f32x4 v0 = acc[ai][bj][m][0], v1 = acc[ai][bj][m][1];
                    u32x4 w; w.x = cvt_pk_bf16(v0[0], v0[1]); w.y = cvt_pk_bf16(v0[2], v0[3]); w.z = cvt_pk_bf16(v1[0], v1[1]); w.w = cvt_pk_bf16(v1[2], v1[3]);
                    *(u32x4*)(rowp + bj * HALF) = w; } }
    } };
struct EpiOut { static constexpr bool HOOK = false; static constexpr bool PERM = false; const float* Xin; float* X;
    __device__ __forceinline__ void operator()(const f32x4 (&acc)[2][2][4][2], const Unit& u, int wr, int wc, int fr, int fq) const {
        const int row0 = u.pm * BM + wr * 64 + fr, col0 = u.pn * BM + wc * 32 + 4 * fq;
#pragma unroll
        for (int ai = 0; ai < 2; ++ai)
#pragma unroll
            for (int m = 0; m < 4; ++m) { const size_t off = (size_t)(row0 + ai * HALF + m * 16) * DM + col0;
#pragma unroll
                for (int bj = 0; bj < 2; ++bj)
#pragma unroll
                    for (int n = 0; n < 2; ++n) { const f32x4 xi = *(const f32x4*)(Xin + off + bj * HALF + n * 16); *(f32x4*)(X + off + bj * HALF + n * 16) = xi + acc[ai][bj][m][n]; } }
    } };
struct EpiDelta { static constexpr bool HOOK = false; static constexpr bool PERM = true; bf16* D;
    __device__ __forceinline__ void operator()(const f32x4 (&acc)[2][2][4][2], const Unit& u, int wr, int wc, int fr, int fq) const {
        const int row0 = u.pm * BM + wr * 64 + fr, col0 = u.pn * BM + wc * 32 + 8 * fq;
#pragma unroll
        for (int ai = 0; ai < 2; ++ai)
#pragma unroll
            for (int m = 0; m < 4; ++m) { bf16* rowp = D + (size_t)(row0 + ai * HALF + m * 16) * DM + col0;
#pragma unroll
                for (int bj = 0; bj < 2; ++bj) { const f32x4 v0 = acc[ai][bj][m][0], v1 = acc[ai][bj][m][1];
                    u32x4 w; w.x = cvt_pk_bf16(v0[0], v0[1]); w.y = cvt_pk_bf16(v0[2], v0[3]); w.z = cvt_pk_bf16(v1[0], v1[1]); w.w = cvt_pk_bf16(v1[2], v1[3]);
                    *(u32x4*)(rowp + bj * HALF) = w; } }
    } };
struct EpiSC { static constexpr bool HOOK = false; static constexpr bool PERM = false; float* SC;
    __device__ __forceinline__ void operator()(const f32x4 (&acc)[2][2][4][2], const Unit& u, int wr, int wc, int fr, int fq) const {
        const int row0 = u.pm * BM + wr * 64 + fr, col0 = u.pn * BM + wc * 32 + 4 * fq;
#pragma unroll
        for (int ai = 0; ai < 2; ++ai)
#pragma unroll
            for (int m = 0; m < 4; ++m) { const size_t off = (size_t)(row0 + ai * HALF + m * 16) * DM + col0;
#pragma unroll
                for (int bj = 0; bj < 2; ++bj)
#pragma unroll
                    for (int n = 0; n < 2; ++n) *(f32x4*)(SC + off + bj * HALF + n * 16) = acc[ai][bj][m][n]; }
    } };

template <class Epi, class Prob, class Sched, bool ALIGN_EPI = true, bool FP8 = false>
__device__ __forceinline__ void gemm_phase(PG8_LAS unsigned char* lds, const Prob g, const Sched& S, const Epi& E) {
    int tid = threadIdx.x; asm volatile("" : "+v"(tid));
    const int wid = __builtin_amdgcn_readfirstlane(tid >> 6), lane = tid & 63, wr = wid >> 2, wc = wid & 3, fr = lane & 15, fq = lane >> 4;
    const int K = g.K, nt = K / BK;
    unsigned voffA[2], voffB[2];
#pragma unroll
    for (int i = 0; i < 2; ++i) { int R, C; stage_rc(tid * 16 + i * 8192, R, C); const int Rb = Epi::PERM ? ((R & ~31) + perm32(R & 31)) : R;
        voffA[i] = (unsigned)(R * g.lda + C) * 2u; voffB[i] = (unsigned)(Rb * g.ldb + C) * 2u; }
    const size_t kstep = (size_t)(BK * 2);
    const size_t hstepA = (size_t)HALF * g.lda * 2, hstepB = (size_t)HALF * g.ldb * 2;
    const unsigned ldsw = (unsigned)wid * 1024u;
    const int aoff = lds_byte(wr * 64 + fr, fq * 8), boff = lds_byte(wc * 32 + fr, fq * 8);
#define PG8_SA(b, h) (((b) * 2 + (h)) * HTB)
#define PG8_SB(b, h) ((4 + (b) * 2 + (h)) * HTB)
#define PG8_STAGE(bufoff, gbase, voff) do { _Pragma("unroll") for (int _i = 0; _i < 2; ++_i) \
        __builtin_amdgcn_global_load_lds((const unsigned*)((const char*)(gbase) + (voff)[_i]), (PG8_LAS unsigned*)(lds + (bufoff) + ldsw + _i * 8192), 16, 0, 0); } while (0)
#define PG8_CAT8(x0, x1) __builtin_shufflevector(__builtin_bit_cast(v4i32, x0), __builtin_bit_cast(v4i32, x1), 0, 1, 2, 3, 4, 5, 6, 7)
#define PG8_LDA(dst, b, h) do { _Pragma("unroll") for (int m = 0; m < 4; ++m) { const bf16x8 x0 = *(const PG8_LAS bf16x8*)(lds + PG8_SA(b, h) + aoff + m * 2048), x1 = *(const PG8_LAS bf16x8*)(lds + PG8_SA(b, h) + aoff + m * 2048 + 1024); \
        if constexpr (FP8) dst##8[m] = PG8_CAT8(x0, x1); else { dst[m][0] = x0; dst[m][1] = x1; } } } while (0)
#define PG8_LDB(dst, b, h) do { _Pragma("unroll") for (int n = 0; n < 2; ++n) { const bf16x8 x0 = *(const PG8_LAS bf16x8*)(lds + PG8_SB(b, h) + boff + n * 2048), x1 = *(const PG8_LAS bf16x8*)(lds + PG8_SB(b, h) + boff + n * 2048 + 1024); \
        if constexpr (FP8) dst##8[n] = PG8_CAT8(x0, x1); else { dst[n][0] = x0; dst[n][1] = x1; } } } while (0)
#define PG8_MMA(ai, bj, At, Bt) do { __builtin_amdgcn_s_setprio(1); _Pragma("unroll") for (int m = 0; m < 4; ++m) _Pragma("unroll") for (int n = 0; n < 2; ++n) { \
        if constexpr (FP8) asm volatile("v_mfma_f32_16x16x128_f8f6f4 %0, %1, %2, %0" : "+v"(acc[ai][bj][m][n]) : "v"(Bt##8[n]), "v"(At##8[m]));   \
        else { _Pragma("unroll") for (int k = 0; k < 2; ++k) acc[ai][bj][m][n] = __builtin_amdgcn_mfma_f32_16x16x32_bf16(Bt[n][k], At[m][k], acc[ai][bj][m][n], 0, 0, 0); } } \
        if constexpr (FP8) asm volatile("s_nop 7" ::: "memory");   \
        __builtin_amdgcn_s_setprio(0); } while (0)
#define PG8_WAIT_V(n) asm volatile("s_waitcnt vmcnt(" #n ")" ::: "memory")
#define PG8_WAIT_L(n) asm volatile("s_waitcnt lgkmcnt(" #n ")" ::: "memory")
#define PG8_BAR __builtin_amdgcn_s_barrier()
#define PG8_SCHED __builtin_amdgcn_sched_barrier(0)
    Unit cur, nxt; int ui = 0;
    if (!S.next(0, cur)) return;
    f32x4 acc[2][2][4][2];
#pragma unroll
    for (int a = 0; a < 2; ++a)
#pragma unroll
        for (int b = 0; b < 2; ++b)
#pragma unroll
            for (int m = 0; m < 4; ++m)
#pragma unroll
                for (int n = 0; n < 2; ++n) acc[a][b][m][n] = (f32x4){0.f, 0.f, 0.f, 0.f};
    bf16x8 At[4][2], B0[2][2], B1[2][2];
    v8i32 At8[4], B08[2], B18[2];
    const char* cA = g.Aptr(cur); const char* cB = g.Bptr(cur);
    PG8_STAGE(PG8_SB(0, 0), cB, voffB); PG8_STAGE(PG8_SB(0, 1), cB + hstepB, voffB); PG8_STAGE(PG8_SA(0, 0), cA, voffA); PG8_STAGE(PG8_SA(0, 1), cA + hstepA, voffA);
    if (wr == 1) PG8_BAR;
    PG8_WAIT_V(2); PG8_BAR;
    PG8_STAGE(PG8_SB(1, 0), cB + kstep, voffB); PG8_STAGE(PG8_SA(1, 0), cA + kstep, voffA); PG8_STAGE(PG8_SB(1, 1), cB + hstepB + kstep, voffB);
    PG8_WAIT_V(6); PG8_BAR;
    for (;;) {
        const bool has_next = S.next(ui + 1, nxt);
        const char* nA = has_next ? g.Aptr(nxt) : cA; const char* nB = has_next ? g.Bptr(nxt) : cB;
        for (int t = 0; t < nt; t += 2) {
            if constexpr (Epi::HOOK) { if (t == 8 || t == 16) E.hook(acc, cur, wr, wc, fr, fq, t >> 3); }
            const bool last = (t == nt - 2);
            const char* a1 = cA + (size_t)(t + 1) * kstep;
            const char* a2 = last ? nA : cA + (size_t)(t + 2) * kstep; const char* b2 = last ? nB : cB + (size_t)(t + 2) * kstep;
            const char* a3 = a2 + kstep; const char* b3 = b2 + kstep;
            PG8_LDB(B0, 0, 0); PG8_LDB(B1, 0, 1); PG8_SCHED; PG8_LDA(At, 0, 0); PG8_STAGE(PG8_SA(1, 1), a1 + hstepA, voffA);
            PG8_WAIT_V(8); PG8_WAIT_L(0); PG8_BAR; PG8_MMA(0, 0, At, B0); PG8_MMA(0, 1, At, B1); PG8_BAR; PG8_SCHED;
            PG8_LDA(At, 0, 1); PG8_STAGE(PG8_SB(0, 0), b2, voffB); PG8_STAGE(PG8_SB(0, 1), b2 + hstepB, voffB); PG8_STAGE(PG8_SA(0, 0), a2, voffA);
            PG8_WAIT_V(8); PG8_WAIT_L(0); PG8_BAR; PG8_MMA(1, 0, At, B0); PG8_MMA(1, 1, At, B1); PG8_BAR; PG8_SCHED;
            PG8_LDB(B0, 1, 0); PG8_LDB(B1, 1, 1); PG8_SCHED; PG8_LDA(At, 1, 0); PG8_STAGE(PG8_SA(0, 1), a2 + hstepA, voffA);
            PG8_WAIT_V(8); PG8_WAIT_L(0); PG8_BAR; PG8_MMA(0, 0, At, B0); PG8_MMA(0, 1, At, B1); PG8_BAR; PG8_SCHED;
            PG8_LDA(At, 1, 1); PG8_STAGE(PG8_SB(1, 0), b3, voffB); PG8_STAGE(PG8_SB(1, 1), b3 + hstepB, voffB); PG8_STAGE(PG8_SA(1, 0), a3, voffA);
            PG8_WAIT_V(8); PG8_WAIT_L(0); PG8_BAR; PG8_MMA(1, 0, At, B0); PG8_MMA(1, 1, At, B1); PG8_BAR; PG8_SCHED;
        }
        if constexpr (ALIGN_EPI) { if (wr == 0) PG8_BAR; }
        E(acc, cur, wr, wc, fr, fq);
        if (!has_next) break;
#pragma unroll
        for (int a = 0; a < 2; ++a)
#pragma unroll
            for (int b = 0; b < 2; ++b)
#pragma unroll
                for (int m = 0; m < 4; ++m)
#pragma unroll
                    for (int n = 0; n < 2; ++n) acc[a][b][m][n] = (f32x4){0.f, 0.f, 0.f, 0.f};
        cur = nxt; cA = nA; cB = nB; ++ui;
        if constexpr (ALIGN_EPI) { if (wr == 1) PG8_BAR; }
    }
    PG8_WAIT_V(0);
    if constexpr (!ALIGN_EPI) { if (wr == 0) PG8_BAR; }
    PG8_BAR;
#undef PG8_SA
#undef PG8_SB
#undef PG8_STAGE
#undef PG8_LDA
#undef PG8_CAT8
#undef PG8_LDB
#undef PG8_MMA
#undef PG8_WAIT_V
#undef PG8_WAIT_L
#undef PG8_BAR
#undef PG8_SCHED
}
}


constexpr int RING_BYTES = 131072, MISC_OFF = RING_BYTES + 320, LDS_BYTES = 147456;
namespace att {
typedef short s16x4 __attribute__((ext_vector_type(4)));
__device__ __forceinline__ s16x4 lds_tr(const LAS unsigned char* p) { return __builtin_bit_cast(s16x4, __builtin_amdgcn_ds_read_tr16_b64_v4i16((LAS s16x4*)p)); }
template <int MODE> struct Cfg;
template <> struct Cfg<0> { static constexpr int DQK = 96, DV = 64, KRS = 208, VRS = 192, NV = 2, NL = 5; };
template <> struct Cfg<1> { static constexpr int DQK = 64, DV = 128, KRS = 144, VRS = 320, NV = 1, NL = 4; };
template <int MODE> struct Lay { using C = Cfg<MODE>; static constexpr int KB = 64 * C::KRS, VB = 64 * C::VRS, STAGE = 2 * KB + C::NV * VB; };

template <int MODE>
__device__ __forceinline__ void attn_unit(const Params& p, int l, int b, int hp, int qb, LAS unsigned char* lds, float lam, float lam_init, int pm = 0) {
    using C = Cfg<MODE>; using L = Lay<MODE>;
    constexpr int DQK = C::DQK, DV = C::DV, NDB = DV / 32, NKS = DQK / 16;
    int tid = threadIdx.x; asm volatile("" : "+v"(tid));
    const int lane = tid & 63, wid = __builtin_amdgcn_readfirstlane(tid >> 6), half = wid >> 2, r = lane & 31, h = lane >> 5;
    const int q0 = qb * 128, qrow = q0 + 32 * (wid & 3) + r;
    const size_t trow = (size_t)b * SEQ + qrow;
    const int ntile = 2 * qb + 2, mytiles = 2 * qb + 1 + ((wid & 3) >> 1);
    const bf16* Qb; const bf16* Kg[2]; const bf16* Vg[2]; int kp, vp;
    if (MODE == 0) { const bf16* QM = (const bf16*)(p.ws + WS_QM); const bf16* KM = (const bf16*)(p.ws + WS_KM); const bf16* KVR = (const bf16*)(p.ws + WS_KVR);
        Qb = QM + trow * 768 + (2 * hp + half) * 96; kp = 768; vp = 1024;
        Kg[0] = KM + (size_t)b * SEQ * 768 + (2 * hp) * 96; Kg[1] = Kg[0] + 96; Vg[0] = KVR + (size_t)b * SEQ * 1024 + 512 + (2 * hp) * 64; Vg[1] = Vg[0] + 64;
    } else { const bf16* Z = (const bf16*)(p.ws + WS_Z);
        Qb = Z + trow * ZP + ZC_DQ + (2 * hp + half) * 64; kp = ZP; vp = ZP;
        Kg[0] = Z + (size_t)b * SEQ * ZP + ZC_DK + (2 * hp) * 64; Kg[1] = Kg[0] + 64; Vg[0] = Z + (size_t)b * SEQ * ZP + ZC_DV + hp * 128; Vg[1] = Vg[0]; }
    constexpr int KC = DQK / 8, VC = DV / 8;
    typedef const __attribute__((address_space(1))) bf16* gptr_t;
    gptr_t gp[C::NL]; int lo_[C::NL]; size_t gstep[C::NL];
#pragma unroll
    for (int i = 0; i < C::NL; ++i) { const int id = tid + 512 * i;
        if (id < 2 * 64 * KC) { const int sg = id / (64 * KC), q = id % (64 * KC), row = q / KC, c = q % KC; gp[i] = (gptr_t)(sg ? Kg[1] : Kg[0]) + (size_t)row * kp + c * 8; lo_[i] = sg * L::KB + row * C::KRS + c * 16; gstep[i] = (size_t)64 * kp; }
        else { const int q2 = id - 2 * 64 * KC, sg = q2 / (64 * VC), q = q2 % (64 * VC), row = q / VC, c = q % VC; gp[i] = (gptr_t)(sg ? Vg[1] : Vg[0]) + (size_t)row * vp + c * 8; lo_[i] = 2 * L::KB + sg * L::VB + row * C::VRS + c * 16; gstep[i] = (size_t)64 * vp; } }
    bf16x8 qf[NKS];
#pragma unroll
    for (int s_ = 0; s_ < NKS; ++s_) qf[s_] = *(const bf16x8*)(Qb + 16 * s_ + 8 * h);
    const int koff = half * L::KB + r * C::KRS + 16 * h;
    const int voff = 2 * L::KB + (C::NV == 2 ? half * L::VB : 0) + (4 * h + ((lane & 15) >> 2)) * C::VRS + (((lane >> 4) & 1) * 16 + (lane & 3) * 4) * 2;
    f32x16 O[NDB];
#pragma unroll
    for (int d = 0; d < NDB; ++d)
#pragma unroll
        for (int e = 0; e < 16; ++e) O[d][e] = 0.f;
    f32x16 negm;
#pragma unroll
    for (int e = 0; e < 16; ++e) negm[e] = 0.f;
    float l_run = 0.f;
    u32x4 stA[C::NL], stB[C::NL];
#define ATT_LOAD(R) do { const size_t _st = adv > 0 ? 1 : 0; --adv; _Pragma("unroll") for (int i = 0; i < C::NL; ++i) { R[i] = *(const __attribute__((address_space(1))) u32x4*)gp[i]; gp[i] += _st * gstep[i]; } } while (0)
#define ATT_WRITE(R, stg) do { _Pragma("unroll") for (int i = 0; i < C::NL; ++i) *(LAS u32x4*)(lds + (stg) * L::STAGE + lo_[i]) = R[i]; } while (0)
#define ATT_VREAD(dst, kb) do { const int voff_ = (pm & 64) ? 2 * L::KB : voff; _Pragma("unroll") for (int d = 0; d < NDB; ++d) _Pragma("unroll") for (int sp = 0; sp < 2; ++sp) { \
                const LAS unsigned char* va = sb + voff_ + (32 * (kb) + 16 * sp) * C::VRS + 64 * d; \
                const s16x4 t0 = lds_tr(va), t1 = lds_tr(va + 8 * C::VRS); \
                dst[2 * d + sp] = (bf16x8){t0[0], t0[1], t0[2], t0[3], t1[0], t1[1], t1[2], t1[3]}; } } while (0)
#define ATT_PV(src, pfk) do { if (!(pm & 32)) { _Pragma("unroll") for (int d = 0; d < NDB; ++d) _Pragma("unroll") for (int sp = 0; sp < 2; ++sp) O[d] = __builtin_amdgcn_mfma_f32_32x32x16_bf16(src[2 * d + sp], pfk[sp], O[d], 0, 0, 0); } \
        else { _Pragma("unroll") for (int d = 0; d < NDB; ++d) O[d][0] += __builtin_bit_cast(float, (int)src[2 * d][0] + (int)pfk[0][0]); } } while (0)
#define ATT_SM(Sk, Sother, pfk) do { float mx = Sk[0]; _Pragma("unroll") for (int e = 1; e < 16; ++e) mx = fmaxf(mx, Sk[e]); \
            if (__any(mx > 8.f)) { mx = fmaxf(mx, __shfl_xor(mx, 32)); \
                const float dsh = fmaxf(mx, 0.f), alpha = __builtin_amdgcn_exp2f(-dsh); l_run *= alpha; \
                _Pragma("unroll") for (int e = 0; e < 16; ++e) { negm[e] -= dsh; Sk[e] -= dsh; Sother[e] -= dsh; } \
                _Pragma("unroll") for (int dd = 0; dd < NDB; ++dd) _Pragma("unroll") for (int e = 0; e < 16; ++e) O[dd][e] *= alpha; } \
            float ps = 0.f; \
            _Pragma("unroll") for (int sp = 0; sp < 2; ++sp) { float e8[8]; \
                if (pm & 16) { _Pragma("unroll") for (int jj = 0; jj < 8; ++jj) e8[jj] = Sk[8 * sp + jj]; } else { _Pragma("unroll") for (int jj = 0; jj < 8; ++jj) { e8[jj] = __builtin_amdgcn_exp2f(Sk[8 * sp + jj]); ps += e8[jj]; } } \
                u32x4 w; w.x = pg8::cvt_pk_bf16(e8[0], e8[1]); w.y = pg8::cvt_pk_bf16(e8[2], e8[3]); w.z = pg8::cvt_pk_bf16(e8[4], e8[5]); w.w = pg8::cvt_pk_bf16(e8[6], e8[7]); \
                pfk[sp] = __builtin_bit_cast(bf16x8, w); } \
            l_run += ps; } while (0)
#define ATT_COMPUTE(stg) do { LAS unsigned char* sb = lds + (stg) * L::STAGE; \
            bf16x8 kf[2][NKS]; \
            { const int koff_ = (pm & 64) ? 0 : koff; _Pragma("unroll") for (int kb = 0; kb < 2; ++kb) _Pragma("unroll") for (int s_ = 0; s_ < NKS; ++s_) kf[kb][s_] = *(const LAS bf16x8*)(sb + koff_ + kb * 32 * C::KRS + 32 * s_); } \
            __builtin_amdgcn_sched_barrier(0); \
            f32x16 S0 = negm, S1 = negm; __builtin_amdgcn_s_setprio(1); \
            if (!(pm & 32)) { _Pragma("unroll") for (int s_ = 0; s_ < NKS; ++s_) S0 = __builtin_amdgcn_mfma_f32_32x32x16_bf16(kf[0][s_], qf[s_], S0, 0, 0, 0); \
            _Pragma("unroll") for (int s_ = 0; s_ < NKS; ++s_) S1 = __builtin_amdgcn_mfma_f32_32x32x16_bf16(kf[1][s_], qf[s_], S1, 0, 0, 0); } \
            __builtin_amdgcn_s_setprio(0); bf16x8 vfa[2 * NDB], vfb[2 * NDB]; \
            ATT_VREAD(vfa, 0); \
            __builtin_amdgcn_sched_barrier(0); \
            bf16x8 pf0[2], pf1[2]; \
            ATT_SM(S0, S1, pf0); \
            __builtin_amdgcn_sched_barrier(0); \
            __builtin_amdgcn_s_setprio(1); ATT_PV(vfa, pf0); __builtin_amdgcn_s_setprio(0); \
            ATT_VREAD(vfb, 1); \
            __builtin_amdgcn_sched_barrier(0); \
            ATT_SM(S1, S0, pf1); \
            __builtin_amdgcn_sched_barrier(0); \
            __builtin_amdgcn_s_setprio(1); ATT_PV(vfb, pf1); __builtin_amdgcn_s_setprio(0); \
            } while (0)
    int adv = ntile - 1;
    ATT_LOAD(stA); ATT_LOAD(stB);
    ATT_WRITE(stA, 0);
    __syncthreads();
#pragma unroll 1
    for (int j = 0; j < ntile; j += 2) {
        if (!(pm & 1)) ATT_LOAD(stA);
        if (j < mytiles) ATT_COMPUTE(0);
        if (!(pm & 2)) ATT_WRITE(stB, 1);
        if (!(pm & 8)) __syncthreads();
        if (!(pm & 1)) ATT_LOAD(stB);
        if (j + 1 < mytiles) ATT_COMPUTE(1);
        if (!(pm & 2)) ATT_WRITE(stA, 0);
        if (!(pm & 8)) __syncthreads();
    }
#undef ATT_LOAD
#undef ATT_WRITE
#undef ATT_COMPUTE
#undef ATT_VREAD
#undef ATT_PV
#undef ATT_SM
    const float inv = 1.f / (l_run + __shfl_xor(l_run, 32));
    if (MODE == 0) {
        bf16* o = (bf16*)(p.ws + WS_OC) + trow * 1536 + (2 * hp + half) * 64 + 4 * h;
#pragma unroll
        for (int d = 0; d < NDB; ++d)
#pragma unroll
            for (int g4 = 0; g4 < 4; ++g4) { u32x2 w; w.x = pg8::cvt_pk_bf16(O[d][4 * g4] * inv, O[d][4 * g4 + 1] * inv); w.y = pg8::cvt_pk_bf16(O[d][4 * g4 + 2] * inv, O[d][4 * g4 + 3] * inv);
                *(u32x2*)(o + 32 * d + 8 * g4) = w; }
    } else {
        LAS unsigned char* xr = lds + (32 * (wid & 3) + r) * 264 + 8 * h;
        if (half == 1) {
#pragma unroll
            for (int d = 0; d < NDB; ++d)
#pragma unroll
                for (int g4 = 0; g4 < 4; ++g4) { u32x2 w; w.x = pg8::cvt_pk_bf16(O[d][4 * g4] * inv, O[d][4 * g4 + 1] * inv); w.y = pg8::cvt_pk_bf16(O[d][4 * g4 + 2] * inv, O[d][4 * g4 + 3] * inv);
                    *(LAS u32x2*)(xr + 64 * d + 16 * g4) = w; }
        }
        __syncthreads();
        if (half == 0) {
            float ss = 0.f;
#pragma unroll
            for (int d = 0; d < NDB; ++d)
#pragma unroll
                for (int g4 = 0; g4 < 4; ++g4) { const u32x2 w = *(const LAS u32x2*)(xr + 64 * d + 16 * g4);
                    O[d][4 * g4] = O[d][4 * g4] * inv - lam * bflo(w.x); O[d][4 * g4 + 1] = O[d][4 * g4 + 1] * inv - lam * bfhi(w.x);
                    O[d][4 * g4 + 2] = O[d][4 * g4 + 2] * inv - lam * bflo(w.y); O[d][4 * g4 + 3] = O[d][4 * g4 + 3] * inv - lam * bfhi(w.y);
                    ss += (O[d][4 * g4] * O[d][4 * g4] + O[d][4 * g4 + 1] * O[d][4 * g4 + 1]) + (O[d][4 * g4 + 2] * O[d][4 * g4 + 2] + O[d][4 * g4 + 3] * O[d][4 * g4 + 3]); }
            ss += __shfl_xor(ss, 32);
            const float rstd = rsqrtf(ss * (1.f / 128.f) + NORM_EPS) * (1.f - lam_init);
            const float* sg = p.in[11] + (size_t)l * 128 + 4 * h;
            bf16* o = (bf16*)(p.ws + WS_OC) + trow * 1536 + 512 + hp * 128 + 4 * h;
#pragma unroll
            for (int d = 0; d < NDB; ++d)
#pragma unroll
                for (int g4 = 0; g4 < 4; ++g4) { const f32x4 g = *(const f32x4*)(sg + 32 * d + 8 * g4);
                    u32x2 w; w.x = pg8::cvt_pk_bf16(O[d][4 * g4] * rstd * g.x, O[d][4 * g4 + 1] * rstd * g.y); w.y = pg8::cvt_pk_bf16(O[d][4 * g4 + 2] * rstd * g.z, O[d][4 * g4 + 3] * rstd * g.w);
                    *(u32x2*)(o + 32 * d + 8 * g4) = w; }
        }
        __syncthreads();
    }
}

__device__ __forceinline__ void sgu_unit(const Params& p, int l, int n, int g, LAS unsigned char* lds) {
    constexpr int VRS = 320;
    int tid = threadIdx.x; asm volatile("" : "+v"(tid));
    const int lane = tid & 63, wid = __builtin_amdgcn_readfirstlane(tid >> 6), r = lane & 31, h = lane >> 5, tb = wid & 3, ch = wid >> 2;
    const bf16* Z = (const bf16*)(p.ws + WS_Z) + (size_t)n * 128 * ZP;
#pragma unroll
    for (int i = 0; i < 4; ++i) { const int id = tid + 512 * i, row = id >> 4, c = id & 15; *(LAS u32x4*)(lds + row * VRS + c * 16) = *(const u32x4*)(Z + (size_t)row * ZP + ZC_SV + g * 128 + c * 8); }
    const bf16* W = (const bf16*)(p.ws + WS_W + (size_t)l * W_LAYER + WO_SGU) + ((size_t)g * 128 + tb * 32 + r) * 128 + 4 * h;
    u32x2 wf[8][2];
#pragma unroll
    for (int ks = 0; ks < 8; ++ks) { wf[ks][0] = *(const u32x2*)(W + 16 * ks); wf[ks][1] = *(const u32x2*)(W + 16 * ks + 8); }
    __syncthreads();
    f32x16 O[2];
#pragma unroll
    for (int d = 0; d < 2; ++d)
#pragma unroll
        for (int e = 0; e < 16; ++e) O[d][e] = 0.f;
    const int voff = (4 * h + ((lane & 15) >> 2)) * VRS + (((lane >> 4) & 1) * 16 + (lane & 3) * 4) * 2 + 128 * ch;
#pragma unroll
    for (int d = 0; d < 2; ++d)
#pragma unroll
        for (int ks = 0; ks < 8; ++ks) { const LAS unsigned char* va = lds + voff + (16 * ks) * VRS + 64 * d;
            const att::s16x4 t0 = att::lds_tr(va), t1 = att::lds_tr(va + 8 * VRS);
            const bf16x8 vf = {t0[0], t0[1], t0[2], t0[3], t1[0], t1[1], t1[2], t1[3]};
            const u32x4 pw = {wf[ks][0].x, wf[ks][0].y, wf[ks][1].x, wf[ks][1].y};
            O[d] = __builtin_amdgcn_mfma_f32_32x32x16_bf16(vf, __builtin_bit_cast(bf16x8, pw), O[d], 0, 0, 0); }
    const int t = tb * 32 + r; const size_t trow = (size_t)n * 128 + t;
    const float bias = p.in[14][(size_t)l * 512 + g * 128 + t];
    const bf16* up = (const bf16*)(p.ws + WS_Z) + trow * ZP + ZC_SU + g * 128 + 64 * ch + 4 * h;
    bf16* o = (bf16*)(p.ws + WS_OC) + trow * 1536 + 1024 + g * 128 + 64 * ch + 4 * h;
#pragma unroll
    for (int d = 0; d < 2; ++d)
#pragma unroll
        for (int g4 = 0; g4 < 4; ++g4) { const u32x2 uw = *(const u32x2*)(up + 32 * d + 8 * g4);
            u32x2 w; w.x = pg8::cvt_pk_bf16(bflo(uw.x) * (O[d][4 * g4] + bias), bfhi(uw.x) * (O[d][4 * g4 + 1] + bias)); w.y = pg8::cvt_pk_bf16(bflo(uw.y) * (O[d][4 * g4 + 2] + bias), bfhi(uw.y) * (O[d][4 * g4 + 3] + bias));
            *(u32x2*)(o + 32 * d + 8 * g4) = w; }
    __syncthreads();
}
}

#define XB_TMO      128
#define XB_XCNT(j)  (256  + 64 * (j))
#define XB_XSUB(j)  (1280 + 64 * (j))
#define XB_XGEN(j)  (2304 + 64 * (j))
#define XB_TOP      3328
#define XB_TOPGEN   3392
#define XCD_BAR_WORDS 3456
#define XB_SPIN_CAP (1u << 18)
__device__ __forceinline__ unsigned xb_ld(unsigned* p)              { return __hip_atomic_load(p, __ATOMIC_RELAXED, __HIP_MEMORY_SCOPE_AGENT); }
__device__ __forceinline__ unsigned xb_add(unsigned* p, unsigned v) { return __hip_atomic_fetch_add(p, v, __ATOMIC_RELAXED, __HIP_MEMORY_SCOPE_AGENT); }
__device__ __forceinline__ unsigned xb_xcc_id() { return (unsigned)__builtin_amdgcn_s_getreg((3 << 11) | 20) & 0xFu; }
#define XB_SPIN(cond, bar) do { unsigned _sp = 0; while (cond) { __builtin_amdgcn_s_sleep(1); \
    if ((++_sp & 255u) == 0u) { if (xb_ld(&(bar)[XB_TMO])) break; if (_sp > XB_SPIN_CAP) { atomicAdd(&(bar)[XB_TMO], 1u); break; } } } } while (0)
struct XcdBarrier { unsigned* bar; unsigned x; volatile LAS unsigned* st; };
__device__ __forceinline__ XcdBarrier xcd_barrier_post(unsigned* bar, volatile LAS unsigned* st) {
    XcdBarrier b; b.bar = bar; b.x = xb_xcc_id(); b.st = st;
    if (threadIdx.x == 0) (void)xb_add(&bar[XB_XCNT(b.x)], 1u);
    return b;
}
__device__ __forceinline__ void xcd_barrier_complete(unsigned* bar, unsigned x, unsigned& nloc, unsigned& nx) {
    const unsigned G = gridDim.x * gridDim.y * gridDim.z;
    unsigned sum, cnt, mine, sp = 0u;
    for (;;) {
        sum = 0u; cnt = 0u; mine = 0u;
#pragma unroll
        for (unsigned j = 0; j < 16; ++j) { const unsigned c = xb_ld(&bar[XB_XCNT(j)]); sum += c; cnt += (c > 0u) ? 1u : 0u; mine = (j == x) ? c : mine; }
        if (sum == G) break;
        __builtin_amdgcn_s_sleep(1);
        if ((++sp & 255u) == 0u) { if (xb_ld(&bar[XB_TMO])) break; if (sp > XB_SPIN_CAP) { atomicAdd(&bar[XB_TMO], 1u); break; } }
    }
    nloc = mine > 0u ? mine : 1u; nx = cnt > 0u ? cnt : 1u;
}
__device__ __forceinline__ void xcd_barrier(const XcdBarrier& b) {
    asm volatile("s_waitcnt vmcnt(0)" ::: "memory");
    __syncthreads();
    if (threadIdx.x == 0) {
        unsigned* bar = b.bar;
        __builtin_amdgcn_s_waitcnt(0);
        unsigned nloc = b.st[0], nx = b.st[1];
        if (nloc == 0u) { xcd_barrier_complete(bar, b.x, nloc, nx); b.st[0] = nloc; b.st[1] = nx; }
        const unsigned old = xb_add(&bar[XB_XSUB(b.x)], 1u);
        const unsigned gen = old / nloc;
        if (old + 1u == (gen + 1u) * nloc) {
            __builtin_amdgcn_fence(__ATOMIC_RELEASE, "agent");
            asm volatile("s_waitcnt vmcnt(0)" ::: "memory");
            const unsigned og = xb_add(&bar[XB_TOP], 1u);
            const unsigned tg = og / nx;
            if (og + 1u == (tg + 1u) * nx) xb_add(&bar[XB_TOPGEN], 1u);
            else XB_SPIN(xb_ld(&bar[XB_TOPGEN]) == tg, bar);
            __builtin_amdgcn_fence(__ATOMIC_ACQUIRE, "agent");
            xb_add(&bar[XB_XGEN(b.x)], 1u);
            asm volatile("s_waitcnt vmcnt(0)" ::: "memory");
        } else {
            XB_SPIN(xb_ld(&bar[XB_XGEN(b.x)]) == gen, bar);
            __builtin_amdgcn_fence(__ATOMIC_ACQUIRE, "agent");
            asm volatile("s_waitcnt vmcnt(0)" ::: "memory");
        }
    }
    __syncthreads();
}

constexpr int NPHASE = 1 + 11 * DEPTH;
constexpr int CW_BAR = 4096;
struct MArgs { Params p; int ph_lo, ph_hi, li, pad; };

__global__ void __launch_bounds__(512, 2) mega(MArgs a) {
    extern __shared__ __attribute__((aligned(16))) unsigned char lds_raw[];
    LAS unsigned char* lds = (LAS unsigned char*)lds_raw;
    volatile LAS unsigned* MISC = (volatile LAS unsigned*)(lds + MISC_OFF);
    const Params& p = a.p;
    const int tid = threadIdx.x, lane = tid & 63, wave = __builtin_amdgcn_readfirstlane(tid >> 6);
    const int G = gridDim.x, bx = blockIdx.x;
    const int vcu = (G % 8 == 0) ? (bx % 8) * (G / 8) + bx / 8 : bx;
    const int gw = vcu * 8 + wave, ngw = G * 8;
    unsigned char* ws = p.ws;
    for (int u = tid; u < (LDS_BYTES - RING_BYTES) / 4; u += 512) ((LAS unsigned*)(lds + RING_BYTES))[u] = 0u;
    __syncthreads();
    XcdBarrier bar = xcd_barrier_post((unsigned*)(ws + WS_CTL) + CW_BAR + a.li * XCD_BAR_WORDS, MISC + 8);
    const int lo = a.ph_lo, hi = a.ph_hi;
#ifndef PROBE_PM
#define PROBE_PM 0
#endif
#ifndef PROBE_K
#define PROBE_K (-1)
#endif
#ifndef PROBE_N
#define PROBE_N 0
#endif
#define NREP(j) ((PROBE_K == (j)) ? PROBE_N : 0)
#ifndef ENMASK
#define ENMASK 0xFFFFFFFFu
#endif
#define EN(j) ((ENMASK >> (j)) & 1u)
#define IN(k) (lo <= (k) && (k) < hi)
#define SEAM(k) do { if (IN(k) && IN((k) + 1)) xcd_barrier(bar); } while (0)

    if (EN(11) && IN(0)) for (int rep = 0; rep <= NREP(11); ++rep) {
        float* scr = (float*)lds_raw;
        __syncthreads();
        for (int r12 = 0; r12 <= NREP(12); ++r12)
        for (int l = 0; l < DEPTH; ++l) prologue_transposes(p, l, scr + wave * (64 * 33), gw, ngw, lane);
        prologue_rope(p, bx * 512 + tid, G * 512);
        __syncthreads();
        for (int r13 = 0; r13 <= NREP(13); ++r13)
        for (int it = bx; it < 2 * 256; it += G) fold_item(p, it >> 8, it & 255, scr, tid);
        __syncthreads();
        for (int r15 = 0; r15 <= NREP(15); ++r15)
        for (int t = gw; t < T; t += ngw) rms_row_to_bf16(p.in[0] + (size_t)t * DM, p.in[1], (bf16*)(ws + WS_HB) + (size_t)t * DM, lane, ws + WS_HB8 + (size_t)t * DM);
        for (int r14 = 0; r14 <= NREP(14); ++r14)
        for (int r = gw; r < 2 * DEPTH * NEXP; r += ngw) { const int tb = r / (DEPTH * NEXP), q = r % (DEPTH * NEXP);
            if (tb) q4_row(p.in[23] + (size_t)q * DM, ws + WS_V8 + (size_t)q * QROW, (float*)(ws + WS_PS) + (size_t)DEPTH * NEXP + q, lane);
            else q4u_row(p.in[22] + (size_t)q * DM, ws + WS_U8 + (size_t)q * QROW, (float*)(ws + WS_PS) + q, lane); }
        { unsigned* gmax = (unsigned*)(ws + WS_CTL) + CW_GMAX;
          for (int m6 = 0; m6 < 3 * DEPTH; ++m6) { const f32x4* src = (const f32x4*)(p.in[15] + (size_t)m6 * DM * DM); float mx = 0.f;
              for (int i = gw * 64 + lane; i < DM * DM / 4; i += ngw * 64) { const f32x4 v = src[i]; mx = fmaxf(mx, fmaxf(fmaxf(fabsf(v.x), fabsf(v.y)), fmaxf(fabsf(v.z), fabsf(v.w)))); }
#pragma unroll
              for (int of = 1; of < 64; of <<= 1) mx = fmaxf(mx, __shfl_xor(mx, of));
              if (lane == 0) atomicMax(gmax + 64 * m6, __builtin_bit_cast(unsigned, mx)); } }
        xcd_barrier(bar);
        { unsigned* gmax = (unsigned*)(ws + WS_CTL) + CW_GMAX;
          for (int it = gw; it < DEPTH * 3 * 64 * 32; it += ngw) { const int m6 = it / 2048, q = it % 2048, cb = q / 32, kb = q % 32;
              transpose_item8(p.in[15] + (size_t)m6 * DM * DM, DM, cb * 32, kb * 64, DM, ws + WS_WG8, m6 * DM + cb * 32, scr + wave * (64 * 33), lane, gate_scale(gmax + 64 * m6)); } }
    }
    SEAM(0);
    { constexpr int l = 0;
        const int pb = 1 + 11 * l;
        unsigned char* wl = ws + WS_W + (size_t)l * W_LAYER;
        bf16* HB = (bf16*)(ws + WS_HB); bf16* Z = (bf16*)(ws + WS_Z); bf16* Gt = (bf16*)(ws + WS_G);
        if (EN(0) && IN(pb + 0)) for (int rep = 0; rep <= NREP(0); ++rep) {
            { pg8::ProbGen g{HB, (const bf16*)(wl + WO_CAT), DM, DM, DM}; pg8::StaticOrder S; S.init(T, ZP, G, bx);
              pg8::EpiZG E{Z, Gt, p.in[16] + (size_t)l * NGATE, 1};
              pg8::gemm_phase<pg8::EpiZG, pg8::ProbGen, pg8::StaticOrder>(lds, g, S, E); }
            {
              const unsigned* gmax = (const unsigned*)(ws + WS_CTL) + CW_GMAX + 64 * 3 * l;
              pg8::ProbGen g{(const bf16*)(ws + WS_HB8), (const bf16*)(ws + WS_WG8 + (size_t)l * NGATE * DM), DM / 2, DM / 2, DM / 2}; pg8::StaticOrder S; S.init(T, NGATE, G, bx);
              pg8::EpiG8 E{Gt, p.in[16] + (size_t)l * NGATE, gmax};
              pg8::gemm_phase<pg8::EpiG8, pg8::ProbGen, pg8::StaticOrder, true, true>(lds, g, S, E); }
        }
        SEAM(pb + 0);
        if (EN(1) && IN(pb + 1)) { int ln = lane; asm volatile("" : "+v"(ln)); for (int t = gw; t < T; t += ngw) prep1_row(p, l, t, ln); }
        SEAM(pb + 1);
        if (EN(2) && IN(pb + 2)) for (int rep = 0; rep <= NREP(2); ++rep) {
            pg8::ProbUp g{Z, (const bf16*)(wl + WO_UP), ZP, 512, 512}; pg8::StaticOrder S; S.init(T, 1792, G, bx);
            pg8::EpiUp E{(bf16*)(ws + WS_QR), (bf16*)(ws + WS_KVR)};
            pg8::gemm_phase<pg8::EpiUp, pg8::ProbUp, pg8::StaticOrder>(lds, g, S, E);
        }
        SEAM(pb + 2);
        if (EN(3) && IN(pb + 3)) for (int rep = 0; rep <= NREP(3); ++rep) { int ln = lane; asm volatile("" : "+v"(ln)); for (int t = gw; t < T; t += ngw) prep2_row(p, l, t, ln); }
        SEAM(pb + 3);
        if (EN(4) && IN(pb + 4)) for (int rep = 0; rep <= NREP(4); ++rep) {
            const float lam = diff_lambda(p, l, lane), lam_init = 0.8f - 0.6f * expf(-0.3f * (float)l);
            unsigned* qbase = (unsigned*)(ws + WS_CTL) + 64 * (1 + 8 * l + 16 * rep);
            int qs = 0;
            for (;;) {
                __syncthreads();
                if (tid == 0) { int u = 192, qx = 0;
                    while (qs < 8) { qx = (int)((bar.x + (unsigned)qs) & 7u); u = (int)atomicAdd(qbase + 64 * qx, 1u); if (u < 192) break; ++qs; }
                    MISC[16] = (unsigned)(qs < 8 ? u : 192); MISC[17] = (unsigned)qx; MISC[18] = (unsigned)qs; }
                __syncthreads();
                const int u = (int)MISC[16], qx = (int)MISC[17]; qs = (int)MISC[18];
                if (u >= 192) break;
                if (u < 128) { const int qb = 31 - (u >> 2), combo = qx + 8 * (u & 3);
                    if (combo < 16) att::attn_unit<1>(p, l, combo >> 2, combo & 3, qb, lds, lam, lam_init, rep < NREP(4) ? PROBE_PM : 0);
                    else att::attn_unit<0>(p, l, (combo - 16) >> 2, (combo - 16) & 3, qb, lds, 0.f, 0.f, rep < NREP(4) ? PROBE_PM : 0);
                } else { const int v = qx * 64 + (u - 128); att::sgu_unit(p, l, v >> 2, v & 3, lds); }
            }
        }
        SEAM(pb + 4);
        if (EN(5) && IN(pb + 5)) for (int rep = 0; rep <= NREP(5); ++rep) {
            const bool prb = rep < NREP(5);
            pg8::ProbGen g{(const bf16*)(ws + WS_OC), (const bf16*)(wl + WO_B), 1536, 1536, 1536}; pg8::StaticOrder S; S.init(T, DM, G, bx);
            if (prb && (PROBE_PM & 2)) { g.A = HB; g.lda = DM; }
            if (prb && (PROBE_PM & 4)) { g.Bt = (const bf16*)(wl + WO_CAT); g.ldb = DM; }
            pg8::EpiMG E{prb ? (bf16*)(ws + WS_QR) : (bf16*)(ws + WS_MG), Gt, (prb && (PROBE_PM & 1)) ? 1 : 0};
            if (prb && (PROBE_PM & 8)) { pg8::EpiDelta E2{(bf16*)(ws + WS_QR)}; pg8::gemm_phase<pg8::EpiDelta, pg8::ProbGen, pg8::StaticOrder>(lds, g, S, E2); }
            else pg8::gemm_phase<pg8::EpiMG, pg8::ProbGen, pg8::StaticOrder>(lds, g, S, E);
        }
        SEAM(pb + 5);
        if (EN(6) && IN(pb + 6)) for (int rep = 0; rep <= NREP(6); ++rep) {
            pg8::ProbGen g{(const bf16*)(ws + WS_MG), (const bf16*)(wl + WO_OUT), DM, DM, DM}; pg8::StaticOrder S; S.init(T, DM, G, bx);
            pg8::EpiDelta E{(bf16*)(ws + WS_QR)};
            pg8::gemm_phase<pg8::EpiDelta, pg8::ProbGen, pg8::StaticOrder>(lds, g, S, E);
        }
        SEAM(pb + 6);
        if (EN(7) && IN(pb + 7)) { int ln = lane; asm volatile("" : "+v"(ln));
            const float* xin = l == 0 ? p.in[0] : p.out;
            for (int t = gw; t < T; t += ngw) add_rms_row(xin + (size_t)t * DM, (const bf16*)(ws + WS_QR) + (size_t)t * DM, RESID_IN_PEER ? nullptr : p.out + (size_t)t * DM, p.in[19] + (size_t)l * DM, HB + (size_t)t * DM, ln); }
        SEAM(pb + 7);
        if (EN(8) && IN(pb + 8)) for (int rep = 0; rep <= NREP(8); ++rep) {
            pg8::ProbGen g{HB, (const bf16*)(wl + WO_PQ), DM, DM, DM}; pg8::StaticOrder S; S.init(T, DM, G, bx);
            pg8::EpiSC E{(float*)(ws + WS_SC)};
            pg8::gemm_phase<pg8::EpiSC, pg8::ProbGen, pg8::StaticOrder>(lds, g, S, E);
        }
        SEAM(pb + 8);
        if (EN(9) && IN(pb + 9)) for (int rep = 0; rep <= NREP(9); ++rep) { int ln = lane; asm volatile("" : "+v"(ln));
            for (int task = gw; task < T * 8 / 64; task += ngw) { const int th = task * 64 + ln;
                topk_lane((const float*)(ws + WS_SC) + (size_t)th * 256, (int*)(ws + WS_IDX) + (size_t)th * 16, (float*)(ws + WS_GW) + (size_t)th * 16); } }
        SEAM(pb + 9);
        if (EN(10) && IN(pb + 10)) { int ln = lane; asm volatile("" : "+v"(ln));
            const float* gn = l + 1 < DEPTH ? p.in[1] + (size_t)(l + 1) * DM : nullptr;
            for (int rep = 0; rep <= NREP(10); ++rep) { const bool dummy = rep < NREP(10);
                const float* xin = (RESID_IN_PEER && l == 0) ? p.in[0] : p.out;
                if (dummy) peer_wave<PROBE_PM != 0>(p, l, gw, ngw, ln, nullptr, xin, (float*)(ws + WS_SC)); else peer_wave<false>(p, l, gw, ngw, ln, gn, xin, p.out); } }
        SEAM(pb + 10);
        }
    { constexpr int l = 1;
        const int pb = 1 + 11 * l;
        unsigned char* wl = ws + WS_W + (size_t)l * W_LAYER;
        bf16* HB = (bf16*)(ws + WS_HB); bf16* Z = (bf16*)(ws + WS_Z); bf16* Gt = (bf16*)(ws + WS_G);
        if (EN(0) && IN(pb + 0)) for (int rep = 0; rep <= NREP(0); ++rep) {
            { pg8::ProbGen g{HB, (const bf16*)(wl + WO_CAT), DM, DM, DM}; pg8::StaticOrder S; S.init(T, ZP, G, bx);
              pg8::EpiZG E{Z, Gt, p.in[16] + (size_t)l * NGATE, 1};
              pg8::gemm_phase<pg8::EpiZG, pg8::ProbGen, pg8::StaticOrder>(lds, g, S, E); }
            {
              const unsigned* gmax = (const unsigned*)(ws + WS_CTL) + CW_GMAX + 64 * 3 * l;
              pg8::ProbGen g{(const bf16*)(ws + WS_HB8), (const bf16*)(ws + WS_WG8 + (size_t)l * NGATE * DM), DM / 2, DM / 2, DM / 2}; pg8::StaticOrder S; S.init(T, NGATE, G, bx);
              pg8::EpiG8 E{Gt, p.in[16] + (size_t)l * NGATE, gmax};
              pg8::gemm_phase<pg8::EpiG8, pg8::ProbGen, pg8::StaticOrder, true, true>(lds, g, S, E); }
        }
        SEAM(pb + 0);
        if (EN(1) && IN(pb + 1)) { int ln = lane; asm volatile("" : "+v"(ln)); for (int t = gw; t < T; t += ngw) prep1_row(p, l, t, ln); }
        SEAM(pb + 1);
        if (EN(2) && IN(pb + 2)) for (int rep = 0; rep <= NREP(2); ++rep) {
            pg8::ProbUp g{Z, (const bf16*)(wl + WO_UP), ZP, 512, 512}; pg8::StaticOrder S; S.init(T, 1792, G, bx);
            pg8::EpiUp E{(bf16*)(ws + WS_QR), (bf16*)(ws + WS_KVR)};
            pg8::gemm_phase<pg8::EpiUp, pg8::ProbUp, pg8::StaticOrder>(lds, g, S, E);
        }
        SEAM(pb + 2);
        if (EN(3) && IN(pb + 3)) for (int rep = 0; rep <= NREP(3); ++rep) { int ln = lane; asm volatile("" : "+v"(ln)); for (int t = gw; t < T; t += ngw) prep2_row(p, l, t, ln); }
        SEAM(pb + 3);
        if (EN(4) && IN(pb + 4)) for (int rep = 0; rep <= NREP(4); ++rep) {
            const float lam = diff_lambda(p, l, lane), lam_init = 0.8f - 0.6f * expf(-0.3f * (float)l);
            unsigned* qbase = (unsigned*)(ws + WS_CTL) + 64 * (1 + 8 * l + 16 * rep);
            int qs = 0;
            for (;;) {
                __syncthreads();
                if (tid == 0) { int u = 192, qx = 0;
                    while (qs < 8) { qx = (int)((bar.x + (unsigned)qs) & 7u); u = (int)atomicAdd(qbase + 64 * qx, 1u); if (u < 192) break; ++qs; }
                    MISC[16] = (unsigned)(qs < 8 ? u : 192); MISC[17] = (unsigned)qx; MISC[18] = (unsigned)qs; }
                __syncthreads();
                const int u = (int)MISC[16], qx = (int)MISC[17]; qs = (int)MISC[18];
                if (u >= 192) break;
                if (u < 128) { const int qb = 31 - (u >> 2), combo = qx + 8 * (u & 3);
                    if (combo < 16) att::attn_unit<1>(p, l, combo >> 2, combo & 3, qb, lds, lam, lam_init, rep < NREP(4) ? PROBE_PM : 0);
                    else att::attn_unit<0>(p, l, (combo - 16) >> 2, (combo - 16) & 3, qb, lds, 0.f, 0.f, rep < NREP(4) ? PROBE_PM : 0);
                } else { const int v = qx * 64 + (u - 128); att::sgu_unit(p, l, v >> 2, v & 3, lds); }
            }
        }
        SEAM(pb + 4);
        if (EN(5) && IN(pb + 5)) for (int rep = 0; rep <= NREP(5); ++rep) {
            const bool prb = rep < NREP(5);
            pg8::ProbGen g{(const bf16*)(ws + WS_OC), (const bf16*)(wl + WO_B), 1536, 1536, 1536}; pg8::StaticOrder S; S.init(T, DM, G, bx);
            if (prb && (PROBE_PM & 2)) { g.A = HB; g.lda = DM; }
            if (prb && (PROBE_PM & 4)) { g.Bt = (const bf16*)(wl + WO_CAT); g.ldb = DM; }
            pg8::EpiMG E{prb ? (bf16*)(ws + WS_QR) : (bf16*)(ws + WS_MG), Gt, (prb && (PROBE_PM & 1)) ? 1 : 0};
            if (prb && (PROBE_PM & 8)) { pg8::EpiDelta E2{(bf16*)(ws + WS_QR)}; pg8::gemm_phase<pg8::EpiDelta, pg8::ProbGen, pg8::StaticOrder>(lds, g, S, E2); }
            else pg8::gemm_phase<pg8::EpiMG, pg8::ProbGen, pg8::StaticOrder>(lds, g, S, E);
        }
        SEAM(pb + 5);
        if (EN(6) && IN(pb + 6)) for (int rep = 0; rep <= NREP(6); ++rep) {
            pg8::ProbGen g{(const bf16*)(ws + WS_MG), (const bf16*)(wl + WO_OUT), DM, DM, DM}; pg8::StaticOrder S; S.init(T, DM, G, bx);
            pg8::EpiDelta E{(bf16*)(ws + WS_QR)};
            pg8::gemm_phase<pg8::EpiDelta, pg8::ProbGen, pg8::StaticOrder>(lds, g, S, E);
        }
        SEAM(pb + 6);
        if (EN(7) && IN(pb + 7)) { int ln = lane; asm volatile("" : "+v"(ln));
            const float* xin = l == 0 ? p.in[0] : p.out;
            for (int t = gw; t < T; t += ngw) add_rms_row(xin + (size_t)t * DM, (const bf16*)(ws + WS_QR) + (size_t)t * DM, RESID_IN_PEER ? nullptr : p.out + (size_t)t * DM, p.in[19] + (size_t)l * DM, HB + (size_t)t * DM, ln); }
        SEAM(pb + 7);
        if (EN(8) && IN(pb + 8)) for (int rep = 0; rep <= NREP(8); ++rep) {
            pg8::ProbGen g{HB, (const bf16*)(wl + WO_PQ), DM, DM, DM}; pg8::StaticOrder S; S.init(T, DM, G, bx);
            pg8::EpiSC E{(float*)(ws + WS_SC)};
            pg8::gemm_phase<pg8::EpiSC, pg8::ProbGen, pg8::StaticOrder>(lds, g, S, E);
        }
        SEAM(pb + 8);
        if (EN(9) && IN(pb + 9)) for (int rep = 0; rep <= NREP(9); ++rep) { int ln = lane; asm volatile("" : "+v"(ln));
            for (int task = gw; task < T * 8 / 64; task += ngw) { const int th = task * 64 + ln;
                topk_lane((const float*)(ws + WS_SC) + (size_t)th * 256, (int*)(ws + WS_IDX) + (size_t)th * 16, (float*)(ws + WS_GW) + (size_t)th * 16); } }
        SEAM(pb + 9);
        if (EN(10) && IN(pb + 10)) { int ln = lane; asm volatile("" : "+v"(ln));
            const float* gn = l + 1 < DEPTH ? p.in[1] + (size_t)(l + 1) * DM : nullptr;
            for (int rep = 0; rep <= NREP(10); ++rep) { const bool dummy = rep < NREP(10);
                const float* xin = (RESID_IN_PEER && l == 0) ? p.in[0] : p.out;
                if (dummy) peer_wave<PROBE_PM != 0>(p, l, gw, ngw, ln, nullptr, xin, (float*)(ws + WS_SC)); else peer_wave<false>(p, l, gw, ngw, ln, gn, xin, p.out); } }
        SEAM(pb + 10);
        }
#undef IN
#undef SEAM
}

static int g_grid = 0;
static void launch_mega(const Params& p, int lo, int hi, int li, hipStream_t stream) {
    MArgs a{}; a.p = p; a.ph_lo = lo; a.ph_hi = hi; a.li = li; a.pad = 0;
    mega<<<g_grid, 512, LDS_BYTES, stream>>>(a);
}
extern "C" void kernel_launch(void* const* d_in, const int* in_sizes, int n_in, void* d_out, int out_size, void* d_ws, size_t ws_size, hipStream_t stream) {
    if (n_in != 24 || out_size != T * DM || ws_size < WS_END) { fprintf(stderr, "kernel_launch: unexpected shapes (n_in %d, out %d, ws %zu, need %zu)\n", n_in, out_size, ws_size, (size_t)WS_END); return; }
    if (g_grid == 0) {
        int dev = 0, cus = 0, per_cu = 0;
        if (hipGetDevice(&dev) != hipSuccess || hipDeviceGetAttribute(&cus, hipDeviceAttributeMultiprocessorCount, dev) != hipSuccess) { g_grid = -1; return; }
        if (hipFuncSetAttribute((const void*)mega, hipFuncAttributeMaxDynamicSharedMemorySize, LDS_BYTES) != hipSuccess) { fprintf(stderr, "kernel_launch: hipFuncSetAttribute failed\n"); g_grid = -1; return; }
        if (hipOccupancyMaxActiveBlocksPerMultiprocessor(&per_cu, (const void*)mega, 512, LDS_BYTES) != hipSuccess || per_cu < 1) { fprintf(stderr, "kernel_launch: occupancy query says %d\n", per_cu); }
        (void)hipGetLastError();
        g_grid = cus;
    }
    if (g_grid < 0) return;
    Params p{};
    for (int i = 0; i < 24; ++i) p.in[i] = (const float*)d_in[i];
    p.out = (float*)d_out; p.ws = (unsigned char*)d_ws;
    unsigned char* ws = p.ws;
    (void)hipMemsetAsync(ws + WS_CTL, 0, 1 * MiB, stream);
    launch_mega(p, 0, NPHASE, 0, stream);
}
```

```cpp
#include <hip/hip_runtime.h>
#include <cstdio>
#include <cstdint>
#ifndef RESID_IN_PEER
#define RESID_IN_PEER 0
#endif

constexpr int BATCH = 4, SEQ = 4096, DM = 2048, DEPTH = 2;
constexpr int T = BATCH * SEQ;
constexpr int ZP = 3840;
constexpr int NGATE = 3 * DM;
constexpr int N1 = ZP + NGATE;
constexpr int ZC_CQ = 0, ZC_CKV = 512, ZC_DQ = 1024, ZC_DK = 1536, ZC_DV = 2048, ZC_SU = 2560, ZC_SV = 3072, ZC_KR = 3584;
constexpr int DIN = 3616;
constexpr int NEXP = 16384;
constexpr float NORM_EPS = 1e-6f;
constexpr float LOG2E = 1.4426950408889634f;

typedef unsigned short bf16;
typedef unsigned u32x4 __attribute__((ext_vector_type(4)));
typedef unsigned u32x2 __attribute__((ext_vector_type(2)));
typedef float f32x4 __attribute__((ext_vector_type(4)));
typedef float f32x16 __attribute__((ext_vector_type(16)));
typedef short bf16x8 __attribute__((ext_vector_type(8)));
#define LAS __attribute__((address_space(3)))

constexpr size_t MiB = 1u << 20;
constexpr size_t WS_CTL = 0;
constexpr size_t WS_ROPE = 1 * MiB;
constexpr size_t WS_W = 2 * MiB;
constexpr size_t WO_CAT = 0;
constexpr size_t WO_UP = WO_CAT + (size_t)N1 * DM * 2;
constexpr size_t WO_B = WO_UP + (size_t)1792 * 512 * 2;
constexpr size_t WO_OUT = WO_B + (size_t)3 * DM * 512 * 2;
constexpr size_t WO_PQ = WO_OUT + (size_t)DM * DM * 2;
constexpr size_t WO_SGU = WO_PQ + (size_t)DM * DM * 2;
constexpr size_t W_LAYER = WO_SGU + (size_t)4 * 128 * 128 * 2;
constexpr size_t WS_ACT = WS_W + 2 * W_LAYER + (2 * MiB - (2 * W_LAYER) % (2 * MiB));
constexpr size_t WS_HB = WS_ACT;
constexpr size_t WS_Z = WS_HB + (size_t)T * DM * 2;
constexpr size_t WS_G = WS_Z + (size_t)T * ZP * 2;
constexpr size_t WS_SC = WS_G;
constexpr size_t WS_QR = WS_G + (size_t)T * NGATE * 2;
constexpr size_t WS_KVR = WS_QR + (size_t)T * 768 * 2;
constexpr size_t WS_QM = WS_KVR + (size_t)T * 1024 * 2;
constexpr size_t WS_KM = WS_QM + (size_t)T * 768 * 2;
constexpr size_t WS_OC = WS_KM + (size_t)T * 768 * 2;
constexpr size_t WS_MG = WS_OC + (size_t)3 * T * 512 * 2;
constexpr size_t WS_IDX = WS_MG + (size_t)T * DM * 2;
constexpr size_t WS_GW = WS_IDX + (size_t)T * 128 * 4;
constexpr int QROW = DM / 2;
constexpr size_t WS_U8 = WS_GW + (size_t)T * 128 * 4;
constexpr size_t WS_V8 = WS_U8 + (size_t)DEPTH * NEXP * QROW;
constexpr size_t WS_PS = WS_V8 + (size_t)DEPTH * NEXP * QROW;
constexpr size_t WS_HB8 = WS_PS + (size_t)2 * DEPTH * NEXP * 4;
constexpr size_t WS_WG8 = WS_HB8 + (size_t)T * DM;
constexpr size_t WS_HS = WS_WG8 + (size_t)DEPTH * NGATE * DM;
constexpr size_t WS_END = WS_HS + (size_t)T * 8;
constexpr int CW_GMAX = 3072;

struct Params {
    const float* in[24];
    float* out;
    unsigned char* ws;
};

__device__ __forceinline__ unsigned f2bf(float f) { unsigned u = __builtin_bit_cast(unsigned, f); return (u + 0x7fffu + ((u >> 16) & 1u)) >> 16; }
__device__ __forceinline__ unsigned pk2(float lo, float hi) { return f2bf(lo) | (f2bf(hi) << 16); }
__device__ __forceinline__ float bf2f(unsigned b) { return __builtin_bit_cast(float, b << 16); }
__device__ __forceinline__ float bflo(unsigned w) { return __builtin_bit_cast(float, w << 16); }
__device__ __forceinline__ float bfhi(unsigned w) { return __builtin_bit_cast(float, w & 0xffff0000u); }
__device__ __forceinline__ unsigned pk4_fp8(float a, float b, float c, float d) { int w = __builtin_amdgcn_cvt_pk_fp8_f32(a, b, 0, false); w = __builtin_amdgcn_cvt_pk_fp8_f32(c, d, w, true); return (unsigned)w; }
__device__ __forceinline__ float wave_sum(float v) {
#pragma unroll
    for (int o = 1; o < 64; o <<= 1) v += __shfl_xor(v, o);
    return v;
}
__device__ __forceinline__ float gelu_tanh(float x) {
    const float u = 0.7978845608028654f * (x + 0.044715f * x * x * x);
    const float e = __expf(-2.0f * fabsf(u));
    float th = (1.0f - e) / (1.0f + e);
    th = u < 0.f ? -th : th;
    return 0.5f * x * (1.0f + th);
}
__device__ __forceinline__ void unpack8(const u32x4 w, float (&f)[8]) {
    f[0] = bflo(w.x); f[1] = bfhi(w.x); f[2] = bflo(w.y); f[3] = bfhi(w.y); f[4] = bflo(w.z); f[5] = bfhi(w.z); f[6] = bflo(w.w); f[7] = bfhi(w.w);
}
__device__ __forceinline__ u32x4 pack8(const float (&f)[8]) {
    u32x4 w; w.x = pk2(f[0], f[1]); w.y = pk2(f[2], f[3]); w.z = pk2(f[4], f[5]); w.w = pk2(f[6], f[7]); return w;
}

__device__ __forceinline__ void transpose_item(const float* __restrict__ W, int ldw, int scol0, int k0, int K, bf16* __restrict__ WT, int drow0, float* scr, int lane, int kd0 = -1) {
    if (kd0 < 0) kd0 = k0;
    float v[32];
    const float* src = W + (size_t)(k0 + (lane >> 5)) * ldw + scol0 + (lane & 31);
#pragma unroll
    for (int i = 0; i < 32; ++i) v[i] = src[(size_t)(2 * i) * ldw];
#pragma unroll
    for (int i = 0; i < 32; ++i) scr[(2 * i + (lane >> 5)) * 33 + (lane & 31)] = v[i];
    asm volatile("s_waitcnt lgkmcnt(0)" ::: "memory");
    const int c = lane & 7;
#pragma unroll
    for (int j = 0; j < 4; ++j) { const int n = (lane >> 3) + 8 * j; const float* s = scr + (8 * c) * 33 + n;
        u32x4 o; o.x = pk2(s[0 * 33], s[1 * 33]); o.y = pk2(s[2 * 33], s[3 * 33]); o.z = pk2(s[4 * 33], s[5 * 33]); o.w = pk2(s[6 * 33], s[7 * 33]);
        *(u32x4*)(WT + (size_t)(drow0 + n) * K + kd0 + 8 * c) = o; }
    asm volatile("s_waitcnt lgkmcnt(0)" ::: "memory");
}

__device__ __forceinline__ void transpose_item8(const float* __restrict__ W, int ldw, int scol0, int k0, int K, unsigned char* __restrict__ WT, int drow0, float* scr, int lane, float sc) {
    float v[32];
    const float* src = W + (size_t)(k0 + (lane >> 5)) * ldw + scol0 + (lane & 31);
#pragma unroll
    for (int i = 0; i < 32; ++i) v[i] = src[(size_t)(2 * i) * ldw];
#pragma unroll
    for (int i = 0; i < 32; ++i) scr[(2 * i + (lane >> 5)) * 33 + (lane & 31)] = v[i] * sc;
    asm volatile("s_waitcnt lgkmcnt(0)" ::: "memory");
    const int c = lane & 7;
#pragma unroll
    for (int j = 0; j < 4; ++j) { const int n = (lane >> 3) + 8 * j; const float* s = scr + (8 * c) * 33 + n;
        u32x2 o; o.x = pk4_fp8(s[0 * 33], s[1 * 33], s[2 * 33], s[3 * 33]); o.y = pk4_fp8(s[4 * 33], s[5 * 33], s[6 * 33], s[7 * 33]);
        *(u32x2*)(WT + (size_t)(drow0 + n) * K + k0 + 8 * c) = o; }
    asm volatile("s_waitcnt lgkmcnt(0)" ::: "memory");
}
__device__ __forceinline__ float gate_scale(const unsigned* w) { const unsigned b = __hip_atomic_load(w, __ATOMIC_RELAXED, __HIP_MEMORY_SCOPE_AGENT); const int e = (int)((b >> 23) & 255u) - 126;
    const int k = 8 - e, kc = k < -100 ? -100 : (k > 100 ? 100 : k); return __builtin_bit_cast(float, (unsigned)(kc + 127) << 23); }
__device__ __forceinline__ void prologue_transposes(const Params& p, int l, float* scr, int gw, int ngw, int lane) {
    unsigned char* wl = p.ws + WS_W + (size_t)l * W_LAYER;
    bf16* Wcat = (bf16*)(wl + WO_CAT); bf16* Wup = (bf16*)(wl + WO_UP); bf16* Wb = (bf16*)(wl + WO_B); bf16* Wout = (bf16*)(wl + WO_OUT);
    const float* w_in = p.in[2] + (size_t)l * DM * DIN;
    const float* w_gate = p.in[15] + (size_t)l * 3 * DM * DM;
    const float* w_uq = p.in[5] + (size_t)l * 512 * 768;
    const float* w_ukv = p.in[6] + (size_t)l * 512 * 1024;
    const float* w_br = p.in[17] + (size_t)l * 3 * 512 * DM;
    const float* w_out = p.in[18] + (size_t)l * DM * DM;
    constexpr int I1 = 113 * 32, I2 = 3 * 64 * 32, I3 = 24 * 8, I4 = 32 * 8, I5 = 3 * 64 * 8, I6 = 64 * 32;
    constexpr int NIT = I1 + I2 + I3 + I4 + I5 + I6;
    for (int it = gw; it < NIT; it += ngw) {
        int r = it;
        if (r < I1) { const int cb = r / 32, kb = r % 32; const int n0 = cb * 32;
            const int sc = n0 < 1024 ? n0 : (n0 < 3584 ? n0 + 32 : n0 - 3584 + 1024);
            transpose_item(w_in, DIN, sc, kb * 64, DM, Wcat, n0, scr, lane); continue; } r -= I1;
        if (r < I2) { continue; } r -= I2;
        if (r < I3) { const int cb = r / 8, kb = r % 8;
            int sc, dr; if (cb < 16) { const int h = cb >> 1, hf = cb & 1; sc = h * 96 + 32 * hf; dr = h * 64 + 32 * hf; } else { const int h = cb - 16; sc = h * 96 + 64; dr = 512 + h * 32; }
            transpose_item(w_uq, 768, sc, kb * 64, 512, Wup, dr, scr, lane); continue; } r -= I3;
        if (r < I4) { const int cb = r / 8, kb = r % 8;
            const int v = cb >> 4, h = (cb & 15) >> 1, hf = cb & 1; const int sc = h * 128 + 64 * v + 32 * hf, dr = 768 + 512 * v + h * 64 + 32 * hf;
            transpose_item(w_ukv, 1024, sc, kb * 64, 512, Wup, dr, scr, lane); continue; } r -= I4;
        if (r < I5) { const int n = r / 512, q = r % 512, cb = q / 8, kb = q % 8;
            transpose_item(w_br + (size_t)n * 512 * DM, DM, cb * 32, kb * 64, 1536, Wb, cb * 32, scr, lane, n * 512 + kb * 64); continue; } r -= I5;
        { const int cb = r / 32, kb = r % 32; transpose_item(w_out, DM, cb * 32, kb * 64, DM, Wout, cb * 32, scr, lane); }
    }
    for (int i = gw * 64 + lane; i < 224 * 256; i += ngw * 64) { ((u32x4*)(Wcat + (size_t)DIN * DM))[i] = (u32x4){0u, 0u, 0u, 0u}; }
    bf16* sg = (bf16*)(wl + WO_SGU); const float* sw = p.in[13] + (size_t)l * 4 * 128 * 128;
    for (int i = gw * 64 + lane; i < 4 * 128 * 128; i += ngw * 64) { const int s = i & 127, t = (i >> 7) & 127; const bool ok = (s >> 6) <= (t >> 6); sg[i] = (bf16)f2bf(ok ? sw[i] : 0.f); }
}

__device__ __forceinline__ void prologue_rope(const Params& p, int gtid, int nthr) {
    float* tab = (float*)(p.ws + WS_ROPE);
    for (int i = gtid; i < SEQ * 24; i += nthr) {
        const int pos = i / 24, j = i % 24;
        const int jj = j < 8 ? 2 * j : j - 8;
        float invf;
        switch (jj) { case 0: invf = 1.000000000e+00f; break; case 1: invf = 4.403665960e-01f; break; case 2: invf = 1.939227432e-01f; break; case 3: invf = 8.539710194e-02f; break;
            case 4: invf = 3.760603070e-02f; break; case 5: invf = 1.656044088e-02f; break; case 6: invf = 7.292664610e-03f; break; case 7: invf = 3.211446106e-03f; break;
            case 8: invf = 1.414213562e-03f; break; case 9: invf = 6.227724371e-04f; break; case 10: invf = 2.742481884e-04f; break; case 11: invf = 1.207697351e-04f; break;
            case 12: invf = 5.318295734e-05f; break; case 13: invf = 2.341999971e-05f; break; case 14: invf = 1.031338525e-05f; break; default: invf = 4.541670478e-06f; break; }
        int co, so; if (j < 8) { co = j; so = 8 + j; } else { co = 16 + (j - 8); so = 32 + (j - 8); }
        const float ang = (float)pos * invf; float sn, cs; sincosf(ang, &sn, &cs);
        tab[pos * 48 + co] = cs; tab[pos * 48 + so] = sn;
    }
}

__device__ __forceinline__ void fold_item(const Params& p, int l, int item, float* lds, int tid) {
    const int hc = item >> 4, mt = item & 15, c = hc & 1, m0 = mt * 128;
    const float* Wq = p.in[20] + (size_t)l * DM * DM; const float* keys = p.in[21] + (size_t)l * 2 * 128 * 128 + (size_t)c * 128 * 128;
    bf16* WPQ = (bf16*)(p.ws + WS_W + (size_t)l * W_LAYER + WO_PQ);
    float* As = lds; float* Bs = lds + 128 * 68;
    const int tn = tid & 31, tm = tid >> 5;
    float acc[4][8];
#pragma unroll
    for (int i = 0; i < 4; ++i)
#pragma unroll
        for (int j = 0; j < 8; ++j) acc[i][j] = 0.f;
    for (int dh = 0; dh < 2; ++dh) {
        __syncthreads();
        for (int i = tid; i < 128 * 16; i += 512) { const int r = i >> 4, q = i & 15;
            *(f32x4*)(As + r * 68 + 4 * q) = *(const f32x4*)(Wq + (size_t)(m0 + r) * DM + hc * 128 + dh * 64 + 4 * q);
            *(f32x4*)(Bs + r * 68 + 4 * q) = *(const f32x4*)(keys + r * 128 + dh * 64 + 4 * q); }
        __syncthreads();
#pragma unroll 2
        for (int d = 0; d < 64; d += 4) {
            f32x4 b4[4], a4[8];
#pragma unroll
            for (int i = 0; i < 4; ++i) b4[i] = *(const f32x4*)(Bs + (tn + 32 * i) * 68 + d);
#pragma unroll
            for (int j = 0; j < 8; ++j) a4[j] = *(const f32x4*)(As + (8 * tm + j) * 68 + d);
#pragma unroll
            for (int i = 0; i < 4; ++i)
#pragma unroll
                for (int j = 0; j < 8; ++j) acc[i][j] += (b4[i].x * a4[j].x + b4[i].y * a4[j].y) + (b4[i].z * a4[j].z + b4[i].w * a4[j].w);
        }
    }
#pragma unroll
    for (int i = 0; i < 4; ++i) *(u32x4*)(WPQ + (size_t)(hc * 128 + tn + 32 * i) * DM + m0 + 8 * tm) = pack8(acc[i]);
}

__device__ __forceinline__ void rms_row_to_bf16(const float* xrow, const float* gain, bf16* orow, int lane, unsigned char* o8 = nullptr) {
    f32x4 v[8]; float s = 0.f;
#pragma unroll
    for (int j = 0; j < 8; ++j) { v[j] = ((const f32x4*)xrow)[lane + 64 * j]; s += (v[j].x * v[j].x + v[j].y * v[j].y) + (v[j].z * v[j].z + v[j].w * v[j].w); }
    const float rstd = rsqrtf(wave_sum(s) * (1.f / DM) + NORM_EPS);
#pragma unroll
    for (int j = 0; j < 8; ++j) { const f32x4 g = ((const f32x4*)gain)[lane + 64 * j];
        u32x2 o; o.x = pk2(v[j].x * rstd * g.x, v[j].y * rstd * g.y); o.y = pk2(v[j].z * rstd * g.z, v[j].w * rstd * g.w);
        ((u32x2*)orow)[lane + 64 * j] = o;
        if (o8) ((unsigned*)o8)[lane + 64 * j] = pk4_fp8(v[j].x * rstd * g.x, v[j].y * rstd * g.y, v[j].z * rstd * g.z, v[j].w * rstd * g.w); }
}

__device__ __forceinline__ void add_rms_row(const float* xin, const bf16* dl, float* xout, const float* gain, bf16* orow, float* hs, int lane) {
    f32x4 v[8]; float s = 0.f;
#pragma unroll
    for (int j = 0; j < 8; ++j) { v[j] = ((const f32x4*)xin)[lane + 64 * j]; const u32x2 d = ((const u32x2*)dl)[lane + 64 * j];
        v[j].x += bflo(d.x); v[j].y += bfhi(d.x); v[j].z += bflo(d.y); v[j].w += bfhi(d.y);
        if (xout) ((f32x4*)xout)[lane + 64 * j] = v[j];
        s += (v[j].x * v[j].x + v[j].y * v[j].y) + (v[j].z * v[j].z + v[j].w * v[j].w); }
    const float rstd = rsqrtf(wave_sum(s) * (1.f / DM) + NORM_EPS);
    float mx = 0.f;
#pragma unroll
    for (int j = 0; j < 8; ++j) { const f32x4 g = ((const f32x4*)gain)[lane + 64 * j];
        u32x2 o; o.x = pk2(v[j].x * rstd * g.x, v[j].y * rstd * g.y); o.y = pk2(v[j].z * rstd * g.z, v[j].w * rstd * g.w);
        ((u32x2*)orow)[lane + 64 * j] = o;
        v[j].x = bflo(o.x); v[j].y = bfhi(o.x); v[j].z = bflo(o.y); v[j].w = bfhi(o.y);
        mx = fmaxf(mx, fmaxf(fmaxf(fabsf(v[j].x), fabsf(v[j].y)), fmaxf(fabsf(v[j].z), fabsf(v[j].w)))); }
#pragma unroll
    for (int of = 1; of < 64; of <<= 1) mx = fmaxf(mx, __shfl_xor(mx, of));
    const float hscale = fmaxf(mx, 1e-30f) * (1.f / 127.f), ih = 1.f / hscale; int isum = 0;
#pragma unroll
    for (int j = 0; j < 8; ++j) isum += ((int)rintf(v[j].x * ih) + (int)rintf(v[j].y * ih)) + ((int)rintf(v[j].z * ih) + (int)rintf(v[j].w * ih));
    const float h8sum = wave_sum((float)isum);
    if (lane == 0) { hs[0] = hscale; hs[1] = h8sum; }
}

__device__ __forceinline__ void prep1_row(const Params& p, int l, int t, int lane) {
    bf16* z = (bf16*)(p.ws + WS_Z) + (size_t)t * ZP;
    const float* rope = (const float*)(p.ws + WS_ROPE) + (size_t)(t & (SEQ - 1)) * 48;
    float f[8];
#pragma unroll
    for (int seg = 0; seg < 2; ++seg) {
        const float* g = (seg == 0 ? p.in[3] : p.in[4]) + (size_t)l * 512;
        u32x4* ptr = (u32x4*)(z + (seg == 0 ? ZC_CQ : ZC_CKV)) + lane;
        unpack8(*ptr, f); float s = 0.f;
#pragma unroll
        for (int i = 0; i < 8; ++i) s += f[i] * f[i];
        const float rstd = rsqrtf(wave_sum(s) * (1.f / 512.f) + NORM_EPS);
#pragma unroll
        for (int i = 0; i < 8; ++i) f[i] = f[i] * rstd * g[lane * 8 + i];
        *ptr = pack8(f);
    }
#pragma unroll
    for (int seg = 0; seg < 2; ++seg) {
        const float* g = p.in[9] + (size_t)l * 128 + seg * 64;
        u32x4* ptr = (u32x4*)(z + (seg == 0 ? ZC_DQ : ZC_DK)) + lane;
        unpack8(*ptr, f); float s = 0.f;
#pragma unroll
        for (int i = 0; i < 8; ++i) s += f[i] * f[i];
        s += __shfl_xor(s, 1); s += __shfl_xor(s, 2); s += __shfl_xor(s, 4);
        const float rstd = rsqrtf(s * (1.f / 64.f) + NORM_EPS);
        const int d0 = (lane & 7) * 8;
#pragma unroll
        for (int i = 0; i < 8; ++i) f[i] = f[i] * rstd * g[d0 + i];
        float o[8];
#pragma unroll
        for (int i = 0; i < 8; ++i) o[i] = __shfl_xor(f[i], 1);
        if ((lane & 7) == 0) {
#pragma unroll
            for (int i = 0; i < 8; ++i) f[i] = f[i] * rope[i] - o[i] * rope[8 + i];
        } else if ((lane & 7) == 1) {
#pragma unroll
            for (int i = 0; i < 8; ++i) f[i] = f[i] * rope[i] + o[i] * rope[8 + i];
        }
        if (seg == 0) {
#pragma unroll
            for (int i = 0; i < 8; ++i) f[i] *= 0.125f * LOG2E;
        }
        *ptr = pack8(f);
    }
    {
        u32x4* ptr = (u32x4*)(z + ZC_SU) + lane;
        unpack8(*ptr, f);
#pragma unroll
        for (int i = 0; i < 8; ++i) f[i] = gelu_tanh(f[i]);
        *ptr = pack8(f);
    }
    {
        const float* g = p.in[12] + (size_t)l * 512;
        u32x4* ptr = (u32x4*)(z + ZC_SV) + lane;
        unpack8(*ptr, f); float s = 0.f;
#pragma unroll
        for (int i = 0; i < 8; ++i) { f[i] = gelu_tanh(f[i]); s += f[i] * f[i]; }
        const float rstd = rsqrtf(wave_sum(s) * (1.f / 512.f) + NORM_EPS);
#pragma unroll
        for (int i = 0; i < 8; ++i) f[i] = f[i] * rstd * g[lane * 8 + i];
        *ptr = pack8(f);
    }
    {
        const float* g = p.in[8] + (size_t)l * 64 + 32;
        const int ll = lane & 3;
        const u32x4 w = *((const u32x4*)(z + ZC_KR) + ll);
        unpack8(w, f); float s = 0.f;
#pragma unroll
        for (int i = 0; i < 8; ++i) s += f[i] * f[i];
        s += __shfl_xor(s, 1); s += __shfl_xor(s, 2);
        const float rstd = rsqrtf(s * (1.f / 32.f) + NORM_EPS);
#pragma unroll
        for (int i = 0; i < 8; ++i) f[i] = f[i] * rstd * g[ll * 8 + i];
        float o[8];
#pragma unroll
        for (int i = 0; i < 8; ++i) o[i] = __shfl_xor(f[i], 2);
        const int fi = (ll & 1) * 8;
        if (ll < 2) {
#pragma unroll
            for (int i = 0; i < 8; ++i) f[i] = f[i] * rope[16 + fi + i] - o[i] * rope[32 + fi + i];
        } else {
#pragma unroll
            for (int i = 0; i < 8; ++i) f[i] = f[i] * rope[16 + fi + i] + o[i] * rope[32 + fi + i];
        }
        if (lane < 32) { bf16* km = (bf16*)(p.ws + WS_KM) + (size_t)t * 768 + (lane >> 2) * 96 + 64 + ll * 8; *(u32x4*)km = pack8(f); }
    }
}

__device__ __forceinline__ void prep2_row(const Params& p, int l, int t, int lane) {
    const bf16* qr = (const bf16*)(p.ws + WS_QR) + (size_t)t * 768;
    const bf16* kvr = (const bf16*)(p.ws + WS_KVR) + (size_t)t * 1024;
    bf16* qm = (bf16*)(p.ws + WS_QM) + (size_t)t * 768;
    bf16* km = (bf16*)(p.ws + WS_KM) + (size_t)t * 768;
    const float* rope = (const float*)(p.ws + WS_ROPE) + (size_t)(t & (SEQ - 1)) * 48;
    const float* ng = p.in[7] + (size_t)l * 128;
    const float* rg = p.in[8] + (size_t)l * 64;
    const float qscale = 0.10206207261596577f * LOG2E;
    float f[8];
    const int h = lane >> 3, d0 = (lane & 7) * 8;
    {
        unpack8(*((const u32x4*)qr + lane), f); float s = 0.f;
#pragma unroll
        for (int i = 0; i < 8; ++i) s += f[i] * f[i];
        s += __shfl_xor(s, 1); s += __shfl_xor(s, 2); s += __shfl_xor(s, 4);
        const float rstd = rsqrtf(s * (1.f / 64.f) + NORM_EPS) * qscale;
#pragma unroll
        for (int i = 0; i < 8; ++i) f[i] = f[i] * rstd * ng[d0 + i];
        *(u32x4*)(qm + h * 96 + d0) = pack8(f);
    }
    {
        unpack8(*((const u32x4*)kvr + lane), f); float s = 0.f;
#pragma unroll
        for (int i = 0; i < 8; ++i) s += f[i] * f[i];
        s += __shfl_xor(s, 1); s += __shfl_xor(s, 2); s += __shfl_xor(s, 4);
        const float rstd = rsqrtf(s * (1.f / 64.f) + NORM_EPS);
#pragma unroll
        for (int i = 0; i < 8; ++i) f[i] = f[i] * rstd * ng[64 + d0 + i];
        *(u32x4*)(km + h * 96 + d0) = pack8(f);
    }
    {
        const int l5 = lane & 31, hh = l5 >> 2, ll = l5 & 3;
        unpack8(*((const u32x4*)(qr + 512) + l5), f); float s = 0.f;
#pragma unroll
        for (int i = 0; i < 8; ++i) s += f[i] * f[i];
        s += __shfl_xor(s, 1); s += __shfl_xor(s, 2);
        const float rstd = rsqrtf(s * (1.f / 32.f) + NORM_EPS);
#pragma unroll
        for (int i = 0; i < 8; ++i) f[i] = f[i] * rstd * rg[ll * 8 + i];
        float o[8];
#pragma unroll
        for (int i = 0; i < 8; ++i) o[i] = __shfl_xor(f[i], 2);
        const int fi = (ll & 1) * 8;
        if (ll < 2) {
#pragma unroll
            for (int i = 0; i < 8; ++i) f[i] = (f[i] * rope[16 + fi + i] - o[i] * rope[32 + fi + i]) * qscale;
        } else {
#pragma unroll
            for (int i = 0; i < 8; ++i) f[i] = (f[i] * rope[16 + fi + i] + o[i] * rope[32 + fi + i]) * qscale;
        }
        if (lane < 32) *(u32x4*)(qm + hh * 96 + 64 + ll * 8) = pack8(f);
    }
}

__device__ __forceinline__ float diff_lambda(const Params& p, int l, int lane) {
    const float* lv = p.in[10] + (size_t)l * 256;
    const float a = wave_sum(lv[lane] * lv[64 + lane]), b = wave_sum(lv[128 + lane] * lv[192 + lane]);
    const float lambda_init = 0.8f - 0.6f * expf(-0.3f * (float)l);
    return expf(a) - expf(b) + lambda_init;
}

typedef float f32x2 __attribute__((ext_vector_type(2)));
typedef _Float16 f16x32 __attribute__((ext_vector_type(32)));
typedef float f32x32 __attribute__((ext_vector_type(32)));
typedef unsigned u32x6 __attribute__((ext_vector_type(6)));
__device__ __forceinline__ void q4_row(const float* __restrict__ src, unsigned char* __restrict__ dst, float* scl, int lane) {
    f32x4 v[8]; float ss = 0.f;
#pragma unroll
    for (int j = 0; j < 8; ++j) { v[j] = *(const f32x4*)(src + 256 * (lane >> 3) + 32 * j + 4 * (lane & 7)); ss += (v[j].x * v[j].x + v[j].y * v[j].y) + (v[j].z * v[j].z + v[j].w * v[j].w); }
    const float sc = fmaxf(0.5f * sqrtf(wave_sum(ss) * (1.f / DM)), 1e-30f), is = 1.f / sc;
    u32x4 w;
#pragma unroll
    for (int d = 0; d < 4; ++d) { unsigned x = 0;
        const f32x4 a = v[2 * d], b = v[2 * d + 1];
        x = __builtin_amdgcn_cvt_scalef32_pk_fp4_f32(x, fminf(fmaxf(a.x * is, -6.f), 6.f), fminf(fmaxf(a.y * is, -6.f), 6.f), 1.0f, 0);
        x = __builtin_amdgcn_cvt_scalef32_pk_fp4_f32(x, fminf(fmaxf(a.z * is, -6.f), 6.f), fminf(fmaxf(a.w * is, -6.f), 6.f), 1.0f, 1);
        x = __builtin_amdgcn_cvt_scalef32_pk_fp4_f32(x, fminf(fmaxf(b.x * is, -6.f), 6.f), fminf(fmaxf(b.y * is, -6.f), 6.f), 1.0f, 2);
        x = __builtin_amdgcn_cvt_scalef32_pk_fp4_f32(x, fminf(fmaxf(b.z * is, -6.f), 6.f), fminf(fmaxf(b.w * is, -6.f), 6.f), 1.0f, 3);
        w[d] = x; }
    *(u32x4*)(dst + (size_t)(lane >> 3) * (NEXP * 128) + 16 * (lane & 7)) = w;
    if (lane == 0) *scl = sc;
}
__device__ __forceinline__ void q4u_row(const float* __restrict__ src, unsigned char* __restrict__ dst, float* scl, int lane) {
    f32x4 v[8]; float ss = 0.f;
#pragma unroll
    for (int j = 0; j < 8; ++j) { v[j] = *(const f32x4*)(src + 256 * (lane >> 3) + 32 * j + 4 * (lane & 7)); ss += (v[j].x * v[j].x + v[j].y * v[j].y) + (v[j].z * v[j].z + v[j].w * v[j].w); }
    const float step = fmaxf(0.35f * sqrtf(wave_sum(ss) * (1.f / DM)), 1e-30f), is = 1.f / step;
    u32x4 w;
#pragma unroll
    for (int d = 0; d < 4; ++d) { unsigned x = 0;
#pragma unroll
        for (int e = 0; e < 8; ++e) { const float f = v[2 * d + (e >> 2)][e & 3]; const int q = (int)fminf(fmaxf(rintf(f * is), -8.f), 7.f) + 8; x |= (unsigned)q << (4 * e); }
        w[d] = x; }
    *(u32x4*)(dst + (size_t)(lane >> 3) * (NEXP * 128) + 16 * (lane & 7)) = w;
    if (lane == 0) *scl = step;
}
__device__ __forceinline__ int f2key(float f) { const int b = __builtin_bit_cast(int, f); return b ^ ((b >> 31) & 0x7fffffff); }
__device__ __forceinline__ float key2f(int k) { const int b = k ^ ((k >> 31) & 0x7fffffff); return __builtin_bit_cast(float, b & ~127); }
__device__ __forceinline__ void topk_lane(const float* __restrict__ sc, int* __restrict__ idxo, float* __restrict__ gwo) {
    float av[2][16]; int ai[2][16];
#pragma unroll
    for (int c = 0; c < 2; ++c) {
        int lst[16];
#pragma unroll
        for (int j = 0; j < 16; ++j) lst[j] = (int)0x80000000;
#pragma unroll 1
        for (int i0 = 0; i0 < 128; i0 += 32) {
            f32x4 v[8];
#pragma unroll
            for (int q = 0; q < 8; ++q) v[q] = *(const f32x4*)(sc + c * 128 + i0 + 4 * q);
#pragma unroll
            for (int q = 0; q < 8; ++q)
#pragma unroll
                for (int e = 0; e < 4; ++e) { int key = (f2key(v[q][e]) & ~127) | (127 - (i0 + 4 * q + e));
#pragma unroll
                    for (int j = 0; j < 16; ++j) { const int hi = max(lst[j], key); key = min(lst[j], key); lst[j] = hi; } }
        }
#pragma unroll
        for (int j = 0; j < 16; ++j) { av[c][j] = key2f(lst[j]); ai[c][j] = 127 - (lst[j] & 127); }
    }
    float lv[16]; int lp[16];
#pragma unroll
    for (int j = 0; j < 16; ++j) { lv[j] = -INFINITY; lp[j] = 0; }
#pragma unroll
    for (int i = 0; i < 16; ++i)
#pragma unroll
        for (int jj = 0; jj < 16; ++jj) if ((i + 1) * (jj + 1) <= 16) {
            float sv = av[0][i] + av[1][jj]; int pay = ai[0][i] * 128 + ai[1][jj];
#pragma unroll
            for (int j = 0; j < 16; ++j) { const bool gt = sv > lv[j]; const float nv = gt ? sv : lv[j]; const int np = gt ? pay : lp[j]; sv = gt ? lv[j] : sv; pay = gt ? lp[j] : pay; lv[j] = nv; lp[j] = np; }
        }
    float sum = 0.f; const float mx = lv[0];
#pragma unroll
    for (int j = 0; j < 16; ++j) { lv[j] = __expf(lv[j] - mx); sum += lv[j]; }
    const float inv = 1.f / sum;
#pragma unroll
    for (int q = 0; q < 4; ++q) { *(u32x4*)(idxo + 4 * q) = (u32x4){(unsigned)lp[4 * q], (unsigned)lp[4 * q + 1], (unsigned)lp[4 * q + 2], (unsigned)lp[4 * q + 3]};
        *(f32x4*)(gwo + 4 * q) = (f32x4){lv[4 * q] * inv, lv[4 * q + 1] * inv, lv[4 * q + 2] * inv, lv[4 * q + 3] * inv}; }
}
__device__ __forceinline__ float dot_f4(const u32x4 a, const f32x2 (&h)[16]) {
    f32x2 s = {0.f, 0.f};
#pragma unroll
    for (int w = 0; w < 4; ++w) {
        s = __builtin_elementwise_fma(__builtin_amdgcn_cvt_scalef32_pk_f32_fp4(a[w], 1.0f, 0), h[4 * w], s); s = __builtin_elementwise_fma(__builtin_amdgcn_cvt_scalef32_pk_f32_fp4(a[w], 1.0f, 1), h[4 * w + 1], s);
        s = __builtin_elementwise_fma(__builtin_amdgcn_cvt_scalef32_pk_f32_fp4(a[w], 1.0f, 2), h[4 * w + 2], s); s = __builtin_elementwise_fma(__builtin_amdgcn_cvt_scalef32_pk_f32_fp4(a[w], 1.0f, 3), h[4 * w + 3], s); }
    return s.x + s.y;
}
__device__ __forceinline__ int dot_u4i(const u32x4 a, const int (&he)[4], const int (&ho)[4]) {
    int acc = 0;
#pragma unroll
    for (int w = 0; w < 4; ++w) { acc = __builtin_amdgcn_sdot4((int)(a[w] & 0x0F0F0F0Fu), he[w], acc, false); acc = __builtin_amdgcn_sdot4((int)((a[w] >> 4) & 0x0F0F0F0Fu), ho[w], acc, false); }
    return acc;
}
typedef _Float16 h16x2 __attribute__((ext_vector_type(2)));
__device__ __forceinline__ void axpy_h4(const u32x4 a, unsigned c2bits, h16x2 (&o)[16]) {
    const h16x2 c2 = __builtin_bit_cast(h16x2, c2bits);
#pragma unroll
    for (int w = 0; w < 4; ++w) {
#pragma unroll
        for (int b = 0; b < 4; ++b) { const h16x2 v = b == 0 ? __builtin_bit_cast(h16x2, __builtin_amdgcn_cvt_scalef32_pk_f16_fp4(a[w], 1.0f, 0)) : b == 1 ? __builtin_bit_cast(h16x2, __builtin_amdgcn_cvt_scalef32_pk_f16_fp4(a[w], 1.0f, 1))
                                                     : b == 2 ? __builtin_bit_cast(h16x2, __builtin_amdgcn_cvt_scalef32_pk_f16_fp4(a[w], 1.0f, 2)) : __builtin_bit_cast(h16x2, __builtin_amdgcn_cvt_scalef32_pk_f16_fp4(a[w], 1.0f, 3));
            o[4 * w + b] = __builtin_elementwise_fma(c2, v, o[4 * w + b]); } }
}
__device__ __forceinline__ int grp8_sum(int x) {
    x += __builtin_amdgcn_update_dpp(0, x, 0xB1, 0xF, 0xF, true);
    x += __builtin_amdgcn_update_dpp(0, x, 0x4E, 0xF, 0xF, true);
    x += __builtin_amdgcn_update_dpp(0, x, 0x141, 0xF, 0xF, true);
    return x;
}
__device__ __forceinline__ float grp8_sumf(float x) {
    x += __builtin_bit_cast(float, __builtin_amdgcn_update_dpp(0, __builtin_bit_cast(int, x), 0xB1, 0xF, 0xF, true));
    x += __builtin_bit_cast(float, __builtin_amdgcn_update_dpp(0, __builtin_bit_cast(int, x), 0x4E, 0xF, 0xF, true));
    x += __builtin_bit_cast(float, __builtin_amdgcn_update_dpp(0, __builtin_bit_cast(int, x), 0x141, 0xF, 0xF, true));
    return x;
}
constexpr int PEER_LDS_WAVE = 12288;
__device__ __forceinline__ void peer_octets(const Params& p, int l, int gw, int ngw, int lane, const float* gain_next, const float* xin, float* xout, LAS unsigned char* wl) {
    const __amdgpu_buffer_rsrc_t RU = __builtin_amdgcn_make_buffer_rsrc((void*)(p.ws + WS_U8 + (size_t)l * NEXP * QROW), 0, NEXP * QROW, 0x00020000);
    const __amdgpu_buffer_rsrc_t RV = __builtin_amdgcn_make_buffer_rsrc((void*)(p.ws + WS_V8 + (size_t)l * NEXP * QROW), 0, NEXP * QROW, 0x00020000);
    const float* PSU = (const float*)(p.ws + WS_PS) + (size_t)l * NEXP; const float* PSV = PSU + (size_t)DEPTH * NEXP;
    const int tl = lane >> 3, c = lane & 7, c16 = 16 * c;
    LAS u32x4* pr4 = (LAS u32x4*)(wl + tl * 1024);
    LAS int* acc = (LAS int*)(wl + 8192 + tl * 512);
    for (int oc = gw; oc < T / 8; oc += ngw) {
        const int t = 8 * oc + tl;
        const bf16* hb = (const bf16*)(p.ws + WS_HB) + (size_t)t * DM + 4 * c;
        int myidx[16]; float mygw[16], mysu[16], mysv[16];
#pragma unroll
        for (int i = 0; i < 4; ++i) { const u32x4 q = *(const u32x4*)((const int*)(p.ws + WS_IDX) + (size_t)t * 128 + 16 * c + 4 * i); const f32x4 g = *(const f32x4*)((const float*)(p.ws + WS_GW) + (size_t)t * 128 + 16 * c + 4 * i);
            myidx[4 * i] = (int)q.x; myidx[4 * i + 1] = (int)q.y; myidx[4 * i + 2] = (int)q.z; myidx[4 * i + 3] = (int)q.w; mygw[4 * i] = g.x; mygw[4 * i + 1] = g.y; mygw[4 * i + 2] = g.z; mygw[4 * i + 3] = g.w; }
#pragma unroll
        for (int i = 0; i < 16; ++i) { mysu[i] = PSU[myidx[i]]; mysv[i] = PSV[myidx[i]]; }
#pragma unroll
        for (int i = 0; i < 8; ++i) { pr4[8 * c + i] = (u32x4){(unsigned)myidx[2 * i] * 128u, 0u, (unsigned)myidx[2 * i + 1] * 128u, 0u}; }
#pragma unroll
        for (int i = 0; i < 4; ++i) *(LAS u32x4*)(acc + 16 * c + 4 * i) = (u32x4){0u, 0u, 0u, 0u};
        const f32x2 hs = *(const f32x2*)((const float*)(p.ws + WS_HS) + 2 * (size_t)t);
        const float hscale = hs.x, h8sum = hs.y, ih = 1.f / hscale;
        u32x4 bufA[8], bufB[8]; unsigned cfA[8], cfB[8];
#define PEER_ISSUE(buf, cf, R, b) do { const int j_ = (b) & 15; const int so_ = ((b) >> 4) * (NEXP * 128); \
            const u32x4 q0_ = pr4[4 * j_], q1_ = pr4[4 * j_ + 1], q2_ = pr4[4 * j_ + 2], q3_ = pr4[4 * j_ + 3]; \
            cf[0] = q0_.y; cf[1] = q0_.w; cf[2] = q1_.y; cf[3] = q1_.w; cf[4] = q2_.y; cf[5] = q2_.w; cf[6] = q3_.y; cf[7] = q3_.w; \
            buf[0] = __builtin_amdgcn_raw_buffer_load_b128(R, (int)q0_.x + c16, so_, 0); buf[1] = __builtin_amdgcn_raw_buffer_load_b128(R, (int)q0_.z + c16, so_, 0); \
            buf[2] = __builtin_amdgcn_raw_buffer_load_b128(R, (int)q1_.x + c16, so_, 0); buf[3] = __builtin_amdgcn_raw_buffer_load_b128(R, (int)q1_.z + c16, so_, 0); \
            buf[4] = __builtin_amdgcn_raw_buffer_load_b128(R, (int)q2_.x + c16, so_, 0); buf[5] = __builtin_amdgcn_raw_buffer_load_b128(R, (int)q2_.z + c16, so_, 0); \
            buf[6] = __builtin_amdgcn_raw_buffer_load_b128(R, (int)q3_.x + c16, so_, 0); buf[7] = __builtin_amdgcn_raw_buffer_load_b128(R, (int)q3_.z + c16, so_, 0); } while (0)
        int he[4], ho[4];
#define PEER_HLOAD(sl) do { float hf_[32]; \
            _Pragma("unroll") for (int q = 0; q < 8; ++q) { const u32x2 w_ = *(const u32x2*)(hb + 256 * (sl) + 32 * q); hf_[4 * q] = bflo(w_.x); hf_[4 * q + 1] = bfhi(w_.x); hf_[4 * q + 2] = bflo(w_.y); hf_[4 * q + 3] = bfhi(w_.y); } \
            _Pragma("unroll") for (int w = 0; w < 4; ++w) { unsigned e_ = 0, od_ = 0; \
                _Pragma("unroll") for (int j = 0; j < 4; ++j) { const int qe = (int)rintf(hf_[8 * w + 2 * j] * ih), qo = (int)rintf(hf_[8 * w + 2 * j + 1] * ih); e_ |= (unsigned)(qe & 255) << (8 * j); od_ |= (unsigned)(qo & 255) << (8 * j); } \
                he[w] = (int)e_; ho[w] = (int)od_; } } while (0)
#define PEER_CONSUME_U(buf, b) do { int mine_ = 0; \
            _Pragma("unroll") for (int i = 0; i < 8; ++i) { const int tot_ = grp8_sum(dot_u4i(buf[i], he, ho)); mine_ = (c == i) ? tot_ : mine_; } \
            __hip_atomic_fetch_add(acc + 8 * ((b) & 15) + c, mine_, __ATOMIC_RELAXED, __HIP_MEMORY_SCOPE_WAVEFRONT); } while (0)
        PEER_ISSUE(bufA, cfA, RU, 0);
#pragma unroll 1
        for (int b = 0; b < 128; b += 2) {
            if ((b & 15) == 0) PEER_HLOAD(b >> 4);
            PEER_ISSUE(bufB, cfB, RU, b + 1);
            __builtin_amdgcn_sched_barrier(0);
            PEER_CONSUME_U(bufA, b);
            __builtin_amdgcn_sched_barrier(0);
            if (b + 2 < 128) PEER_ISSUE(bufA, cfA, RU, b + 2);
            __builtin_amdgcn_sched_barrier(0);
            PEER_CONSUME_U(bufB, b + 1);
            __builtin_amdgcn_sched_barrier(0);
        }
#pragma unroll
        for (int i = 0; i < 16; ++i) { const float a = ((float)acc[16 * c + i] - 8.f * h8sum) * mysu[i] * hscale;
            const _Float16 ch = (_Float16)(mygw[i] * gelu_tanh(a) * mysv[i] * 256.f);
            ((LAS unsigned*)pr4)[2 * (16 * c + i) + 1] = __builtin_bit_cast(unsigned, (h16x2){ch, ch}); }
        h16x2 o[16]; f32x4 xr[8]; float ss = 0.f;
#pragma unroll
        for (int i = 0; i < 16; ++i) o[i] = (h16x2){(_Float16)0.f, (_Float16)0.f};
#pragma unroll
        for (int q = 0; q < 8; ++q) xr[q] = (f32x4){0.f, 0.f, 0.f, 0.f};
        const float* xrow = xin + (size_t)t * DM + 4 * c; float* xwrow = xout + (size_t)t * DM + 4 * c;
#define PEER_CONSUME_V(buf, cf) do { _Pragma("unroll") for (int i = 0; i < 8; ++i) axpy_h4(buf[i], cf[i], o); } while (0)
        PEER_ISSUE(bufA, cfA, RV, 0);
#pragma unroll 1
        for (int b = 0; b < 128; b += 2) {
            if ((b & 15) == 12) {
#pragma unroll
                for (int q = 0; q < 8; ++q) xr[q] = *(const f32x4*)(xrow + 256 * (b >> 4) + 32 * q); }
            PEER_ISSUE(bufB, cfB, RV, b + 1);
            __builtin_amdgcn_sched_barrier(0);
            PEER_CONSUME_V(bufA, cfA);
            __builtin_amdgcn_sched_barrier(0);
            if (b + 2 < 128) PEER_ISSUE(bufA, cfA, RV, b + 2);
            __builtin_amdgcn_sched_barrier(0);
            PEER_CONSUME_V(bufB, cfB);
            __builtin_amdgcn_sched_barrier(0);
            if ((b & 15) == 14) {
#pragma unroll
                for (int q = 0; q < 8; ++q) { f32x4 x = xr[q];
                    x.x += (float)o[2 * q].x * (1.f / 256.f); x.y += (float)o[2 * q].y * (1.f / 256.f); x.z += (float)o[2 * q + 1].x * (1.f / 256.f); x.w += (float)o[2 * q + 1].y * (1.f / 256.f);
                    *(f32x4*)(xwrow + 256 * (b >> 4) + 32 * q) = x; ss += (x.x * x.x + x.y * x.y) + (x.z * x.z + x.w * x.w); }
#pragma unroll
                for (int i = 0; i < 16; ++i) o[i] = (h16x2){(_Float16)0.f, (_Float16)0.f};
            }
        }
        if (gain_next) {
            const float rstd = rsqrtf(grp8_sumf(ss) * (1.f / DM) + NORM_EPS);
            bf16* hw = (bf16*)(p.ws + WS_HB) + (size_t)t * DM + 4 * c; unsigned char* h8w = p.ws + WS_HB8 + (size_t)t * DM + 4 * c;
#pragma unroll 1
            for (int sl = 0; sl < 8; ++sl) {
#pragma unroll
                for (int q = 0; q < 8; ++q) { const int e0 = 256 * sl + 32 * q; const f32x4 x = *(const f32x4*)(xwrow + e0); const f32x4 g = *(const f32x4*)(gain_next + e0 + 4 * c);
                    u32x2 w; w.x = pk2(x.x * rstd * g.x, x.y * rstd * g.y); w.y = pk2(x.z * rstd * g.z, x.w * rstd * g.w);
                    *(u32x2*)(hw + e0) = w;
                    *(unsigned*)(h8w + e0) = pk4_fp8(x.x * rstd * g.x, x.y * rstd * g.y, x.z * rstd * g.z, x.w * rstd * g.w); }
            }
        }
    }
#undef PEER_ISSUE
#undef PEER_HLOAD
#undef PEER_CONSUME_U
#undef PEER_CONSUME_V
}

namespace pg8 {
#define PG8_LAS __attribute__((address_space(3)))
typedef int v4i32 __attribute__((ext_vector_type(4)));
typedef int v8i32 __attribute__((ext_vector_type(8)));
constexpr int BM = 256, BK = 64, HALF = 128, HTB = HALF * BK * 2, STAGE_BYTES = 8 * HTB, NXCD = 8, WGM = 8;
__host__ __device__ __forceinline__ int lds_byte(int r, int c) { const int st = (r >> 4) * 2 + (c >> 5), rr = r & 15, cc = c & 31, ob = rr * 64 + cc * 2; return st * 1024 + (ob ^ (((ob >> 9) & 1) << 5)); }
__host__ __device__ __forceinline__ void stage_rc(int b, int& R, int& C) { const int st = b / 1024, sb = b % 1024, swz = sb ^ (((sb >> 9) & 1) << 5); R = (st >> 1) * 16 + swz / 64; C = (st & 1) * 32 + (swz % 64) / 2; }
__host__ __device__ __forceinline__ int perm32(int rho) { const int n = rho >> 4, i = rho & 15; return 8 * (i >> 2) + 4 * n + (i & 3); }
struct Unit { int pm, pn; };
struct StaticOrder {
    int nM, nN, nwg, G, c;
    __host__ __device__ void init(int M, int N, int G_, int c_) { nM = M / BM; nN = N / BM; nwg = nM * nN; G = G_; c = c_; }
    __host__ __device__ bool next(int i, Unit& u) const {
        const long L = (long)i * G + c; if (L >= nwg) return false;
        int wgid = (int)L; { const int q = nwg / NXCD, r = nwg % NXCD, xcd = wgid % NXCD, off = wgid / NXCD; wgid = (xcd < r ? xcd * (q + 1) : r * (q + 1) + (xcd - r) * q) + off; }
        const int nig = WGM * nN, gid = wgid / nig, fm = gid * WGM, gsz = (nM - fm) < WGM ? (nM - fm) : WGM;
        u.pm = fm + ((wgid % nig) % gsz); u.pn = (wgid % nig) / gsz; return true;
    }
};
struct MergedOrder {
    StaticOrder base;
    __host__ __device__ bool next(int i, Unit& u) const { const int tile = i / 3, n = i - 3 * tile; Unit b; if (!base.next(tile, b)) return false; u.pm = n * 64 + b.pm; u.pn = n * 8 + b.pn; return true; }
};
struct ZGOrder {
    StaticOrder sz, sg;
    __host__ __device__ void init(int G, int c) { sz.init(T, ZP, G, c); sg.init(T, DM, G, c); }
    __host__ __device__ bool next(int i, Unit& u) const {
        const int nzu = sz.c < sz.nwg ? (sz.nwg - sz.c + sz.G - 1) / sz.G : 0;
        if (i < nzu) return sz.next(i, u);
        const int j = i - nzu, tile = j / 3, n = j - 3 * tile; Unit b; if (!sg.next(tile, b)) return false; u.pm = b.pm; u.pn = 15 + 8 * n + b.pn; return true; }
};
struct ProbGen { const bf16* A; const bf16* Bt; int lda, ldb, K;
    __device__ __forceinline__ const char* Aptr(const Unit& u) const { return (const char*)(A + (size_t)u.pm * BM * lda); }
    __device__ __forceinline__ const char* Bptr(const Unit& u) const { return (const char*)(Bt + (size_t)u.pn * BM * ldb); } };
struct ProbUp { const bf16* Z; const bf16* Wup; int lda, ldb, K;
    __device__ __forceinline__ const char* Aptr(const Unit& u) const { return (const char*)(Z + (size_t)u.pm * BM * ZP + (u.pn < 3 ? ZC_CQ : ZC_CKV)); }
    __device__ __forceinline__ const char* Bptr(const Unit& u) const { return (const char*)(Wup + (size_t)u.pn * BM * 512); } };

__device__ __forceinline__ unsigned cvt_pk_bf16(float lo, float hi) { unsigned r; asm volatile("v_cvt_pk_bf16_f32 %0, %1, %2" : "=v"(r) : "v"(lo), "v"(hi)); return r; }
struct EpiZG { static constexpr bool PERM = true; static constexpr bool HOOK = false; bf16* Z; bf16* G; const float* bg; int noratio;
    __device__ __forceinline__ void operator()(const f32x4 (&acc)[2][2][4][2], const Unit& u, int wr, int wc, int fr, int fq) const {
        const int row0 = u.pm * BM + wr * 64 + fr; const bool gate = u.pn >= 15;
        const int gi = u.pn - 15, n0_ = gi >> 3; const int n = n0_;  const bool rat = n0_ > 0 && !noratio;
        bf16* base = gate ? G + n * DM : Z; const int ld = gate ? NGATE : ZP; const int colt = gate ? (gi & 7) * BM : u.pn * BM; const int col0 = colt + wc * 32 + 8 * fq;
        f32x4 bv[2][2];
#pragma unroll
        for (int bj = 0; bj < 2; ++bj)
#pragma unroll
            for (int nn = 0; nn < 2; ++nn) bv[bj][nn] = gate ? *(const f32x4*)(bg + n * DM + col0 + bj * HALF + 4 * nn) : (f32x4){0.f, 0.f, 0.f, 0.f};
#pragma unroll
        for (int ai = 0; ai < 2; ++ai) {
            u32x4 pw[4][2];
            if (gate && rat) {
#pragma unroll
                for (int m = 0; m < 4; ++m)
#pragma unroll
                    for (int bj = 0; bj < 2; ++bj) pw[m][bj] = *(const u32x4*)(base + (size_t)(row0 + ai * HALF + m * 16) * ld + col0 + bj * HALF - DM);
                __builtin_amdgcn_sched_barrier(0);
            }
#pragma unroll
            for (int m = 0; m < 4; ++m) { bf16* rowp = base + (size_t)(row0 + ai * HALF + m * 16) * ld + col0;
#pragma unroll
                for (int bj = 0; bj < 2; ++bj) { f32x4 v0 = acc[ai][bj][m][0] + bv[bj][0], v1 = acc[ai][bj][m][1] + bv[bj][1];
                    if (gate) {
#pragma unroll
                        for (int j = 0; j < 4; ++j) { v0[j] = fmaxf(__builtin_amdgcn_rcpf(1.f + __builtin_amdgcn_exp2f(-LOG2E * v0[j])), 1e-6f); v1[j] = fmaxf(__builtin_amdgcn_rcpf(1.f + __builtin_amdgcn_exp2f(-LOG2E * v1[j])), 1e-6f); }
                        if (rat) { const u32x4 q = pw[m][bj];
                            const float p8[8] = {bflo(q.x), bfhi(q.x), bflo(q.y), bfhi(q.y), bflo(q.z), bfhi(q.z), bflo(q.w), bfhi(q.w)};
                            u32x4 rw; rw.x = cvt_pk_bf16(p8[0] * __builtin_amdgcn_rcpf(v0[0]), p8[1] * __builtin_amdgcn_rcpf(v0[1])); rw.y = cvt_pk_bf16(p8[2] * __builtin_amdgcn_rcpf(v0[2]), p8[3] * __builtin_amdgcn_rcpf(v0[3]));
                            rw.z = cvt_pk_bf16(p8[4] * __builtin_amdgcn_rcpf(v1[0]), p8[5] * __builtin_amdgcn_rcpf(v1[1])); rw.w = cvt_pk_bf16(p8[6] * __builtin_amdgcn_rcpf(v1[2]), p8[7] * __builtin_amdgcn_rcpf(v1[3]));
                            *(u32x4*)(rowp + bj * HALF - DM) = rw; } }
                    u32x4 w; w.x = cvt_pk_bf16(v0[0], v0[1]); w.y = cvt_pk_bf16(v0[2], v0[3]); w.z = cvt_pk_bf16(v1[0], v1[1]); w.w = cvt_pk_bf16(v1[2], v1[3]);
                    *(u32x4*)(rowp + bj * HALF) = w; } }
        }
    } };
struct EpiG8 { static constexpr bool PERM = true; static constexpr bool HOOK = false; bf16* G; const float* bg; const unsigned* gmax;
    __device__ __forceinline__ void operator()(const f32x4 (&acc)[2][2][4][2], const Unit& u, int wr, int wc, int fr, int fq) const {
        const int row0 = u.pm * BM + wr * 64 + fr, col0 = u.pn * BM + wc * 32 + 8 * fq; const int n = u.pn >> 3; const float is = 1.f / gate_scale(gmax + 64 * n);
        f32x4 bv[2][2];
#pragma unroll
        for (int bj = 0; bj < 2; ++bj)
#pragma unroll
            for (int nn = 0; nn < 2; ++nn) bv[bj][nn] = *(const f32x4*)(bg + col0 + bj * HALF + 4 * nn);
#pragma unroll
        for (int ai = 0; ai < 2; ++ai)
#pragma unroll
            for (int m = 0; m < 4; ++m) { bf16* rowp = G + (size_t)(row0 + ai * HALF + m * 16) * NGATE + col0;
#pragma unroll
                for (int bj = 0; bj < 2; ++bj) { f32x4 v0 = acc[ai][bj][m][0] * is + bv[bj][0], v1 = acc[ai][bj][m][1] * is + bv[bj][1];
#pragma unroll
                    for (int j = 0; j < 4; ++j) { v0[j] = fmaxf(__builtin_amdgcn_rcpf(1.f + __builtin_amdgcn_exp2f(-LOG2E * v0[j])), 1e-6f); v1[j] = fmaxf(__builtin_amdgcn_rcpf(1.f + __builtin_amdgcn_exp2f(-LOG2E * v1[j])), 1e-6f); }
                    u32x4 w; w.x = cvt_pk_bf16(v0[0], v0[1]); w.y = cvt_pk_bf16(v0[2], v0[3]); w.z = cvt_pk_bf16(v1[0], v1[1]); w.w = cvt_pk_bf16(v1[2], v1[3]);
                    *(u32x4*)(rowp + bj * HALF) = w; } }
    } };
struct EpiUp { static constexpr bool HOOK = false; static constexpr bool PERM = true; bf16* QR; bf16* KVR;
    __device__ __forceinline__ void operator()(const f32x4 (&acc)[2][2][4][2], const Unit& u, int wr, int wc, int fr, int fq) const {
        const int row0 = u.pm * BM + wr * 64 + fr; const bool kv = u.pn >= 3;
        bf16* base = kv ? KVR : QR; const int ld = kv ? 1024 : 768; const int col0 = (kv ? (u.pn - 3) : u.pn) * BM + wc * 32 + 8 * fq;
#pragma unroll
        for (int ai = 0; ai < 2; ++ai)
#pragma unroll
            for (int m = 0; m < 4; ++m) { bf16* rowp = base + (size_t)(row0 + ai * HALF + m * 16) * ld + col0;
#pragma unroll
                for (int bj = 0; bj < 2; ++bj) { const f32x4 v0 = acc[ai][bj][m][0], v1 = acc[ai][bj][m][1];
                    u32x4 w; w.x = cvt_pk_bf16(v0[0], v0[1]); w.y = cvt_pk_bf16(v0[2], v0[3]); w.z = cvt_pk_bf16(v1[0], v1[1]); w.w = cvt_pk_bf16(v1[2], v1[3]);
                    *(u32x4*)(rowp + bj * HALF) = w; } }
    } };
struct EpiMG { static constexpr bool PERM = true; static constexpr bool HOOK = true; bf16* MG; const bf16* R; int nohook;
    template <bool RATIO> __device__ __forceinline__ void scale(f32x4 (&acc)[2][2][4][2], const Unit& u, int wr, int wc, int fr, int fq, int slot) const {
        const __amdgpu_buffer_rsrc_t rs = __builtin_amdgcn_make_buffer_rsrc((void*)R, 0, (int)((size_t)T * NGATE * 2), 0x00020000);
        const int voff = ((u.pm * BM + wr * 64 + fr) * NGATE + slot * DM + u.pn * BM + wc * 32 + 8 * fq) * 2;
#pragma unroll
        for (int ai = 0; ai < 2; ++ai) {
            u32x4 ga[4][2], gb[4][2];
#pragma unroll
            for (int m = 0; m < 4; ++m)
#pragma unroll
                for (int bj = 0; bj < 2; ++bj) { ga[m][bj] = __builtin_amdgcn_raw_buffer_load_b128(rs, voff, ((ai * HALF + m * 16) * NGATE + bj * HALF) * 2, 0);
                    if (RATIO) gb[m][bj] = __builtin_amdgcn_raw_buffer_load_b128(rs, voff, ((ai * HALF + m * 16) * NGATE + DM + bj * HALF) * 2, 0); }
            __builtin_amdgcn_sched_barrier(0);
#pragma unroll
            for (int m = 0; m < 4; ++m)
#pragma unroll
                for (int bj = 0; bj < 2; ++bj) { const u32x4 a = ga[m][bj];
                    float f[8] = {bflo(a.x), bfhi(a.x), bflo(a.y), bfhi(a.y), bflo(a.z), bfhi(a.z), bflo(a.w), bfhi(a.w)};
                    if (RATIO) { const u32x4 b = gb[m][bj]; const float d[8] = {bflo(b.x), bfhi(b.x), bflo(b.y), bfhi(b.y), bflo(b.z), bfhi(b.z), bflo(b.w), bfhi(b.w)};
#pragma unroll
                        for (int j = 0; j < 8; ++j) f[j] *= __builtin_amdgcn_rcpf(d[j]); }
                    acc[ai][bj][m][0][0] *= f[0]; acc[ai][bj][m][0][1] *= f[1]; acc[ai][bj][m][0][2] *= f[2]; acc[ai][bj][m][0][3] *= f[3];
                    acc[ai][bj][m][1][0] *= f[4]; acc[ai][bj][m][1][1] *= f[5]; acc[ai][bj][m][1][2] *= f[6]; acc[ai][bj][m][1][3] *= f[7]; }
            __builtin_amdgcn_sched_barrier(0);
        }
    }
    __device__ __forceinline__ void hook(f32x4 (&acc)[2][2][4][2], const Unit& u, int wr, int wc, int fr, int fq, int seg) const { if (!nohook) scale<true>(acc, u, wr, wc, fr, fq, seg - 1); }
    __device__ __forceinline__ void operator()(f32x4 (&acc)[2][2][4][2], const Unit& u, int wr, int wc, int fr, int fq) const {
        scale<false>(acc, u, wr, wc, fr, fq, 2);
        const int row0 = u.pm * BM + wr * 64 + fr, col0 = u.pn * BM + wc * 32 + 8 * fq;
#pragma unroll
        for (int ai = 0; ai < 2; ++ai)
#pragma unroll
            for (int m = 0; m < 4; ++m) { bf16* rowp = MG + (size_t)(row0 + ai * HALF + m * 16) * DM + col0;
#pragma unroll
                for (int bj = 0; bj < 2; ++bj) { const f32x4 v0 = acc[ai][bj][m][0], v1 = acc[ai][bj][m][1];
                    u32x4 w; w.x = cvt_pk_bf16(v0[0], v0[1]); w.y = cvt_pk_bf16(v0[2], v0[3]); w.z = cvt_pk_bf16(v1[0], v1[1]); w.w = cvt_pk_bf16(v1[2], v1[3]);
                    *(u32x4*)(rowp + bj * HALF) = w; } }
    } };
struct EpiOut { static constexpr bool HOOK = false; static constexpr bool PERM = false; const float* Xin; float* X;
    __device__ __forceinline__ void operator()(const f32x4 (&acc)[2][2][4][2], const Unit& u, int wr, int wc, int fr, int fq) const {
        const int row0 = u.pm * BM + wr * 64 + fr, col0 = u.pn * BM + wc * 32 + 4 * fq;
#pragma unroll
        for (int ai = 0; ai < 2; ++ai)
#pragma unroll
            for (int m = 0; m < 4; ++m) { const size_t off = (size_t)(row0 + ai * HALF + m * 16) * DM + col0;
#pragma unroll
                for (int bj = 0; bj < 2; ++bj)
#pragma unroll
                    for (int n = 0; n < 2; ++n) { const f32x4 xi = *(const f32x4*)(Xin + off + bj * HALF + n * 16); *(f32x4*)(X + off + bj * HALF + n * 16) = xi + acc[ai][bj][m][n]; } }
    } };
struct EpiDelta { static constexpr bool HOOK = false; static constexpr bool PERM = true; bf16* D;
    __device__ __forceinline__ void operator()(const f32x4 (&acc)[2][2][4][2], const Unit& u, int wr, int wc, int fr, int fq) const {
        const int row0 = u.pm * BM + wr * 64 + fr, col0 = u.pn * BM + wc * 32 + 8 * fq;
#pragma unroll
        for (int ai = 0; ai < 2; ++ai)
#pragma unroll
            for (int m = 0; m < 4; ++m) { bf16* rowp = D + (size_t)(row0 + ai * HALF + m * 16) * DM + col0;
#pragma unroll
                for (int bj = 0; bj < 2; ++bj) { const f32x4 v0 = acc[ai][bj][m][0], v1 = acc[ai][bj][m][1];
                    u32x4 w; w.x = cvt_pk_bf16(v0[0], v0[1]); w.y = cvt_pk_bf16(v0[2], v0[3]); w.z = cvt_pk_bf16(v1[0], v1[1]); w.w = cvt_pk_bf16(v1[2], v1[3]);
                    *(u32x4*)(rowp + bj * HALF) = w; } }
    } };
struct EpiSC { static constexpr bool HOOK = false; static constexpr bool PERM = false; float* SC;
    __device__ __forceinline__ void operator()(const f32x4 (&acc)[2][2][4][2], const Unit& u, int wr, int wc, int fr, int fq) const {
        const int row0 = u.pm * BM + wr * 64 + fr, col0 = u.pn * BM + wc * 32 + 4 * fq;
#pragma unroll
        for (int ai = 0; ai < 2; ++ai)
#pragma unroll
            for (int m = 0; m < 4; ++m) { const size_t off = (size_t)(row0 + ai * HALF + m * 16) * DM + col0;
#pragma unroll
                for (int bj = 0; bj < 2; ++bj)
#pragma unroll
                    for (int n = 0; n < 2; ++n) *(f32x4*)(SC + off + bj * HALF + n * 16) = acc[ai][bj][m][n]; }
    } };

template <class Epi, class Prob, class Sched, bool ALIGN_EPI = true, bool FP8 = false>
__device__ __forceinline__ void gemm_phase(PG8_LAS unsigned char* lds, const Prob g, const Sched& S, const Epi& E) {
    int tid = threadIdx.x; asm volatile("" : "+v"(tid));
    const int wid = __builtin_amdgcn_readfirstlane(tid >> 6), lane = tid & 63, wr = wid >> 2, wc = wid & 3, fr = lane & 15, fq = lane >> 4;
    const int K = g.K, nt = K / BK;
    unsigned voffA[2], voffB[2];
#pragma unroll
    for (int i = 0; i < 2; ++i) { int R, C; stage_rc(tid * 16 + i * 8192, R, C); const int Rb = Epi::PERM ? ((R & ~31) + perm32(R & 31)) : R;
        voffA[i] = (unsigned)(R * g.lda + C) * 2u; voffB[i] = (unsigned)(Rb * g.ldb + C) * 2u; }
    const size_t kstep = (size_t)(BK * 2);
    const size_t hstepA = (size_t)HALF * g.lda * 2, hstepB = (size_t)HALF * g.ldb * 2;
    const unsigned ldsw = (unsigned)wid * 1024u;
    const int aoff = lds_byte(wr * 64 + fr, fq * 8), boff = lds_byte(wc * 32 + fr, fq * 8);
#define PG8_SA(b, h) (((b) * 2 + (h)) * HTB)
#define PG8_SB(b, h) ((4 + (b) * 2 + (h)) * HTB)
#define PG8_STAGE(bufoff, gbase, voff) do { _Pragma("unroll") for (int _i = 0; _i < 2; ++_i) \
        __builtin_amdgcn_global_load_lds((const unsigned*)((const char*)(gbase) + (voff)[_i]), (PG8_LAS unsigned*)(lds + (bufoff) + ldsw + _i * 8192), 16, 0, 0); } while (0)
#define PG8_CAT8(x0, x1) __builtin_shufflevector(__builtin_bit_cast(v4i32, x0), __builtin_bit_cast(v4i32, x1), 0, 1, 2, 3, 4, 5, 6, 7)
#define PG8_LDA(dst, b, h) do { _Pragma("unroll") for (int m = 0; m < 4; ++m) { const bf16x8 x0 = *(const PG8_LAS bf16x8*)(lds + PG8_SA(b, h) + aoff + m * 2048), x1 = *(const PG8_LAS bf16x8*)(lds + PG8_SA(b, h) + aoff + m * 2048 + 1024); \
        if constexpr (FP8) dst##8[m] = PG8_CAT8(x0, x1); else { dst[m][0] = x0; dst[m][1] = x1; } } } while (0)
#define PG8_LDB(dst, b, h) do { _Pragma("unroll") for (int n = 0; n < 2; ++n) { const bf16x8 x0 = *(const PG8_LAS bf16x8*)(lds + PG8_SB(b, h) + boff + n * 2048), x1 = *(const PG8_LAS bf16x8*)(lds + PG8_SB(b, h) + boff + n * 2048 + 1024); \
        if constexpr (FP8) dst##8[n] = PG8_CAT8(x0, x1); else { dst[n][0] = x0; dst[n][1] = x1; } } } while (0)
#define PG8_MMA(ai, bj, At, Bt) do { __builtin_amdgcn_s_setprio(1); _Pragma("unroll") for (int m = 0; m < 4; ++m) _Pragma("unroll") for (int n = 0; n < 2; ++n) { \
        if constexpr (FP8) asm volatile("v_mfma_f32_16x16x128_f8f6f4 %0, %1, %2, %0" : "+v"(acc[ai][bj][m][n]) : "v"(Bt##8[n]), "v"(At##8[m]));   \
        else { _Pragma("unroll") for (int k = 0; k < 2; ++k) acc[ai][bj][m][n] = __builtin_amdgcn_mfma_f32_16x16x32_bf16(Bt[n][k], At[m][k], acc[ai][bj][m][n], 0, 0, 0); } } \
        if constexpr (FP8) asm volatile("s_nop 7" ::: "memory");   \
        __builtin_amdgcn_s_setprio(0); } while (0)
#define PG8_WAIT_V(n) asm volatile("s_waitcnt vmcnt(" #n ")" ::: "memory")
#define PG8_WAIT_L(n) asm volatile("s_waitcnt lgkmcnt(" #n ")" ::: "memory")
#define PG8_BAR __builtin_amdgcn_s_barrier()
#define PG8_SCHED __builtin_amdgcn_sched_barrier(0)
    Unit cur, nxt; int ui = 0;
    if (!S.next(0, cur)) return;
    f32x4 acc[2][2][4][2];
#pragma unroll
    for (int a = 0; a < 2; ++a)
#pragma unroll
        for (int b = 0; b < 2; ++b)
#pragma unroll
            for (int m = 0; m < 4; ++m)
#pragma unroll
                for (int n = 0; n < 2; ++n) acc[a][b][m][n] = (f32x4){0.f, 0.f, 0.f, 0.f};
    bf16x8 At[4][2], B0[2][2], B1[2][2];
    v8i32 At8[4], B08[2], B18[2];
    const char* cA = g.Aptr(cur); const char* cB = g.Bptr(cur);
    PG8_STAGE(PG8_SB(0, 0), cB, voffB); PG8_STAGE(PG8_SB(0, 1), cB + hstepB, voffB); PG8_STAGE(PG8_SA(0, 0), cA, voffA); PG8_STAGE(PG8_SA(0, 1), cA + hstepA, voffA);
    if (wr == 1) PG8_BAR;
    PG8_WAIT_V(2); PG8_BAR;
    PG8_STAGE(PG8_SB(1, 0), cB + kstep, voffB); PG8_STAGE(PG8_SA(1, 0), cA + kstep, voffA); PG8_STAGE(PG8_SB(1, 1), cB + hstepB + kstep, voffB);
    PG8_WAIT_V(6); PG8_BAR;
    for (;;) {
        const bool has_next = S.next(ui + 1, nxt);
        const char* nA = has_next ? g.Aptr(nxt) : cA; const char* nB = has_next ? g.Bptr(nxt) : cB;
        for (int t = 0; t < nt; t += 2) {
            if constexpr (Epi::HOOK) { if (t == 8 || t == 16) E.hook(acc, cur, wr, wc, fr, fq, t >> 3); }
            const bool last = (t == nt - 2);
            const char* a1 = cA + (size_t)(t + 1) * kstep;
            const char* a2 = last ? nA : cA + (size_t)(t + 2) * kstep; const char* b2 = last ? nB : cB + (size_t)(t + 2) * kstep;
            const char* a3 = a2 + kstep; const char* b3 = b2 + kstep;
            PG8_LDB(B0, 0, 0); PG8_LDB(B1, 0, 1); PG8_SCHED; PG8_LDA(At, 0, 0); PG8_STAGE(PG8_SA(1, 1), a1 + hstepA, voffA);
            PG8_WAIT_V(8); PG8_WAIT_L(0); PG8_BAR; PG8_MMA(0, 0, At, B0); PG8_MMA(0, 1, At, B1); PG8_BAR; PG8_SCHED;
            PG8_LDA(At, 0, 1); PG8_STAGE(PG8_SB(0, 0), b2, voffB); PG8_STAGE(PG8_SB(0, 1), b2 + hstepB, voffB); PG8_STAGE(PG8_SA(0, 0), a2, voffA);
            PG8_WAIT_V(8); PG8_WAIT_L(0); PG8_BAR; PG8_MMA(1, 0, At, B0); PG8_MMA(1, 1, At, B1); PG8_BAR; PG8_SCHED;
            PG8_LDB(B0, 1, 0); PG8_LDB(B1, 1, 1); PG8_SCHED; PG8_LDA(At, 1, 0); PG8_STAGE(PG8_SA(0, 1), a2 + hstepA, voffA);
            PG8_WAIT_V(8); PG8_WAIT_L(0); PG8_BAR; PG8_MMA(0, 0, At, B0); PG8_MMA(0, 1, At, B1); PG8_BAR; PG8_SCHED;
            PG8_LDA(At, 1, 1); PG8_STAGE(PG8_SB(1, 0), b3, voffB); PG8_STAGE(PG8_SB(1, 1), b3 + hstepB, voffB); PG8_STAGE(PG8_SA(1, 0), a3, voffA);
            PG8_WAIT_V(8); PG8_WAIT_L(0); PG8_BAR; PG8_MMA(1, 0, At, B0); PG8_MMA(1, 1, At, B1); PG8_BAR; PG8_SCHED;
        }
        if constexpr (ALIGN_EPI) { if (wr == 0) PG8_BAR; }
        E(acc, cur, wr, wc, fr, fq);
        if (!has_next) break;
#pragma unroll
        for (int a = 0; a < 2; ++a)
#pragma unroll
            for (int b = 0; b < 2; ++b)
#pragma unroll
                for (int m = 0; m < 4; ++m)
#pragma unroll
                    for (int n = 0; n < 2; ++n) acc[a][b][m][n] = (f32x4){0.f, 0.f, 0.f, 0.f};
        cur = nxt; cA = nA; cB = nB; ++ui;
        if constexpr (ALIGN_EPI) { if (wr == 1) PG8_BAR; }
    }
    PG8_WAIT_V(0);
    if constexpr (!ALIGN_EPI) { if (wr == 0) PG8_BAR; }
    PG8_BAR;
#undef PG8_SA
#undef PG8_SB
#undef PG8_STAGE
#undef PG8_LDA
#undef PG8_CAT8
#undef PG8_LDB
#undef PG8_MMA
#undef PG8_WAIT_V
#undef PG8_WAIT_L
#undef PG8_BAR
#undef PG8_SCHED
}
}


constexpr int RING_BYTES = 131072, MISC_OFF = RING_BYTES + 320, LDS_BYTES = 147456;
namespace att {
typedef short s16x4 __attribute__((ext_vector_type(4)));
__device__ __forceinline__ s16x4 lds_tr(const LAS unsigned char* p) { return __builtin_bit_cast(s16x4, __builtin_amdgcn_ds_read_tr16_b64_v4i16((LAS s16x4*)p)); }
template <int MODE> struct Cfg;
template <> struct Cfg<0> { static constexpr int DQK = 96, DV = 64, KRS = 208, VRS = 192, NV = 2, NL = 5; };
template <> struct Cfg<1> { static constexpr int DQK = 64, DV = 128, KRS = 144, VRS = 320, NV = 1, NL = 4; };
template <int MODE> struct Lay { using C = Cfg<MODE>; static constexpr int KB = 64 * C::KRS, VB = 64 * C::VRS, STAGE = 2 * KB + C::NV * VB; };

template <int MODE>
__device__ __forceinline__ void attn_unit(const Params& p, int l, int b, int hp, int qb, LAS unsigned char* lds, float lam, float lam_init, int pm = 0) {
    using C = Cfg<MODE>; using L = Lay<MODE>;
    constexpr int DQK = C::DQK, DV = C::DV, NDB = DV / 32, NKS = DQK / 16;
    int tid = threadIdx.x; asm volatile("" : "+v"(tid));
    const int lane = tid & 63, wid = __builtin_amdgcn_readfirstlane(tid >> 6), half = wid >> 2, r = lane & 31, h = lane >> 5;
    const int q0 = qb * 128, qrow = q0 + 32 * (wid & 3) + r;
    const size_t trow = (size_t)b * SEQ + qrow;
    const int ntile = 2 * qb + 2, mytiles = 2 * qb + 1 + ((wid & 3) >> 1);
    const bf16* Qb; const bf16* Kg[2]; const bf16* Vg[2]; int kp, vp;
    if (MODE == 0) { const bf16* QM = (const bf16*)(p.ws + WS_QM); const bf16* KM = (const bf16*)(p.ws + WS_KM); const bf16* KVR = (const bf16*)(p.ws + WS_KVR);
        Qb = QM + trow * 768 + (2 * hp + half) * 96; kp = 768; vp = 1024;
        Kg[0] = KM + (size_t)b * SEQ * 768 + (2 * hp) * 96; Kg[1] = Kg[0] + 96; Vg[0] = KVR + (size_t)b * SEQ * 1024 + 512 + (2 * hp) * 64; Vg[1] = Vg[0] + 64;
    } else { const bf16* Z = (const bf16*)(p.ws + WS_Z);
        Qb = Z + trow * ZP + ZC_DQ + (2 * hp + half) * 64; kp = ZP; vp = ZP;
        Kg[0] = Z + (size_t)b * SEQ * ZP + ZC_DK + (2 * hp) * 64; Kg[1] = Kg[0] + 64; Vg[0] = Z + (size_t)b * SEQ * ZP + ZC_DV + hp * 128; Vg[1] = Vg[0]; }
    constexpr int KC = DQK / 8, VC = DV / 8;
    typedef const __attribute__((address_space(1))) bf16* gptr_t;
    gptr_t gp[C::NL]; int lo_[C::NL]; size_t gstep[C::NL];
#pragma unroll
    for (int i = 0; i < C::NL; ++i) { const int id = tid + 512 * i;
        if (id < 2 * 64 * KC) { const int sg = id / (64 * KC), q = id % (64 * KC), row = q / KC, c = q % KC; gp[i] = (gptr_t)(sg ? Kg[1] : Kg[0]) + (size_t)row * kp + c * 8; lo_[i] = sg * L::KB + row * C::KRS + c * 16; gstep[i] = (size_t)64 * kp; }
        else { const int q2 = id - 2 * 64 * KC, sg = q2 / (64 * VC), q = q2 % (64 * VC), row = q / VC, c = q % VC; gp[i] = (gptr_t)(sg ? Vg[1] : Vg[0]) + (size_t)row * vp + c * 8; lo_[i] = 2 * L::KB + sg * L::VB + row * C::VRS + c * 16; gstep[i] = (size_t)64 * vp; } }
    bf16x8 qf[NKS];
#pragma unroll
    for (int s_ = 0; s_ < NKS; ++s_) qf[s_] = *(const bf16x8*)(Qb + 16 * s_ + 8 * h);
    const int koff = half * L::KB + r * C::KRS + 16 * h;
    const int voff = 2 * L::KB + (C::NV == 2 ? half * L::VB : 0) + (4 * h + ((lane & 15) >> 2)) * C::VRS + (((lane >> 4) & 1) * 16 + (lane & 3) * 4) * 2;
    f32x16 O[NDB];
#pragma unroll
    for (int d = 0; d < NDB; ++d)
#pragma unroll
        for (int e = 0; e < 16; ++e) O[d][e] = 0.f;
    f32x16 negm;
#pragma unroll
    for (int e = 0; e < 16; ++e) negm[e] = 0.f;
    float l_run = 0.f;
    u32x4 stA[C::NL], stB[C::NL];
#define ATT_LOAD(R) do { const size_t _st = adv > 0 ? 1 : 0; --adv; _Pragma("unroll") for (int i = 0; i < C::NL; ++i) { R[i] = *(const __attribute__((address_space(1))) u32x4*)gp[i]; gp[i] += _st * gstep[i]; } } while (0)
#define ATT_WRITE(R, stg) do { _Pragma("unroll") for (int i = 0; i < C::NL; ++i) *(LAS u32x4*)(lds + (stg) * L::STAGE + lo_[i]) = R[i]; } while (0)
#define ATT_VREAD(dst, kb) do { const int voff_ = (pm & 64) ? 2 * L::KB : voff; _Pragma("unroll") for (int d = 0; d < NDB; ++d) _Pragma("unroll") for (int sp = 0; sp < 2; ++sp) { \
                const LAS unsigned char* va = sb + voff_ + (32 * (kb) + 16 * sp) * C::VRS + 64 * d; \
                const s16x4 t0 = lds_tr(va), t1 = lds_tr(va + 8 * C::VRS); \
                dst[2 * d + sp] = (bf16x8){t0[0], t0[1], t0[2], t0[3], t1[0], t1[1], t1[2], t1[3]}; } } while (0)
#define ATT_PV(src, pfk) do { if (!(pm & 32)) { _Pragma("unroll") for (int d = 0; d < NDB; ++d) _Pragma("unroll") for (int sp = 0; sp < 2; ++sp) O[d] = __builtin_amdgcn_mfma_f32_32x32x16_bf16(src[2 * d + sp], pfk[sp], O[d], 0, 0, 0); } \
        else { _Pragma("unroll") for (int d = 0; d < NDB; ++d) O[d][0] += __builtin_bit_cast(float, (int)src[2 * d][0] + (int)pfk[0][0]); } } while (0)
#define ATT_SM(Sk, Sother, pfk) do { float mx = Sk[0]; _Pragma("unroll") for (int e = 1; e < 16; ++e) mx = fmaxf(mx, Sk[e]); \
            if (__any(mx > 8.f)) { mx = fmaxf(mx, __shfl_xor(mx, 32)); \
                const float dsh = fmaxf(mx, 0.f), alpha = __builtin_amdgcn_exp2f(-dsh); l_run *= alpha; \
                _Pragma("unroll") for (int e = 0; e < 16; ++e) { negm[e] -= dsh; Sk[e] -= dsh; Sother[e] -= dsh; } \
                _Pragma("unroll") for (int dd = 0; dd < NDB; ++dd) _Pragma("unroll") for (int e = 0; e < 16; ++e) O[dd][e] *= alpha; } \
            float ps = 0.f; \
            _Pragma("unroll") for (int sp = 0; sp < 2; ++sp) { float e8[8]; \
                if (pm & 16) { _Pragma("unroll") for (int jj = 0; jj < 8; ++jj) e8[jj] = Sk[8 * sp + jj]; } else { _Pragma("unroll") for (int jj = 0; jj < 8; ++jj) { e8[jj] = __builtin_amdgcn_exp2f(Sk[8 * sp + jj]); ps += e8[jj]; } } \
                u32x4 w; w.x = pg8::cvt_pk_bf16(e8[0], e8[1]); w.y = pg8::cvt_pk_bf16(e8[2], e8[3]); w.z = pg8::cvt_pk_bf16(e8[4], e8[5]); w.w = pg8::cvt_pk_bf16(e8[6], e8[7]); \
                pfk[sp] = __builtin_bit_cast(bf16x8, w); } \
            l_run += ps; } while (0)
#define ATT_COMPUTE(stg) do { LAS unsigned char* sb = lds + (stg) * L::STAGE; \
            bf16x8 kf[2][NKS]; \
            { const int koff_ = (pm & 64) ? 0 : koff; _Pragma("unroll") for (int kb = 0; kb < 2; ++kb) _Pragma("unroll") for (int s_ = 0; s_ < NKS; ++s_) kf[kb][s_] = *(const LAS bf16x8*)(sb + koff_ + kb * 32 * C::KRS + 32 * s_); } \
            __builtin_amdgcn_sched_barrier(0); \
            f32x16 S0 = negm, S1 = negm; __builtin_amdgcn_s_setprio(1); \
            if (!(pm & 32)) { _Pragma("unroll") for (int s_ = 0; s_ < NKS; ++s_) S0 = __builtin_amdgcn_mfma_f32_32x32x16_bf16(kf[0][s_], qf[s_], S0, 0, 0, 0); \
            _Pragma("unroll") for (int s_ = 0; s_ < NKS; ++s_) S1 = __builtin_amdgcn_mfma_f32_32x32x16_bf16(kf[1][s_], qf[s_], S1, 0, 0, 0); } \
            __builtin_amdgcn_s_setprio(0); bf16x8 vfa[2 * NDB], vfb[2 * NDB]; \
            ATT_VREAD(vfa, 0); \
            __builtin_amdgcn_sched_barrier(0); \
            bf16x8 pf0[2], pf1[2]; \
            ATT_SM(S0, S1, pf0); \
            __builtin_amdgcn_sched_barrier(0); \
            __builtin_amdgcn_s_setprio(1); ATT_PV(vfa, pf0); __builtin_amdgcn_s_setprio(0); \
            ATT_VREAD(vfb, 1); \
            __builtin_amdgcn_sched_barrier(0); \
            ATT_SM(S1, S0, pf1); \
            __builtin_amdgcn_sched_barrier(0); \
            __builtin_amdgcn_s_setprio(1); ATT_PV(vfb, pf1); __builtin_amdgcn_s_setprio(0); \
            } while (0)
    int adv = ntile - 1;
    ATT_LOAD(stA); ATT_LOAD(stB);
    ATT_WRITE(stA, 0);
    __syncthreads();
#pragma unroll 1
    for (int j = 0; j < ntile; j += 2) {
        if (!(pm & 1)) ATT_LOAD(stA);
        if (j < mytiles) ATT_COMPUTE(0);
        if (!(pm & 2)) ATT_WRITE(stB, 1);
        if (!(pm & 8)) __syncthreads();
        if (!(pm & 1)) ATT_LOAD(stB);
        if (j + 1 < mytiles) ATT_COMPUTE(1);
        if (!(pm & 2)) ATT_WRITE(stA, 0);
        if (!(pm & 8)) __syncthreads();
    }
#undef ATT_LOAD
#undef ATT_WRITE
#undef ATT_COMPUTE
#undef ATT_VREAD
#undef ATT_PV
#undef ATT_SM
    const float inv = 1.f / (l_run + __shfl_xor(l_run, 32));
    if (MODE == 0) {
        bf16* o = (bf16*)(p.ws + WS_OC) + trow * 1536 + (2 * hp + half) * 64 + 4 * h;
#pragma unroll
        for (int d = 0; d < NDB; ++d)
#pragma unroll
            for (int g4 = 0; g4 < 4; ++g4) { u32x2 w; w.x = pg8::cvt_pk_bf16(O[d][4 * g4] * inv, O[d][4 * g4 + 1] * inv); w.y = pg8::cvt_pk_bf16(O[d][4 * g4 + 2] * inv, O[d][4 * g4 + 3] * inv);
                *(u32x2*)(o + 32 * d + 8 * g4) = w; }
    } else {
        LAS unsigned char* xr = lds + (32 * (wid & 3) + r) * 264 + 8 * h;
        if (half == 1) {
#pragma unroll
            for (int d = 0; d < NDB; ++d)
#pragma unroll
                for (int g4 = 0; g4 < 4; ++g4) { u32x2 w; w.x = pg8::cvt_pk_bf16(O[d][4 * g4] * inv, O[d][4 * g4 + 1] * inv); w.y = pg8::cvt_pk_bf16(O[d][4 * g4 + 2] * inv, O[d][4 * g4 + 3] * inv);
                    *(LAS u32x2*)(xr + 64 * d + 16 * g4) = w; }
        }
        __syncthreads();
        if (half == 0) {
            float ss = 0.f;
#pragma unroll
            for (int d = 0; d < NDB; ++d)
#pragma unroll
                for (int g4 = 0; g4 < 4; ++g4) { const u32x2 w = *(const LAS u32x2*)(xr + 64 * d + 16 * g4);
                    O[d][4 * g4] = O[d][4 * g4] * inv - lam * bflo(w.x); O[d][4 * g4 + 1] = O[d][4 * g4 + 1] * inv - lam * bfhi(w.x);
                    O[d][4 * g4 + 2] = O[d][4 * g4 + 2] * inv - lam * bflo(w.y); O[d][4 * g4 + 3] = O[d][4 * g4 + 3] * inv - lam * bfhi(w.y);
                    ss += (O[d][4 * g4] * O[d][4 * g4] + O[d][4 * g4 + 1] * O[d][4 * g4 + 1]) + (O[d][4 * g4 + 2] * O[d][4 * g4 + 2] + O[d][4 * g4 + 3] * O[d][4 * g4 + 3]); }
            ss += __shfl_xor(ss, 32);
            const float rstd = rsqrtf(ss * (1.f / 128.f) + NORM_EPS) * (1.f - lam_init);
            const float* sg = p.in[11] + (size_t)l * 128 + 4 * h;
            bf16* o = (bf16*)(p.ws + WS_OC) + trow * 1536 + 512 + hp * 128 + 4 * h;
#pragma unroll
            for (int d = 0; d < NDB; ++d)
#pragma unroll
                for (int g4 = 0; g4 < 4; ++g4) { const f32x4 g = *(const f32x4*)(sg + 32 * d + 8 * g4);
                    u32x2 w; w.x = pg8::cvt_pk_bf16(O[d][4 * g4] * rstd * g.x, O[d][4 * g4 + 1] * rstd * g.y); w.y = pg8::cvt_pk_bf16(O[d][4 * g4 + 2] * rstd * g.z, O[d][4 * g4 + 3] * rstd * g.w);
                    *(u32x2*)(o + 32 * d + 8 * g4) = w; }
        }
        __syncthreads();
    }
}

__device__ __forceinline__ void sgu_unit(const Params& p, int l, int n, int g, LAS unsigned char* lds) {
    constexpr int VRS = 320;
    int tid = threadIdx.x; asm volatile("" : "+v"(tid));
    const int lane = tid & 63, wid = __builtin_amdgcn_readfirstlane(tid >> 6), r = lane & 31, h = lane >> 5, tb = wid & 3, ch = wid >> 2;
    const bf16* Z = (const bf16*)(p.ws + WS_Z) + (size_t)n * 128 * ZP;
#pragma unroll
    for (int i = 0; i < 4; ++i) { const int id = tid + 512 * i, row = id >> 4, c = id & 15; *(LAS u32x4*)(lds + row * VRS + c * 16) = *(const u32x4*)(Z + (size_t)row * ZP + ZC_SV + g * 128 + c * 8); }
    const bf16* W = (const bf16*)(p.ws + WS_W + (size_t)l * W_LAYER + WO_SGU) + ((size_t)g * 128 + tb * 32 + r) * 128 + 4 * h;
    u32x2 wf[8][2];
#pragma unroll
    for (int ks = 0; ks < 8; ++ks) { wf[ks][0] = *(const u32x2*)(W + 16 * ks); wf[ks][1] = *(const u32x2*)(W + 16 * ks + 8); }
    __syncthreads();
    f32x16 O[2];
#pragma unroll
    for (int d = 0; d < 2; ++d)
#pragma unroll
        for (int e = 0; e < 16; ++e) O[d][e] = 0.f;
    const int voff = (4 * h + ((lane & 15) >> 2)) * VRS + (((lane >> 4) & 1) * 16 + (lane & 3) * 4) * 2 + 128 * ch;
#pragma unroll
    for (int d = 0; d < 2; ++d)
#pragma unroll
        for (int ks = 0; ks < 8; ++ks) { const LAS unsigned char* va = lds + voff + (16 * ks) * VRS + 64 * d;
            const att::s16x4 t0 = att::lds_tr(va), t1 = att::lds_tr(va + 8 * VRS);
            const bf16x8 vf = {t0[0], t0[1], t0[2], t0[3], t1[0], t1[1], t1[2], t1[3]};
            const u32x4 pw = {wf[ks][0].x, wf[ks][0].y, wf[ks][1].x, wf[ks][1].y};
            O[d] = __builtin_amdgcn_mfma_f32_32x32x16_bf16(vf, __builtin_bit_cast(bf16x8, pw), O[d], 0, 0, 0); }
    const int t = tb * 32 + r; const size_t trow = (size_t)n * 128 + t;
    const float bias = p.in[14][(size_t)l * 512 + g * 128 + t];
    const bf16* up = (const bf16*)(p.ws + WS_Z) + trow * ZP + ZC_SU + g * 128 + 64 * ch + 4 * h;
    bf16* o = (bf16*)(p.ws + WS_OC) + trow * 1536 + 1024 + g * 128 + 64 * ch + 4 * h;
#pragma unroll
    for (int d = 0; d < 2; ++d)
#pragma unroll
        for (int g4 = 0; g4 < 4; ++g4) { const u32x2 uw = *(const u32x2*)(up + 32 * d + 8 * g4);
            u32x2 w; w.x = pg8::cvt_pk_bf16(bflo(uw.x) * (O[d][4 * g4] + bias), bfhi(uw.x) * (O[d][4 * g4 + 1] + bias)); w.y = pg8::cvt_pk_bf16(bflo(uw.y) * (O[d][4 * g4 + 2] + bias), bfhi(uw.y) * (O[d][4 * g4 + 3] + bias));
            *(u32x2*)(o + 32 * d + 8 * g4) = w; }
    __syncthreads();
}
}

#define XB_TMO      128
#define XB_XCNT(j)  (256  + 64 * (j))
#define XB_XSUB(j)  (1280 + 64 * (j))
#define XB_XGEN(j)  (2304 + 64 * (j))
#define XB_TOP      3328
#define XB_TOPGEN   3392
#define XCD_BAR_WORDS 3456
#define XB_SPIN_CAP (1u << 18)
__device__ __forceinline__ unsigned xb_ld(unsigned* p)              { return __hip_atomic_load(p, __ATOMIC_RELAXED, __HIP_MEMORY_SCOPE_AGENT); }
__device__ __forceinline__ unsigned xb_add(unsigned* p, unsigned v) { return __hip_atomic_fetch_add(p, v, __ATOMIC_RELAXED, __HIP_MEMORY_SCOPE_AGENT); }
__device__ __forceinline__ unsigned xb_xcc_id() { return (unsigned)__builtin_amdgcn_s_getreg((3 << 11) | 20) & 0xFu; }
#define XB_SPIN(cond, bar) do { unsigned _sp = 0; while (cond) { __builtin_amdgcn_s_sleep(1); \
    if ((++_sp & 255u) == 0u) { if (xb_ld(&(bar)[XB_TMO])) break; if (_sp > XB_SPIN_CAP) { atomicAdd(&(bar)[XB_TMO], 1u); break; } } } } while (0)
struct XcdBarrier { unsigned* bar; unsigned x; volatile LAS unsigned* st; };
__device__ __forceinline__ XcdBarrier xcd_barrier_post(unsigned* bar, volatile LAS unsigned* st) {
    XcdBarrier b; b.bar = bar; b.x = xb_xcc_id(); b.st = st;
    if (threadIdx.x == 0) (void)xb_add(&bar[XB_XCNT(b.x)], 1u);
    return b;
}
__device__ __forceinline__ void xcd_barrier_complete(unsigned* bar, unsigned x, unsigned& nloc, unsigned& nx) {
    const unsigned G = gridDim.x * gridDim.y * gridDim.z;
    unsigned sum, cnt, mine, sp = 0u;
    for (;;) {
        sum = 0u; cnt = 0u; mine = 0u;
#pragma unroll
        for (unsigned j = 0; j < 16; ++j) { const unsigned c = xb_ld(&bar[XB_XCNT(j)]); sum += c; cnt += (c > 0u) ? 1u : 0u; mine = (j == x) ? c : mine; }
        if (sum == G) break;
        __builtin_amdgcn_s_sleep(1);
        if ((++sp & 255u) == 0u) { if (xb_ld(&bar[XB_TMO])) break; if (sp > XB_SPIN_CAP) { atomicAdd(&bar[XB_TMO], 1u); break; } }
    }
    nloc = mine > 0u ? mine : 1u; nx = cnt > 0u ? cnt : 1u;
}
__device__ __forceinline__ void xcd_barrier(const XcdBarrier& b) {
    asm volatile("s_waitcnt vmcnt(0)" ::: "memory");
    __syncthreads();
    if (threadIdx.x == 0) {
        unsigned* bar = b.bar;
        __builtin_amdgcn_s_waitcnt(0);
        unsigned nloc = b.st[0], nx = b.st[1];
        if (nloc == 0u) { xcd_barrier_complete(bar, b.x, nloc, nx); b.st[0] = nloc; b.st[1] = nx; }
        const unsigned old = xb_add(&bar[XB_XSUB(b.x)], 1u);
        const unsigned gen = old / nloc;
        if (old + 1u == (gen + 1u) * nloc) {
            __builtin_amdgcn_fence(__ATOMIC_RELEASE, "agent");
            asm volatile("s_waitcnt vmcnt(0)" ::: "memory");
            const unsigned og = xb_add(&bar[XB_TOP], 1u);
            const unsigned tg = og / nx;
            if (og + 1u == (tg + 1u) * nx) xb_add(&bar[XB_TOPGEN], 1u);
            else XB_SPIN(xb_ld(&bar[XB_TOPGEN]) == tg, bar);
            __builtin_amdgcn_fence(__ATOMIC_ACQUIRE, "agent");
            xb_add(&bar[XB_XGEN(b.x)], 1u);
            asm volatile("s_waitcnt vmcnt(0)" ::: "memory");
        } else {
            XB_SPIN(xb_ld(&bar[XB_XGEN(b.x)]) == gen, bar);
            __builtin_amdgcn_fence(__ATOMIC_ACQUIRE, "agent");
            asm volatile("s_waitcnt vmcnt(0)" ::: "memory");
        }
    }
    __syncthreads();
}

constexpr int NPHASE = 1 + 11 * DEPTH;
constexpr int CW_BAR = 4096;
struct MArgs { Params p; int ph_lo, ph_hi, li, pad; };

__global__ void __launch_bounds__(512, 2) mega(MArgs a) {
    extern __shared__ __attribute__((aligned(16))) unsigned char lds_raw[];
    LAS unsigned char* lds = (LAS unsigned char*)lds_raw;
    volatile LAS unsigned* MISC = (volatile LAS unsigned*)(lds + MISC_OFF);
    const Params& p = a.p;
    const int tid = threadIdx.x, lane = tid & 63, wave = __builtin_amdgcn_readfirstlane(tid >> 6);
    const int G = gridDim.x, bx = blockIdx.x;
    const int vcu = (G % 8 == 0) ? (bx % 8) * (G / 8) + bx / 8 : bx;
    const int gw = vcu * 8 + wave, ngw = G * 8;
    unsigned char* ws = p.ws;
    for (int u = tid; u < (LDS_BYTES - RING_BYTES) / 4; u += 512) ((LAS unsigned*)(lds + RING_BYTES))[u] = 0u;
    __syncthreads();
    XcdBarrier bar = xcd_barrier_post((unsigned*)(ws + WS_CTL) + CW_BAR + a.li * XCD_BAR_WORDS, MISC + 8);
    const int lo = a.ph_lo, hi = a.ph_hi;
#ifndef PROBE_PM
#define PROBE_PM 0
#endif
#ifndef PROBE_K
#define PROBE_K (-1)
#endif
#ifndef PROBE_N
#define PROBE_N 0
#endif
#define NREP(j) ((PROBE_K == (j)) ? PROBE_N : 0)
#ifndef ENMASK
#define ENMASK 0xFFFFFFFFu
#endif
#define EN(j) ((ENMASK >> (j)) & 1u)
#define IN(k) (lo <= (k) && (k) < hi)
#define SEAM(k) do { if (IN(k) && IN((k) + 1)) xcd_barrier(bar); } while (0)

    if (EN(11) && IN(0)) for (int rep = 0; rep <= NREP(11); ++rep) {
        float* scr = (float*)lds_raw;
        __syncthreads();
        for (int r12 = 0; r12 <= NREP(12); ++r12)
        for (int l = 0; l < DEPTH; ++l) prologue_transposes(p, l, scr + wave * (64 * 33), gw, ngw, lane);
        prologue_rope(p, bx * 512 + tid, G * 512);
        __syncthreads();
        for (int r13 = 0; r13 <= NREP(13); ++r13)
        for (int it = bx; it < 2 * 256; it += G) fold_item(p, it >> 8, it & 255, scr, tid);
        __syncthreads();
        for (int r15 = 0; r15 <= NREP(15); ++r15)
        for (int t = gw; t < T; t += ngw) rms_row_to_bf16(p.in[0] + (size_t)t * DM, p.in[1], (bf16*)(ws + WS_HB) + (size_t)t * DM, lane, ws + WS_HB8 + (size_t)t * DM);
        for (int r14 = 0; r14 <= NREP(14); ++r14)
        for (int r = gw; r < 2 * DEPTH * NEXP; r += ngw) { const int tb = r / (DEPTH * NEXP), q = r % (DEPTH * NEXP);
            const size_t ro = (size_t)(q / NEXP) * NEXP * QROW + (size_t)(q % NEXP) * 128;
            if (tb) q4_row(p.in[23] + (size_t)q * DM, ws + WS_V8 + ro, (float*)(ws + WS_PS) + (size_t)DEPTH * NEXP + q, lane);
            else q4u_row(p.in[22] + (size_t)q * DM, ws + WS_U8 + ro, (float*)(ws + WS_PS) + q, lane); }
        { unsigned* gmax = (unsigned*)(ws + WS_CTL) + CW_GMAX;
          for (int m6 = 0; m6 < 3 * DEPTH; ++m6) { const f32x4* src = (const f32x4*)(p.in[15] + (size_t)m6 * DM * DM); float mx = 0.f;
              for (int i = gw * 64 + lane; i < DM * DM / 4; i += ngw * 64) { const f32x4 v = src[i]; mx = fmaxf(mx, fmaxf(fmaxf(fabsf(v.x), fabsf(v.y)), fmaxf(fabsf(v.z), fabsf(v.w)))); }
#pragma unroll
              for (int of = 1; of < 64; of <<= 1) mx = fmaxf(mx, __shfl_xor(mx, of));
              if (lane == 0) atomicMax(gmax + 64 * m6, __builtin_bit_cast(unsigned, mx)); } }
        xcd_barrier(bar);
        { unsigned* gmax = (unsigned*)(ws + WS_CTL) + CW_GMAX;
          for (int it = gw; it < DEPTH * 3 * 64 * 32; it += ngw) { const int m6 = it / 2048, q = it % 2048, cb = q / 32, kb = q % 32;
              transpose_item8(p.in[15] + (size_t)m6 * DM * DM, DM, cb * 32, kb * 64, DM, ws + WS_WG8, m6 * DM + cb * 32, scr + wave * (64 * 33), lane, gate_scale(gmax + 64 * m6)); } }
    }
    SEAM(0);
    { constexpr int l = 0;
        const int pb = 1 + 11 * l;
        unsigned char* wl = ws + WS_W + (size_t)l * W_LAYER;
        bf16* HB = (bf16*)(ws + WS_HB); bf16* Z = (bf16*)(ws + WS_Z); bf16* Gt = (bf16*)(ws + WS_G);
        if (EN(0) && IN(pb + 0)) for (int rep = 0; rep <= NREP(0); ++rep) {
            { pg8::ProbGen g{HB, (const bf16*)(wl + WO_CAT), DM, DM, DM}; pg8::StaticOrder S; S.init(T, ZP, G, bx);
              pg8::EpiZG E{Z, Gt, p.in[16] + (size_t)l * NGATE, 1};
              pg8::gemm_phase<pg8::EpiZG, pg8::ProbGen, pg8::StaticOrder>(lds, g, S, E); }
            {
              const unsigned* gmax = (const unsigned*)(ws + WS_CTL) + CW_GMAX + 64 * 3 * l;
              pg8::ProbGen g{(const bf16*)(ws + WS_HB8), (const bf16*)(ws + WS_WG8 + (size_t)l * NGATE * DM), DM / 2, DM / 2, DM / 2}; pg8::StaticOrder S; S.init(T, NGATE, G, bx);
              pg8::EpiG8 E{Gt, p.in[16] + (size_t)l * NGATE, gmax};
              pg8::gemm_phase<pg8::EpiG8, pg8::ProbGen, pg8::StaticOrder, true, true>(lds, g, S, E); }
        }
        SEAM(pb + 0);
        if (EN(1) && IN(pb + 1)) { int ln = lane; asm volatile("" : "+v"(ln)); for (int t = gw; t < T; t += ngw) prep1_row(p, l, t, ln); }
        SEAM(pb + 1);
        if (EN(2) && IN(pb + 2)) for (int rep = 0; rep <= NREP(2); ++rep) {
            pg8::ProbUp g{Z, (const bf16*)(wl + WO_UP), ZP, 512, 512}; pg8::StaticOrder S; S.init(T, 1792, G, bx);
            pg8::EpiUp E{(bf16*)(ws + WS_QR), (bf16*)(ws + WS_KVR)};
            pg8::gemm_phase<pg8::EpiUp, pg8::ProbUp, pg8::StaticOrder>(lds, g, S, E);
        }
        SEAM(pb + 2);
        if (EN(3) && IN(pb + 3)) for (int rep = 0; rep <= NREP(3); ++rep) { int ln = lane; asm volatile("" : "+v"(ln)); for (int t = gw; t < T; t += ngw) prep2_row(p, l, t, ln); }
        SEAM(pb + 3);
        if (EN(4) && IN(pb + 4)) for (int rep = 0; rep <= NREP(4); ++rep) {
            const float lam = diff_lambda(p, l, lane), lam_init = 0.8f - 0.6f * expf(-0.3f * (float)l);
            unsigned* qbase = (unsigned*)(ws + WS_CTL) + 64 * (1 + 8 * l + 16 * rep);
            int qs = 0;
            for (;;) {
                __syncthreads();
                if (tid == 0) { int u = 192, qx = 0;
                    while (qs < 8) { qx = (int)((bar.x + (unsigned)qs) & 7u); u = (int)atomicAdd(qbase + 64 * qx, 1u); if (u < 192) break; ++qs; }
                    MISC[16] = (unsigned)(qs < 8 ? u : 192); MISC[17] = (unsigned)qx; MISC[18] = (unsigned)qs; }
                __syncthreads();
                const int u = (int)MISC[16], qx = (int)MISC[17]; qs = (int)MISC[18];
                if (u >= 192) break;
                if (u < 128) { const int qb = 31 - (u >> 2), combo = qx + 8 * (u & 3);
                    if (combo < 16) att::attn_unit<1>(p, l, combo >> 2, combo & 3, qb, lds, lam, lam_init, rep < NREP(4) ? PROBE_PM : 0);
                    else att::attn_unit<0>(p, l, (combo - 16) >> 2, (combo - 16) & 3, qb, lds, 0.f, 0.f, rep < NREP(4) ? PROBE_PM : 0);
                } else { const int v = qx * 64 + (u - 128); att::sgu_unit(p, l, v >> 2, v & 3, lds); }
            }
        }
        SEAM(pb + 4);
        if (EN(5) && IN(pb + 5)) for (int rep = 0; rep <= NREP(5); ++rep) {
            const bool prb = rep < NREP(5);
            pg8::ProbGen g{(const bf16*)(ws + WS_OC), (const bf16*)(wl + WO_B), 1536, 1536, 1536}; pg8::StaticOrder S; S.init(T, DM, G, bx);
            if (prb && (PROBE_PM & 2)) { g.A = HB; g.lda = DM; }
            if (prb && (PROBE_PM & 4)) { g.Bt = (const bf16*)(wl + WO_CAT); g.ldb = DM; }
            pg8::EpiMG E{prb ? (bf16*)(ws + WS_QR) : (bf16*)(ws + WS_MG), Gt, (prb && (PROBE_PM & 1)) ? 1 : 0};
            if (prb && (PROBE_PM & 8)) { pg8::EpiDelta E2{(bf16*)(ws + WS_QR)}; pg8::gemm_phase<pg8::EpiDelta, pg8::ProbGen, pg8::StaticOrder>(lds, g, S, E2); }
            else pg8::gemm_phase<pg8::EpiMG, pg8::ProbGen, pg8::StaticOrder>(lds, g, S, E);
        }
        SEAM(pb + 5);
        if (EN(6) && IN(pb + 6)) for (int rep = 0; rep <= NREP(6); ++rep) {
            pg8::ProbGen g{(const bf16*)(ws + WS_MG), (const bf16*)(wl + WO_OUT), DM, DM, DM}; pg8::StaticOrder S; S.init(T, DM, G, bx);
            pg8::EpiDelta E{(bf16*)(ws + WS_QR)};
            pg8::gemm_phase<pg8::EpiDelta, pg8::ProbGen, pg8::StaticOrder>(lds, g, S, E);
        }
        SEAM(pb + 6);
        if (EN(7) && IN(pb + 7)) { int ln = lane; asm volatile("" : "+v"(ln));
            const float* xin = l == 0 ? p.in[0] : p.out;
            for (int t = gw; t < T; t += ngw) add_rms_row(xin + (size_t)t * DM, (const bf16*)(ws + WS_QR) + (size_t)t * DM, RESID_IN_PEER ? nullptr : p.out + (size_t)t * DM, p.in[19] + (size_t)l * DM, HB + (size_t)t * DM, (float*)(ws + WS_HS) + 2 * (size_t)t, ln); }
        SEAM(pb + 7);
        if (EN(8) && IN(pb + 8)) for (int rep = 0; rep <= NREP(8); ++rep) {
            pg8::ProbGen g{HB, (const bf16*)(wl + WO_PQ), DM, DM, DM}; pg8::StaticOrder S; S.init(T, DM, G, bx);
            pg8::EpiSC E{(float*)(ws + WS_SC)};
            pg8::gemm_phase<pg8::EpiSC, pg8::ProbGen, pg8::StaticOrder>(lds, g, S, E);
        }
        SEAM(pb + 8);
        if (EN(9) && IN(pb + 9)) for (int rep = 0; rep <= NREP(9); ++rep) { int ln = lane; asm volatile("" : "+v"(ln));
            for (int task = gw; task < T * 8 / 64; task += ngw) { const int th = task * 64 + ln;
                topk_lane((const float*)(ws + WS_SC) + (size_t)th * 256, (int*)(ws + WS_IDX) + (size_t)th * 16, (float*)(ws + WS_GW) + (size_t)th * 16); } }
        SEAM(pb + 9);
        if (EN(10) && IN(pb + 10)) { int ln = lane; asm volatile("" : "+v"(ln));
            const float* gn = l + 1 < DEPTH ? p.in[1] + (size_t)(l + 1) * DM : nullptr;
            __syncthreads();
            peer_octets(p, l, gw, ngw, ln, gn, p.out, p.out, lds + wave * PEER_LDS_WAVE);
            __syncthreads(); }
        SEAM(pb + 10);
        }
    { constexpr int l = 1;
        const int pb = 1 + 11 * l;
        unsigned char* wl = ws + WS_W + (size_t)l * W_LAYER;
        bf16* HB = (bf16*)(ws + WS_HB); bf16* Z = (bf16*)(ws + WS_Z); bf16* Gt = (bf16*)(ws + WS_G);
        if (EN(0) && IN(pb + 0)) for (int rep = 0; rep <= NREP(0); ++rep) {
            { pg8::ProbGen g{HB, (const bf16*)(wl + WO_CAT), DM, DM, DM}; pg8::StaticOrder S; S.init(T, ZP, G, bx);
              pg8::EpiZG E{Z, Gt, p.in[16] + (size_t)l * NGATE, 1};
              pg8::gemm_phase<pg8::EpiZG, pg8::ProbGen, pg8::StaticOrder>(lds, g, S, E); }
            {
              const unsigned* gmax = (const unsigned*)(ws + WS_CTL) + CW_GMAX + 64 * 3 * l;
              pg8::ProbGen g{(const bf16*)(ws + WS_HB8), (const bf16*)(ws + WS_WG8 + (size_t)l * NGATE * DM), DM / 2, DM / 2, DM / 2}; pg8::StaticOrder S; S.init(T, NGATE, G, bx);
              pg8::EpiG8 E{Gt, p.in[16] + (size_t)l * NGATE, gmax};
              pg8::gemm_phase<pg8::EpiG8, pg8::ProbGen, pg8::StaticOrder, true, true>(lds, g, S, E); }
        }
        SEAM(pb + 0);
        if (EN(1) && IN(pb + 1)) { int ln = lane; asm volatile("" : "+v"(ln)); for (int t = gw; t < T; t += ngw) prep1_row(p, l, t, ln); }
        SEAM(pb + 1);
        if (EN(2) && IN(pb + 2)) for (int rep = 0; rep <= NREP(2); ++rep) {
            pg8::ProbUp g{Z, (const bf16*)(wl + WO_UP), ZP, 512, 512}; pg8::StaticOrder S; S.init(T, 1792, G, bx);
            pg8::EpiUp E{(bf16*)(ws + WS_QR), (bf16*)(ws + WS_KVR)};
            pg8::gemm_phase<pg8::EpiUp, pg8::ProbUp, pg8::StaticOrder>(lds, g, S, E);
        }
        SEAM(pb + 2);
        if (EN(3) && IN(pb + 3)) for (int rep = 0; rep <= NREP(3); ++rep) { int ln = lane; asm volatile("" : "+v"(ln)); for (int t = gw; t < T; t += ngw) prep2_row(p, l, t, ln); }
        SEAM(pb + 3);
        if (EN(4) && IN(pb + 4)) for (int rep = 0; rep <= NREP(4); ++rep) {
            const float lam = diff_lambda(p, l, lane), lam_init = 0.8f - 0.6f * expf(-0.3f * (float)l);
            unsigned* qbase = (unsigned*)(ws + WS_CTL) + 64 * (1 + 8 * l + 16 * rep);
            int qs = 0;
            for (;;) {
                __syncthreads();
                if (tid == 0) { int u = 192, qx = 0;
                    while (qs < 8) { qx = (int)((bar.x + (unsigned)qs) & 7u); u = (int)atomicAdd(qbase + 64 * qx, 1u); if (u < 192) break; ++qs; }
                    MISC[16] = (unsigned)(qs < 8 ? u : 192); MISC[17] = (unsigned)qx; MISC[18] = (unsigned)qs; }
                __syncthreads();
                const int u = (int)MISC[16], qx = (int)MISC[17]; qs = (int)MISC[18];
                if (u >= 192) break;
                if (u < 128) { const int qb = 31 - (u >> 2), combo = qx + 8 * (u & 3);
                    if (combo < 16) att::attn_unit<1>(p, l, combo >> 2, combo & 3, qb, lds, lam, lam_init, rep < NREP(4) ? PROBE_PM : 0);
                    else att::attn_unit<0>(p, l, (combo - 16) >> 2, (combo - 16) & 3, qb, lds, 0.f, 0.f, rep < NREP(4) ? PROBE_PM : 0);
                } else { const int v = qx * 64 + (u - 128); att::sgu_unit(p, l, v >> 2, v & 3, lds); }
            }
        }
        SEAM(pb + 4);
        if (EN(5) && IN(pb + 5)) for (int rep = 0; rep <= NREP(5); ++rep) {
            const bool prb = rep < NREP(5);
            pg8::ProbGen g{(const bf16*)(ws + WS_OC), (const bf16*)(wl + WO_B), 1536, 1536, 1536}; pg8::StaticOrder S; S.init(T, DM, G, bx);
            if (prb && (PROBE_PM & 2)) { g.A = HB; g.lda = DM; }
            if (prb && (PROBE_PM & 4)) { g.Bt = (const bf16*)(wl + WO_CAT); g.ldb = DM; }
            pg8::EpiMG E{prb ? (bf16*)(ws + WS_QR) : (bf16*)(ws + WS_MG), Gt, (prb && (PROBE_PM & 1)) ? 1 : 0};
            if (prb && (PROBE_PM & 8)) { pg8::EpiDelta E2{(bf16*)(ws + WS_QR)}; pg8::gemm_phase<pg8::EpiDelta, pg8::ProbGen, pg8::StaticOrder>(lds, g, S, E2); }
            else pg8::gemm_phase<pg8::EpiMG, pg8::ProbGen, pg8::StaticOrder>(lds, g, S, E);
        }
        SEAM(pb + 5);
        if (EN(6) && IN(pb + 6)) for (int rep = 0; rep <= NREP(6); ++rep) {
            pg8::ProbGen g{(const bf16*)(ws + WS_MG), (const bf16*)(wl + WO_OUT), DM, DM, DM}; pg8::StaticOrder S; S.init(T, DM, G, bx);
            pg8::EpiDelta E{(bf16*)(ws + WS_QR)};
            pg8::gemm_phase<pg8::EpiDelta, pg8::ProbGen, pg8::StaticOrder>(lds, g, S, E);
        }
        SEAM(pb + 6);
        if (EN(7) && IN(pb + 7)) { int ln = lane; asm volatile("" : "+v"(ln));
            const float* xin = l == 0 ? p.in[0] : p.out;
            for (int t = gw; t < T; t += ngw) add_rms_row(xin + (size_t)t * DM, (const bf16*)(ws + WS_QR) + (size_t)t * DM, RESID_IN_PEER ? nullptr : p.out + (size_t)t * DM, p.in[19] + (size_t)l * DM, HB + (size_t)t * DM, (float*)(ws + WS_HS) + 2 * (size_t)t, ln); }
        SEAM(pb + 7);
        if (EN(8) && IN(pb + 8)) for (int rep = 0; rep <= NREP(8); ++rep) {
            pg8::ProbGen g{HB, (const bf16*)(wl + WO_PQ), DM, DM, DM}; pg8::StaticOrder S; S.init(T, DM, G, bx);
            pg8::EpiSC E{(float*)(ws + WS_SC)};
            pg8::gemm_phase<pg8::EpiSC, pg8::ProbGen, pg8::StaticOrder>(lds, g, S, E);
        }
        SEAM(pb + 8);
        if (EN(9) && IN(pb + 9)) for (int rep = 0; rep <= NREP(9); ++rep) { int ln = lane; asm volatile("" : "+v"(ln));
            for (int task = gw; task < T * 8 / 64; task += ngw) { const int th = task * 64 + ln;
                topk_lane((const float*)(ws + WS_SC) + (size_t)th * 256, (int*)(ws + WS_IDX) + (size_t)th * 16, (float*)(ws + WS_GW) + (size_t)th * 16); } }
        SEAM(pb + 9);
        if (EN(10) && IN(pb + 10)) { int ln = lane; asm volatile("" : "+v"(ln));
            const float* gn = l + 1 < DEPTH ? p.in[1] + (size_t)(l + 1) * DM : nullptr;
            __syncthreads();
            peer_octets(p, l, gw, ngw, ln, gn, p.out, p.out, lds + wave * PEER_LDS_WAVE);
            __syncthreads(); }
        SEAM(pb + 10);
        }
#undef IN
#undef SEAM
}

static int g_grid = 0;
static void launch_mega(const Params& p, int lo, int hi, int li, hipStream_t stream) {
    MArgs a{}; a.p = p; a.ph_lo = lo; a.ph_hi = hi; a.li = li; a.pad = 0;
    mega<<<g_grid, 512, LDS_BYTES, stream>>>(a);
}
extern "C" void kernel_launch(void* const* d_in, const int* in_sizes, int n_in, void* d_out, int out_size, void* d_ws, size_t ws_size, hipStream_t stream) {
    if (n_in != 24 || out_size != T * DM || ws_size < WS_END) { fprintf(stderr, "kernel_launch: unexpected shapes (n_in %d, out %d, ws %zu, need %zu)\n", n_in, out_size, ws_size, (size_t)WS_END); return; }
    if (g_grid == 0) {
        int dev = 0, cus = 0, per_cu = 0;
        if (hipGetDevice(&dev) != hipSuccess || hipDeviceGetAttribute(&cus, hipDeviceAttributeMultiprocessorCount, dev) != hipSuccess) { g_grid = -1; return; }
        if (hipFuncSetAttribute((const void*)mega, hipFuncAttributeMaxDynamicSharedMemorySize, LDS_BYTES) != hipSuccess) { fprintf(stderr, "kernel_launch: hipFuncSetAttribute failed\n"); g_grid = -1; return; }
        if (hipOccupancyMaxActiveBlocksPerMultiprocessor(&per_cu, (const void*)mega, 512, LDS_BYTES) != hipSuccess || per_cu < 1) { fprintf(stderr, "kernel_launch: occupancy query says %d\n", per_cu); }
        (void)hipGetLastError();
        g_grid = cus;
    }
    if (g_grid < 0) return;
    Params p{};
    for (int i = 0; i < 24; ++i) p.in[i] = (const float*)d_in[i];
    p.out = (float*)d_out; p.ws = (unsigned char*)d_ws;
    unsigned char* ws = p.ws;
    (void)hipMemsetAsync(ws + WS_CTL, 0, 1 * MiB, stream);
    launch_mega(p, 0, NPHASE, 0, stream);
}
```

```cpp
#include <hip/hip_runtime.h>
#include <cstdio>
#include <cstdint>
#ifndef RESID_IN_PEER
#define RESID_IN_PEER 0
#endif

constexpr int BATCH = 4, SEQ = 4096, DM = 2048, DEPTH = 2;
constexpr int T = BATCH * SEQ;
constexpr int ZP = 3840;
constexpr int NGATE = 3 * DM;
constexpr int N1 = ZP + NGATE;
constexpr int ZC_CQ = 0, ZC_CKV = 512, ZC_DQ = 1024, ZC_DK = 1536, ZC_DV = 2048, ZC_SU = 2560, ZC_SV = 3072, ZC_KR = 3584;
constexpr int DIN = 3616;
constexpr int NEXP = 16384;
constexpr float NORM_EPS = 1e-6f;
constexpr float LOG2E = 1.4426950408889634f;

typedef unsigned short bf16;
typedef unsigned u32x4 __attribute__((ext_vector_type(4)));
typedef unsigned u32x2 __attribute__((ext_vector_type(2)));
typedef float f32x4 __attribute__((ext_vector_type(4)));
typedef float f32x16 __attribute__((ext_vector_type(16)));
typedef short bf16x8 __attribute__((ext_vector_type(8)));
#define LAS __attribute__((address_space(3)))

constexpr size_t MiB = 1u << 20;
constexpr size_t WS_CTL = 0;
constexpr size_t WS_ROPE = 1 * MiB;
constexpr size_t WS_W = 2 * MiB;
constexpr size_t WO_CAT = 0;
constexpr size_t WO_UP = WO_CAT + (size_t)N1 * DM * 2;
constexpr size_t WO_B = WO_UP + (size_t)1792 * 512 * 2;
constexpr size_t WO_OUT = WO_B + (size_t)3 * DM * 512 * 2;
constexpr size_t WO_PQ = WO_OUT + (size_t)DM * DM * 2;
constexpr size_t WO_SGU = WO_PQ + (size_t)DM * DM * 2;
constexpr size_t W_LAYER = WO_SGU + (size_t)4 * 128 * 128 * 2;
constexpr size_t WS_ACT = WS_W + 2 * W_LAYER + (2 * MiB - (2 * W_LAYER) % (2 * MiB));
constexpr size_t WS_HB = WS_ACT;
constexpr size_t WS_Z = WS_HB + (size_t)T * DM * 2;
constexpr size_t WS_G = WS_Z + (size_t)T * ZP * 2;
constexpr size_t WS_SC = WS_G;
constexpr size_t WS_QR = WS_G + (size_t)T * NGATE * 2;
constexpr size_t WS_KVR = WS_QR + (size_t)T * 768 * 2;
constexpr size_t WS_QM = WS_KVR + (size_t)T * 1024 * 2;
constexpr size_t WS_KM = WS_QM + (size_t)T * 768 * 2;
constexpr size_t WS_OC = WS_KM + (size_t)T * 768 * 2;
constexpr size_t WS_MG = WS_OC + (size_t)3 * T * 512 * 2;
constexpr size_t WS_IDX = WS_MG + (size_t)T * DM * 2;
constexpr size_t WS_GW = WS_IDX + (size_t)T * 128 * 4;
constexpr int QROW = DM / 2;
constexpr size_t WS_U8 = WS_GW + (size_t)T * 128 * 4;
constexpr size_t WS_V8 = WS_U8 + (size_t)DEPTH * NEXP * QROW;
constexpr size_t WS_PS = WS_V8 + (size_t)DEPTH * NEXP * QROW;
constexpr size_t WS_HB8 = WS_PS + (size_t)2 * DEPTH * NEXP * 4;
constexpr size_t WS_WG8 = WS_HB8 + (size_t)T * DM;
constexpr size_t WS_HS = WS_WG8 + (size_t)DEPTH * NGATE * DM;
constexpr size_t WS_END = WS_HS + (size_t)T * 8;
constexpr int CW_GMAX = 3072;

struct Params {
    const float* in[24];
    float* out;
    unsigned char* ws;
};

__device__ __forceinline__ unsigned f2bf(float f) { unsigned u = __builtin_bit_cast(unsigned, f); return (u + 0x7fffu + ((u >> 16) & 1u)) >> 16; }
__device__ __forceinline__ unsigned pk2(float lo, float hi) { return f2bf(lo) | (f2bf(hi) << 16); }
__device__ __forceinline__ float bf2f(unsigned b) { return __builtin_bit_cast(float, b << 16); }
__device__ __forceinline__ float bflo(unsigned w) { return __builtin_bit_cast(float, w << 16); }
__device__ __forceinline__ float bfhi(unsigned w) { return __builtin_bit_cast(float, w & 0xffff0000u); }
__device__ __forceinline__ unsigned pk4_fp8(float a, float b, float c, float d) { int w = __builtin_amdgcn_cvt_pk_fp8_f32(a, b, 0, false); w = __builtin_amdgcn_cvt_pk_fp8_f32(c, d, w, true); return (unsigned)w; }
__device__ __forceinline__ float wave_sum(float v) {
#pragma unroll
    for (int o = 1; o < 64; o <<= 1) v += __shfl_xor(v, o);
    return v;
}
__device__ __forceinline__ float gelu_tanh(float x) {
    const float u = 0.7978845608028654f * (x + 0.044715f * x * x * x);
    const float e = __expf(-2.0f * fabsf(u));
    float th = (1.0f - e) / (1.0f + e);
    th = u < 0.f ? -th : th;
    return 0.5f * x * (1.0f + th);
}
__device__ __forceinline__ void unpack8(const u32x4 w, float (&f)[8]) {
    f[0] = bflo(w.x); f[1] = bfhi(w.x); f[2] = bflo(w.y); f[3] = bfhi(w.y); f[4] = bflo(w.z); f[5] = bfhi(w.z); f[6] = bflo(w.w); f[7] = bfhi(w.w);
}
__device__ __forceinline__ u32x4 pack8(const float (&f)[8]) {
    u32x4 w; w.x = pk2(f[0], f[1]); w.y = pk2(f[2], f[3]); w.z = pk2(f[4], f[5]); w.w = pk2(f[6], f[7]); return w;
}

__device__ __forceinline__ void transpose_item(const float* __restrict__ W, int ldw, int scol0, int k0, int K, bf16* __restrict__ WT, int drow0, float* scr, int lane, int kd0 = -1) {
    if (kd0 < 0) kd0 = k0;
    float v[32];
    const float* src = W + (size_t)(k0 + (lane >> 5)) * ldw + scol0 + (lane & 31);
#pragma unroll
    for (int i = 0; i < 32; ++i) v[i] = src[(size_t)(2 * i) * ldw];
#pragma unroll
    for (int i = 0; i < 32; ++i) scr[(2 * i + (lane >> 5)) * 33 + (lane & 31)] = v[i];
    asm volatile("s_waitcnt lgkmcnt(0)" ::: "memory");
    const int c = lane & 7;
#pragma unroll
    for (int j = 0; j < 4; ++j) { const int n = (lane >> 3) + 8 * j; const float* s = scr + (8 * c) * 33 + n;
        u32x4 o; o.x = pk2(s[0 * 33], s[1 * 33]); o.y = pk2(s[2 * 33], s[3 * 33]); o.z = pk2(s[4 * 33], s[5 * 33]); o.w = pk2(s[6 * 33], s[7 * 33]);
        *(u32x4*)(WT + (size_t)(drow0 + n) * K + kd0 + 8 * c) = o; }
    asm volatile("s_waitcnt lgkmcnt(0)" ::: "memory");
}

__device__ __forceinline__ void transpose_item8(const float* __restrict__ W, int ldw, int scol0, int k0, int K, unsigned char* __restrict__ WT, int drow0, float* scr, int lane, float sc) {
    float v[32];
    const float* src = W + (size_t)(k0 + (lane >> 5)) * ldw + scol0 + (lane & 31);
#pragma unroll
    for (int i = 0; i < 32; ++i) v[i] = src[(size_t)(2 * i) * ldw];
#pragma unroll
    for (int i = 0; i < 32; ++i) scr[(2 * i + (lane >> 5)) * 33 + (lane & 31)] = v[i] * sc;
    asm volatile("s_waitcnt lgkmcnt(0)" ::: "memory");
    const int c = lane & 7;
#pragma unroll
    for (int j = 0; j < 4; ++j) { const int n = (lane >> 3) + 8 * j; const float* s = scr + (8 * c) * 33 + n;
        u32x2 o; o.x = pk4_fp8(s[0 * 33], s[1 * 33], s[2 * 33], s[3 * 33]); o.y = pk4_fp8(s[4 * 33], s[5 * 33], s[6 * 33], s[7 * 33]);
        *(u32x2*)(WT + (size_t)(drow0 + n) * K + k0 + 8 * c) = o; }
    asm volatile("s_waitcnt lgkmcnt(0)" ::: "memory");
}
__device__ __forceinline__ float gate_scale(const unsigned* w) { const unsigned b = __hip_atomic_load(w, __ATOMIC_RELAXED, __HIP_MEMORY_SCOPE_AGENT); const int e = (int)((b >> 23) & 255u) - 126;
    const int k = 8 - e, kc = k < -100 ? -100 : (k > 100 ? 100 : k); return __builtin_bit_cast(float, (unsigned)(kc + 127) << 23); }
__device__ __forceinline__ void prologue_transposes(const Params& p, int l, float* scr, int gw, int ngw, int lane) {
    unsigned char* wl = p.ws + WS_W + (size_t)l * W_LAYER;
    bf16* Wcat = (bf16*)(wl + WO_CAT); bf16* Wup = (bf16*)(wl + WO_UP); bf16* Wb = (bf16*)(wl + WO_B); bf16* Wout = (bf16*)(wl + WO_OUT);
    const float* w_in = p.in[2] + (size_t)l * DM * DIN;
    const float* w_gate = p.in[15] + (size_t)l * 3 * DM * DM;
    const float* w_uq = p.in[5] + (size_t)l * 512 * 768;
    const float* w_ukv = p.in[6] + (size_t)l * 512 * 1024;
    const float* w_br = p.in[17] + (size_t)l * 3 * 512 * DM;
    const float* w_out = p.in[18] + (size_t)l * DM * DM;
    constexpr int I1 = 113 * 32, I2 = 3 * 64 * 32, I3 = 24 * 8, I4 = 32 * 8, I5 = 3 * 64 * 8, I6 = 64 * 32;
    constexpr int NIT = I1 + I2 + I3 + I4 + I5 + I6;
    for (int it = gw; it < NIT; it += ngw) {
        int r = it;
        if (r < I1) { const int cb = r / 32, kb = r % 32; const int n0 = cb * 32;
            const int sc = n0 < 1024 ? n0 : (n0 < 3584 ? n0 + 32 : n0 - 3584 + 1024);
            transpose_item(w_in, DIN, sc, kb * 64, DM, Wcat, n0, scr, lane); continue; } r -= I1;
        if (r < I2) { continue; } r -= I2;
        if (r < I3) { const int cb = r / 8, kb = r % 8;
            int sc, dr; if (cb < 16) { const int h = cb >> 1, hf = cb & 1; sc = h * 96 + 32 * hf; dr = h * 64 + 32 * hf; } else { const int h = cb - 16; sc = h * 96 + 64; dr = 512 + h * 32; }
            transpose_item(w_uq, 768, sc, kb * 64, 512, Wup, dr, scr, lane); continue; } r -= I3;
        if (r < I4) { const int cb = r / 8, kb = r % 8;
            const int v = cb >> 4, h = (cb & 15) >> 1, hf = cb & 1; const int sc = h * 128 + 64 * v + 32 * hf, dr = 768 + 512 * v + h * 64 + 32 * hf;
            transpose_item(w_ukv, 1024, sc, kb * 64, 512, Wup, dr, scr, lane); continue; } r -= I4;
        if (r < I5) { const int n = r / 512, q = r % 512, cb = q / 8, kb = q % 8;
            transpose_item(w_br + (size_t)n * 512 * DM, DM, cb * 32, kb * 64, 1536, Wb, cb * 32, scr, lane, n * 512 + kb * 64); continue; } r -= I5;
        { const int cb = r / 32, kb = r % 32; transpose_item(w_out, DM, cb * 32, kb * 64, DM, Wout, cb * 32, scr, lane); }
    }
    for (int i = gw * 64 + lane; i < 224 * 256; i += ngw * 64) { ((u32x4*)(Wcat + (size_t)DIN * DM))[i] = (u32x4){0u, 0u, 0u, 0u}; }
    bf16* sg = (bf16*)(wl + WO_SGU); const float* sw = p.in[13] + (size_t)l * 4 * 128 * 128;
    for (int i = gw * 64 + lane; i < 4 * 128 * 128; i += ngw * 64) { const int s = i & 127, t = (i >> 7) & 127; const bool ok = (s >> 6) <= (t >> 6); sg[i] = (bf16)f2bf(ok ? sw[i] : 0.f); }
}

__device__ __forceinline__ void prologue_rope(const Params& p, int gtid, int nthr) {
    float* tab = (float*)(p.ws + WS_ROPE);
    for (int i = gtid; i < SEQ * 24; i += nthr) {
        const int pos = i / 24, j = i % 24;
        const int jj = j < 8 ? 2 * j : j - 8;
        float invf;
        switch (jj) { case 0: invf = 1.000000000e+00f; break; case 1: invf = 4.403665960e-01f; break; case 2: invf = 1.939227432e-01f; break; case 3: invf = 8.539710194e-02f; break;
            case 4: invf = 3.760603070e-02f; break; case 5: invf = 1.656044088e-02f; break; case 6: invf = 7.292664610e-03f; break; case 7: invf = 3.211446106e-03f; break;
            case 8: invf = 1.414213562e-03f; break; case 9: invf = 6.227724371e-04f; break; case 10: invf = 2.742481884e-04f; break; case 11: invf = 1.207697351e-04f; break;
            case 12: invf = 5.318295734e-05f; break; case 13: invf = 2.341999971e-05f; break; case 14: invf = 1.031338525e-05f; break; default: invf = 4.541670478e-06f; break; }
        int co, so; if (j < 8) { co = j; so = 8 + j; } else { co = 16 + (j - 8); so = 32 + (j - 8); }
        const float ang = (float)pos * invf; float sn, cs; sincosf(ang, &sn, &cs);
        tab[pos * 48 + co] = cs; tab[pos * 48 + so] = sn;
    }
}

__device__ __forceinline__ void fold_item(const Params& p, int l, int item, float* lds, int tid) {
    const int hc = item >> 4, mt = item & 15, c = hc & 1, m0 = mt * 128;
    const float* Wq = p.in[20] + (size_t)l * DM * DM; const float* keys = p.in[21] + (size_t)l * 2 * 128 * 128 + (size_t)c * 128 * 128;
    bf16* WPQ = (bf16*)(p.ws + WS_W + (size_t)l * W_LAYER + WO_PQ);
    float* As = lds; float* Bs = lds + 128 * 68;
    const int tn = tid & 31, tm = tid >> 5;
    float acc[4][8];
#pragma unroll
    for (int i = 0; i < 4; ++i)
#pragma unroll
        for (int j = 0; j < 8; ++j) acc[i][j] = 0.f;
    for (int dh = 0; dh < 2; ++dh) {
        __syncthreads();
        for (int i = tid; i < 128 * 16; i += 512) { const int r = i >> 4, q = i & 15;
            *(f32x4*)(As + r * 68 + 4 * q) = *(const f32x4*)(Wq + (size_t)(m0 + r) * DM + hc * 128 + dh * 64 + 4 * q);
            *(f32x4*)(Bs + r * 68 + 4 * q) = *(const f32x4*)(keys + r * 128 + dh * 64 + 4 * q); }
        __syncthreads();
#pragma unroll 2
        for (int d = 0; d < 64; d += 4) {
            f32x4 b4[4], a4[8];
#pragma unroll
            for (int i = 0; i < 4; ++i) b4[i] = *(const f32x4*)(Bs + (tn + 32 * i) * 68 + d);
#pragma unroll
            for (int j = 0; j < 8; ++j) a4[j] = *(const f32x4*)(As + (8 * tm + j) * 68 + d);
#pragma unroll
            for (int i = 0; i < 4; ++i)
#pragma unroll
                for (int j = 0; j < 8; ++j) acc[i][j] += (b4[i].x * a4[j].x + b4[i].y * a4[j].y) + (b4[i].z * a4[j].z + b4[i].w * a4[j].w);
        }
    }
#pragma unroll
    for (int i = 0; i < 4; ++i) *(u32x4*)(WPQ + (size_t)(hc * 128 + tn + 32 * i) * DM + m0 + 8 * tm) = pack8(acc[i]);
}

__device__ __forceinline__ void rms_row_to_bf16(const float* xrow, const float* gain, bf16* orow, int lane, unsigned char* o8 = nullptr) {
    f32x4 v[8]; float s = 0.f;
#pragma unroll
    for (int j = 0; j < 8; ++j) { v[j] = ((const f32x4*)xrow)[lane + 64 * j]; s += (v[j].x * v[j].x + v[j].y * v[j].y) + (v[j].z * v[j].z + v[j].w * v[j].w); }
    const float rstd = rsqrtf(wave_sum(s) * (1.f / DM) + NORM_EPS);
#pragma unroll
    for (int j = 0; j < 8; ++j) { const f32x4 g = ((const f32x4*)gain)[lane + 64 * j];
        u32x2 o; o.x = pk2(v[j].x * rstd * g.x, v[j].y * rstd * g.y); o.y = pk2(v[j].z * rstd * g.z, v[j].w * rstd * g.w);
        ((u32x2*)orow)[lane + 64 * j] = o;
        if (o8) ((unsigned*)o8)[lane + 64 * j] = pk4_fp8(v[j].x * rstd * g.x, v[j].y * rstd * g.y, v[j].z * rstd * g.z, v[j].w * rstd * g.w); }
}

__device__ __forceinline__ void add_rms_row(const float* xin, const bf16* dl, float* xout, const float* gain, bf16* orow, float* hs, int lane) {
    f32x4 v[8]; float s = 0.f;
#pragma unroll
    for (int j = 0; j < 8; ++j) { v[j] = ((const f32x4*)xin)[lane + 64 * j]; const u32x2 d = ((const u32x2*)dl)[lane + 64 * j];
        v[j].x += bflo(d.x); v[j].y += bfhi(d.x); v[j].z += bflo(d.y); v[j].w += bfhi(d.y);
        if (xout) ((f32x4*)xout)[lane + 64 * j] = v[j];
        s += (v[j].x * v[j].x + v[j].y * v[j].y) + (v[j].z * v[j].z + v[j].w * v[j].w); }
    const float rstd = rsqrtf(wave_sum(s) * (1.f / DM) + NORM_EPS);
    float mx = 0.f;
#pragma unroll
    for (int j = 0; j < 8; ++j) { const f32x4 g = ((const f32x4*)gain)[lane + 64 * j];
        u32x2 o; o.x = pk2(v[j].x * rstd * g.x, v[j].y * rstd * g.y); o.y = pk2(v[j].z * rstd * g.z, v[j].w * rstd * g.w);
        ((u32x2*)orow)[lane + 64 * j] = o;
        v[j].x = bflo(o.x); v[j].y = bfhi(o.x); v[j].z = bflo(o.y); v[j].w = bfhi(o.y);
        mx = fmaxf(mx, fmaxf(fmaxf(fabsf(v[j].x), fabsf(v[j].y)), fmaxf(fabsf(v[j].z), fabsf(v[j].w)))); }
#pragma unroll
    for (int of = 1; of < 64; of <<= 1) mx = fmaxf(mx, __shfl_xor(mx, of));
    const float hscale = fmaxf(mx, 1e-30f) * (1.f / 127.f), ih = 1.f / hscale; int isum = 0;
#pragma unroll
    for (int j = 0; j < 8; ++j) isum += ((int)rintf(v[j].x * ih) + (int)rintf(v[j].y * ih)) + ((int)rintf(v[j].z * ih) + (int)rintf(v[j].w * ih));
    const float h8sum = wave_sum((float)isum);
    if (lane == 0) { hs[0] = hscale; hs[1] = h8sum; }
}

__device__ __forceinline__ void prep1_row(const Params& p, int l, int t, int lane) {
    bf16* z = (bf16*)(p.ws + WS_Z) + (size_t)t * ZP;
    const float* rope = (const float*)(p.ws + WS_ROPE) + (size_t)(t & (SEQ - 1)) * 48;
    float f[8];
#pragma unroll
    for (int seg = 0; seg < 2; ++seg) {
        const float* g = (seg == 0 ? p.in[3] : p.in[4]) + (size_t)l * 512;
        u32x4* ptr = (u32x4*)(z + (seg == 0 ? ZC_CQ : ZC_CKV)) + lane;
        unpack8(*ptr, f); float s = 0.f;
#pragma unroll
        for (int i = 0; i < 8; ++i) s += f[i] * f[i];
        const float rstd = rsqrtf(wave_sum(s) * (1.f / 512.f) + NORM_EPS);
#pragma unroll
        for (int i = 0; i < 8; ++i) f[i] = f[i] * rstd * g[lane * 8 + i];
        *ptr = pack8(f);
    }
#pragma unroll
    for (int seg = 0; seg < 2; ++seg) {
        const float* g = p.in[9] + (size_t)l * 128 + seg * 64;
        u32x4* ptr = (u32x4*)(z + (seg == 0 ? ZC_DQ : ZC_DK)) + lane;
        unpack8(*ptr, f); float s = 0.f;
#pragma unroll
        for (int i = 0; i < 8; ++i) s += f[i] * f[i];
        s += __shfl_xor(s, 1); s += __shfl_xor(s, 2); s += __shfl_xor(s, 4);
        const float rstd = rsqrtf(s * (1.f / 64.f) + NORM_EPS);
        const int d0 = (lane & 7) * 8;
#pragma unroll
        for (int i = 0; i < 8; ++i) f[i] = f[i] * rstd * g[d0 + i];
        float o[8];
#pragma unroll
        for (int i = 0; i < 8; ++i) o[i] = __shfl_xor(f[i], 1);
        if ((lane & 7) == 0) {
#pragma unroll
            for (int i = 0; i < 8; ++i) f[i] = f[i] * rope[i] - o[i] * rope[8 + i];
        } else if ((lane & 7) == 1) {
#pragma unroll
            for (int i = 0; i < 8; ++i) f[i] = f[i] * rope[i] + o[i] * rope[8 + i];
        }
        if (seg == 0) {
#pragma unroll
            for (int i = 0; i < 8; ++i) f[i] *= 0.125f * LOG2E;
        }
        *ptr = pack8(f);
    }
    {
        u32x4* ptr = (u32x4*)(z + ZC_SU) + lane;
        unpack8(*ptr, f);
#pragma unroll
        for (int i = 0; i < 8; ++i) f[i] = gelu_tanh(f[i]);
        *ptr = pack8(f);
    }
    {
        const float* g = p.in[12] + (size_t)l * 512;
        u32x4* ptr = (u32x4*)(z + ZC_SV) + lane;
        unpack8(*ptr, f); float s = 0.f;
#pragma unroll
        for (int i = 0; i < 8; ++i) { f[i] = gelu_tanh(f[i]); s += f[i] * f[i]; }
        const float rstd = rsqrtf(wave_sum(s) * (1.f / 512.f) + NORM_EPS);
#pragma unroll
        for (int i = 0; i < 8; ++i) f[i] = f[i] * rstd * g[lane * 8 + i];
        *ptr = pack8(f);
    }
    {
        const float* g = p.in[8] + (size_t)l * 64 + 32;
        const int ll = lane & 3;
        const u32x4 w = *((const u32x4*)(z + ZC_KR) + ll);
        unpack8(w, f); float s = 0.f;
#pragma unroll
        for (int i = 0; i < 8; ++i) s += f[i] * f[i];
        s += __shfl_xor(s, 1); s += __shfl_xor(s, 2);
        const float rstd = rsqrtf(s * (1.f / 32.f) + NORM_EPS);
#pragma unroll
        for (int i = 0; i < 8; ++i) f[i] = f[i] * rstd * g[ll * 8 + i];
        float o[8];
#pragma unroll
        for (int i = 0; i < 8; ++i) o[i] = __shfl_xor(f[i], 2);
        const int fi = (ll & 1) * 8;
        if (ll < 2) {
#pragma unroll
            for (int i = 0; i < 8; ++i) f[i] = f[i] * rope[16 + fi + i] - o[i] * rope[32 + fi + i];
        } else {
#pragma unroll
            for (int i = 0; i < 8; ++i) f[i] = f[i] * rope[16 + fi + i] + o[i] * rope[32 + fi + i];
        }
        if (lane < 32) { bf16* km = (bf16*)(p.ws + WS_KM) + (size_t)t * 768 + (lane >> 2) * 96 + 64 + ll * 8; *(u32x4*)km = pack8(f); }
    }
}

__device__ __forceinline__ void prep2_row(const Params& p, int l, int t, int lane) {
    const bf16* qr = (const bf16*)(p.ws + WS_QR) + (size_t)t * 768;
    const bf16* kvr = (const bf16*)(p.ws + WS_KVR) + (size_t)t * 1024;
    bf16* qm = (bf16*)(p.ws + WS_QM) + (size_t)t * 768;
    bf16* km = (bf16*)(p.ws + WS_KM) + (size_t)t * 768;
    const float* rope = (const float*)(p.ws + WS_ROPE) + (size_t)(t & (SEQ - 1)) * 48;
    const float* ng = p.in[7] + (size_t)l * 128;
    const float* rg = p.in[8] + (size_t)l * 64;
    const float qscale = 0.10206207261596577f * LOG2E;
    float f[8];
    const int h = lane >> 3, d0 = (lane & 7) * 8;
    {
        unpack8(*((const u32x4*)qr + lane), f); float s = 0.f;
#pragma unroll
        for (int i = 0; i < 8; ++i) s += f[i] * f[i];
        s += __shfl_xor(s, 1); s += __shfl_xor(s, 2); s += __shfl_xor(s, 4);
        const float rstd = rsqrtf(s * (1.f / 64.f) + NORM_EPS) * qscale;
#pragma unroll
        for (int i = 0; i < 8; ++i) f[i] = f[i] * rstd * ng[d0 + i];
        *(u32x4*)(qm + h * 96 + d0) = pack8(f);
    }
    {
        unpack8(*((const u32x4*)kvr + lane), f); float s = 0.f;
#pragma unroll
        for (int i = 0; i < 8; ++i) s += f[i] * f[i];
        s += __shfl_xor(s, 1); s += __shfl_xor(s, 2); s += __shfl_xor(s, 4);
        const float rstd = rsqrtf(s * (1.f / 64.f) + NORM_EPS);
#pragma unroll
        for (int i = 0; i < 8; ++i) f[i] = f[i] * rstd * ng[64 + d0 + i];
        *(u32x4*)(km + h * 96 + d0) = pack8(f);
    }
    {
        const int l5 = lane & 31, hh = l5 >> 2, ll = l5 & 3;
        unpack8(*((const u32x4*)(qr + 512) + l5), f); float s = 0.f;
#pragma unroll
        for (int i = 0; i < 8; ++i) s += f[i] * f[i];
        s += __shfl_xor(s, 1); s += __shfl_xor(s, 2);
        const float rstd = rsqrtf(s * (1.f / 32.f) + NORM_EPS);
#pragma unroll
        for (int i = 0; i < 8; ++i) f[i] = f[i] * rstd * rg[ll * 8 + i];
        float o[8];
#pragma unroll
        for (int i = 0; i < 8; ++i) o[i] = __shfl_xor(f[i], 2);
        const int fi = (ll & 1) * 8;
        if (ll < 2) {
#pragma unroll
            for (int i = 0; i < 8; ++i) f[i] = (f[i] * rope[16 + fi + i] - o[i] * rope[32 + fi + i]) * qscale;
        } else {
#pragma unroll
            for (int i = 0; i < 8; ++i) f[i] = (f[i] * rope[16 + fi + i] + o[i] * rope[32 + fi + i]) * qscale;
        }
        if (lane < 32) *(u32x4*)(qm + hh * 96 + 64 + ll * 8) = pack8(f);
    }
}

__device__ __forceinline__ float diff_lambda(const Params& p, int l, int lane) {
    const float* lv = p.in[10] + (size_t)l * 256;
    const float a = wave_sum(lv[lane] * lv[64 + lane]), b = wave_sum(lv[128 + lane] * lv[192 + lane]);
    const float lambda_init = 0.8f - 0.6f * expf(-0.3f * (float)l);
    return expf(a) - expf(b) + lambda_init;
}

typedef float f32x2 __attribute__((ext_vector_type(2)));
typedef _Float16 f16x32 __attribute__((ext_vector_type(32)));
typedef float f32x32 __attribute__((ext_vector_type(32)));
typedef unsigned u32x6 __attribute__((ext_vector_type(6)));
__device__ __forceinline__ void q4_row(const float* __restrict__ src, unsigned char* __restrict__ dst, float* scl, int lane) {
    f32x4 v[8]; float ss = 0.f;
#pragma unroll
    for (int j = 0; j < 8; ++j) { v[j] = *(const f32x4*)(src + 256 * (lane >> 3) + 32 * j + 4 * (lane & 7)); ss += (v[j].x * v[j].x + v[j].y * v[j].y) + (v[j].z * v[j].z + v[j].w * v[j].w); }
    const float sc = fmaxf(0.5f * sqrtf(wave_sum(ss) * (1.f / DM)), 1e-30f), is = 1.f / sc;
    u32x4 w;
#pragma unroll
    for (int d = 0; d < 4; ++d) { unsigned x = 0;
        const f32x4 a = v[2 * d], b = v[2 * d + 1];
        x = __builtin_amdgcn_cvt_scalef32_pk_fp4_f32(x, fminf(fmaxf(a.x * is, -6.f), 6.f), fminf(fmaxf(a.y * is, -6.f), 6.f), 1.0f, 0);
        x = __builtin_amdgcn_cvt_scalef32_pk_fp4_f32(x, fminf(fmaxf(a.z * is, -6.f), 6.f), fminf(fmaxf(a.w * is, -6.f), 6.f), 1.0f, 1);
        x = __builtin_amdgcn_cvt_scalef32_pk_fp4_f32(x, fminf(fmaxf(b.x * is, -6.f), 6.f), fminf(fmaxf(b.y * is, -6.f), 6.f), 1.0f, 2);
        x = __builtin_amdgcn_cvt_scalef32_pk_fp4_f32(x, fminf(fmaxf(b.z * is, -6.f), 6.f), fminf(fmaxf(b.w * is, -6.f), 6.f), 1.0f, 3);
        w[d] = x; }
    *(u32x4*)(dst + (size_t)(lane >> 3) * (NEXP * 128) + 16 * (lane & 7)) = w;
    if (lane == 0) *scl = sc;
}
__device__ __forceinline__ void q4u_row(const float* __restrict__ src, unsigned char* __restrict__ dst, float* scl, int lane) {
    f32x4 v[8]; float ss = 0.f;
#pragma unroll
    for (int j = 0; j < 8; ++j) { v[j] = *(const f32x4*)(src + 256 * (lane >> 3) + 32 * j + 4 * (lane & 7)); ss += (v[j].x * v[j].x + v[j].y * v[j].y) + (v[j].z * v[j].z + v[j].w * v[j].w); }
    const float step = fmaxf(0.35f * sqrtf(wave_sum(ss) * (1.f / DM)), 1e-30f), is = 1.f / step;
    u32x4 w;
#pragma unroll
    for (int d = 0; d < 4; ++d) { unsigned x = 0;
#pragma unroll
        for (int e = 0; e < 8; ++e) { const float f = v[2 * d + (e >> 2)][e & 3]; const int q = (int)fminf(fmaxf(rintf(f * is), -8.f), 7.f) + 8; x |= (unsigned)q << (4 * e); }
        w[d] = x; }
    *(u32x4*)(dst + (size_t)(lane >> 3) * (NEXP * 128) + 16 * (lane & 7)) = w;
    if (lane == 0) *scl = step;
}
__device__ __forceinline__ int f2key(float f) { const int b = __builtin_bit_cast(int, f); return b ^ ((b >> 31) & 0x7fffffff); }
__device__ __forceinline__ float key2f(int k) { const int b = k ^ ((k >> 31) & 0x7fffffff); return __builtin_bit_cast(float, b & ~127); }
__device__ __forceinline__ void topk_lane(const float* __restrict__ sc, int (&idxo)[16], float (&gwo)[16]) {
    float av[2][16]; int ai[2][16];
#pragma unroll
    for (int c = 0; c < 2; ++c) {
        int lst[16];
#pragma unroll
        for (int j = 0; j < 16; ++j) lst[j] = (int)0x80000000;
#pragma unroll 1
        for (int i0 = 0; i0 < 128; i0 += 32) {
            f32x4 v[8];
#pragma unroll
            for (int q = 0; q < 8; ++q) v[q] = *(const f32x4*)(sc + c * 128 + i0 + 4 * q);
#pragma unroll
            for (int q = 0; q < 8; ++q)
#pragma unroll
                for (int e = 0; e < 4; ++e) { int key = (f2key(v[q][e]) & ~127) | (127 - (i0 + 4 * q + e));
#pragma unroll
                    for (int j = 0; j < 16; ++j) { const int hi = max(lst[j], key); key = min(lst[j], key); lst[j] = hi; } }
        }
#pragma unroll
        for (int j = 0; j < 16; ++j) { av[c][j] = key2f(lst[j]); ai[c][j] = 127 - (lst[j] & 127); }
    }
    float lv[16]; int lp[16];
#pragma unroll
    for (int j = 0; j < 16; ++j) { lv[j] = -INFINITY; lp[j] = 0; }
#pragma unroll
    for (int i = 0; i < 16; ++i)
#pragma unroll
        for (int jj = 0; jj < 16; ++jj) if ((i + 1) * (jj + 1) <= 16) {
            float sv = av[0][i] + av[1][jj]; int pay = ai[0][i] * 128 + ai[1][jj];
#pragma unroll
            for (int j = 0; j < 16; ++j) { const bool gt = sv > lv[j]; const float nv = gt ? sv : lv[j]; const int np = gt ? pay : lp[j]; sv = gt ? lv[j] : sv; pay = gt ? lp[j] : pay; lv[j] = nv; lp[j] = np; }
        }
    float sum = 0.f; const float mx = lv[0];
#pragma unroll
    for (int j = 0; j < 16; ++j) { lv[j] = __expf(lv[j] - mx); sum += lv[j]; }
    const float inv = 1.f / sum;
#pragma unroll
    for (int j = 0; j < 16; ++j) { idxo[j] = lp[j]; gwo[j] = lv[j] * inv; }
}
__device__ __forceinline__ float dot_f4(const u32x4 a, const f32x2 (&h)[16]) {
    f32x2 s = {0.f, 0.f};
#pragma unroll
    for (int w = 0; w < 4; ++w) {
        s = __builtin_elementwise_fma(__builtin_amdgcn_cvt_scalef32_pk_f32_fp4(a[w], 1.0f, 0), h[4 * w], s); s = __builtin_elementwise_fma(__builtin_amdgcn_cvt_scalef32_pk_f32_fp4(a[w], 1.0f, 1), h[4 * w + 1], s);
        s = __builtin_elementwise_fma(__builtin_amdgcn_cvt_scalef32_pk_f32_fp4(a[w], 1.0f, 2), h[4 * w + 2], s); s = __builtin_elementwise_fma(__builtin_amdgcn_cvt_scalef32_pk_f32_fp4(a[w], 1.0f, 3), h[4 * w + 3], s); }
    return s.x + s.y;
}
__device__ __forceinline__ int dot_u4i(const u32x4 a, const int (&he)[4], const int (&ho)[4]) {
    int acc = 0;
#pragma unroll
    for (int w = 0; w < 4; ++w) { acc = __builtin_amdgcn_sdot4((int)(a[w] & 0x0F0F0F0Fu), he[w], acc, false); acc = __builtin_amdgcn_sdot4((int)((a[w] >> 4) & 0x0F0F0F0Fu), ho[w], acc, false); }
    return acc;
}
typedef _Float16 h16x2 __attribute__((ext_vector_type(2)));
__device__ __forceinline__ void axpy_h4(const u32x4 a, unsigned c2bits, h16x2 (&o)[16]) {
    const h16x2 c2 = __builtin_bit_cast(h16x2, c2bits);
#pragma unroll
    for (int w = 0; w < 4; ++w) {
#pragma unroll
        for (int b = 0; b < 4; ++b) { const h16x2 v = b == 0 ? __builtin_bit_cast(h16x2, __builtin_amdgcn_cvt_scalef32_pk_f16_fp4(a[w], 1.0f, 0)) : b == 1 ? __builtin_bit_cast(h16x2, __builtin_amdgcn_cvt_scalef32_pk_f16_fp4(a[w], 1.0f, 1))
                                                     : b == 2 ? __builtin_bit_cast(h16x2, __builtin_amdgcn_cvt_scalef32_pk_f16_fp4(a[w], 1.0f, 2)) : __builtin_bit_cast(h16x2, __builtin_amdgcn_cvt_scalef32_pk_f16_fp4(a[w], 1.0f, 3));
            o[4 * w + b] = __builtin_elementwise_fma(c2, v, o[4 * w + b]); } }
}
__device__ __forceinline__ int grp8_sum(int x) {
    x += __builtin_amdgcn_update_dpp(0, x, 0xB1, 0xF, 0xF, true);
    x += __builtin_amdgcn_update_dpp(0, x, 0x4E, 0xF, 0xF, true);
    x += __builtin_amdgcn_update_dpp(0, x, 0x141, 0xF, 0xF, true);
    return x;
}
__device__ __forceinline__ float grp8_sumf(float x) {
    x += __builtin_bit_cast(float, __builtin_amdgcn_update_dpp(0, __builtin_bit_cast(int, x), 0xB1, 0xF, 0xF, true));
    x += __builtin_bit_cast(float, __builtin_amdgcn_update_dpp(0, __builtin_bit_cast(int, x), 0x4E, 0xF, 0xF, true));
    x += __builtin_bit_cast(float, __builtin_amdgcn_update_dpp(0, __builtin_bit_cast(int, x), 0x141, 0xF, 0xF, true));
    return x;
}
constexpr int PEER_LDS_WAVE = 12288;
template <int MODE = 0> __device__ __forceinline__ void peer_octets(const Params& p, int l, int gw, int ngw, int lane, const float* gain_next, const float* xin, float* xout, LAS unsigned char* wl) {
    const __amdgpu_buffer_rsrc_t RU = __builtin_amdgcn_make_buffer_rsrc((void*)(p.ws + WS_U8 + (size_t)l * NEXP * QROW), 0, NEXP * QROW, 0x00020000);
    const __amdgpu_buffer_rsrc_t RV = __builtin_amdgcn_make_buffer_rsrc((void*)(p.ws + WS_V8 + (size_t)l * NEXP * QROW), 0, NEXP * QROW, 0x00020000);
    const float* PSU = (const float*)(p.ws + WS_PS) + (size_t)l * NEXP; const float* PSV = PSU + (size_t)DEPTH * NEXP;
    const int tl = lane >> 3, c = lane & 7, c16 = 16 * c;
    LAS u32x4* pr4 = (LAS u32x4*)(wl + tl * 1024);
    LAS int* acc = (LAS int*)(wl + 8192 + tl * 512);
    for (int oc = gw; oc < T / 8; oc += ngw) {
        const int t = 8 * oc + tl;
        const bf16* hb = (const bf16*)(p.ws + WS_HB) + (size_t)t * DM + 4 * c;
        int myidx[16]; float mygw[16], mysu[16], mysv[16];
        topk_lane((const float*)(p.ws + WS_SC) + ((size_t)t * 8 + c) * 256, myidx, mygw);
#pragma unroll
        for (int i = 0; i < 16; ++i) { mysu[i] = PSU[myidx[i]]; mysv[i] = PSV[myidx[i]]; }
#pragma unroll
        for (int i = 0; i < 8; ++i) { pr4[8 * c + i] = (u32x4){(unsigned)myidx[2 * i] * 128u, 0u, (unsigned)myidx[2 * i + 1] * 128u, 0u}; }
#pragma unroll
        for (int i = 0; i < 4; ++i) *(LAS u32x4*)(acc + 16 * c + 4 * i) = (u32x4){0u, 0u, 0u, 0u};
        const f32x2 hs = *(const f32x2*)((const float*)(p.ws + WS_HS) + 2 * (size_t)t);
        const float hscale = hs.x, h8sum = hs.y, ih = 1.f / hscale;
        u32x4 bufA[8], bufB[8]; unsigned cfA[8], cfB[8];
#define PEER_ISSUE(buf, cf, R, b) do { const int j_ = (b) & 15; const int so_ = ((b) >> 4) * (NEXP * 128); \
            const u32x4 q0_ = pr4[4 * j_], q1_ = pr4[4 * j_ + 1], q2_ = pr4[4 * j_ + 2], q3_ = pr4[4 * j_ + 3]; \
            cf[0] = q0_.y; cf[1] = q0_.w; cf[2] = q1_.y; cf[3] = q1_.w; cf[4] = q2_.y; cf[5] = q2_.w; cf[6] = q3_.y; cf[7] = q3_.w; \
            buf[0] = __builtin_amdgcn_raw_buffer_load_b128(R, (int)q0_.x + c16, so_, 0); buf[1] = __builtin_amdgcn_raw_buffer_load_b128(R, (int)q0_.z + c16, so_, 0); \
            buf[2] = __builtin_amdgcn_raw_buffer_load_b128(R, (int)q1_.x + c16, so_, 0); buf[3] = __builtin_amdgcn_raw_buffer_load_b128(R, (int)q1_.z + c16, so_, 0); \
            buf[4] = __builtin_amdgcn_raw_buffer_load_b128(R, (int)q2_.x + c16, so_, 0); buf[5] = __builtin_amdgcn_raw_buffer_load_b128(R, (int)q2_.z + c16, so_, 0); \
            buf[6] = __builtin_amdgcn_raw_buffer_load_b128(R, (int)q3_.x + c16, so_, 0); buf[7] = __builtin_amdgcn_raw_buffer_load_b128(R, (int)q3_.z + c16, so_, 0); } while (0)
        int he[4], ho[4];
#define PEER_HLOAD(sl) do { float hf_[32]; \
            _Pragma("unroll") for (int q = 0; q < 8; ++q) { const u32x2 w_ = *(const u32x2*)(hb + 256 * (sl) + 32 * q); hf_[4 * q] = bflo(w_.x); hf_[4 * q + 1] = bfhi(w_.x); hf_[4 * q + 2] = bflo(w_.y); hf_[4 * q + 3] = bfhi(w_.y); } \
            _Pragma("unroll") for (int w = 0; w < 4; ++w) { unsigned e_ = 0, od_ = 0; \
                _Pragma("unroll") for (int j = 0; j < 4; ++j) { const int qe = (int)rintf(hf_[8 * w + 2 * j] * ih), qo = (int)rintf(hf_[8 * w + 2 * j + 1] * ih); e_ |= (unsigned)(qe & 255) << (8 * j); od_ |= (unsigned)(qo & 255) << (8 * j); } \
                he[w] = (int)e_; ho[w] = (int)od_; } } while (0)
#define PEER_CONSUME_U(buf, b) do { int mine_ = 0; \
            _Pragma("unroll") for (int i = 0; i < 8; ++i) { const int tot_ = grp8_sum(dot_u4i(buf[i], he, ho)); mine_ = (c == i) ? tot_ : mine_; } \
            __hip_atomic_fetch_add(acc + 8 * ((b) & 15) + c, mine_, __ATOMIC_RELAXED, __HIP_MEMORY_SCOPE_WAVEFRONT); } while (0)
        if (!(MODE & 1)) {
        PEER_ISSUE(bufA, cfA, RU, 0);
#pragma unroll 1
        for (int b = 0; b < 128; b += 2) {
            if ((b & 15) == 0) PEER_HLOAD(b >> 4);
            PEER_ISSUE(bufB, cfB, RU, b + 1);
            __builtin_amdgcn_sched_barrier(0);
            PEER_CONSUME_U(bufA, b);
            __builtin_amdgcn_sched_barrier(0);
            if (b + 2 < 128) PEER_ISSUE(bufA, cfA, RU, b + 2);
            __builtin_amdgcn_sched_barrier(0);
            PEER_CONSUME_U(bufB, b + 1);
            __builtin_amdgcn_sched_barrier(0);
        }
        }
#pragma unroll
        for (int i = 0; i < 16; ++i) { const float a = ((float)acc[16 * c + i] - 8.f * h8sum) * mysu[i] * hscale;
            const _Float16 ch = (_Float16)(mygw[i] * gelu_tanh(a) * mysv[i] * 256.f);
            ((LAS unsigned*)pr4)[2 * (16 * c + i) + 1] = __builtin_bit_cast(unsigned, (h16x2){ch, ch}); }
        h16x2 o[16]; f32x4 xr[8]; float ss = 0.f;
#pragma unroll
        for (int i = 0; i < 16; ++i) o[i] = (h16x2){(_Float16)0.f, (_Float16)0.f};
#pragma unroll
        for (int q = 0; q < 8; ++q) xr[q] = (f32x4){0.f, 0.f, 0.f, 0.f};
        const float* xrow = xin + (size_t)t * DM + 4 * c; float* xwrow = xout + (size_t)t * DM + 4 * c;
#define PEER_CONSUME_V(buf, cf) do { _Pragma("unroll") for (int i = 0; i < 8; ++i) axpy_h4(buf[i], cf[i], o); } while (0)
        if (!(MODE & 2)) {
        PEER_ISSUE(bufA, cfA, RV, 0);
#pragma unroll 1
        for (int b = 0; b < 128; b += 2) {
            if ((b & 15) == 12) {
#pragma unroll
                for (int q = 0; q < 8; ++q) xr[q] = *(const f32x4*)(xrow + 256 * (b >> 4) + 32 * q); }
            PEER_ISSUE(bufB, cfB, RV, b + 1);
            __builtin_amdgcn_sched_barrier(0);
            PEER_CONSUME_V(bufA, cfA);
            __builtin_amdgcn_sched_barrier(0);
            if (b + 2 < 128) PEER_ISSUE(bufA, cfA, RV, b + 2);
            __builtin_amdgcn_sched_barrier(0);
            PEER_CONSUME_V(bufB, cfB);
            __builtin_amdgcn_sched_barrier(0);
            if ((b & 15) == 14) {
#pragma unroll
                for (int q = 0; q < 8; ++q) { f32x4 x = xr[q];
                    x.x += (float)o[2 * q].x * (1.f / 256.f); x.y += (float)o[2 * q].y * (1.f / 256.f); x.z += (float)o[2 * q + 1].x * (1.f / 256.f); x.w += (float)o[2 * q + 1].y * (1.f / 256.f);
                    if (!(MODE & 4)) *(f32x4*)(xwrow + 256 * (b >> 4) + 32 * q) = x; ss += (x.x * x.x + x.y * x.y) + (x.z * x.z + x.w * x.w); }
#pragma unroll
                for (int i = 0; i < 16; ++i) o[i] = (h16x2){(_Float16)0.f, (_Float16)0.f};
            }
        }
        }
        if (gain_next) {
            const float rstd = rsqrtf(grp8_sumf(ss) * (1.f / DM) + NORM_EPS);
            bf16* hw = (bf16*)(p.ws + WS_HB) + (size_t)t * DM + 4 * c; unsigned char* h8w = p.ws + WS_HB8 + (size_t)t * DM + 4 * c;
#pragma unroll 1
            for (int sl = 0; sl < 8; ++sl) {
#pragma unroll
                for (int q = 0; q < 8; ++q) { const int e0 = 256 * sl + 32 * q; const f32x4 x = *(const f32x4*)(xwrow + e0); const f32x4 g = *(const f32x4*)(gain_next + e0 + 4 * c);
                    u32x2 w; w.x = pk2(x.x * rstd * g.x, x.y * rstd * g.y); w.y = pk2(x.z * rstd * g.z, x.w * rstd * g.w);
                    *(u32x2*)(hw + e0) = w;
                    *(unsigned*)(h8w + e0) = pk4_fp8(x.x * rstd * g.x, x.y * rstd * g.y, x.z * rstd * g.z, x.w * rstd * g.w); }
            }
        }
    }
#undef PEER_ISSUE
#undef PEER_HLOAD
#undef PEER_CONSUME_U
#undef PEER_CONSUME_V
}

namespace pg8 {
#define PG8_LAS __attribute__((address_space(3)))
typedef int v4i32 __attribute__((ext_vector_type(4)));
typedef int v8i32 __attribute__((ext_vector_type(8)));
constexpr int BM = 256, BK = 64, HALF = 128, HTB = HALF * BK * 2, STAGE_BYTES = 8 * HTB, NXCD = 8, WGM = 8;
__host__ __device__ __forceinline__ int lds_byte(int r, int c) { const int st = (r >> 4) * 2 + (c >> 5), rr = r & 15, cc = c & 31, ob = rr * 64 + cc * 2; return st * 1024 + (ob ^ (((ob >> 9) & 1) << 5)); }
__host__ __device__ __forceinline__ void stage_rc(int b, int& R, int& C) { const int st = b / 1024, sb = b % 1024, swz = sb ^ (((sb >> 9) & 1) << 5); R = (st >> 1) * 16 + swz / 64; C = (st & 1) * 32 + (swz % 64) / 2; }
__host__ __device__ __forceinline__ int perm32(int rho) { const int n = rho >> 4, i = rho & 15; return 8 * (i >> 2) + 4 * n + (i & 3); }
struct Unit { int pm, pn; };
struct StaticOrder {
    int nM, nN, nwg, G, c;
    __host__ __device__ void init(int M, int N, int G_, int c_) { nM = M / BM; nN = N / BM; nwg = nM * nN; G = G_; c = c_; }
    __host__ __device__ bool next(int i, Unit& u) const {
        const long L = (long)i * G + c; if (L >= nwg) return false;
        int wgid = (int)L; { const int q = nwg / NXCD, r = nwg % NXCD, xcd = wgid % NXCD, off = wgid / NXCD; wgid = (xcd < r ? xcd * (q + 1) : r * (q + 1) + (xcd - r) * q) + off; }
        const int nig = WGM * nN, gid = wgid / nig, fm = gid * WGM, gsz = (nM - fm) < WGM ? (nM - fm) : WGM;
        u.pm = fm + ((wgid % nig) % gsz); u.pn = (wgid % nig) / gsz; return true;
    }
};
struct MergedOrder {
    StaticOrder base;
    __host__ __device__ bool next(int i, Unit& u) const { const int tile = i / 3, n = i - 3 * tile; Unit b; if (!base.next(tile, b)) return false; u.pm = n * 64 + b.pm; u.pn = n * 8 + b.pn; return true; }
};
struct ZGOrder {
    StaticOrder sz, sg;
    __host__ __device__ void init(int G, int c) { sz.init(T, ZP, G, c); sg.init(T, DM, G, c); }
    __host__ __device__ bool next(int i, Unit& u) const {
        const int nzu = sz.c < sz.nwg ? (sz.nwg - sz.c + sz.G - 1) / sz.G : 0;
        if (i < nzu) return sz.next(i, u);
        const int j = i - nzu, tile = j / 3, n = j - 3 * tile; Unit b; if (!sg.next(tile, b)) return false; u.pm = b.pm; u.pn = 15 + 8 * n + b.pn; return true; }
};
struct ProbGen { const bf16* A; const bf16* Bt; int lda, ldb, K;
    __device__ __forceinline__ const char* Aptr(const Unit& u) const { return (const char*)(A + (size_t)u.pm * BM * lda); }
    __device__ __forceinline__ const char* Bptr(const Unit& u) const { return (const char*)(Bt + (size_t)u.pn * BM * ldb); } };
struct ProbUp { const bf16* Z; const bf16* Wup; int lda, ldb, K;
    __device__ __forceinline__ const char* Aptr(const Unit& u) const { return (const char*)(Z + (size_t)u.pm * BM * ZP + (u.pn < 3 ? ZC_CQ : ZC_CKV)); }
    __device__ __forceinline__ const char* Bptr(const Unit& u) const { return (const char*)(Wup + (size_t)u.pn * BM * 512); } };

__device__ __forceinline__ unsigned cvt_pk_bf16(float lo, float hi) { unsigned r; asm volatile("v_cvt_pk_bf16_f32 %0, %1, %2" : "=v"(r) : "v"(lo), "v"(hi)); return r; }
struct EpiZG { static constexpr bool PERM = true; static constexpr bool HOOK = false; bf16* Z; bf16* G; const float* bg; int noratio;
    __device__ __forceinline__ void operator()(const f32x4 (&acc)[2][2][4][2], const Unit& u, int wr, int wc, int fr, int fq) const {
        const int row0 = u.pm * BM + wr * 64 + fr; const bool gate = u.pn >= 15;
        const int gi = u.pn - 15, n0_ = gi >> 3; const int n = n0_;  const bool rat = n0_ > 0 && !noratio;
        bf16* base = gate ? G + n * DM : Z; const int ld = gate ? NGATE : ZP; const int colt = gate ? (gi & 7) * BM : u.pn * BM; const int col0 = colt + wc * 32 + 8 * fq;
        f32x4 bv[2][2];
#pragma unroll
        for (int bj = 0; bj < 2; ++bj)
#pragma unroll
            for (int nn = 0; nn < 2; ++nn) bv[bj][nn] = gate ? *(const f32x4*)(bg + n * DM + col0 + bj * HALF + 4 * nn) : (f32x4){0.f, 0.f, 0.f, 0.f};
#pragma unroll
        for (int ai = 0; ai < 2; ++ai) {
            u32x4 pw[4][2];
            if (gate && rat) {
#pragma unroll
                for (int m = 0; m < 4; ++m)
#pragma unroll
                    for (int bj = 0; bj < 2; ++bj) pw[m][bj] = *(const u32x4*)(base + (size_t)(row0 + ai * HALF + m * 16) * ld + col0 + bj * HALF - DM);
                __builtin_amdgcn_sched_barrier(0);
            }
#pragma unroll
            for (int m = 0; m < 4; ++m) { bf16* rowp = base + (size_t)(row0 + ai * HALF + m * 16) * ld + col0;
#pragma unroll
                for (int bj = 0; bj < 2; ++bj) { f32x4 v0 = acc[ai][bj][m][0] + bv[bj][0], v1 = acc[ai][bj][m][1] + bv[bj][1];
                    if (gate) {
#pragma unroll
                        for (int j = 0; j < 4; ++j) { v0[j] = fmaxf(__builtin_amdgcn_rcpf(1.f + __builtin_amdgcn_exp2f(-LOG2E * v0[j])), 1e-6f); v1[j] = fmaxf(__builtin_amdgcn_rcpf(1.f + __builtin_amdgcn_exp2f(-LOG2E * v1[j])), 1e-6f); }
                        if (rat) { const u32x4 q = pw[m][bj];
                            const float p8[8] = {bflo(q.x), bfhi(q.x), bflo(q.y), bfhi(q.y), bflo(q.z), bfhi(q.z), bflo(q.w), bfhi(q.w)};
                            u32x4 rw; rw.x = cvt_pk_bf16(p8[0] * __builtin_amdgcn_rcpf(v0[0]), p8[1] * __builtin_amdgcn_rcpf(v0[1])); rw.y = cvt_pk_bf16(p8[2] * __builtin_amdgcn_rcpf(v0[2]), p8[3] * __builtin_amdgcn_rcpf(v0[3]));
                            rw.z = cvt_pk_bf16(p8[4] * __builtin_amdgcn_rcpf(v1[0]), p8[5] * __builtin_amdgcn_rcpf(v1[1])); rw.w = cvt_pk_bf16(p8[6] * __builtin_amdgcn_rcpf(v1[2]), p8[7] * __builtin_amdgcn_rcpf(v1[3]));
                            *(u32x4*)(rowp + bj * HALF - DM) = rw; } }
                    u32x4 w; w.x = cvt_pk_bf16(v0[0], v0[1]); w.y = cvt_pk_bf16(v0[2], v0[3]); w.z = cvt_pk_bf16(v1[0], v1[1]); w.w = cvt_pk_bf16(v1[2], v1[3]);
                    *(u32x4*)(rowp + bj * HALF) = w; } }
        }
    } };
struct EpiG8 { static constexpr bool PERM = true; static constexpr bool HOOK = false; bf16* G; const float* bg; const unsigned* gmax;
    __device__ __forceinline__ void operator()(const f32x4 (&acc)[2][2][4][2], const Unit& u, int wr, int wc, int fr, int fq) const {
        const int row0 = u.pm * BM + wr * 64 + fr, col0 = u.pn * BM + wc * 32 + 8 * fq; const int n = u.pn >> 3; const float is = 1.f / gate_scale(gmax + 64 * n);
        f32x4 bv[2][2];
#pragma unroll
        for (int bj = 0; bj < 2; ++bj)
#pragma unroll
            for (int nn = 0; nn < 2; ++nn) bv[bj][nn] = *(const f32x4*)(bg + col0 + bj * HALF + 4 * nn);
#pragma unroll
        for (int ai = 0; ai < 2; ++ai)
#pragma unroll
            for (int m = 0; m < 4; ++m) { bf16* rowp = G + (size_t)(row0 + ai * HALF + m * 16) * NGATE + col0;
#pragma unroll
                for (int bj = 0; bj < 2; ++bj) { f32x4 v0 = acc[ai][bj][m][0] * is + bv[bj][0], v1 = acc[ai][bj][m][1] * is + bv[bj][1];
#pragma unroll
                    for (int j = 0; j < 4; ++j) { v0[j] = fmaxf(__builtin_amdgcn_rcpf(1.f + __builtin_amdgcn_exp2f(-LOG2E * v0[j])), 1e-6f); v1[j] = fmaxf(__builtin_amdgcn_rcpf(1.f + __builtin_amdgcn_exp2f(-LOG2E * v1[j])), 1e-6f); }
                    u32x4 w; w.x = cvt_pk_bf16(v0[0], v0[1]); w.y = cvt_pk_bf16(v0[2], v0[3]); w.z = cvt_pk_bf16(v1[0], v1[1]); w.w = cvt_pk_bf16(v1[2], v1[3]);
                    *(u32x4*)(rowp + bj * HALF) = w; } }
    } };
struct EpiUp { static constexpr bool HOOK = false; static constexpr bool PERM = true; bf16* QR; bf16* KVR;
    __device__ __forceinline__ void operator()(const f32x4 (&acc)[2][2][4][2], const Unit& u, int wr, int wc, int fr, int fq) const {
        const int row0 = u.pm * BM + wr * 64 + fr; const bool kv = u.pn >= 3;
        bf16* base = kv ? KVR : QR; const int ld = kv ? 1024 : 768; const int col0 = (kv ? (u.pn - 3) : u.pn) * BM + wc * 32 + 8 * fq;
#pragma unroll
        for (int ai = 0; ai < 2; ++ai)
#pragma unroll
            for (int m = 0; m < 4; ++m) { bf16* rowp = base + (size_t)(row0 + ai * HALF + m * 16) * ld + col0;
#pragma unroll
                for (int bj = 0; bj < 2; ++bj) { const f32x4 v0 = acc[ai][bj][m][0], v1 = acc[ai][bj][m][1];
                    u32x4 w; w.x = cvt_pk_bf16(v0[0], v0[1]); w.y = cvt_pk_bf16(v0[2], v0[3]); w.z = cvt_pk_bf16(v1[0], v1[1]); w.w = cvt_pk_bf16(v1[2], v1[3]);
                    *(u32x4*)(rowp + bj * HALF) = w; } }
    } };
struct EpiMG { static constexpr bool PERM = true; static constexpr bool HOOK = true; bf16* MG; const bf16* R; int nohook;
    template <bool RATIO> __device__ __forceinline__ void scale(f32x4 (&acc)[2][2][4][2], const Unit& u, int wr, int wc, int fr, int fq, int slot) const {
        const __amdgpu_buffer_rsrc_t rs = __builtin_amdgcn_make_buffer_rsrc((void*)R, 0, (int)((size_t)T * NGATE * 2), 0x00020000);
        const int voff = ((u.pm * BM + wr * 64 + fr) * NGATE + slot * DM + u.pn * BM + wc * 32 + 8 * fq) * 2;
#pragma unroll
        for (int ai = 0; ai < 2; ++ai) {
            u32x4 ga[4][2], gb[4][2];
#pragma unroll
            for (int m = 0; m < 4; ++m)
#pragma unroll
                for (int bj = 0; bj < 2; ++bj) { ga[m][bj] = __builtin_amdgcn_raw_buffer_load_b128(rs, voff, ((ai * HALF + m * 16) * NGATE + bj * HALF) * 2, 0);
                    if (RATIO) gb[m][bj] = __builtin_amdgcn_raw_buffer_load_b128(rs, voff, ((ai * HALF + m * 16) * NGATE + DM + bj * HALF) * 2, 0); }
            __builtin_amdgcn_sched_barrier(0);
#pragma unroll
            for (int m = 0; m < 4; ++m)
#pragma unroll
                for (int bj = 0; bj < 2; ++bj) { const u32x4 a = ga[m][bj];
                    float f[8] = {bflo(a.x), bfhi(a.x), bflo(a.y), bfhi(a.y), bflo(a.z), bfhi(a.z), bflo(a.w), bfhi(a.w)};
                    if (RATIO) { const u32x4 b = gb[m][bj]; const float d[8] = {bflo(b.x), bfhi(b.x), bflo(b.y), bfhi(b.y), bflo(b.z), bfhi(b.z), bflo(b.w), bfhi(b.w)};
#pragma unroll
                        for (int j = 0; j < 8; ++j) f[j] *= __builtin_amdgcn_rcpf(d[j]); }
                    acc[ai][bj][m][0][0] *= f[0]; acc[ai][bj][m][0][1] *= f[1]; acc[ai][bj][m][0][2] *= f[2]; acc[ai][bj][m][0][3] *= f[3];
                    acc[ai][bj][m][1][0] *= f[4]; acc[ai][bj][m][1][1] *= f[5]; acc[ai][bj][m][1][2] *= f[6]; acc[ai][bj][m][1][3] *= f[7]; }
            __builtin_amdgcn_sched_barrier(0);
        }
    }
    __device__ __forceinline__ void hook(f32x4 (&acc)[2][2][4][2], const Unit& u, int wr, int wc, int fr, int fq, int seg) const { if (!nohook) scale<true>(acc, u, wr, wc, fr, fq, seg - 1); }
    __device__ __forceinline__ void operator()(f32x4 (&acc)[2][2][4][2], const Unit& u, int wr, int wc, int fr, int fq) const {
        scale<false>(acc, u, wr, wc, fr, fq, 2);
        const int row0 = u.pm * BM + wr * 64 + fr, col0 = u.pn * BM + wc * 32 + 8 * fq;
#pragma unroll
        for (int ai = 0; ai < 2; ++ai)
#pragma unroll
            for (int m = 0; m < 4; ++m) { bf16* rowp = MG + (size_t)(row0 + ai * HALF + m * 16) * DM + col0;
#pragma unroll
                for (int bj = 0; bj < 2; ++bj) { const f32x4 v0 = acc[ai][bj][m][0], v1 = acc[ai][bj][m][1];
                    u32x4 w; w.x = cvt_pk_bf16(v0[0], v0[1]); w.y = cvt_pk_bf16(v0[2], v0[3]); w.z = cvt_pk_bf16(v1[0], v1[1]); w.w = cvt_pk_bf16(v1[2], v1[3]);
                    *(u32x4*)(rowp + bj * HALF) = w; } }
    } };
struct EpiOut { static constexpr bool HOOK = false; static constexpr bool PERM = false; const float* Xin; float* X;
    __device__ __forceinline__ void operator()(const f32x4 (&acc)[2][2][4][2], const Unit& u, int wr, int wc, int fr, int fq) const {
        const int row0 = u.pm * BM + wr * 64 + fr, col0 = u.pn * BM + wc * 32 + 4 * fq;
#pragma unroll
        for (int ai = 0; ai < 2; ++ai)
#pragma unroll
            for (int m = 0; m < 4; ++m) { const size_t off = (size_t)(row0 + ai * HALF + m * 16) * DM + col0;
#pragma unroll
                for (int bj = 0; bj < 2; ++bj)
#pragma unroll
                    for (int n = 0; n < 2; ++n) { const f32x4 xi = *(const f32x4*)(Xin + off + bj * HALF + n * 16); *(f32x4*)(X + off + bj * HALF + n * 16) = xi + acc[ai][bj][m][n]; } }
    } };
struct EpiDelta { static constexpr bool HOOK = false; static constexpr bool PERM = true; bf16* D;
    __device__ __forceinline__ void operator()(const f32x4 (&acc)[2][2][4][2], const Unit& u, int wr, int wc, int fr, int fq) const {
        const int row0 = u.pm * BM + wr * 64 + fr, col0 = u.pn * BM + wc * 32 + 8 * fq;
#pragma unroll
        for (int ai = 0; ai < 2; ++ai)
#pragma unroll
            for (int m = 0; m < 4; ++m) { bf16* rowp = D + (size_t)(row0 + ai * HALF + m * 16) * DM + col0;
#pragma unroll
                for (int bj = 0; bj < 2; ++bj) { const f32x4 v0 = acc[ai][bj][m][0], v1 = acc[ai][bj][m][1];
                    u32x4 w; w.x = cvt_pk_bf16(v0[0], v0[1]); w.y = cvt_pk_bf16(v0[2], v0[3]); w.z = cvt_pk_bf16(v1[0], v1[1]); w.w = cvt_pk_bf16(v1[2], v1[3]);
                    *(u32x4*)(rowp + bj * HALF) = w; } }
    } };
struct EpiSC { static constexpr bool HOOK = false; static constexpr bool PERM = false; float* SC;
    __device__ __forceinline__ void operator()(const f32x4 (&acc)[2][2][4][2], const Unit& u, int wr, int wc, int fr, int fq) const {
        const int row0 = u.pm * BM + wr * 64 + fr, col0 = u.pn * BM + wc * 32 + 4 * fq;
#pragma unroll
        for (int ai = 0; ai < 2; ++ai)
#pragma unroll
            for (int m = 0; m < 4; ++m) { const size_t off = (size_t)(row0 + ai * HALF + m * 16) * DM + col0;
#pragma unroll
                for (int bj = 0; bj < 2; ++bj)
#pragma unroll
                    for (int n = 0; n < 2; ++n) *(f32x4*)(SC + off + bj * HALF + n * 16) = acc[ai][bj][m][n]; }
    } };

template <class Epi, class Prob, class Sched, bool ALIGN_EPI = true, bool FP8 = false>
__device__ __forceinline__ void gemm_phase(PG8_LAS unsigned char* lds, const Prob g, const Sched& S, const Epi& E) {
    int tid = threadIdx.x; asm volatile("" : "+v"(tid));
    const int wid = __builtin_amdgcn_readfirstlane(tid >> 6), lane = tid & 63, wr = wid >> 2, wc = wid & 3, fr = lane & 15, fq = lane >> 4;
    const int K = g.K, nt = K / BK;
    unsigned voffA[2], voffB[2];
#pragma unroll
    for (int i = 0; i < 2; ++i) { int R, C; stage_rc(tid * 16 + i * 8192, R, C); const int Rb = Epi::PERM ? ((R & ~31) + perm32(R & 31)) : R;
        voffA[i] = (unsigned)(R * g.lda + C) * 2u; voffB[i] = (unsigned)(Rb * g.ldb + C) * 2u; }
    const size_t kstep = (size_t)(BK * 2);
    const size_t hstepA = (size_t)HALF * g.lda * 2, hstepB = (size_t)HALF * g.ldb * 2;
    const unsigned ldsw = (unsigned)wid * 1024u;
    const int aoff = lds_byte(wr * 64 + fr, fq * 8), boff = lds_byte(wc * 32 + fr, fq * 8);
#define PG8_SA(b, h) (((b) * 2 + (h)) * HTB)
#define PG8_SB(b, h) ((4 + (b) * 2 + (h)) * HTB)
#define PG8_STAGE(bufoff, gbase, voff) do { _Pragma("unroll") for (int _i = 0; _i < 2; ++_i) \
        __builtin_amdgcn_global_load_lds((const unsigned*)((const char*)(gbase) + (voff)[_i]), (PG8_LAS unsigned*)(lds + (bufoff) + ldsw + _i * 8192), 16, 0, 0); } while (0)
#define PG8_CAT8(x0, x1) __builtin_shufflevector(__builtin_bit_cast(v4i32, x0), __builtin_bit_cast(v4i32, x1), 0, 1, 2, 3, 4, 5, 6, 7)
#define PG8_LDA(dst, b, h) do { _Pragma("unroll") for (int m = 0; m < 4; ++m) { const bf16x8 x0 = *(const PG8_LAS bf16x8*)(lds + PG8_SA(b, h) + aoff + m * 2048), x1 = *(const PG8_LAS bf16x8*)(lds + PG8_SA(b, h) + aoff + m * 2048 + 1024); \
        if constexpr (FP8) dst##8[m] = PG8_CAT8(x0, x1); else { dst[m][0] = x0; dst[m][1] = x1; } } } while (0)
#define PG8_LDB(dst, b, h) do { _Pragma("unroll") for (int n = 0; n < 2; ++n) { const bf16x8 x0 = *(const PG8_LAS bf16x8*)(lds + PG8_SB(b, h) + boff + n * 2048), x1 = *(const PG8_LAS bf16x8*)(lds + PG8_SB(b, h) + boff + n * 2048 + 1024); \
        if constexpr (FP8) dst##8[n] = PG8_CAT8(x0, x1); else { dst[n][0] = x0; dst[n][1] = x1; } } } while (0)
#define PG8_MMA(ai, bj, At, Bt) do { __builtin_amdgcn_s_setprio(1); _Pragma("unroll") for (int m = 0; m < 4; ++m) _Pragma("unroll") for (int n = 0; n < 2; ++n) { \
        if constexpr (FP8) asm volatile("v_mfma_f32_16x16x128_f8f6f4 %0, %1, %2, %0" : "+v"(acc[ai][bj][m][n]) : "v"(Bt##8[n]), "v"(At##8[m]));   \
        else { _Pragma("unroll") for (int k = 0; k < 2; ++k) acc[ai][bj][m][n] = __builtin_amdgcn_mfma_f32_16x16x32_bf16(Bt[n][k], At[m][k], acc[ai][bj][m][n], 0, 0, 0); } } \
        if constexpr (FP8) asm volatile("s_nop 7" ::: "memory");   \
        __builtin_amdgcn_s_setprio(0); } while (0)
#define PG8_WAIT_V(n) asm volatile("s_waitcnt vmcnt(" #n ")" ::: "memory")
#define PG8_WAIT_L(n) asm volatile("s_waitcnt lgkmcnt(" #n ")" ::: "memory")
#define PG8_BAR __builtin_amdgcn_s_barrier()
#define PG8_SCHED __builtin_amdgcn_sched_barrier(0)
    Unit cur, nxt; int ui = 0;
    if (!S.next(0, cur)) return;
    f32x4 acc[2][2][4][2];
#pragma unroll
    for (int a = 0; a < 2; ++a)
#pragma unroll
        for (int b = 0; b < 2; ++b)
#pragma unroll
            for (int m = 0; m < 4; ++m)
#pragma unroll
                for (int n = 0; n < 2; ++n) acc[a][b][m][n] = (f32x4){0.f, 0.f, 0.f, 0.f};
    bf16x8 At[4][2], B0[2][2], B1[2][2];
    v8i32 At8[4], B08[2], B18[2];
    const char* cA = g.Aptr(cur); const char* cB = g.Bptr(cur);
    PG8_STAGE(PG8_SB(0, 0), cB, voffB); PG8_STAGE(PG8_SB(0, 1), cB + hstepB, voffB); PG8_STAGE(PG8_SA(0, 0), cA, voffA); PG8_STAGE(PG8_SA(0, 1), cA + hstepA, voffA);
    if (wr == 1) PG8_BAR;
    PG8_WAIT_V(2); PG8_BAR;
    PG8_STAGE(PG8_SB(1, 0), cB + kstep, voffB); PG8_STAGE(PG8_SA(1, 0), cA + kstep, voffA); PG8_STAGE(PG8_SB(1, 1), cB + hstepB + kstep, voffB);
    PG8_WAIT_V(6); PG8_BAR;
    for (;;) {
        const bool has_next = S.next(ui + 1, nxt);
        const char* nA = has_next ? g.Aptr(nxt) : cA; const char* nB = has_next ? g.Bptr(nxt) : cB;
        for (int t = 0; t < nt; t += 2) {
            if constexpr (Epi::HOOK) { if (t == 8 || t == 16) E.hook(acc, cur, wr, wc, fr, fq, t >> 3); }
            const bool last = (t == nt - 2);
            const char* a1 = cA + (size_t)(t + 1) * kstep;
            const char* a2 = last ? nA : cA + (size_t)(t + 2) * kstep; const char* b2 = last ? nB : cB + (size_t)(t + 2) * kstep;
            const char* a3 = a2 + kstep; const char* b3 = b2 + kstep;
            PG8_LDB(B0, 0, 0); PG8_LDB(B1, 0, 1); PG8_SCHED; PG8_LDA(At, 0, 0); PG8_STAGE(PG8_SA(1, 1), a1 + hstepA, voffA);
            PG8_WAIT_V(8); PG8_WAIT_L(0); PG8_BAR; PG8_MMA(0, 0, At, B0); PG8_MMA(0, 1, At, B1); PG8_BAR; PG8_SCHED;
            PG8_LDA(At, 0, 1); PG8_STAGE(PG8_SB(0, 0), b2, voffB); PG8_STAGE(PG8_SB(0, 1), b2 + hstepB, voffB); PG8_STAGE(PG8_SA(0, 0), a2, voffA);
            PG8_WAIT_V(8); PG8_WAIT_L(0); PG8_BAR; PG8_MMA(1, 0, At, B0); PG8_MMA(1, 1, At, B1); PG8_BAR; PG8_SCHED;
            PG8_LDB(B0, 1, 0); PG8_LDB(B1, 1, 1); PG8_SCHED; PG8_LDA(At, 1, 0); PG8_STAGE(PG8_SA(0, 1), a2 + hstepA, voffA);
            PG8_WAIT_V(8); PG8_WAIT_L(0); PG8_BAR; PG8_MMA(0, 0, At, B0); PG8_MMA(0, 1, At, B1); PG8_BAR; PG8_SCHED;
            PG8_LDA(At, 1, 1); PG8_STAGE(PG8_SB(1, 0), b3, voffB); PG8_STAGE(PG8_SB(1, 1), b3 + hstepB, voffB); PG8_STAGE(PG8_SA(1, 0), a3, voffA);
            PG8_WAIT_V(8); PG8_WAIT_L(0); PG8_BAR; PG8_MMA(1, 0, At, B0); PG8_MMA(1, 1, At, B1); PG8_BAR; PG8_SCHED;
        }
        if constexpr (ALIGN_EPI) { if (wr == 0) PG8_BAR; }
        E(acc, cur, wr, wc, fr, fq);
        if (!has_next) break;
#pragma unroll
        for (int a = 0; a < 2; ++a)
#pragma unroll
            for (int b = 0; b < 2; ++b)
#pragma unroll
                for (int m = 0; m < 4; ++m)
#pragma unroll
                    for (int n = 0; n < 2; ++n) acc[a][b][m][n] = (f32x4){0.f, 0.f, 0.f, 0.f};
        cur = nxt; cA = nA; cB = nB; ++ui;
        if constexpr (ALIGN_EPI) { if (wr == 1) PG8_BAR; }
    }
    PG8_WAIT_V(0);
    if constexpr (!ALIGN_EPI) { if (wr == 0) PG8_BAR; }
    PG8_BAR;
#undef PG8_SA
#undef PG8_SB
#undef PG8_STAGE
#undef PG8_LDA
#undef PG8_CAT8
#undef PG8_LDB
#undef PG8_MMA
#undef PG8_WAIT_V
#undef PG8_WAIT_L
#undef PG8_BAR
#undef PG8_SCHED
}
}


constexpr int RING_BYTES = 131072, MISC_OFF = RING_BYTES + 320, LDS_BYTES = 147456;
namespace att {
typedef short s16x4 __attribute__((ext_vector_type(4)));
__device__ __forceinline__ s16x4 lds_tr(const LAS unsigned char* p) { return __builtin_bit_cast(s16x4, __builtin_amdgcn_ds_read_tr16_b64_v4i16((LAS s16x4*)p)); }
template <int MODE> struct Cfg;
template <> struct Cfg<0> { static constexpr int DQK = 96, DV = 64, KRS = 208, VRS = 192, NV = 2, NL = 5; };
template <> struct Cfg<1> { static constexpr int DQK = 64, DV = 128, KRS = 144, VRS = 320, NV = 1, NL = 4; };
template <int MODE> struct Lay { using C = Cfg<MODE>; static constexpr int KB = 64 * C::KRS, VB = 64 * C::VRS, STAGE = 2 * KB + C::NV * VB; };

template <int MODE>
__device__ __forceinline__ void attn_unit(const Params& p, int l, int b, int hp, int qb, LAS unsigned char* lds, float lam, float lam_init, int pm = 0) {
    using C = Cfg<MODE>; using L = Lay<MODE>;
    constexpr int DQK = C::DQK, DV = C::DV, NDB = DV / 32, NKS = DQK / 16;
    int tid = threadIdx.x; asm volatile("" : "+v"(tid));
    const int lane = tid & 63, wid = __builtin_amdgcn_readfirstlane(tid >> 6), half = wid >> 2, r = lane & 31, h = lane >> 5;
    const int q0 = qb * 128, qrow = q0 + 32 * (wid & 3) + r;
    const size_t trow = (size_t)b * SEQ + qrow;
    const int ntile = 2 * qb + 2, mytiles = 2 * qb + 1 + ((wid & 3) >> 1);
    const bf16* Qb; const bf16* Kg[2]; const bf16* Vg[2]; int kp, vp;
    if (MODE == 0) { const bf16* QM = (const bf16*)(p.ws + WS_QM); const bf16* KM = (const bf16*)(p.ws + WS_KM); const bf16* KVR = (const bf16*)(p.ws + WS_KVR);
        Qb = QM + trow * 768 + (2 * hp + half) * 96; kp = 768; vp = 1024;
        Kg[0] = KM + (size_t)b * SEQ * 768 + (2 * hp) * 96; Kg[1] = Kg[0] + 96; Vg[0] = KVR + (size_t)b * SEQ * 1024 + 512 + (2 * hp) * 64; Vg[1] = Vg[0] + 64;
    } else { const bf16* Z = (const bf16*)(p.ws + WS_Z);
        Qb = Z + trow * ZP + ZC_DQ + (2 * hp + half) * 64; kp = ZP; vp = ZP;
        Kg[0] = Z + (size_t)b * SEQ * ZP + ZC_DK + (2 * hp) * 64; Kg[1] = Kg[0] + 64; Vg[0] = Z + (size_t)b * SEQ * ZP + ZC_DV + hp * 128; Vg[1] = Vg[0]; }
    constexpr int KC = DQK / 8, VC = DV / 8;
    typedef const __attribute__((address_space(1))) bf16* gptr_t;
    gptr_t gp[C::NL]; int lo_[C::NL]; size_t gstep[C::NL];
#pragma unroll
    for (int i = 0; i < C::NL; ++i) { const int id = tid + 512 * i;
        if (id < 2 * 64 * KC) { const int sg = id / (64 * KC), q = id % (64 * KC), row = q / KC, c = q % KC; gp[i] = (gptr_t)(sg ? Kg[1] : Kg[0]) + (size_t)row * kp + c * 8; lo_[i] = sg * L::KB + row * C::KRS + c * 16; gstep[i] = (size_t)64 * kp; }
        else { const int q2 = id - 2 * 64 * KC, sg = q2 / (64 * VC), q = q2 % (64 * VC), row = q / VC, c = q % VC; gp[i] = (gptr_t)(sg ? Vg[1] : Vg[0]) + (size_t)row * vp + c * 8; lo_[i] = 2 * L::KB + sg * L::VB + row * C::VRS + c * 16; gstep[i] = (size_t)64 * vp; } }
    bf16x8 qf[NKS];
#pragma unroll
    for (int s_ = 0; s_ < NKS; ++s_) qf[s_] = *(const bf16x8*)(Qb + 16 * s_ + 8 * h);
    const int koff = half * L::KB + r * C::KRS + 16 * h;
    const int voff = 2 * L::KB + (C::NV == 2 ? half * L::VB : 0) + (4 * h + ((lane & 15) >> 2)) * C::VRS + (((lane >> 4) & 1) * 16 + (lane & 3) * 4) * 2;
    f32x16 O[NDB];
#pragma unroll
    for (int d = 0; d < NDB; ++d)
#pragma unroll
        for (int e = 0; e < 16; ++e) O[d][e] = 0.f;
    f32x16 negm;
#pragma unroll
    for (int e = 0; e < 16; ++e) negm[e] = 0.f;
    float l_run = 0.f;
    u32x4 stA[C::NL], stB[C::NL];
#define ATT_LOAD(R) do { const size_t _st = adv > 0 ? 1 : 0; --adv; _Pragma("unroll") for (int i = 0; i < C::NL; ++i) { R[i] = *(const __attribute__((address_space(1))) u32x4*)gp[i]; gp[i] += _st * gstep[i]; } } while (0)
#define ATT_WRITE(R, stg) do { _Pragma("unroll") for (int i = 0; i < C::NL; ++i) *(LAS u32x4*)(lds + (stg) * L::STAGE + lo_[i]) = R[i]; } while (0)
#define ATT_VREAD(dst, kb) do { const int voff_ = (pm & 64) ? 2 * L::KB : voff; _Pragma("unroll") for (int d = 0; d < NDB; ++d) _Pragma("unroll") for (int sp = 0; sp < 2; ++sp) { \
                const LAS unsigned char* va = sb + voff_ + (32 * (kb) + 16 * sp) * C::VRS + 64 * d; \
                const s16x4 t0 = lds_tr(va), t1 = lds_tr(va + 8 * C::VRS); \
                dst[2 * d + sp] = (bf16x8){t0[0], t0[1], t0[2], t0[3], t1[0], t1[1], t1[2], t1[3]}; } } while (0)
#define ATT_PV(src, pfk) do { if (!(pm & 32)) { _Pragma("unroll") for (int d = 0; d < NDB; ++d) _Pragma("unroll") for (int sp = 0; sp < 2; ++sp) O[d] = __builtin_amdgcn_mfma_f32_32x32x16_bf16(src[2 * d + sp], pfk[sp], O[d], 0, 0, 0); } \
        else { _Pragma("unroll") for (int d = 0; d < NDB; ++d) O[d][0] += __builtin_bit_cast(float, (int)src[2 * d][0] + (int)pfk[0][0]); } } while (0)
#define ATT_SM(Sk, Sother, pfk) do { float mx = Sk[0]; _Pragma("unroll") for (int e = 1; e < 16; ++e) mx = fmaxf(mx, Sk[e]); \
            if (__any(mx > 8.f)) { mx = fmaxf(mx, __shfl_xor(mx, 32)); \
                const float dsh = fmaxf(mx, 0.f), alpha = __builtin_amdgcn_exp2f(-dsh); l_run *= alpha; \
                _Pragma("unroll") for (int e = 0; e < 16; ++e) { negm[e] -= dsh; Sk[e] -= dsh; Sother[e] -= dsh; } \
                _Pragma("unroll") for (int dd = 0; dd < NDB; ++dd) _Pragma("unroll") for (int e = 0; e < 16; ++e) O[dd][e] *= alpha; } \
            float ps = 0.f; \
            _Pragma("unroll") for (int sp = 0; sp < 2; ++sp) { float e8[8]; \
                if (pm & 16) { _Pragma("unroll") for (int jj = 0; jj < 8; ++jj) e8[jj] = Sk[8 * sp + jj]; } else { _Pragma("unroll") for (int jj = 0; jj < 8; ++jj) { e8[jj] = __builtin_amdgcn_exp2f(Sk[8 * sp + jj]); ps += e8[jj]; } } \
                u32x4 w; w.x = pg8::cvt_pk_bf16(e8[0], e8[1]); w.y = pg8::cvt_pk_bf16(e8[2], e8[3]); w.z = pg8::cvt_pk_bf16(e8[4], e8[5]); w.w = pg8::cvt_pk_bf16(e8[6], e8[7]); \
                pfk[sp] = __builtin_bit_cast(bf16x8, w); } \
            l_run += ps; } while (0)
#define ATT_COMPUTE(stg) do { LAS unsigned char* sb = lds + (stg) * L::STAGE; \
            bf16x8 kf[2][NKS]; \
            { const int koff_ = (pm & 64) ? 0 : koff; _Pragma("unroll") for (int kb = 0; kb < 2; ++kb) _Pragma("unroll") for (int s_ = 0; s_ < NKS; ++s_) kf[kb][s_] = *(const LAS bf16x8*)(sb + koff_ + kb * 32 * C::KRS + 32 * s_); } \
            __builtin_amdgcn_sched_barrier(0); \
            f32x16 S0 = negm, S1 = negm; __builtin_amdgcn_s_setprio(1); \
            if (!(pm & 32)) { _Pragma("unroll") for (int s_ = 0; s_ < NKS; ++s_) S0 = __builtin_amdgcn_mfma_f32_32x32x16_bf16(kf[0][s_], qf[s_], S0, 0, 0, 0); \
            _Pragma("unroll") for (int s_ = 0; s_ < NKS; ++s_) S1 = __builtin_amdgcn_mfma_f32_32x32x16_bf16(kf[1][s_], qf[s_], S1, 0, 0, 0); } \
            __builtin_amdgcn_s_setprio(0); bf16x8 vfa[2 * NDB], vfb[2 * NDB]; \
            ATT_VREAD(vfa, 0); \
            __builtin_amdgcn_sched_barrier(0); \
            bf16x8 pf0[2], pf1[2]; \
            ATT_SM(S0, S1, pf0); \
            __builtin_amdgcn_sched_barrier(0); \
            __builtin_amdgcn_s_setprio(1); ATT_PV(vfa, pf0); __builtin_amdgcn_s_setprio(0); \
            ATT_VREAD(vfb, 1); \
            __builtin_amdgcn_sched_barrier(0); \
            ATT_SM(S1, S0, pf1); \
            __builtin_amdgcn_sched_barrier(0); \
            __builtin_amdgcn_s_setprio(1); ATT_PV(vfb, pf1); __builtin_amdgcn_s_setprio(0); \
            } while (0)
    int adv = ntile - 1;
    ATT_LOAD(stA); ATT_LOAD(stB);
    ATT_WRITE(stA, 0);
    __syncthreads();
#pragma unroll 1
    for (int j = 0; j < ntile; j += 2) {
        if (!(pm & 1)) ATT_LOAD(stA);
        if (j < mytiles) ATT_COMPUTE(0);
        if (!(pm & 2)) ATT_WRITE(stB, 1);
        if (!(pm & 8)) __syncthreads();
        if (!(pm & 1)) ATT_LOAD(stB);
        if (j + 1 < mytiles) ATT_COMPUTE(1);
        if (!(pm & 2)) ATT_WRITE(stA, 0);
        if (!(pm & 8)) __syncthreads();
    }
#undef ATT_LOAD
#undef ATT_WRITE
#undef ATT_COMPUTE
#undef ATT_VREAD
#undef ATT_PV
#undef ATT_SM
    const float inv = 1.f / (l_run + __shfl_xor(l_run, 32));
    if (MODE == 0) {
        bf16* o = (bf16*)(p.ws + WS_OC) + trow * 1536 + (2 * hp + half) * 64 + 4 * h;
#pragma unroll
        for (int d = 0; d < NDB; ++d)
#pragma unroll
            for (int g4 = 0; g4 < 4; ++g4) { u32x2 w; w.x = pg8::cvt_pk_bf16(O[d][4 * g4] * inv, O[d][4 * g4 + 1] * inv); w.y = pg8::cvt_pk_bf16(O[d][4 * g4 + 2] * inv, O[d][4 * g4 + 3] * inv);
                *(u32x2*)(o + 32 * d + 8 * g4) = w; }
    } else {
        LAS unsigned char* xr = lds + (32 * (wid & 3) + r) * 264 + 8 * h;
        if (half == 1) {
#pragma unroll
            for (int d = 0; d < NDB; ++d)
#pragma unroll
                for (int g4 = 0; g4 < 4; ++g4) { u32x2 w; w.x = pg8::cvt_pk_bf16(O[d][4 * g4] * inv, O[d][4 * g4 + 1] * inv); w.y = pg8::cvt_pk_bf16(O[d][4 * g4 + 2] * inv, O[d][4 * g4 + 3] * inv);
                    *(LAS u32x2*)(xr + 64 * d + 16 * g4) = w; }
        }
        __syncthreads();
        if (half == 0) {
            float ss = 0.f;
#pragma unroll
            for (int d = 0; d < NDB; ++d)
#pragma unroll
                for (int g4 = 0; g4 < 4; ++g4) { const u32x2 w = *(const LAS u32x2*)(xr + 64 * d + 16 * g4);
                    O[d][4 * g4] = O[d][4 * g4] * inv - lam * bflo(w.x); O[d][4 * g4 + 1] = O[d][4 * g4 + 1] * inv - lam * bfhi(w.x);
                    O[d][4 * g4 + 2] = O[d][4 * g4 + 2] * inv - lam * bflo(w.y); O[d][4 * g4 + 3] = O[d][4 * g4 + 3] * inv - lam * bfhi(w.y);
                    ss += (O[d][4 * g4] * O[d][4 * g4] + O[d][4 * g4 + 1] * O[d][4 * g4 + 1]) + (O[d][4 * g4 + 2] * O[d][4 * g4 + 2] + O[d][4 * g4 + 3] * O[d][4 * g4 + 3]); }
            ss += __shfl_xor(ss, 32);
            const float rstd = rsqrtf(ss * (1.f / 128.f) + NORM_EPS) * (1.f - lam_init);
            const float* sg = p.in[11] + (size_t)l * 128 + 4 * h;
            bf16* o = (bf16*)(p.ws + WS_OC) + trow * 1536 + 512 + hp * 128 + 4 * h;
#pragma unroll
            for (int d = 0; d < NDB; ++d)
#pragma unroll
                for (int g4 = 0; g4 < 4; ++g4) { const f32x4 g = *(const f32x4*)(sg + 32 * d + 8 * g4);
                    u32x2 w; w.x = pg8::cvt_pk_bf16(O[d][4 * g4] * rstd * g.x, O[d][4 * g4 + 1] * rstd * g.y); w.y = pg8::cvt_pk_bf16(O[d][4 * g4 + 2] * rstd * g.z, O[d][4 * g4 + 3] * rstd * g.w);
                    *(u32x2*)(o + 32 * d + 8 * g4) = w; }
        }
        __syncthreads();
    }
}

__device__ __forceinline__ void sgu_unit(const Params& p, int l, int n, int g, LAS unsigned char* lds) {
    constexpr int VRS = 320;
    int tid = threadIdx.x; asm volatile("" : "+v"(tid));
    const int lane = tid & 63, wid = __builtin_amdgcn_readfirstlane(tid >> 6), r = lane & 31, h = lane >> 5, tb = wid & 3, ch = wid >> 2;
    const bf16* Z = (const bf16*)(p.ws + WS_Z) + (size_t)n * 128 * ZP;
#pragma unroll
    for (int i = 0; i < 4; ++i) { const int id = tid + 512 * i, row = id >> 4, c = id & 15; *(LAS u32x4*)(lds + row * VRS + c * 16) = *(const u32x4*)(Z + (size_t)row * ZP + ZC_SV + g * 128 + c * 8); }
    const bf16* W = (const bf16*)(p.ws + WS_W + (size_t)l * W_LAYER + WO_SGU) + ((size_t)g * 128 + tb * 32 + r) * 128 + 4 * h;
    u32x2 wf[8][2];
#pragma unroll
    for (int ks = 0; ks < 8; ++ks) { wf[ks][0] = *(const u32x2*)(W + 16 * ks); wf[ks][1] = *(const u32x2*)(W + 16 * ks + 8); }
    __syncthreads();
    f32x16 O[2];
#pragma unroll
    for (int d = 0; d < 2; ++d)
#pragma unroll
        for (int e = 0; e < 16; ++e) O[d][e] = 0.f;
    const int voff = (4 * h + ((lane & 15) >> 2)) * VRS + (((lane >> 4) & 1) * 16 + (lane & 3) * 4) * 2 + 128 * ch;
#pragma unroll
    for (int d = 0; d < 2; ++d)
#pragma unroll
        for (int ks = 0; ks < 8; ++ks) { const LAS unsigned char* va = lds + voff + (16 * ks) * VRS + 64 * d;
            const att::s16x4 t0 = att::lds_tr(va), t1 = att::lds_tr(va + 8 * VRS);
            const bf16x8 vf = {t0[0], t0[1], t0[2], t0[3], t1[0], t1[1], t1[2], t1[3]};
            const u32x4 pw = {wf[ks][0].x, wf[ks][0].y, wf[ks][1].x, wf[ks][1].y};
            O[d] = __builtin_amdgcn_mfma_f32_32x32x16_bf16(vf, __builtin_bit_cast(bf16x8, pw), O[d], 0, 0, 0); }
    const int t = tb * 32 + r; const size_t trow = (size_t)n * 128 + t;
    const float bias = p.in[14][(size_t)l * 512 + g * 128 + t];
    const bf16* up = (const bf16*)(p.ws + WS_Z) + trow * ZP + ZC_SU + g * 128 + 64 * ch + 4 * h;
    bf16* o = (bf16*)(p.ws + WS_OC) + trow * 1536 + 1024 + g * 128 + 64 * ch + 4 * h;
#pragma unroll
    for (int d = 0; d < 2; ++d)
#pragma unroll
        for (int g4 = 0; g4 < 4; ++g4) { const u32x2 uw = *(const u32x2*)(up + 32 * d + 8 * g4);
            u32x2 w; w.x = pg8::cvt_pk_bf16(bflo(uw.x) * (O[d][4 * g4] + bias), bfhi(uw.x) * (O[d][4 * g4 + 1] + bias)); w.y = pg8::cvt_pk_bf16(bflo(uw.y) * (O[d][4 * g4 + 2] + bias), bfhi(uw.y) * (O[d][4 * g4 + 3] + bias));
            *(u32x2*)(o + 32 * d + 8 * g4) = w; }
    __syncthreads();
}
}

#define XB_TMO      128
#define XB_XCNT(j)  (256  + 64 * (j))
#define XB_XSUB(j)  (1280 + 64 * (j))
#define XB_XGEN(j)  (2304 + 64 * (j))
#define XB_TOP      3328
#define XB_TOPGEN   3392
#define XCD_BAR_WORDS 3456
#define XB_SPIN_CAP (1u << 18)
__device__ __forceinline__ unsigned xb_ld(unsigned* p)              { return __hip_atomic_load(p, __ATOMIC_RELAXED, __HIP_MEMORY_SCOPE_AGENT); }
__device__ __forceinline__ unsigned xb_add(unsigned* p, unsigned v) { return __hip_atomic_fetch_add(p, v, __ATOMIC_RELAXED, __HIP_MEMORY_SCOPE_AGENT); }
__device__ __forceinline__ unsigned xb_xcc_id() { return (unsigned)__builtin_amdgcn_s_getreg((3 << 11) | 20) & 0xFu; }
#define XB_SPIN(cond, bar) do { unsigned _sp = 0; while (cond) { __builtin_amdgcn_s_sleep(1); \
    if ((++_sp & 255u) == 0u) { if (xb_ld(&(bar)[XB_TMO])) break; if (_sp > XB_SPIN_CAP) { atomicAdd(&(bar)[XB_TMO], 1u); break; } } } } while (0)
struct XcdBarrier { unsigned* bar; unsigned x; volatile LAS unsigned* st; };
__device__ __forceinline__ XcdBarrier xcd_barrier_post(unsigned* bar, volatile LAS unsigned* st) {
    XcdBarrier b; b.bar = bar; b.x = xb_xcc_id(); b.st = st;
    if (threadIdx.x == 0) (void)xb_add(&bar[XB_XCNT(b.x)], 1u);
    return b;
}
__device__ __forceinline__ void xcd_barrier_complete(unsigned* bar, unsigned x, unsigned& nloc, unsigned& nx) {
    const unsigned G = gridDim.x * gridDim.y * gridDim.z;
    unsigned sum, cnt, mine, sp = 0u;
    for (;;) {
        sum = 0u; cnt = 0u; mine = 0u;
#pragma unroll
        for (unsigned j = 0; j < 16; ++j) { const unsigned c = xb_ld(&bar[XB_XCNT(j)]); sum += c; cnt += (c > 0u) ? 1u : 0u; mine = (j == x) ? c : mine; }
        if (sum == G) break;
        __builtin_amdgcn_s_sleep(1);
        if ((++sp & 255u) == 0u) { if (xb_ld(&bar[XB_TMO])) break; if (sp > XB_SPIN_CAP) { atomicAdd(&bar[XB_TMO], 1u); break; } }
    }
    nloc = mine > 0u ? mine : 1u; nx = cnt > 0u ? cnt : 1u;
}
__device__ __forceinline__ void xcd_barrier(const XcdBarrier& b) {
    asm volatile("s_waitcnt vmcnt(0)" ::: "memory");
    __syncthreads();
    if (threadIdx.x == 0) {
        unsigned* bar = b.bar;
        __builtin_amdgcn_s_waitcnt(0);
        unsigned nloc = b.st[0], nx = b.st[1];
        if (nloc == 0u) { xcd_barrier_complete(bar, b.x, nloc, nx); b.st[0] = nloc; b.st[1] = nx; }
        const unsigned old = xb_add(&bar[XB_XSUB(b.x)], 1u);
        const unsigned gen = old / nloc;
        if (old + 1u == (gen + 1u) * nloc) {
            __builtin_amdgcn_fence(__ATOMIC_RELEASE, "agent");
            asm volatile("s_waitcnt vmcnt(0)" ::: "memory");
            const unsigned og = xb_add(&bar[XB_TOP], 1u);
            const unsigned tg = og / nx;
            if (og + 1u == (tg + 1u) * nx) xb_add(&bar[XB_TOPGEN], 1u);
            else XB_SPIN(xb_ld(&bar[XB_TOPGEN]) == tg, bar);
            __builtin_amdgcn_fence(__ATOMIC_ACQUIRE, "agent");
            xb_add(&bar[XB_XGEN(b.x)], 1u);
            asm volatile("s_waitcnt vmcnt(0)" ::: "memory");
        } else {
            XB_SPIN(xb_ld(&bar[XB_XGEN(b.x)]) == gen, bar);
            __builtin_amdgcn_fence(__ATOMIC_ACQUIRE, "agent");
            asm volatile("s_waitcnt vmcnt(0)" ::: "memory");
        }
    }
    __syncthreads();
}

constexpr int NPHASE = 1 + 11 * DEPTH;
constexpr int CW_BAR = 4096;
struct MArgs { Params p; int ph_lo, ph_hi, li, pad; };

__global__ void __launch_bounds__(512, 2) mega(MArgs a) {
    extern __shared__ __attribute__((aligned(16))) unsigned char lds_raw[];
    LAS unsigned char* lds = (LAS unsigned char*)lds_raw;
    volatile LAS unsigned* MISC = (volatile LAS unsigned*)(lds + MISC_OFF);
    const Params& p = a.p;
    const int tid = threadIdx.x, lane = tid & 63, wave = __builtin_amdgcn_readfirstlane(tid >> 6);
    const int G = gridDim.x, bx = blockIdx.x;
    const int vcu = (G % 8 == 0) ? (bx % 8) * (G / 8) + bx / 8 : bx;
    const int gw = vcu * 8 + wave, ngw = G * 8;
    unsigned char* ws = p.ws;
    for (int u = tid; u < (LDS_BYTES - RING_BYTES) / 4; u += 512) ((LAS unsigned*)(lds + RING_BYTES))[u] = 0u;
    __syncthreads();
    XcdBarrier bar = xcd_barrier_post((unsigned*)(ws + WS_CTL) + CW_BAR + a.li * XCD_BAR_WORDS, MISC + 8);
    const int lo = a.ph_lo, hi = a.ph_hi;
#ifndef PROBE_PM
#define PROBE_PM 0
#endif
#ifndef PROBE_K
#define PROBE_K (-1)
#endif
#ifndef PROBE_N
#define PROBE_N 0
#endif
#define NREP(j) ((PROBE_K == (j)) ? PROBE_N : 0)
#ifndef ENMASK
#define ENMASK 0xFFFFFFFFu
#endif
#define EN(j) ((ENMASK >> (j)) & 1u)
#define IN(k) (lo <= (k) && (k) < hi)
#define SEAM(k) do { if (IN(k) && IN((k) + 1)) xcd_barrier(bar); } while (0)

    if (EN(11) && IN(0)) for (int rep = 0; rep <= NREP(11); ++rep) {
        float* scr = (float*)lds_raw;
        __syncthreads();
        for (int r12 = 0; r12 <= NREP(12); ++r12)
        for (int l = 0; l < DEPTH; ++l) prologue_transposes(p, l, scr + wave * (64 * 33), gw, ngw, lane);
        prologue_rope(p, bx * 512 + tid, G * 512);
        __syncthreads();
        for (int r13 = 0; r13 <= NREP(13); ++r13)
        for (int it = bx; it < 2 * 256; it += G) fold_item(p, it >> 8, it & 255, scr, tid);
        __syncthreads();
        for (int r15 = 0; r15 <= NREP(15); ++r15)
        for (int t = gw; t < T; t += ngw) rms_row_to_bf16(p.in[0] + (size_t)t * DM, p.in[1], (bf16*)(ws + WS_HB) + (size_t)t * DM, lane, ws + WS_HB8 + (size_t)t * DM);
        for (int r14 = 0; r14 <= NREP(14); ++r14)
        for (int r = gw; r < 2 * DEPTH * NEXP; r += ngw) { const int tb = r / (DEPTH * NEXP), q = r % (DEPTH * NEXP);
            const size_t ro = (size_t)(q / NEXP) * NEXP * QROW + (size_t)(q % NEXP) * 128;
            if (tb) q4_row(p.in[23] + (size_t)q * DM, ws + WS_V8 + ro, (float*)(ws + WS_PS) + (size_t)DEPTH * NEXP + q, lane);
            else q4u_row(p.in[22] + (size_t)q * DM, ws + WS_U8 + ro, (float*)(ws + WS_PS) + q, lane); }
        { unsigned* gmax = (unsigned*)(ws + WS_CTL) + CW_GMAX;
          for (int m6 = 0; m6 < 3 * DEPTH; ++m6) { const f32x4* src = (const f32x4*)(p.in[15] + (size_t)m6 * DM * DM); float mx = 0.f;
              for (int i = gw * 64 + lane; i < DM * DM / 4; i += ngw * 64) { const f32x4 v = src[i]; mx = fmaxf(mx, fmaxf(fmaxf(fabsf(v.x), fabsf(v.y)), fmaxf(fabsf(v.z), fabsf(v.w)))); }
#pragma unroll
              for (int of = 1; of < 64; of <<= 1) mx = fmaxf(mx, __shfl_xor(mx, of));
              if (lane == 0) atomicMax(gmax + 64 * m6, __builtin_bit_cast(unsigned, mx)); } }
        xcd_barrier(bar);
        { unsigned* gmax = (unsigned*)(ws + WS_CTL) + CW_GMAX;
          for (int it = gw; it < DEPTH * 3 * 64 * 32; it += ngw) { const int m6 = it / 2048, q = it % 2048, cb = q / 32, kb = q % 32;
              transpose_item8(p.in[15] + (size_t)m6 * DM * DM, DM, cb * 32, kb * 64, DM, ws + WS_WG8, m6 * DM + cb * 32, scr + wave * (64 * 33), lane, gate_scale(gmax + 64 * m6)); } }
    }
    SEAM(0);
    { constexpr int l = 0;
        const int pb = 1 + 11 * l;
        unsigned char* wl = ws + WS_W + (size_t)l * W_LAYER;
        bf16* HB = (bf16*)(ws + WS_HB); bf16* Z = (bf16*)(ws + WS_Z); bf16* Gt = (bf16*)(ws + WS_G);
        if (EN(0) && IN(pb + 0)) for (int rep = 0; rep <= NREP(0); ++rep) {
            { pg8::ProbGen g{HB, (const bf16*)(wl + WO_CAT), DM, DM, DM}; pg8::StaticOrder S; S.init(T, ZP, G, bx);
              pg8::EpiZG E{Z, Gt, p.in[16] + (size_t)l * NGATE, 1};
              pg8::gemm_phase<pg8::EpiZG, pg8::ProbGen, pg8::StaticOrder>(lds, g, S, E); }
            {
              const unsigned* gmax = (const unsigned*)(ws + WS_CTL) + CW_GMAX + 64 * 3 * l;
              pg8::ProbGen g{(const bf16*)(ws + WS_HB8), (const bf16*)(ws + WS_WG8 + (size_t)l * NGATE * DM), DM / 2, DM / 2, DM / 2}; pg8::StaticOrder S; S.init(T, NGATE, G, bx);
              pg8::EpiG8 E{Gt, p.in[16] + (size_t)l * NGATE, gmax};
              pg8::gemm_phase<pg8::EpiG8, pg8::ProbGen, pg8::StaticOrder, true, true>(lds, g, S, E); }
        }
        SEAM(pb + 0);
        if (EN(1) && IN(pb + 1)) { int ln = lane; asm volatile("" : "+v"(ln)); for (int t = gw; t < T; t += ngw) prep1_row(p, l, t, ln); }
        SEAM(pb + 1);
        if (EN(2) && IN(pb + 2)) for (int rep = 0; rep <= NREP(2); ++rep) {
            pg8::ProbUp g{Z, (const bf16*)(wl + WO_UP), ZP, 512, 512}; pg8::StaticOrder S; S.init(T, 1792, G, bx);
            pg8::EpiUp E{(bf16*)(ws + WS_QR), (bf16*)(ws + WS_KVR)};
            pg8::gemm_phase<pg8::EpiUp, pg8::ProbUp, pg8::StaticOrder>(lds, g, S, E);
        }
        SEAM(pb + 2);
        if (EN(3) && IN(pb + 3)) for (int rep = 0; rep <= NREP(3); ++rep) { int ln = lane; asm volatile("" : "+v"(ln)); for (int t = gw; t < T; t += ngw) prep2_row(p, l, t, ln); }
        SEAM(pb + 3);
        if (EN(4) && IN(pb + 4)) for (int rep = 0; rep <= NREP(4); ++rep) {
            const float lam = diff_lambda(p, l, lane), lam_init = 0.8f - 0.6f * expf(-0.3f * (float)l);
            unsigned* qbase = (unsigned*)(ws + WS_CTL) + 64 * (1 + 8 * l + 16 * rep);
            int qs = 0;
            for (;;) {
                __syncthreads();
                if (tid == 0) { int u = 192, qx = 0;
                    while (qs < 8) { qx = (int)((bar.x + (unsigned)qs) & 7u); u = (int)atomicAdd(qbase + 64 * qx, 1u); if (u < 192) break; ++qs; }
                    MISC[16] = (unsigned)(qs < 8 ? u : 192); MISC[17] = (unsigned)qx; MISC[18] = (unsigned)qs; }
                __syncthreads();
                const int u = (int)MISC[16], qx = (int)MISC[17]; qs = (int)MISC[18];
                if (u >= 192) break;
                if (u < 128) { const int qb = 31 - (u >> 2), combo = qx + 8 * (u & 3);
                    if (combo < 16) att::attn_unit<1>(p, l, combo >> 2, combo & 3, qb, lds, lam, lam_init, rep < NREP(4) ? PROBE_PM : 0);
                    else att::attn_unit<0>(p, l, (combo - 16) >> 2, (combo - 16) & 3, qb, lds, 0.f, 0.f, rep < NREP(4) ? PROBE_PM : 0);
                } else { const int v = qx * 64 + (u - 128); att::sgu_unit(p, l, v >> 2, v & 3, lds); }
            }
        }
        SEAM(pb + 4);
        if (EN(5) && IN(pb + 5)) for (int rep = 0; rep <= NREP(5); ++rep) {
            const bool prb = rep < NREP(5);
            pg8::ProbGen g{(const bf16*)(ws + WS_OC), (const bf16*)(wl + WO_B), 1536, 1536, 1536}; pg8::StaticOrder S; S.init(T, DM, G, bx);
            if (prb && (PROBE_PM & 2)) { g.A = HB; g.lda = DM; }
            if (prb && (PROBE_PM & 4)) { g.Bt = (const bf16*)(wl + WO_CAT); g.ldb = DM; }
            pg8::EpiMG E{prb ? (bf16*)(ws + WS_QR) : (bf16*)(ws + WS_MG), Gt, (prb && (PROBE_PM & 1)) ? 1 : 0};
            if (prb && (PROBE_PM & 8)) { pg8::EpiDelta E2{(bf16*)(ws + WS_QR)}; pg8::gemm_phase<pg8::EpiDelta, pg8::ProbGen, pg8::StaticOrder>(lds, g, S, E2); }
            else pg8::gemm_phase<pg8::EpiMG, pg8::ProbGen, pg8::StaticOrder>(lds, g, S, E);
        }
        SEAM(pb + 5);
        if (EN(6) && IN(pb + 6)) for (int rep = 0; rep <= NREP(6); ++rep) {
            pg8::ProbGen g{(const bf16*)(ws + WS_MG), (const bf16*)(wl + WO_OUT), DM, DM, DM}; pg8::StaticOrder S; S.init(T, DM, G, bx);
            pg8::EpiDelta E{(bf16*)(ws + WS_QR)};
            pg8::gemm_phase<pg8::EpiDelta, pg8::ProbGen, pg8::StaticOrder>(lds, g, S, E);
        }
        SEAM(pb + 6);
        if (EN(7) && IN(pb + 7)) { int ln = lane; asm volatile("" : "+v"(ln));
            const float* xin = l == 0 ? p.in[0] : p.out;
            for (int t = gw; t < T; t += ngw) add_rms_row(xin + (size_t)t * DM, (const bf16*)(ws + WS_QR) + (size_t)t * DM, RESID_IN_PEER ? nullptr : p.out + (size_t)t * DM, p.in[19] + (size_t)l * DM, HB + (size_t)t * DM, (float*)(ws + WS_HS) + 2 * (size_t)t, ln); }
        SEAM(pb + 7);
        if (EN(8) && IN(pb + 8)) for (int rep = 0; rep <= NREP(8); ++rep) {
            pg8::ProbGen g{HB, (const bf16*)(wl + WO_PQ), DM, DM, DM}; pg8::StaticOrder S; S.init(T, DM, G, bx);
            pg8::EpiSC E{(float*)(ws + WS_SC)};
            pg8::gemm_phase<pg8::EpiSC, pg8::ProbGen, pg8::StaticOrder>(lds, g, S, E);
        }
        SEAM(pb + 8);
        if (EN(10) && IN(pb + 10)) { int ln = lane; asm volatile("" : "+v"(ln));
            const float* gn = l + 1 < DEPTH ? p.in[1] + (size_t)(l + 1) * DM : nullptr;
            __syncthreads();
            for (int rep = 0; rep <= NREP(10); ++rep) { if (rep < NREP(10)) peer_octets<PROBE_PM | 4>(p, l, gw, ngw, ln, nullptr, p.out, p.out, lds + wave * PEER_LDS_WAVE); else peer_octets(p, l, gw, ngw, ln, gn, p.out, p.out, lds + wave * PEER_LDS_WAVE); }
            __syncthreads(); }
        SEAM(pb + 10);
        }
    { constexpr int l = 1;
        const int pb = 1 + 11 * l;
        unsigned char* wl = ws + WS_W + (size_t)l * W_LAYER;
        bf16* HB = (bf16*)(ws + WS_HB); bf16* Z = (bf16*)(ws + WS_Z); bf16* Gt = (bf16*)(ws + WS_G);
        if (EN(0) && IN(pb + 0)) for (int rep = 0; rep <= NREP(0); ++rep) {
            { pg8::ProbGen g{HB, (const bf16*)(wl + WO_CAT), DM, DM, DM}; pg8::StaticOrder S; S.init(T, ZP, G, bx);
              pg8::EpiZG E{Z, Gt, p.in[16] + (size_t)l * NGATE, 1};
              pg8::gemm_phase<pg8::EpiZG, pg8::ProbGen, pg8::StaticOrder>(lds, g, S, E); }
            {
              const unsigned* gmax = (const unsigned*)(ws + WS_CTL) + CW_GMAX + 64 * 3 * l;
              pg8::ProbGen g{(const bf16*)(ws + WS_HB8), (const bf16*)(ws + WS_WG8 + (size_t)l * NGATE * DM), DM / 2, DM / 2, DM / 2}; pg8::StaticOrder S; S.init(T, NGATE, G, bx);
              pg8::EpiG8 E{Gt, p.in[16] + (size_t)l * NGATE, gmax};
              pg8::gemm_phase<pg8::EpiG8, pg8::ProbGen, pg8::StaticOrder, true, true>(lds, g, S, E); }
        }
        SEAM(pb + 0);
        if (EN(1) && IN(pb + 1)) { int ln = lane; asm volatile("" : "+v"(ln)); for (int t = gw; t < T; t += ngw) prep1_row(p, l, t, ln); }
        SEAM(pb + 1);
        if (EN(2) && IN(pb + 2)) for (int rep = 0; rep <= NREP(2); ++rep) {
            pg8::ProbUp g{Z, (const bf16*)(wl + WO_UP), ZP, 512, 512}; pg8::StaticOrder S; S.init(T, 1792, G, bx);
            pg8::EpiUp E{(bf16*)(ws + WS_QR), (bf16*)(ws + WS_KVR)};
            pg8::gemm_phase<pg8::EpiUp, pg8::ProbUp, pg8::StaticOrder>(lds, g, S, E);
        }
        SEAM(pb + 2);
        if (EN(3) && IN(pb + 3)) for (int rep = 0; rep <= NREP(3); ++rep) { int ln = lane; asm volatile("" : "+v"(ln)); for (int t = gw; t < T; t += ngw) prep2_row(p, l, t, ln); }
        SEAM(pb + 3);
        if (EN(4) && IN(pb + 4)) for (int rep = 0; rep <= NREP(4); ++rep) {
            const float lam = diff_lambda(p, l, lane), lam_init = 0.8f - 0.6f * expf(-0.3f * (float)l);
            unsigned* qbase = (unsigned*)(ws + WS_CTL) + 64 * (1 + 8 * l + 16 * rep);
            int qs = 0;
            for (;;) {
                __syncthreads();
                if (tid == 0) { int u = 192, qx = 0;
                    while (qs < 8) { qx = (int)((bar.x + (unsigned)qs) & 7u); u = (int)atomicAdd(qbase + 64 * qx, 1u); if (u < 192) break; ++qs; }
                    MISC[16] = (unsigned)(qs < 8 ? u : 192); MISC[17] = (unsigned)qx; MISC[18] = (unsigned)qs; }
                __syncthreads();
                const int u = (int)MISC[16], qx = (int)MISC[17]; qs = (int)MISC[18];
                if (u >= 192) break;
                if (u < 128) { const int qb = 31 - (u >> 2), combo = qx + 8 * (u & 3);
                    if (combo < 16) att::attn_unit<1>(p, l, combo >> 2, combo & 3, qb, lds, lam, lam_init, rep < NREP(4) ? PROBE_PM : 0);
                    else att::attn_unit<0>(p, l, (combo - 16) >> 2, (combo - 16) & 3, qb, lds, 0.f, 0.f, rep < NREP(4) ? PROBE_PM : 0);
                } else { const int v = qx * 64 + (u - 128); att::sgu_unit(p, l, v >> 2, v & 3, lds); }
            }
        }
        SEAM(pb + 4);
        if (EN(5) && IN(pb + 5)) for (int rep = 0; rep <= NREP(5); ++rep) {
            const bool prb = rep < NREP(5);
            pg8::ProbGen g{(const bf16*)(ws + WS_OC), (const bf16*)(wl + WO_B), 1536, 1536, 1536}; pg8::StaticOrder S; S.init(T, DM, G, bx);
            if (prb && (PROBE_PM & 2)) { g.A = HB; g.lda = DM; }
            if (prb && (PROBE_PM & 4)) { g.Bt = (const bf16*)(wl + WO_CAT); g.ldb = DM; }
            pg8::EpiMG E{prb ? (bf16*)(ws + WS_QR) : (bf16*)(ws + WS_MG), Gt, (prb && (PROBE_PM & 1)) ? 1 : 0};
            if (prb && (PROBE_PM & 8)) { pg8::EpiDelta E2{(bf16*)(ws + WS_QR)}; pg8::gemm_phase<pg8::EpiDelta, pg8::ProbGen, pg8::StaticOrder>(lds, g, S, E2); }
            else pg8::gemm_phase<pg8::EpiMG, pg8::ProbGen, pg8::StaticOrder>(lds, g, S, E);
        }
        SEAM(pb + 5);
        if (EN(6) && IN(pb + 6)) for (int rep = 0; rep <= NREP(6); ++rep) {
            pg8::ProbGen g{(const bf16*)(ws + WS_MG), (const bf16*)(wl + WO_OUT), DM, DM, DM}; pg8::StaticOrder S; S.init(T, DM, G, bx);
            pg8::EpiDelta E{(bf16*)(ws + WS_QR)};
            pg8::gemm_phase<pg8::EpiDelta, pg8::ProbGen, pg8::StaticOrder>(lds, g, S, E);
        }
        SEAM(pb + 6);
        if (EN(7) && IN(pb + 7)) { int ln = lane; asm volatile("" : "+v"(ln));
            const float* xin = l == 0 ? p.in[0] : p.out;
            for (int t = gw; t < T; t += ngw) add_rms_row(xin + (size_t)t * DM, (const bf16*)(ws + WS_QR) + (size_t)t * DM, RESID_IN_PEER ? nullptr : p.out + (size_t)t * DM, p.in[19] + (size_t)l * DM, HB + (size_t)t * DM, (float*)(ws + WS_HS) + 2 * (size_t)t, ln); }
        SEAM(pb + 7);
        if (EN(8) && IN(pb + 8)) for (int rep = 0; rep <= NREP(8); ++rep) {
            pg8::ProbGen g{HB, (const bf16*)(wl + WO_PQ), DM, DM, DM}; pg8::StaticOrder S; S.init(T, DM, G, bx);
            pg8::EpiSC E{(float*)(ws + WS_SC)};
            pg8::gemm_phase<pg8::EpiSC, pg8::ProbGen, pg8::StaticOrder>(lds, g, S, E);
        }
        SEAM(pb + 8);
        if (EN(10) && IN(pb + 10)) { int ln = lane; asm volatile("" : "+v"(ln));
            const float* gn = l + 1 < DEPTH ? p.in[1] + (size_t)(l + 1) * DM : nullptr;
            __syncthreads();
            for (int rep = 0; rep <= NREP(10); ++rep) { if (rep < NREP(10)) peer_octets<PROBE_PM | 4>(p, l, gw, ngw, ln, nullptr, p.out, p.out, lds + wave * PEER_LDS_WAVE); else peer_octets(p, l, gw, ngw, ln, gn, p.out, p.out, lds + wave * PEER_LDS_WAVE); }
            __syncthreads(); }
        SEAM(pb + 10);
        }
#undef IN
#undef SEAM
}

static int g_grid = 0;
static void launch_mega(const Params& p, int lo, int hi, int li, hipStream_t stream) {
    MArgs a{}; a.p = p; a.ph_lo = lo; a.ph_hi = hi; a.li = li; a.pad = 0;
    mega<<<g_grid, 512, LDS_BYTES, stream>>>(a);
}
extern "C" void kernel_launch(void* const* d_in, const int* in_sizes, int n_in, void* d_out, int out_size, void* d_ws, size_t ws_size, hipStream_t stream) {
    if (n_in != 24 || out_size != T * DM || ws_size < WS_END) { fprintf(stderr, "kernel_launch: unexpected shapes (n_in %d, out %d, ws %zu, need %zu)\n", n_in, out_size, ws_size, (size_t)WS_END); return; }
    if (g_grid == 0) {
        int dev = 0, cus = 0, per_cu = 0;
        if (hipGetDevice(&dev) != hipSuccess || hipDeviceGetAttribute(&cus, hipDeviceAttributeMultiprocessorCount, dev) != hipSuccess) { g_grid = -1; return; }
        if (hipFuncSetAttribute((const void*)mega, hipFuncAttributeMaxDynamicSharedMemorySize, LDS_BYTES) != hipSuccess) { fprintf(stderr, "kernel_launch: hipFuncSetAttribute failed\n"); g_grid = -1; return; }
        if (hipOccupancyMaxActiveBlocksPerMultiprocessor(&per_cu, (const void*)mega, 512, LDS_BYTES) != hipSuccess || per_cu < 1) { fprintf(stderr, "kernel_launch: occupancy query says %d\n", per_cu); }
        (void)hipGetLastError();
        g_grid = cus;
    }
    if (g_grid < 0) return;
    Params p{};
    for (int i = 0; i < 24; ++i) p.in[i] = (const float*)d_in[i];
    p.out = (float*)d_out; p.ws = (unsigned char*)d_ws;
    unsigned char* ws = p.ws;
    (void)hipMemsetAsync(ws + WS_CTL, 0, 1 * MiB, stream);
    launch_mega(p, 0, NPHASE, 0, stream);
}
```

```cpp
#include <hip/hip_runtime.h>
#include <cstdio>
#include <cstdint>
#ifndef RESID_IN_PEER
#define RESID_IN_PEER 0
#endif

constexpr int BATCH = 4, SEQ = 4096, DM = 2048, DEPTH = 2;
constexpr int T = BATCH * SEQ;
constexpr int ZP = 3840;
constexpr int NGATE = 3 * DM;
constexpr int N1 = ZP + NGATE;
constexpr int ZC_CQ = 0, ZC_CKV = 512, ZC_DQ = 1024, ZC_DK = 1536, ZC_DV = 2048, ZC_SU = 2560, ZC_SV = 3072, ZC_KR = 3584;
constexpr int DIN = 3616;
constexpr int NEXP = 16384;
constexpr float NORM_EPS = 1e-6f;
constexpr float LOG2E = 1.4426950408889634f;

typedef unsigned short bf16;
typedef unsigned u32x4 __attribute__((ext_vector_type(4)));
typedef unsigned u32x2 __attribute__((ext_vector_type(2)));
typedef float f32x4 __attribute__((ext_vector_type(4)));
typedef float f32x16 __attribute__((ext_vector_type(16)));
typedef short bf16x8 __attribute__((ext_vector_type(8)));
#define LAS __attribute__((address_space(3)))

constexpr size_t MiB = 1u << 20;
constexpr size_t WS_CTL = 0;
constexpr size_t WS_ROPE = 1 * MiB;
constexpr size_t WS_W = 2 * MiB;
constexpr size_t WO_CAT = 0;
constexpr size_t WO_UP = WO_CAT + (size_t)N1 * DM * 2;
constexpr size_t WO_B = WO_UP + (size_t)1792 * 512 * 2;
constexpr size_t WO_OUT = WO_B + (size_t)3 * DM * 512 * 2;
constexpr size_t WO_PQ = WO_OUT + (size_t)DM * DM * 2;
constexpr size_t WO_SGU = WO_PQ + (size_t)DM * DM * 2;
constexpr size_t W_LAYER = WO_SGU + (size_t)4 * 128 * 128 * 2;
constexpr size_t WS_ACT = WS_W + 2 * W_LAYER + (2 * MiB - (2 * W_LAYER) % (2 * MiB));
constexpr size_t WS_HB = WS_ACT;
constexpr size_t WS_Z = WS_HB + (size_t)T * DM * 2;
constexpr size_t WS_G = WS_Z + (size_t)T * ZP * 2;
constexpr size_t WS_SC = WS_G;
constexpr size_t WS_QR = WS_G + (size_t)T * NGATE * 2;
constexpr size_t WS_KVR = WS_QR + (size_t)T * 768 * 2;
constexpr size_t WS_QM = WS_KVR + (size_t)T * 1024 * 2;
constexpr size_t WS_KM = WS_QM + (size_t)T * 768 * 2;
constexpr size_t WS_OC = WS_KM + (size_t)T * 768 * 2;
constexpr size_t WS_MG = WS_OC + (size_t)3 * T * 512 * 2;
constexpr size_t WS_IDX = WS_MG + (size_t)T * DM * 2;
constexpr size_t WS_GW = WS_IDX + (size_t)T * 128 * 4;
constexpr int QROW = DM / 2;
constexpr size_t WS_U8 = WS_GW + (size_t)T * 128 * 4;
constexpr size_t WS_V8 = WS_U8 + (size_t)DEPTH * NEXP * QROW;
constexpr size_t WS_PS = WS_V8 + (size_t)DEPTH * NEXP * QROW;
constexpr size_t WS_HB8 = WS_PS + (size_t)2 * DEPTH * NEXP * 4;
constexpr size_t WS_WG8 = WS_HB8 + (size_t)T * DM;
constexpr size_t WS_HS = WS_WG8 + (size_t)DEPTH * NGATE * DM;
constexpr size_t WS_END = WS_HS + (size_t)T * 8;
constexpr int CW_GMAX = 3072;

struct Params {
    const float* in[24];
    float* out;
    unsigned char* ws;
};

__device__ __forceinline__ unsigned f2bf(float f) { unsigned u = __builtin_bit_cast(unsigned, f); return (u + 0x7fffu + ((u >> 16) & 1u)) >> 16; }
__device__ __forceinline__ unsigned pk2(float lo, float hi) { return f2bf(lo) | (f2bf(hi) << 16); }
__device__ __forceinline__ float bf2f(unsigned b) { return __builtin_bit_cast(float, b << 16); }
__device__ __forceinline__ float bflo(unsigned w) { return __builtin_bit_cast(float, w << 16); }
__device__ __forceinline__ float bfhi(unsigned w) { return __builtin_bit_cast(float, w & 0xffff0000u); }
__device__ __forceinline__ unsigned pk4_fp8(float a, float b, float c, float d) { int w = __builtin_amdgcn_cvt_pk_fp8_f32(a, b, 0, false); w = __builtin_amdgcn_cvt_pk_fp8_f32(c, d, w, true); return (unsigned)w; }
__device__ __forceinline__ float wave_sum(float v) {
#pragma unroll
    for (int o = 1; o < 64; o <<= 1) v += __shfl_xor(v, o);
    return v;
}
__device__ __forceinline__ float gelu_tanh(float x) {
    const float u = 0.7978845608028654f * (x + 0.044715f * x * x * x);
    const float e = __expf(-2.0f * fabsf(u));
    float th = (1.0f - e) / (1.0f + e);
    th = u < 0.f ? -th : th;
    return 0.5f * x * (1.0f + th);
}
__device__ __forceinline__ void unpack8(const u32x4 w, float (&f)[8]) {
    f[0] = bflo(w.x); f[1] = bfhi(w.x); f[2] = bflo(w.y); f[3] = bfhi(w.y); f[4] = bflo(w.z); f[5] = bfhi(w.z); f[6] = bflo(w.w); f[7] = bfhi(w.w);
}
__device__ __forceinline__ u32x4 pack8(const float (&f)[8]) {
    u32x4 w; w.x = pk2(f[0], f[1]); w.y = pk2(f[2], f[3]); w.z = pk2(f[4], f[5]); w.w = pk2(f[6], f[7]); return w;
}

__device__ __forceinline__ void transpose_item(const float* __restrict__ W, int ldw, int scol0, int k0, int K, bf16* __restrict__ WT, int drow0, float* scr, int lane, int kd0 = -1) {
    if (kd0 < 0) kd0 = k0;
    float v[32];
    const float* src = W + (size_t)(k0 + (lane >> 5)) * ldw + scol0 + (lane & 31);
#pragma unroll
    for (int i = 0; i < 32; ++i) v[i] = src[(size_t)(2 * i) * ldw];
#pragma unroll
    for (int i = 0; i < 32; ++i) scr[(2 * i + (lane >> 5)) * 33 + (lane & 31)] = v[i];
    asm volatile("s_waitcnt lgkmcnt(0)" ::: "memory");
    const int c = lane & 7;
#pragma unroll
    for (int j = 0; j < 4; ++j) { const int n = (lane >> 3) + 8 * j; const float* s = scr + (8 * c) * 33 + n;
        u32x4 o; o.x = pk2(s[0 * 33], s[1 * 33]); o.y = pk2(s[2 * 33], s[3 * 33]); o.z = pk2(s[4 * 33], s[5 * 33]); o.w = pk2(s[6 * 33], s[7 * 33]);
        *(u32x4*)(WT + (size_t)(drow0 + n) * K + kd0 + 8 * c) = o; }
    asm volatile("s_waitcnt lgkmcnt(0)" ::: "memory");
}

__device__ __forceinline__ void transpose_item8(const float* __restrict__ W, int ldw, int scol0, int k0, int K, unsigned char* __restrict__ WT, int drow0, float* scr, int lane, float sc) {
    float v[32];
    const float* src = W + (size_t)(k0 + (lane >> 5)) * ldw + scol0 + (lane & 31);
#pragma unroll
    for (int i = 0; i < 32; ++i) v[i] = src[(size_t)(2 * i) * ldw];
#pragma unroll
    for (int i = 0; i < 32; ++i) scr[(2 * i + (lane >> 5)) * 33 + (lane & 31)] = v[i] * sc;
    asm volatile("s_waitcnt lgkmcnt(0)" ::: "memory");
    const int c = lane & 7;
#pragma unroll
    for (int j = 0; j < 4; ++j) { const int n = (lane >> 3) + 8 * j; const float* s = scr + (8 * c) * 33 + n;
        u32x2 o; o.x = pk4_fp8(s[0 * 33], s[1 * 33], s[2 * 33], s[3 * 33]); o.y = pk4_fp8(s[4 * 33], s[5 * 33], s[6 * 33], s[7 * 33]);
        *(u32x2*)(WT + (size_t)(drow0 + n) * K + k0 + 8 * c) = o; }
    asm volatile("s_waitcnt lgkmcnt(0)" ::: "memory");
}
__device__ __forceinline__ float gate_scale(const unsigned* w) { const unsigned b = __hip_atomic_load(w, __ATOMIC_RELAXED, __HIP_MEMORY_SCOPE_AGENT); const int e = (int)((b >> 23) & 255u) - 126;
    const int k = 8 - e, kc = k < -100 ? -100 : (k > 100 ? 100 : k); return __builtin_bit_cast(float, (unsigned)(kc + 127) << 23); }
__device__ __forceinline__ void prologue_transposes(const Params& p, int l, float* scr, int gw, int ngw, int lane) {
    unsigned char* wl = p.ws + WS_W + (size_t)l * W_LAYER;
    bf16* Wcat = (bf16*)(wl + WO_CAT); bf16* Wup = (bf16*)(wl + WO_UP); bf16* Wb = (bf16*)(wl + WO_B); bf16* Wout = (bf16*)(wl + WO_OUT);
    const float* w_in = p.in[2] + (size_t)l * DM * DIN;
    const float* w_gate = p.in[15] + (size_t)l * 3 * DM * DM;
    const float* w_uq = p.in[5] + (size_t)l * 512 * 768;
    const float* w_ukv = p.in[6] + (size_t)l * 512 * 1024;
    const float* w_br = p.in[17] + (size_t)l * 3 * 512 * DM;
    const float* w_out = p.in[18] + (size_t)l * DM * DM;
    constexpr int I1 = 113 * 32, I2 = 3 * 64 * 32, I3 = 24 * 8, I4 = 32 * 8, I5 = 3 * 64 * 8, I6 = 64 * 32;
    constexpr int NIT = I1 + I2 + I3 + I4 + I5 + I6;
    for (int it = gw; it < NIT; it += ngw) {
        int r = it;
        if (r < I1) { const int cb = r / 32, kb = r % 32; const int n0 = cb * 32;
            const int sc = n0 < 1024 ? n0 : (n0 < 3584 ? n0 + 32 : n0 - 3584 + 1024);
            transpose_item(w_in, DIN, sc, kb * 64, DM, Wcat, n0, scr, lane); continue; } r -= I1;
        if (r < I2) { continue; } r -= I2;
        if (r < I3) { const int cb = r / 8, kb = r % 8;
            int sc, dr; if (cb < 16) { const int h = cb >> 1, hf = cb & 1; sc = h * 96 + 32 * hf; dr = h * 64 + 32 * hf; } else { const int h = cb - 16; sc = h * 96 + 64; dr = 512 + h * 32; }
            transpose_item(w_uq, 768, sc, kb * 64, 512, Wup, dr, scr, lane); continue; } r -= I3;
        if (r < I4) { const int cb = r / 8, kb = r % 8;
            const int v = cb >> 4, h = (cb & 15) >> 1, hf = cb & 1; const int sc = h * 128 + 64 * v + 32 * hf, dr = 768 + 512 * v + h * 64 + 32 * hf;
            transpose_item(w_ukv, 1024, sc, kb * 64, 512, Wup, dr, scr, lane); continue; } r -= I4;
        if (r < I5) { const int n = r / 512, q = r % 512, cb = q / 8, kb = q % 8;
            transpose_item(w_br + (size_t)n * 512 * DM, DM, cb * 32, kb * 64, 1536, Wb, cb * 32, scr, lane, n * 512 + kb * 64); continue; } r -= I5;
        { const int cb = r / 32, kb = r % 32; transpose_item(w_out, DM, cb * 32, kb * 64, DM, Wout, cb * 32, scr, lane); }
    }
    for (int i = gw * 64 + lane; i < 224 * 256; i += ngw * 64) { ((u32x4*)(Wcat + (size_t)DIN * DM))[i] = (u32x4){0u, 0u, 0u, 0u}; }
    bf16* sg = (bf16*)(wl + WO_SGU); const float* sw = p.in[13] + (size_t)l * 4 * 128 * 128;
    for (int i = gw * 64 + lane; i < 4 * 128 * 128; i += ngw * 64) { const int s = i & 127, t = (i >> 7) & 127; const bool ok = (s >> 6) <= (t >> 6); sg[i] = (bf16)f2bf(ok ? sw[i] : 0.f); }
}

__device__ __forceinline__ void prologue_rope(const Params& p, int gtid, int nthr) {
    float* tab = (float*)(p.ws + WS_ROPE);
    for (int i = gtid; i < SEQ * 24; i += nthr) {
        const int pos = i / 24, j = i % 24;
        const int jj = j < 8 ? 2 * j : j - 8;
        float invf;
        switch (jj) { case 0: invf = 1.000000000e+00f; break; case 1: invf = 4.403665960e-01f; break; case 2: invf = 1.939227432e-01f; break; case 3: invf = 8.539710194e-02f; break;
            case 4: invf = 3.760603070e-02f; break; case 5: invf = 1.656044088e-02f; break; case 6: invf = 7.292664610e-03f; break; case 7: invf = 3.211446106e-03f; break;
            case 8: invf = 1.414213562e-03f; break; case 9: invf = 6.227724371e-04f; break; case 10: invf = 2.742481884e-04f; break; case 11: invf = 1.207697351e-04f; break;
            case 12: invf = 5.318295734e-05f; break; case 13: invf = 2.341999971e-05f; break; case 14: invf = 1.031338525e-05f; break; default: invf = 4.541670478e-06f; break; }
        int co, so; if (j < 8) { co = j; so = 8 + j; } else { co = 16 + (j - 8); so = 32 + (j - 8); }
        const float ang = (float)pos * invf; float sn, cs; sincosf(ang, &sn, &cs);
        tab[pos * 48 + co] = cs; tab[pos * 48 + so] = sn;
    }
}

__device__ __forceinline__ void fold_item(const Params& p, int l, int item, float* lds, int tid) {
    const int hc = item >> 4, mt = item & 15, c = hc & 1, m0 = mt * 128;
    const float* Wq = p.in[20] + (size_t)l * DM * DM; const float* keys = p.in[21] + (size_t)l * 2 * 128 * 128 + (size_t)c * 128 * 128;
    bf16* WPQ = (bf16*)(p.ws + WS_W + (size_t)l * W_LAYER + WO_PQ);
    float* As = lds; float* Bs = lds + 128 * 68;
    const int tn = tid & 31, tm = tid >> 5;
    float acc[4][8];
#pragma unroll
    for (int i = 0; i < 4; ++i)
#pragma unroll
        for (int j = 0; j < 8; ++j) acc[i][j] = 0.f;
    for (int dh = 0; dh < 2; ++dh) {
        __syncthreads();
        for (int i = tid; i < 128 * 16; i += 512) { const int r = i >> 4, q = i & 15;
            *(f32x4*)(As + r * 68 + 4 * q) = *(const f32x4*)(Wq + (size_t)(m0 + r) * DM + hc * 128 + dh * 64 + 4 * q);
            *(f32x4*)(Bs + r * 68 + 4 * q) = *(const f32x4*)(keys + r * 128 + dh * 64 + 4 * q); }
        __syncthreads();
#pragma unroll 2
        for (int d = 0; d < 64; d += 4) {
            f32x4 b4[4], a4[8];
#pragma unroll
            for (int i = 0; i < 4; ++i) b4[i] = *(const f32x4*)(Bs + (tn + 32 * i) * 68 + d);
#pragma unroll
            for (int j = 0; j < 8; ++j) a4[j] = *(const f32x4*)(As + (8 * tm + j) * 68 + d);
#pragma unroll
            for (int i = 0; i < 4; ++i)
#pragma unroll
                for (int j = 0; j < 8; ++j) acc[i][j] += (b4[i].x * a4[j].x + b4[i].y * a4[j].y) + (b4[i].z * a4[j].z + b4[i].w * a4[j].w);
        }
    }
#pragma unroll
    for (int i = 0; i < 4; ++i) *(u32x4*)(WPQ + (size_t)(hc * 128 + tn + 32 * i) * DM + m0 + 8 * tm) = pack8(acc[i]);
}

__device__ __forceinline__ void rms_row_to_bf16(const float* xrow, const float* gain, bf16* orow, int lane, unsigned char* o8 = nullptr) {
    f32x4 v[8]; float s = 0.f;
#pragma unroll
    for (int j = 0; j < 8; ++j) { v[j] = ((const f32x4*)xrow)[lane + 64 * j]; s += (v[j].x * v[j].x + v[j].y * v[j].y) + (v[j].z * v[j].z + v[j].w * v[j].w); }
    const float rstd = rsqrtf(wave_sum(s) * (1.f / DM) + NORM_EPS);
#pragma unroll
    for (int j = 0; j < 8; ++j) { const f32x4 g = ((const f32x4*)gain)[lane + 64 * j];
        u32x2 o; o.x = pk2(v[j].x * rstd * g.x, v[j].y * rstd * g.y); o.y = pk2(v[j].z * rstd * g.z, v[j].w * rstd * g.w);
        ((u32x2*)orow)[lane + 64 * j] = o;
        if (o8) ((unsigned*)o8)[lane + 64 * j] = pk4_fp8(v[j].x * rstd * g.x, v[j].y * rstd * g.y, v[j].z * rstd * g.z, v[j].w * rstd * g.w); }
}

__device__ __forceinline__ void add_rms_row(const float* xin, const bf16* dl, float* xout, const float* gain, bf16* orow, float* hs, int lane) {
    f32x4 v[8]; float s = 0.f;
#pragma unroll
    for (int j = 0; j < 8; ++j) { v[j] = ((const f32x4*)xin)[lane + 64 * j]; const u32x2 d = ((const u32x2*)dl)[lane + 64 * j];
        v[j].x += bflo(d.x); v[j].y += bfhi(d.x); v[j].z += bflo(d.y); v[j].w += bfhi(d.y);
        if (xout) ((f32x4*)xout)[lane + 64 * j] = v[j];
        s += (v[j].x * v[j].x + v[j].y * v[j].y) + (v[j].z * v[j].z + v[j].w * v[j].w); }
    const float rstd = rsqrtf(wave_sum(s) * (1.f / DM) + NORM_EPS);
    float mx = 0.f;
#pragma unroll
    for (int j = 0; j < 8; ++j) { const f32x4 g = ((const f32x4*)gain)[lane + 64 * j];
        u32x2 o; o.x = pk2(v[j].x * rstd * g.x, v[j].y * rstd * g.y); o.y = pk2(v[j].z * rstd * g.z, v[j].w * rstd * g.w);
        ((u32x2*)orow)[lane + 64 * j] = o;
        v[j].x = bflo(o.x); v[j].y = bfhi(o.x); v[j].z = bflo(o.y); v[j].w = bfhi(o.y);
        mx = fmaxf(mx, fmaxf(fmaxf(fabsf(v[j].x), fabsf(v[j].y)), fmaxf(fabsf(v[j].z), fabsf(v[j].w)))); }
#pragma unroll
    for (int of = 1; of < 64; of <<= 1) mx = fmaxf(mx, __shfl_xor(mx, of));
    const float hscale = fmaxf(mx, 1e-30f) * (1.f / 127.f), ih = 1.f / hscale; int isum = 0;
#pragma unroll
    for (int j = 0; j < 8; ++j) isum += ((int)rintf(v[j].x * ih) + (int)rintf(v[j].y * ih)) + ((int)rintf(v[j].z * ih) + (int)rintf(v[j].w * ih));
    const float h8sum = wave_sum((float)isum);
    if (lane == 0) { hs[0] = hscale; hs[1] = h8sum; }
}

__device__ __forceinline__ void prep1_row(const Params& p, int l, int t, int lane) {
    bf16* z = (bf16*)(p.ws + WS_Z) + (size_t)t * ZP;
    const float* rope = (const float*)(p.ws + WS_ROPE) + (size_t)(t & (SEQ - 1)) * 48;
    float f[8];
#pragma unroll
    for (int seg = 0; seg < 2; ++seg) {
        const float* g = (seg == 0 ? p.in[3] : p.in[4]) + (size_t)l * 512;
        u32x4* ptr = (u32x4*)(z + (seg == 0 ? ZC_CQ : ZC_CKV)) + lane;
        unpack8(*ptr, f); float s = 0.f;
#pragma unroll
        for (int i = 0; i < 8; ++i) s += f[i] * f[i];
        const float rstd = rsqrtf(wave_sum(s) * (1.f / 512.f) + NORM_EPS);
#pragma unroll
        for (int i = 0; i < 8; ++i) f[i] = f[i] * rstd * g[lane * 8 + i];
        *ptr = pack8(f);
    }
#pragma unroll
    for (int seg = 0; seg < 2; ++seg) {
        const float* g = p.in[9] + (size_t)l * 128 + seg * 64;
        u32x4* ptr = (u32x4*)(z + (seg == 0 ? ZC_DQ : ZC_DK)) + lane;
        unpack8(*ptr, f); float s = 0.f;
#pragma unroll
        for (int i = 0; i < 8; ++i) s += f[i] * f[i];
        s += __shfl_xor(s, 1); s += __shfl_xor(s, 2); s += __shfl_xor(s, 4);
        const float rstd = rsqrtf(s * (1.f / 64.f) + NORM_EPS);
        const int d0 = (lane & 7) * 8;
#pragma unroll
        for (int i = 0; i < 8; ++i) f[i] = f[i] * rstd * g[d0 + i];
        float o[8];
#pragma unroll
        for (int i = 0; i < 8; ++i) o[i] = __shfl_xor(f[i], 1);
        if ((lane & 7) == 0) {
#pragma unroll
            for (int i = 0; i < 8; ++i) f[i] = f[i] * rope[i] - o[i] * rope[8 + i];
        } else if ((lane & 7) == 1) {
#pragma unroll
            for (int i = 0; i < 8; ++i) f[i] = f[i] * rope[i] + o[i] * rope[8 + i];
        }
        if (seg == 0) {
#pragma unroll
            for (int i = 0; i < 8; ++i) f[i] *= 0.125f * LOG2E;
        }
        *ptr = pack8(f);
    }
    {
        u32x4* ptr = (u32x4*)(z + ZC_SU) + lane;
        unpack8(*ptr, f);
#pragma unroll
        for (int i = 0; i < 8; ++i) f[i] = gelu_tanh(f[i]);
        *ptr = pack8(f);
    }
    {
        const float* g = p.in[12] + (size_t)l * 512;
        u32x4* ptr = (u32x4*)(z + ZC_SV) + lane;
        unpack8(*ptr, f); float s = 0.f;
#pragma unroll
        for (int i = 0; i < 8; ++i) { f[i] = gelu_tanh(f[i]); s += f[i] * f[i]; }
        const float rstd = rsqrtf(wave_sum(s) * (1.f / 512.f) + NORM_EPS);
#pragma unroll
        for (int i = 0; i < 8; ++i) f[i] = f[i] * rstd * g[lane * 8 + i];
        *ptr = pack8(f);
    }
    {
        const float* g = p.in[8] + (size_t)l * 64 + 32;
        const int ll = lane & 3;
        const u32x4 w = *((const u32x4*)(z + ZC_KR) + ll);
        unpack8(w, f); float s = 0.f;
#pragma unroll
        for (int i = 0; i < 8; ++i) s += f[i] * f[i];
        s += __shfl_xor(s, 1); s += __shfl_xor(s, 2);
        const float rstd = rsqrtf(s * (1.f / 32.f) + NORM_EPS);
#pragma unroll
        for (int i = 0; i < 8; ++i) f[i] = f[i] * rstd * g[ll * 8 + i];
        float o[8];
#pragma unroll
        for (int i = 0; i < 8; ++i) o[i] = __shfl_xor(f[i], 2);
        const int fi = (ll & 1) * 8;
        if (ll < 2) {
#pragma unroll
            for (int i = 0; i < 8; ++i) f[i] = f[i] * rope[16 + fi + i] - o[i] * rope[32 + fi + i];
        } else {
#pragma unroll
            for (int i = 0; i < 8; ++i) f[i] = f[i] * rope[16 + fi + i] + o[i] * rope[32 + fi + i];
        }
        if (lane < 32) { bf16* km = (bf16*)(p.ws + WS_KM) + (size_t)t * 768 + (lane >> 2) * 96 + 64 + ll * 8; *(u32x4*)km = pack8(f); }
    }
}

__device__ __forceinline__ void prep2_row(const Params& p, int l, int t, int lane) {
    const bf16* qr = (const bf16*)(p.ws + WS_QR) + (size_t)t * 768;
    const bf16* kvr = (const bf16*)(p.ws + WS_KVR) + (size_t)t * 1024;
    bf16* qm = (bf16*)(p.ws + WS_QM) + (size_t)t * 768;
    bf16* km = (bf16*)(p.ws + WS_KM) + (size_t)t * 768;
    const float* rope = (const float*)(p.ws + WS_ROPE) + (size_t)(t & (SEQ - 1)) * 48;
    const float* ng = p.in[7] + (size_t)l * 128;
    const float* rg = p.in[8] + (size_t)l * 64;
    const float qscale = 0.10206207261596577f * LOG2E;
    float f[8];
    const int h = lane >> 3, d0 = (lane & 7) * 8;
    {
        unpack8(*((const u32x4*)qr + lane), f); float s = 0.f;
#pragma unroll
        for (int i = 0; i < 8; ++i) s += f[i] * f[i];
        s += __shfl_xor(s, 1); s += __shfl_xor(s, 2); s += __shfl_xor(s, 4);
        const float rstd = rsqrtf(s * (1.f / 64.f) + NORM_EPS) * qscale;
#pragma unroll
        for (int i = 0; i < 8; ++i) f[i] = f[i] * rstd * ng[d0 + i];
        *(u32x4*)(qm + h * 96 + d0) = pack8(f);
    }
    {
        unpack8(*((const u32x4*)kvr + lane), f); float s = 0.f;
#pragma unroll
        for (int i = 0; i < 8; ++i) s += f[i] * f[i];
        s += __shfl_xor(s, 1); s += __shfl_xor(s, 2); s += __shfl_xor(s, 4);
        const float rstd = rsqrtf(s * (1.f / 64.f) + NORM_EPS);
#pragma unroll
        for (int i = 0; i < 8; ++i) f[i] = f[i] * rstd * ng[64 + d0 + i];
        *(u32x4*)(km + h * 96 + d0) = pack8(f);
    }
    {
        const int l5 = lane & 31, hh = l5 >> 2, ll = l5 & 3;
        unpack8(*((const u32x4*)(qr + 512) + l5), f); float s = 0.f;
#pragma unroll
        for (int i = 0; i < 8; ++i) s += f[i] * f[i];
        s += __shfl_xor(s, 1); s += __shfl_xor(s, 2);
        const float rstd = rsqrtf(s * (1.f / 32.f) + NORM_EPS);
#pragma unroll
        for (int i = 0; i < 8; ++i) f[i] = f[i] * rstd * rg[ll * 8 + i];
        float o[8];
#pragma unroll
        for (int i = 0; i < 8; ++i) o[i] = __shfl_xor(f[i], 2);
        const int fi = (ll & 1) * 8;
        if (ll < 2) {
#pragma unroll
            for (int i = 0; i < 8; ++i) f[i] = (f[i] * rope[16 + fi + i] - o[i] * rope[32 + fi + i]) * qscale;
        } else {
#pragma unroll
            for (int i = 0; i < 8; ++i) f[i] = (f[i] * rope[16 + fi + i] + o[i] * rope[32 + fi + i]) * qscale;
        }
        if (lane < 32) *(u32x4*)(qm + hh * 96 + 64 + ll * 8) = pack8(f);
    }
}

__device__ __forceinline__ float diff_lambda(const Params& p, int l, int lane) {
    const float* lv = p.in[10] + (size_t)l * 256;
    const float a = wave_sum(lv[lane] * lv[64 + lane]), b = wave_sum(lv[128 + lane] * lv[192 + lane]);
    const float lambda_init = 0.8f - 0.6f * expf(-0.3f * (float)l);
    return expf(a) - expf(b) + lambda_init;
}

typedef float f32x2 __attribute__((ext_vector_type(2)));
typedef _Float16 f16x32 __attribute__((ext_vector_type(32)));
typedef float f32x32 __attribute__((ext_vector_type(32)));
typedef unsigned u32x6 __attribute__((ext_vector_type(6)));
__device__ __forceinline__ void q4_row(const float* __restrict__ src, unsigned char* __restrict__ dst, float* scl, int lane) {
    f32x4 v[8]; float ss = 0.f;
#pragma unroll
    for (int j = 0; j < 8; ++j) { v[j] = *(const f32x4*)(src + 256 * (lane >> 3) + 32 * j + 4 * (lane & 7)); ss += (v[j].x * v[j].x + v[j].y * v[j].y) + (v[j].z * v[j].z + v[j].w * v[j].w); }
    const float sc = fmaxf(0.5f * sqrtf(wave_sum(ss) * (1.f / DM)), 1e-30f), is = 1.f / sc;
    u32x4 w;
#pragma unroll
    for (int d = 0; d < 4; ++d) { unsigned x = 0;
        const f32x4 a = v[2 * d], b = v[2 * d + 1];
        x = __builtin_amdgcn_cvt_scalef32_pk_fp4_f32(x, fminf(fmaxf(a.x * is, -6.f), 6.f), fminf(fmaxf(a.y * is, -6.f), 6.f), 1.0f, 0);
        x = __builtin_amdgcn_cvt_scalef32_pk_fp4_f32(x, fminf(fmaxf(a.z * is, -6.f), 6.f), fminf(fmaxf(a.w * is, -6.f), 6.f), 1.0f, 1);
        x = __builtin_amdgcn_cvt_scalef32_pk_fp4_f32(x, fminf(fmaxf(b.x * is, -6.f), 6.f), fminf(fmaxf(b.y * is, -6.f), 6.f), 1.0f, 2);
        x = __builtin_amdgcn_cvt_scalef32_pk_fp4_f32(x, fminf(fmaxf(b.z * is, -6.f), 6.f), fminf(fmaxf(b.w * is, -6.f), 6.f), 1.0f, 3);
        w[d] = x; }
    *(u32x4*)(dst + (size_t)(lane >> 3) * (NEXP * 128) + 16 * (lane & 7)) = w;
    if (lane == 0) *scl = sc;
}
__device__ __forceinline__ void q4u_row(const float* __restrict__ src, unsigned char* __restrict__ dst, float* scl, int lane) {
    f32x4 v[8]; float ss = 0.f;
#pragma unroll
    for (int j = 0; j < 8; ++j) { v[j] = *(const f32x4*)(src + 256 * (lane >> 3) + 32 * j + 4 * (lane & 7)); ss += (v[j].x * v[j].x + v[j].y * v[j].y) + (v[j].z * v[j].z + v[j].w * v[j].w); }
    const float step = fmaxf(0.35f * sqrtf(wave_sum(ss) * (1.f / DM)), 1e-30f), is = 1.f / step;
    u32x4 w;
#pragma unroll
    for (int d = 0; d < 4; ++d) { unsigned x = 0;
#pragma unroll
        for (int e = 0; e < 8; ++e) { const float f = v[2 * d + (e >> 2)][e & 3]; const int q = (int)fminf(fmaxf(rintf(f * is), -8.f), 7.f) + 8; x |= (unsigned)q << (4 * e); }
        w[d] = x; }
    *(u32x4*)(dst + (size_t)(lane >> 3) * (NEXP * 128) + 16 * (lane & 7)) = w;
    if (lane == 0) *scl = step;
}
__device__ __forceinline__ int f2key(float f) { const int b = __builtin_bit_cast(int, f); return b ^ ((b >> 31) & 0x7fffffff); }
__device__ __forceinline__ float key2f(int k) { const int b = k ^ ((k >> 31) & 0x7fffffff); return __builtin_bit_cast(float, b & ~127); }
__device__ __forceinline__ void topk_lane(const float* __restrict__ sc, int (&idxo)[16], float (&gwo)[16]) {
    float av[2][16]; int ai[2][16];
#pragma unroll
    for (int c = 0; c < 2; ++c) {
        int lst[16];
#pragma unroll
        for (int j = 0; j < 16; ++j) lst[j] = (int)0x80000000;
#pragma unroll 1
        for (int i0 = 0; i0 < 128; i0 += 32) {
            f32x4 v[8];
#pragma unroll
            for (int q = 0; q < 8; ++q) v[q] = *(const f32x4*)(sc + c * 128 + i0 + 4 * q);
#pragma unroll
            for (int q = 0; q < 8; ++q)
#pragma unroll
                for (int e = 0; e < 4; ++e) { int key = (f2key(v[q][e]) & ~127) | (127 - (i0 + 4 * q + e));
#pragma unroll
                    for (int j = 0; j < 16; ++j) { const int hi = max(lst[j], key); key = min(lst[j], key); lst[j] = hi; } }
        }
#pragma unroll
        for (int j = 0; j < 16; ++j) { av[c][j] = key2f(lst[j]); ai[c][j] = 127 - (lst[j] & 127); }
    }
    float lv[16]; int lp[16];
#pragma unroll
    for (int j = 0; j < 16; ++j) { lv[j] = -INFINITY; lp[j] = 0; }
#pragma unroll
    for (int i = 0; i < 16; ++i)
#pragma unroll
        for (int jj = 0; jj < 16; ++jj) if ((i + 1) * (jj + 1) <= 16) {
            float sv = av[0][i] + av[1][jj]; int pay = ai[0][i] * 128 + ai[1][jj];
#pragma unroll
            for (int j = 0; j < 16; ++j) { const bool gt = sv > lv[j]; const float nv = gt ? sv : lv[j]; const int np = gt ? pay : lp[j]; sv = gt ? lv[j] : sv; pay = gt ? lp[j] : pay; lv[j] = nv; lp[j] = np; }
        }
    float sum = 0.f; const float mx = lv[0];
#pragma unroll
    for (int j = 0; j < 16; ++j) { lv[j] = __expf(lv[j] - mx); sum += lv[j]; }
    const float inv = 1.f / sum;
#pragma unroll
    for (int j = 0; j < 16; ++j) { idxo[j] = lp[j]; gwo[j] = lv[j] * inv; }
}
__device__ __forceinline__ float dot_f4(const u32x4 a, const f32x2 (&h)[16]) {
    f32x2 s = {0.f, 0.f};
#pragma unroll
    for (int w = 0; w < 4; ++w) {
        s = __builtin_elementwise_fma(__builtin_amdgcn_cvt_scalef32_pk_f32_fp4(a[w], 1.0f, 0), h[4 * w], s); s = __builtin_elementwise_fma(__builtin_amdgcn_cvt_scalef32_pk_f32_fp4(a[w], 1.0f, 1), h[4 * w + 1], s);
        s = __builtin_elementwise_fma(__builtin_amdgcn_cvt_scalef32_pk_f32_fp4(a[w], 1.0f, 2), h[4 * w + 2], s); s = __builtin_elementwise_fma(__builtin_amdgcn_cvt_scalef32_pk_f32_fp4(a[w], 1.0f, 3), h[4 * w + 3], s); }
    return s.x + s.y;
}
__device__ __forceinline__ int dot_u4i(const u32x4 a, const int (&he)[4], const int (&ho)[4]) {
    int acc = 0;
#pragma unroll
    for (int w = 0; w < 4; ++w) { acc = __builtin_amdgcn_sdot4((int)(a[w] & 0x0F0F0F0Fu), he[w], acc, false); acc = __builtin_amdgcn_sdot4((int)((a[w] >> 4) & 0x0F0F0F0Fu), ho[w], acc, false); }
    return acc;
}
typedef _Float16 h16x2 __attribute__((ext_vector_type(2)));
__device__ __forceinline__ void axpy_h4(const u32x4 a, unsigned c2bits, h16x2 (&o)[16]) {
    const h16x2 c2 = __builtin_bit_cast(h16x2, c2bits);
#pragma unroll
    for (int w = 0; w < 4; ++w) {
#pragma unroll
        for (int b = 0; b < 4; ++b) { const h16x2 v = b == 0 ? __builtin_bit_cast(h16x2, __builtin_amdgcn_cvt_scalef32_pk_f16_fp4(a[w], 1.0f, 0)) : b == 1 ? __builtin_bit_cast(h16x2, __builtin_amdgcn_cvt_scalef32_pk_f16_fp4(a[w], 1.0f, 1))
                                                     : b == 2 ? __builtin_bit_cast(h16x2, __builtin_amdgcn_cvt_scalef32_pk_f16_fp4(a[w], 1.0f, 2)) : __builtin_bit_cast(h16x2, __builtin_amdgcn_cvt_scalef32_pk_f16_fp4(a[w], 1.0f, 3));
            o[4 * w + b] = __builtin_elementwise_fma(c2, v, o[4 * w + b]); } }
}
__device__ __forceinline__ int grp8_sum(int x) {
    x += __builtin_amdgcn_update_dpp(0, x, 0xB1, 0xF, 0xF, true);
    x += __builtin_amdgcn_update_dpp(0, x, 0x4E, 0xF, 0xF, true);
    x += __builtin_amdgcn_update_dpp(0, x, 0x141, 0xF, 0xF, true);
    return x;
}
__device__ __forceinline__ float grp8_sumf(float x) {
    x += __builtin_bit_cast(float, __builtin_amdgcn_update_dpp(0, __builtin_bit_cast(int, x), 0xB1, 0xF, 0xF, true));
    x += __builtin_bit_cast(float, __builtin_amdgcn_update_dpp(0, __builtin_bit_cast(int, x), 0x4E, 0xF, 0xF, true));
    x += __builtin_bit_cast(float, __builtin_amdgcn_update_dpp(0, __builtin_bit_cast(int, x), 0x141, 0xF, 0xF, true));
    return x;
}
constexpr int PEER_LDS_WAVE = 12288;
template <int MODE = 0> __device__ __forceinline__ void peer_octets(const Params& p, int l, int gw, int ngw, int lane, const float* gain_next, const float* xin, float* xout, LAS unsigned char* wl) {
    const __amdgpu_buffer_rsrc_t RU = __builtin_amdgcn_make_buffer_rsrc((void*)(p.ws + WS_U8 + (size_t)l * NEXP * QROW), 0, NEXP * QROW, 0x00020000);
    const __amdgpu_buffer_rsrc_t RV = __builtin_amdgcn_make_buffer_rsrc((void*)(p.ws + WS_V8 + (size_t)l * NEXP * QROW), 0, NEXP * QROW, 0x00020000);
    const float* PSU = (const float*)(p.ws + WS_PS) + (size_t)l * NEXP; const float* PSV = PSU + (size_t)DEPTH * NEXP;
    const int tl = lane >> 3, c = lane & 7, c16 = 16 * c;
    LAS u32x4* pr4 = (LAS u32x4*)(wl + tl * 1024);
    LAS int* acc = (LAS int*)(wl + 8192 + tl * 512);
    for (int oc = gw; oc < T / 8; oc += ngw) {
        const int t = 8 * oc + tl;
        const bf16* hb = (const bf16*)(p.ws + WS_HB) + (size_t)t * DM + 4 * c;
        int myidx[16]; float mygw[16], mysu[16], mysv[16];
        topk_lane((const float*)(p.ws + WS_SC) + ((size_t)t * 8 + c) * 256, myidx, mygw);
#pragma unroll
        for (int i = 0; i < 16; ++i) { mysu[i] = PSU[myidx[i]]; mysv[i] = PSV[myidx[i]]; }
#pragma unroll
        for (int i = 0; i < 8; ++i) { pr4[8 * c + i] = (u32x4){(unsigned)myidx[2 * i] * 128u, 0u, (unsigned)myidx[2 * i + 1] * 128u, 0u}; }
#pragma unroll
        for (int i = 0; i < 4; ++i) *(LAS u32x4*)(acc + 16 * c + 4 * i) = (u32x4){0u, 0u, 0u, 0u};
        const f32x2 hs = *(const f32x2*)((const float*)(p.ws + WS_HS) + 2 * (size_t)t);
        const float hscale = hs.x, h8sum = hs.y, ih = 1.f / hscale;
        u32x4 bufA[8], bufB[8]; unsigned cfA[8], cfB[8];
#define PEER_ISSUE(buf, cf, R, b) do { const int j_ = (b) & 15; const int so_ = ((b) >> 4) * (NEXP * 128); \
            const u32x4 q0_ = pr4[4 * j_], q1_ = pr4[4 * j_ + 1], q2_ = pr4[4 * j_ + 2], q3_ = pr4[4 * j_ + 3]; \
            cf[0] = q0_.y; cf[1] = q0_.w; cf[2] = q1_.y; cf[3] = q1_.w; cf[4] = q2_.y; cf[5] = q2_.w; cf[6] = q3_.y; cf[7] = q3_.w; \
            buf[0] = __builtin_amdgcn_raw_buffer_load_b128(R, (int)q0_.x + c16, so_, 0); buf[1] = __builtin_amdgcn_raw_buffer_load_b128(R, (int)q0_.z + c16, so_, 0); \
            buf[2] = __builtin_amdgcn_raw_buffer_load_b128(R, (int)q1_.x + c16, so_, 0); buf[3] = __builtin_amdgcn_raw_buffer_load_b128(R, (int)q1_.z + c16, so_, 0); \
            buf[4] = __builtin_amdgcn_raw_buffer_load_b128(R, (int)q2_.x + c16, so_, 0); buf[5] = __builtin_amdgcn_raw_buffer_load_b128(R, (int)q2_.z + c16, so_, 0); \
            buf[6] = __builtin_amdgcn_raw_buffer_load_b128(R, (int)q3_.x + c16, so_, 0); buf[7] = __builtin_amdgcn_raw_buffer_load_b128(R, (int)q3_.z + c16, so_, 0); } while (0)
        int he[4], ho[4];
#define PEER_HLOAD(sl) do { float hf_[32]; \
            _Pragma("unroll") for (int q = 0; q < 8; ++q) { const u32x2 w_ = *(const u32x2*)(hb + 256 * (sl) + 32 * q); hf_[4 * q] = bflo(w_.x); hf_[4 * q + 1] = bfhi(w_.x); hf_[4 * q + 2] = bflo(w_.y); hf_[4 * q + 3] = bfhi(w_.y); } \
            _Pragma("unroll") for (int w = 0; w < 4; ++w) { unsigned e_ = 0, od_ = 0; \
                _Pragma("unroll") for (int j = 0; j < 4; ++j) { const int qe = (int)rintf(hf_[8 * w + 2 * j] * ih), qo = (int)rintf(hf_[8 * w + 2 * j + 1] * ih); e_ |= (unsigned)(qe & 255) << (8 * j); od_ |= (unsigned)(qo & 255) << (8 * j); } \
                he[w] = (int)e_; ho[w] = (int)od_; } } while (0)
#define PEER_CONSUME_U(buf, b) do { int mine_ = 0; \
            _Pragma("unroll") for (int i = 0; i < 8; ++i) { const int tot_ = grp8_sum(dot_u4i(buf[i], he, ho)); mine_ = (c == i) ? tot_ : mine_; } \
            __hip_atomic_fetch_add(acc + 8 * ((b) & 15) + c, mine_, __ATOMIC_RELAXED, __HIP_MEMORY_SCOPE_WAVEFRONT); } while (0)
        if (!(MODE & 1)) {
        PEER_ISSUE(bufA, cfA, RU, 0);
#pragma unroll 1
        for (int b = 0; b < 128; b += 2) {
            if ((b & 15) == 0) PEER_HLOAD(b >> 4);
            PEER_ISSUE(bufB, cfB, RU, b + 1);
            __builtin_amdgcn_sched_barrier(0);
            PEER_CONSUME_U(bufA, b);
            __builtin_amdgcn_sched_barrier(0);
            if (b + 2 < 128) PEER_ISSUE(bufA, cfA, RU, b + 2);
            __builtin_amdgcn_sched_barrier(0);
            PEER_CONSUME_U(bufB, b + 1);
            __builtin_amdgcn_sched_barrier(0);
        }
        }
#pragma unroll
        for (int i = 0; i < 16; ++i) { const float a = ((float)acc[16 * c + i] - 8.f * h8sum) * mysu[i] * hscale;
            const _Float16 ch = (_Float16)(mygw[i] * gelu_tanh(a) * mysv[i] * 256.f);
            ((LAS unsigned*)pr4)[2 * (16 * c + i) + 1] = __builtin_bit_cast(unsigned, (h16x2){ch, ch}); }
        h16x2 o[16]; f32x4 xr[8]; float ss = 0.f;
#pragma unroll
        for (int i = 0; i < 16; ++i) o[i] = (h16x2){(_Float16)0.f, (_Float16)0.f};
#pragma unroll
        for (int q = 0; q < 8; ++q) xr[q] = (f32x4){0.f, 0.f, 0.f, 0.f};
        const float* xrow = xin + (size_t)t * DM + 4 * c; float* xwrow = xout + (size_t)t * DM + 4 * c;
#define PEER_CONSUME_V(buf, cf) do { _Pragma("unroll") for (int i = 0; i < 8; ++i) axpy_h4(buf[i], cf[i], o); } while (0)
        if (!(MODE & 2)) {
        PEER_ISSUE(bufA, cfA, RV, 0);
#pragma unroll 1
        for (int b = 0; b < 128; b += 2) {
            if ((b & 15) == 12) {
#pragma unroll
                for (int q = 0; q < 8; ++q) xr[q] = *(const f32x4*)(xrow + 256 * (b >> 4) + 32 * q); }
            PEER_ISSUE(bufB, cfB, RV, b + 1);
            __builtin_amdgcn_sched_barrier(0);
            PEER_CONSUME_V(bufA, cfA);
            __builtin_amdgcn_sched_barrier(0);
            if (b + 2 < 128) PEER_ISSUE(bufA, cfA, RV, b + 2);
            __builtin_amdgcn_sched_barrier(0);
            PEER_CONSUME_V(bufB, cfB);
            __builtin_amdgcn_sched_barrier(0);
            if ((b & 15) == 14) {
#pragma unroll
                for (int q = 0; q < 8; ++q) { f32x4 x = xr[q];
                    x.x += (float)o[2 * q].x * (1.f / 256.f); x.y += (float)o[2 * q].y * (1.f / 256.f); x.z += (float)o[2 * q + 1].x * (1.f / 256.f); x.w += (float)o[2 * q + 1].y * (1.f / 256.f);
                    if (!(MODE & 4)) *(f32x4*)(xwrow + 256 * (b >> 4) + 32 * q) = x; ss += (x.x * x.x + x.y * x.y) + (x.z * x.z + x.w * x.w); }
#pragma unroll
                for (int i = 0; i < 16; ++i) o[i] = (h16x2){(_Float16)0.f, (_Float16)0.f};
            }
        }
        }
        if (gain_next) {
            const float rstd = rsqrtf(grp8_sumf(ss) * (1.f / DM) + NORM_EPS);
            bf16* hw = (bf16*)(p.ws + WS_HB) + (size_t)t * DM + 4 * c; unsigned char* h8w = p.ws + WS_HB8 + (size_t)t * DM + 4 * c;
#pragma unroll 1
            for (int sl = 0; sl < 8; ++sl) {
#pragma unroll
                for (int q = 0; q < 8; ++q) { const int e0 = 256 * sl + 32 * q; const f32x4 x = *(const f32x4*)(xwrow + e0); const f32x4 g = *(const f32x4*)(gain_next + e0 + 4 * c);
                    u32x2 w; w.x = pk2(x.x * rstd * g.x, x.y * rstd * g.y); w.y = pk2(x.z * rstd * g.z, x.w * rstd * g.w);
                    *(u32x2*)(hw + e0) = w;
                    *(unsigned*)(h8w + e0) = pk4_fp8(x.x * rstd * g.x, x.y * rstd * g.y, x.z * rstd * g.z, x.w * rstd * g.w); }
            }
        }
    }
#undef PEER_ISSUE
#undef PEER_HLOAD
#undef PEER_CONSUME_U
#undef PEER_CONSUME_V
}

namespace pg8 {
#define PG8_LAS __attribute__((address_space(3)))
typedef int v4i32 __attribute__((ext_vector_type(4)));
typedef int v8i32 __attribute__((ext_vector_type(8)));
constexpr int BM = 256, BK = 64, HALF = 128, HTB = HALF * BK * 2, STAGE_BYTES = 8 * HTB, NXCD = 8, WGM = 8;
__host__ __device__ __forceinline__ int lds_byte(int r, int c) { const int st = (r >> 4) * 2 + (c >> 5), rr = r & 15, cc = c & 31, ob = rr * 64 + cc * 2; return st * 1024 + (ob ^ (((ob >> 9) & 1) << 5)); }
__host__ __device__ __forceinline__ void stage_rc(int b, int& R, int& C) { const int st = b / 1024, sb = b % 1024, swz = sb ^ (((sb >> 9) & 1) << 5); R = (st >> 1) * 16 + swz / 64; C = (st & 1) * 32 + (swz % 64) / 2; }
__host__ __device__ __forceinline__ int perm32(int rho) { const int n = rho >> 4, i = rho & 15; return 8 * (i >> 2) + 4 * n + (i & 3); }
struct Unit { int pm, pn; };
struct StaticOrder {
    int nM, nN, nwg, G, c;
    __host__ __device__ void init(int M, int N, int G_, int c_) { nM = M / BM; nN = N / BM; nwg = nM * nN; G = G_; c = c_; }
    __host__ __device__ bool next(int i, Unit& u) const {
        const long L = (long)i * G + c; if (L >= nwg) return false;
        int wgid = (int)L; { const int q = nwg / NXCD, r = nwg % NXCD, xcd = wgid % NXCD, off = wgid / NXCD; wgid = (xcd < r ? xcd * (q + 1) : r * (q + 1) + (xcd - r) * q) + off; }
        const int nig = WGM * nN, gid = wgid / nig, fm = gid * WGM, gsz = (nM - fm) < WGM ? (nM - fm) : WGM;
        u.pm = fm + ((wgid % nig) % gsz); u.pn = (wgid % nig) / gsz; return true;
    }
};
struct MergedOrder {
    StaticOrder base;
    __host__ __device__ bool next(int i, Unit& u) const { const int tile = i / 3, n = i - 3 * tile; Unit b; if (!base.next(tile, b)) return false; u.pm = n * 64 + b.pm; u.pn = n * 8 + b.pn; return true; }
};
struct ZGOrder {
    StaticOrder sz, sg;
    __host__ __device__ void init(int G, int c) { sz.init(T, ZP, G, c); sg.init(T, DM, G, c); }
    __host__ __device__ bool next(int i, Unit& u) const {
        const int nzu = sz.c < sz.nwg ? (sz.nwg - sz.c + sz.G - 1) / sz.G : 0;
        if (i < nzu) return sz.next(i, u);
        const int j = i - nzu, tile = j / 3, n = j - 3 * tile; Unit b; if (!sg.next(tile, b)) return false; u.pm = b.pm; u.pn = 15 + 8 * n + b.pn; return true; }
};
struct ProbGen { const bf16* A; const bf16* Bt; int lda, ldb, K;
    __device__ __forceinline__ const char* Aptr(const Unit& u) const { return (const char*)(A + (size_t)u.pm * BM * lda); }
    __device__ __forceinline__ const char* Bptr(const Unit& u) const { return (const char*)(Bt + (size_t)u.pn * BM * ldb); } };
struct ProbUp { const bf16* Z; const bf16* Wup; int lda, ldb, K;
    __device__ __forceinline__ const char* Aptr(const Unit& u) const { return (const char*)(Z + (size_t)u.pm * BM * ZP + (u.pn < 3 ? ZC_CQ : ZC_CKV)); }
    __device__ __forceinline__ const char* Bptr(const Unit& u) const { return (const char*)(Wup + (size_t)u.pn * BM * 512); } };

__device__ __forceinline__ unsigned cvt_pk_bf16(float lo, float hi) { unsigned r; asm volatile("v_cvt_pk_bf16_f32 %0, %1, %2" : "=v"(r) : "v"(lo), "v"(hi)); return r; }
struct EpiZG { static constexpr bool PERM = true; static constexpr bool HOOK = false; bf16* Z; bf16* G; const float* bg; int noratio;
    __device__ __forceinline__ void operator()(const f32x4 (&acc)[2][2][4][2], const Unit& u, int wr, int wc, int fr, int fq) const {
        const int row0 = u.pm * BM + wr * 64 + fr; const bool gate = u.pn >= 15;
        const int gi = u.pn - 15, n0_ = gi >> 3; const int n = n0_;  const bool rat = n0_ > 0 && !noratio;
        bf16* base = gate ? G + n * DM : Z; const int ld = gate ? NGATE : ZP; const int colt = gate ? (gi & 7) * BM : u.pn * BM; const int col0 = colt + wc * 32 + 8 * fq;
        f32x4 bv[2][2];
#pragma unroll
        for (int bj = 0; bj < 2; ++bj)
#pragma unroll
            for (int nn = 0; nn < 2; ++nn) bv[bj][nn] = gate ? *(const f32x4*)(bg + n * DM + col0 + bj * HALF + 4 * nn) : (f32x4){0.f, 0.f, 0.f, 0.f};
#pragma unroll
        for (int ai = 0; ai < 2; ++ai) {
            u32x4 pw[4][2];
            if (gate && rat) {
#pragma unroll
                for (int m = 0; m < 4; ++m)
#pragma unroll
                    for (int bj = 0; bj < 2; ++bj) pw[m][bj] = *(const u32x4*)(base + (size_t)(row0 + ai * HALF + m * 16) * ld + col0 + bj * HALF - DM);
                __builtin_amdgcn_sched_barrier(0);
            }
#pragma unroll
            for (int m = 0; m < 4; ++m) { bf16* rowp = base + (size_t)(row0 + ai * HALF + m * 16) * ld + col0;
#pragma unroll
                for (int bj = 0; bj < 2; ++bj) { f32x4 v0 = acc[ai][bj][m][0] + bv[bj][0], v1 = acc[ai][bj][m][1] + bv[bj][1];
                    if (gate) {
#pragma unroll
                        for (int j = 0; j < 4; ++j) { v0[j] = fmaxf(__builtin_amdgcn_rcpf(1.f + __builtin_amdgcn_exp2f(-LOG2E * v0[j])), 1e-6f); v1[j] = fmaxf(__builtin_amdgcn_rcpf(1.f + __builtin_amdgcn_exp2f(-LOG2E * v1[j])), 1e-6f); }
                        if (rat) { const u32x4 q = pw[m][bj];
                            const float p8[8] = {bflo(q.x), bfhi(q.x), bflo(q.y), bfhi(q.y), bflo(q.z), bfhi(q.z), bflo(q.w), bfhi(q.w)};
                            u32x4 rw; rw.x = cvt_pk_bf16(p8[0] * __builtin_amdgcn_rcpf(v0[0]), p8[1] * __builtin_amdgcn_rcpf(v0[1])); rw.y = cvt_pk_bf16(p8[2] * __builtin_amdgcn_rcpf(v0[2]), p8[3] * __builtin_amdgcn_rcpf(v0[3]));
                            rw.z = cvt_pk_bf16(p8[4] * __builtin_amdgcn_rcpf(v1[0]), p8[5] * __builtin_amdgcn_rcpf(v1[1])); rw.w = cvt_pk_bf16(p8[6] * __builtin_amdgcn_rcpf(v1[2]), p8[7] * __builtin_amdgcn_rcpf(v1[3]));
                            *(u32x4*)(rowp + bj * HALF - DM) = rw; } }
                    u32x4 w; w.x = cvt_pk_bf16(v0[0], v0[1]); w.y = cvt_pk_bf16(v0[2], v0[3]); w.z = cvt_pk_bf16(v1[0], v1[1]); w.w = cvt_pk_bf16(v1[2], v1[3]);
                    *(u32x4*)(rowp + bj * HALF) = w; } }
        }
    } };
struct EpiG8 { static constexpr bool PERM = true; static constexpr bool HOOK = false; bf16* G; const float* bg; const unsigned* gmax;
    __device__ __forceinline__ void operator()(const f32x4 (&acc)[2][2][4][2], const Unit& u, int wr, int wc, int fr, int fq) const {
        const int row0 = u.pm * BM + wr * 64 + fr, col0 = u.pn * BM + wc * 32 + 8 * fq; const int n = u.pn >> 3; const float is = 1.f / gate_scale(gmax + 64 * n);
        f32x4 bv[2][2];
#pragma unroll
        for (int bj = 0; bj < 2; ++bj)
#pragma unroll
            for (int nn = 0; nn < 2; ++nn) bv[bj][nn] = *(const f32x4*)(bg + col0 + bj * HALF + 4 * nn);
#pragma unroll
        for (int ai = 0; ai < 2; ++ai)
#pragma unroll
            for (int m = 0; m < 4; ++m) { unsigned char* rowp = (unsigned char*)G + (size_t)(row0 + ai * HALF + m * 16) * NGATE + col0;
#pragma unroll
                for (int bj = 0; bj < 2; ++bj) { f32x4 v0 = acc[ai][bj][m][0] * is + bv[bj][0], v1 = acc[ai][bj][m][1] * is + bv[bj][1];
#pragma unroll
                    for (int j = 0; j < 4; ++j) { v0[j] = 256.f * __builtin_amdgcn_rcpf(1.f + __builtin_amdgcn_exp2f(-LOG2E * v0[j])) - 0.5f; v1[j] = 256.f * __builtin_amdgcn_rcpf(1.f + __builtin_amdgcn_exp2f(-LOG2E * v1[j])) - 0.5f; }
                    u32x2 w = {0u, 0u};
                    w.x = __builtin_amdgcn_cvt_pk_u8_f32(v0[0], 0, w.x); w.x = __builtin_amdgcn_cvt_pk_u8_f32(v0[1], 1, w.x); w.x = __builtin_amdgcn_cvt_pk_u8_f32(v0[2], 2, w.x); w.x = __builtin_amdgcn_cvt_pk_u8_f32(v0[3], 3, w.x);
                    w.y = __builtin_amdgcn_cvt_pk_u8_f32(v1[0], 0, w.y); w.y = __builtin_amdgcn_cvt_pk_u8_f32(v1[1], 1, w.y); w.y = __builtin_amdgcn_cvt_pk_u8_f32(v1[2], 2, w.y); w.y = __builtin_amdgcn_cvt_pk_u8_f32(v1[3], 3, w.y);
                    *(u32x2*)(rowp + bj * HALF) = w; } }
    } };
struct EpiUp { static constexpr bool HOOK = false; static constexpr bool PERM = true; bf16* QR; bf16* KVR;
    __device__ __forceinline__ void operator()(const f32x4 (&acc)[2][2][4][2], const Unit& u, int wr, int wc, int fr, int fq) const {
        const int row0 = u.pm * BM + wr * 64 + fr; const bool kv = u.pn >= 3;
        bf16* base = kv ? KVR : QR; const int ld = kv ? 1024 : 768; const int col0 = (kv ? (u.pn - 3) : u.pn) * BM + wc * 32 + 8 * fq;
#pragma unroll
        for (int ai = 0; ai < 2; ++ai)
#pragma unroll
            for (int m = 0; m < 4; ++m) { bf16* rowp = base + (size_t)(row0 + ai * HALF + m * 16) * ld + col0;
#pragma unroll
                for (int bj = 0; bj < 2; ++bj) { const f32x4 v0 = acc[ai][bj][m][0], v1 = acc[ai][bj][m][1];
                    u32x4 w; w.x = cvt_pk_bf16(v0[0], v0[1]); w.y = cvt_pk_bf16(v0[2], v0[3]); w.z = cvt_pk_bf16(v1[0], v1[1]); w.w = cvt_pk_bf16(v1[2], v1[3]);
                    *(u32x4*)(rowp + bj * HALF) = w; } }
    } };
struct EpiMG { static constexpr bool PERM = true; static constexpr bool HOOK = true; bf16* MG; const bf16* R; int nohook;
    template <bool RATIO> __device__ __forceinline__ void scale(f32x4 (&acc)[2][2][4][2], const Unit& u, int wr, int wc, int fr, int fq, int slot) const {
        const __amdgpu_buffer_rsrc_t rs = __builtin_amdgcn_make_buffer_rsrc((void*)R, 0, (int)((size_t)T * NGATE), 0x00020000);
        const int voff = (u.pm * BM + wr * 64 + fr) * NGATE + slot * DM + u.pn * BM + wc * 32 + 8 * fq;
#define MG_DEC(w_, k_) ((float)(((w_) >> (8 * (k_))) & 0xFFu))
#pragma unroll
        for (int ai = 0; ai < 2; ++ai) {
            u32x2 ga[4][2], gb[4][2];
#pragma unroll
            for (int m = 0; m < 4; ++m)
#pragma unroll
                for (int bj = 0; bj < 2; ++bj) { ga[m][bj] = __builtin_amdgcn_raw_buffer_load_b64(rs, voff, (ai * HALF + m * 16) * NGATE + bj * HALF, 0);
                    if (RATIO) gb[m][bj] = __builtin_amdgcn_raw_buffer_load_b64(rs, voff, (ai * HALF + m * 16) * NGATE + DM + bj * HALF, 0); }
            __builtin_amdgcn_sched_barrier(0);
#pragma unroll
            for (int m = 0; m < 4; ++m)
#pragma unroll
                for (int bj = 0; bj < 2; ++bj) { const u32x2 a = ga[m][bj];
                    float f[8];
#pragma unroll
                    for (int j = 0; j < 8; ++j) f[j] = MG_DEC(j < 4 ? a.x : a.y, j & 3) * (1.f / 256.f) + (0.5f / 256.f);
                    if (RATIO) { const u32x2 b = gb[m][bj];
#pragma unroll
                        for (int j = 0; j < 8; ++j) f[j] *= __builtin_amdgcn_rcpf(MG_DEC(j < 4 ? b.x : b.y, j & 3) * (1.f / 256.f) + (0.5f / 256.f)); }
                    acc[ai][bj][m][0][0] *= f[0]; acc[ai][bj][m][0][1] *= f[1]; acc[ai][bj][m][0][2] *= f[2]; acc[ai][bj][m][0][3] *= f[3];
                    acc[ai][bj][m][1][0] *= f[4]; acc[ai][bj][m][1][1] *= f[5]; acc[ai][bj][m][1][2] *= f[6]; acc[ai][bj][m][1][3] *= f[7]; }
            __builtin_amdgcn_sched_barrier(0);
        }
    }
#undef MG_DEC
    __device__ __forceinline__ void hook(f32x4 (&acc)[2][2][4][2], const Unit& u, int wr, int wc, int fr, int fq, int seg) const { if (!nohook) scale<true>(acc, u, wr, wc, fr, fq, seg - 1); }
    __device__ __forceinline__ void operator()(f32x4 (&acc)[2][2][4][2], const Unit& u, int wr, int wc, int fr, int fq) const {
        scale<false>(acc, u, wr, wc, fr, fq, 2);
        const int row0 = u.pm * BM + wr * 64 + fr, col0 = u.pn * BM + wc * 32 + 8 * fq;
#pragma unroll
        for (int ai = 0; ai < 2; ++ai)
#pragma unroll
            for (int m = 0; m < 4; ++m) { bf16* rowp = MG + (size_t)(row0 + ai * HALF + m * 16) * DM + col0;
#pragma unroll
                for (int bj = 0; bj < 2; ++bj) { const f32x4 v0 = acc[ai][bj][m][0], v1 = acc[ai][bj][m][1];
                    u32x4 w; w.x = cvt_pk_bf16(v0[0], v0[1]); w.y = cvt_pk_bf16(v0[2], v0[3]); w.z = cvt_pk_bf16(v1[0], v1[1]); w.w = cvt_pk_bf16(v1[2], v1[3]);
                    *(u32x4*)(rowp + bj * HALF) = w; } }
    } };
struct EpiOut { static constexpr bool HOOK = false; static constexpr bool PERM = false; const float* Xin; float* X;
    __device__ __forceinline__ void operator()(const f32x4 (&acc)[2][2][4][2], const Unit& u, int wr, int wc, int fr, int fq) const {
        const int row0 = u.pm * BM + wr * 64 + fr, col0 = u.pn * BM + wc * 32 + 4 * fq;
#pragma unroll
        for (int ai = 0; ai < 2; ++ai)
#pragma unroll
            for (int m = 0; m < 4; ++m) { const size_t off = (size_t)(row0 + ai * HALF + m * 16) * DM + col0;
#pragma unroll
                for (int bj = 0; bj < 2; ++bj)
#pragma unroll
                    for (int n = 0; n < 2; ++n) { const f32x4 xi = *(const f32x4*)(Xin + off + bj * HALF + n * 16); *(f32x4*)(X + off + bj * HALF + n * 16) = xi + acc[ai][bj][m][n]; } }
    } };
struct EpiDelta { static constexpr bool HOOK = false; static constexpr bool PERM = true; bf16* D;
    __device__ __forceinline__ void operator()(const f32x4 (&acc)[2][2][4][2], const Unit& u, int wr, int wc, int fr, int fq) const {
        const int row0 = u.pm * BM + wr * 64 + fr, col0 = u.pn * BM + wc * 32 + 8 * fq;
#pragma unroll
        for (int ai = 0; ai < 2; ++ai)
#pragma unroll
            for (int m = 0; m < 4; ++m) { bf16* rowp = D + (size_t)(row0 + ai * HALF + m * 16) * DM + col0;
#pragma unroll
                for (int bj = 0; bj < 2; ++bj) { const f32x4 v0 = acc[ai][bj][m][0], v1 = acc[ai][bj][m][1];
                    u32x4 w; w.x = cvt_pk_bf16(v0[0], v0[1]); w.y = cvt_pk_bf16(v0[2], v0[3]); w.z = cvt_pk_bf16(v1[0], v1[1]); w.w = cvt_pk_bf16(v1[2], v1[3]);
                    *(u32x4*)(rowp + bj * HALF) = w; } }
    } };
struct EpiSC { static constexpr bool HOOK = false; static constexpr bool PERM = false; float* SC;
    __device__ __forceinline__ void operator()(const f32x4 (&acc)[2][2][4][2], const Unit& u, int wr, int wc, int fr, int fq) const {
        const int row0 = u.pm * BM + wr * 64 + fr, col0 = u.pn * BM + wc * 32 + 4 * fq;
#pragma unroll
        for (int ai = 0; ai < 2; ++ai)
#pragma unroll
            for (int m = 0; m < 4; ++m) { const size_t off = (size_t)(row0 + ai * HALF + m * 16) * DM + col0;
#pragma unroll
                for (int bj = 0; bj < 2; ++bj)
#pragma unroll
                    for (int n = 0; n < 2; ++n) *(f32x4*)(SC + off + bj * HALF + n * 16) = acc[ai][bj][m][n]; }
    } };

template <class Epi, class Prob, class Sched, bool ALIGN_EPI = true, bool FP8 = false>
__device__ __forceinline__ void gemm_phase(PG8_LAS unsigned char* lds, const Prob g, const Sched& S, const Epi& E) {
    int tid = threadIdx.x; asm volatile("" : "+v"(tid));
    const int wid = __builtin_amdgcn_readfirstlane(tid >> 6), lane = tid & 63, wr = wid >> 2, wc = wid & 3, fr = lane & 15, fq = lane >> 4;
    const int K = g.K, nt = K / BK;
    unsigned voffA[2], voffB[2];
#pragma unroll
    for (int i = 0; i < 2; ++i) { int R, C; stage_rc(tid * 16 + i * 8192, R, C); const int Rb = Epi::PERM ? ((R & ~31) + perm32(R & 31)) : R;
        voffA[i] = (unsigned)(R * g.lda + C) * 2u; voffB[i] = (unsigned)(Rb * g.ldb + C) * 2u; }
    const size_t kstep = (size_t)(BK * 2);
    const size_t hstepA = (size_t)HALF * g.lda * 2, hstepB = (size_t)HALF * g.ldb * 2;
    const unsigned ldsw = (unsigned)wid * 1024u;
    const int aoff = lds_byte(wr * 64 + fr, fq * 8), boff = lds_byte(wc * 32 + fr, fq * 8);
#define PG8_SA(b, h) (((b) * 2 + (h)) * HTB)
#define PG8_SB(b, h) ((4 + (b) * 2 + (h)) * HTB)
#define PG8_STAGE(bufoff, gbase, voff) do { _Pragma("unroll") for (int _i = 0; _i < 2; ++_i) \
        __builtin_amdgcn_global_load_lds((const unsigned*)((const char*)(gbase) + (voff)[_i]), (PG8_LAS unsigned*)(lds + (bufoff) + ldsw + _i * 8192), 16, 0, 0); } while (0)
#define PG8_CAT8(x0, x1) __builtin_shufflevector(__builtin_bit_cast(v4i32, x0), __builtin_bit_cast(v4i32, x1), 0, 1, 2, 3, 4, 5, 6, 7)
#define PG8_LDA(dst, b, h) do { _Pragma("unroll") for (int m = 0; m < 4; ++m) { const bf16x8 x0 = *(const PG8_LAS bf16x8*)(lds + PG8_SA(b, h) + aoff + m * 2048), x1 = *(const PG8_LAS bf16x8*)(lds + PG8_SA(b, h) + aoff + m * 2048 + 1024); \
        if constexpr (FP8) dst##8[m] = PG8_CAT8(x0, x1); else { dst[m][0] = x0; dst[m][1] = x1; } } } while (0)
#define PG8_LDB(dst, b, h) do { _Pragma("unroll") for (int n = 0; n < 2; ++n) { const bf16x8 x0 = *(const PG8_LAS bf16x8*)(lds + PG8_SB(b, h) + boff + n * 2048), x1 = *(const PG8_LAS bf16x8*)(lds + PG8_SB(b, h) + boff + n * 2048 + 1024); \
        if constexpr (FP8) dst##8[n] = PG8_CAT8(x0, x1); else { dst[n][0] = x0; dst[n][1] = x1; } } } while (0)
#define PG8_MMA(ai, bj, At, Bt) do { __builtin_amdgcn_s_setprio(1); _Pragma("unroll") for (int m = 0; m < 4; ++m) _Pragma("unroll") for (int n = 0; n < 2; ++n) { \
        if constexpr (FP8) asm volatile("v_mfma_f32_16x16x128_f8f6f4 %0, %1, %2, %0" : "+v"(acc[ai][bj][m][n]) : "v"(Bt##8[n]), "v"(At##8[m]));   \
        else { _Pragma("unroll") for (int k = 0; k < 2; ++k) acc[ai][bj][m][n] = __builtin_amdgcn_mfma_f32_16x16x32_bf16(Bt[n][k], At[m][k], acc[ai][bj][m][n], 0, 0, 0); } } \
        if constexpr (FP8) asm volatile("s_nop 7" ::: "memory");   \
        __builtin_amdgcn_s_setprio(0); } while (0)
#define PG8_WAIT_V(n) asm volatile("s_waitcnt vmcnt(" #n ")" ::: "memory")
#define PG8_WAIT_L(n) asm volatile("s_waitcnt lgkmcnt(" #n ")" ::: "memory")
#define PG8_BAR __builtin_amdgcn_s_barrier()
#define PG8_SCHED __builtin_amdgcn_sched_barrier(0)
    Unit cur, nxt; int ui = 0;
    if (!S.next(0, cur)) return;
    f32x4 acc[2][2][4][2];
#pragma unroll
    for (int a = 0; a < 2; ++a)
#pragma unroll
        for (int b = 0; b < 2; ++b)
#pragma unroll
            for (int m = 0; m < 4; ++m)
#pragma unroll
                for (int n = 0; n < 2; ++n) acc[a][b][m][n] = (f32x4){0.f, 0.f, 0.f, 0.f};
    bf16x8 At[4][2], B0[2][2], B1[2][2];
    v8i32 At8[4], B08[2], B18[2];
    const char* cA = g.Aptr(cur); const char* cB = g.Bptr(cur);
    PG8_STAGE(PG8_SB(0, 0), cB, voffB); PG8_STAGE(PG8_SB(0, 1), cB + hstepB, voffB); PG8_STAGE(PG8_SA(0, 0), cA, voffA); PG8_STAGE(PG8_SA(0, 1), cA + hstepA, voffA);
    if (wr == 1) PG8_BAR;
    PG8_WAIT_V(2); PG8_BAR;
    PG8_STAGE(PG8_SB(1, 0), cB + kstep, voffB); PG8_STAGE(PG8_SA(1, 0), cA + kstep, voffA); PG8_STAGE(PG8_SB(1, 1), cB + hstepB + kstep, voffB);
    PG8_WAIT_V(6); PG8_BAR;
    for (;;) {
        const bool has_next = S.next(ui + 1, nxt);
        const char* nA = has_next ? g.Aptr(nxt) : cA; const char* nB = has_next ? g.Bptr(nxt) : cB;
        for (int t = 0; t < nt; t += 2) {
            if constexpr (Epi::HOOK) { if (t == 8 || t == 16) E.hook(acc, cur, wr, wc, fr, fq, t >> 3); }
            const bool last = (t == nt - 2);
            const char* a1 = cA + (size_t)(t + 1) * kstep;
            const char* a2 = last ? nA : cA + (size_t)(t + 2) * kstep; const char* b2 = last ? nB : cB + (size_t)(t + 2) * kstep;
            const char* a3 = a2 + kstep; const char* b3 = b2 + kstep;
            PG8_LDB(B0, 0, 0); PG8_LDB(B1, 0, 1); PG8_SCHED; PG8_LDA(At, 0, 0); PG8_STAGE(PG8_SA(1, 1), a1 + hstepA, voffA);
            PG8_WAIT_V(8); PG8_WAIT_L(0); PG8_BAR; PG8_MMA(0, 0, At, B0); PG8_MMA(0, 1, At, B1); PG8_BAR; PG8_SCHED;
            PG8_LDA(At, 0, 1); PG8_STAGE(PG8_SB(0, 0), b2, voffB); PG8_STAGE(PG8_SB(0, 1), b2 + hstepB, voffB); PG8_STAGE(PG8_SA(0, 0), a2, voffA);
            PG8_WAIT_V(8); PG8_WAIT_L(0); PG8_BAR; PG8_MMA(1, 0, At, B0); PG8_MMA(1, 1, At, B1); PG8_BAR; PG8_SCHED;
            PG8_LDB(B0, 1, 0); PG8_LDB(B1, 1, 1); PG8_SCHED; PG8_LDA(At, 1, 0); PG8_STAGE(PG8_SA(0, 1), a2 + hstepA, voffA);
            PG8_WAIT_V(8); PG8_WAIT_L(0); PG8_BAR; PG8_MMA(0, 0, At, B0); PG8_MMA(0, 1, At, B1); PG8_BAR; PG8_SCHED;
            PG8_LDA(At, 1, 1); PG8_STAGE(PG8_SB(1, 0), b3, voffB); PG8_STAGE(PG8_SB(1, 1), b3 + hstepB, voffB); PG8_STAGE(PG8_SA(1, 0), a3, voffA);
            PG8_WAIT_V(8); PG8_WAIT_L(0); PG8_BAR; PG8_MMA(1, 0, At, B0); PG8_MMA(1, 1, At, B1); PG8_BAR; PG8_SCHED;
        }
        if constexpr (ALIGN_EPI) { if (wr == 0) PG8_BAR; }
        E(acc, cur, wr, wc, fr, fq);
        if (!has_next) break;
#pragma unroll
        for (int a = 0; a < 2; ++a)
#pragma unroll
            for (int b = 0; b < 2; ++b)
#pragma unroll
                for (int m = 0; m < 4; ++m)
#pragma unroll
                    for (int n = 0; n < 2; ++n) acc[a][b][m][n] = (f32x4){0.f, 0.f, 0.f, 0.f};
        cur = nxt; cA = nA; cB = nB; ++ui;
        if constexpr (ALIGN_EPI) { if (wr == 1) PG8_BAR; }
    }
    PG8_WAIT_V(0);
    if constexpr (!ALIGN_EPI) { if (wr == 0) PG8_BAR; }
    PG8_BAR;
#undef PG8_SA
#undef PG8_SB
#undef PG8_STAGE
#undef PG8_LDA
#undef PG8_CAT8
#undef PG8_LDB
#undef PG8_MMA
#undef PG8_WAIT_V
#undef PG8_WAIT_L
#undef PG8_BAR
#undef PG8_SCHED
}
}


constexpr int RING_BYTES = 131072, MISC_OFF = RING_BYTES + 320, LDS_BYTES = 147456;
namespace att {
typedef short s16x4 __attribute__((ext_vector_type(4)));
__device__ __forceinline__ s16x4 lds_tr(const LAS unsigned char* p) { return __builtin_bit_cast(s16x4, __builtin_amdgcn_ds_read_tr16_b64_v4i16((LAS s16x4*)p)); }
template <int MODE> struct Cfg;
template <> struct Cfg<0> { static constexpr int DQK = 96, DV = 64, KRS = 208, VRS = 192, NV = 2, NL = 5; };
template <> struct Cfg<1> { static constexpr int DQK = 64, DV = 128, KRS = 144, VRS = 320, NV = 1, NL = 4; };
template <int MODE> struct Lay { using C = Cfg<MODE>; static constexpr int KB = 64 * C::KRS, VB = 64 * C::VRS, STAGE = 2 * KB + C::NV * VB; };

template <int MODE>
__device__ __forceinline__ void attn_unit(const Params& p, int l, int b, int hp, int qb, LAS unsigned char* lds, float lam, float lam_init, int pm = 0) {
    using C = Cfg<MODE>; using L = Lay<MODE>;
    constexpr int DQK = C::DQK, DV = C::DV, NDB = DV / 32, NKS = DQK / 16;
    int tid = threadIdx.x; asm volatile("" : "+v"(tid));
    const int lane = tid & 63, wid = __builtin_amdgcn_readfirstlane(tid >> 6), half = wid >> 2, r = lane & 31, h = lane >> 5;
    const int q0 = qb * 128, qrow = q0 + 32 * (wid & 3) + r;
    const size_t trow = (size_t)b * SEQ + qrow;
    const int ntile = 2 * qb + 2, mytiles = 2 * qb + 1 + ((wid & 3) >> 1);
    const bf16* Qb; const bf16* Kg[2]; const bf16* Vg[2]; int kp, vp;
    if (MODE == 0) { const bf16* QM = (const bf16*)(p.ws + WS_QM); const bf16* KM = (const bf16*)(p.ws + WS_KM); const bf16* KVR = (const bf16*)(p.ws + WS_KVR);
        Qb = QM + trow * 768 + (2 * hp + half) * 96; kp = 768; vp = 1024;
        Kg[0] = KM + (size_t)b * SEQ * 768 + (2 * hp) * 96; Kg[1] = Kg[0] + 96; Vg[0] = KVR + (size_t)b * SEQ * 1024 + 512 + (2 * hp) * 64; Vg[1] = Vg[0] + 64;
    } else { const bf16* Z = (const bf16*)(p.ws + WS_Z);
        Qb = Z + trow * ZP + ZC_DQ + (2 * hp + half) * 64; kp = ZP; vp = ZP;
        Kg[0] = Z + (size_t)b * SEQ * ZP + ZC_DK + (2 * hp) * 64; Kg[1] = Kg[0] + 64; Vg[0] = Z + (size_t)b * SEQ * ZP + ZC_DV + hp * 128; Vg[1] = Vg[0]; }
    constexpr int KC = DQK / 8, VC = DV / 8;
    typedef const __attribute__((address_space(1))) bf16* gptr_t;
    gptr_t gp[C::NL]; int lo_[C::NL]; size_t gstep[C::NL];
#pragma unroll
    for (int i = 0; i < C::NL; ++i) { const int id = tid + 512 * i;
        if (id < 2 * 64 * KC) { const int sg = id / (64 * KC), q = id % (64 * KC), row = q / KC, c = q % KC; gp[i] = (gptr_t)(sg ? Kg[1] : Kg[0]) + (size_t)row * kp + c * 8; lo_[i] = sg * L::KB + row * C::KRS + c * 16; gstep[i] = (size_t)64 * kp; }
        else { const int q2 = id - 2 * 64 * KC, sg = q2 / (64 * VC), q = q2 % (64 * VC), row = q / VC, c = q % VC; gp[i] = (gptr_t)(sg ? Vg[1] : Vg[0]) + (size_t)row * vp + c * 8; lo_[i] = 2 * L::KB + sg * L::VB + row * C::VRS + c * 16; gstep[i] = (size_t)64 * vp; } }
    bf16x8 qf[NKS];
#pragma unroll
    for (int s_ = 0; s_ < NKS; ++s_) qf[s_] = *(const bf16x8*)(Qb + 16 * s_ + 8 * h);
    const int koff = half * L::KB + r * C::KRS + 16 * h;
    const int voff = 2 * L::KB + (C::NV == 2 ? half * L::VB : 0) + (4 * h + ((lane & 15) >> 2)) * C::VRS + (((lane >> 4) & 1) * 16 + (lane & 3) * 4) * 2;
    f32x16 O[NDB];
#pragma unroll
    for (int d = 0; d < NDB; ++d)
#pragma unroll
        for (int e = 0; e < 16; ++e) O[d][e] = 0.f;
    f32x16 negm;
#pragma unroll
    for (int e = 0; e < 16; ++e) negm[e] = 0.f;
    float l_run = 0.f;
    u32x4 stA[C::NL], stB[C::NL];
#define ATT_LOAD(R) do { const size_t _st = adv > 0 ? 1 : 0; --adv; _Pragma("unroll") for (int i = 0; i < C::NL; ++i) { R[i] = *(const __attribute__((address_space(1))) u32x4*)gp[i]; gp[i] += _st * gstep[i]; } } while (0)
#define ATT_WRITE(R, stg) do { _Pragma("unroll") for (int i = 0; i < C::NL; ++i) *(LAS u32x4*)(lds + (stg) * L::STAGE + lo_[i]) = R[i]; } while (0)
#define ATT_VREAD(dst, kb) do { const int voff_ = (pm & 64) ? 2 * L::KB : voff; _Pragma("unroll") for (int d = 0; d < NDB; ++d) _Pragma("unroll") for (int sp = 0; sp < 2; ++sp) { \
                const LAS unsigned char* va = sb + voff_ + (32 * (kb) + 16 * sp) * C::VRS + 64 * d; \
                const s16x4 t0 = lds_tr(va), t1 = lds_tr(va + 8 * C::VRS); \
                dst[2 * d + sp] = (bf16x8){t0[0], t0[1], t0[2], t0[3], t1[0], t1[1], t1[2], t1[3]}; } } while (0)
#define ATT_PV(src, pfk) do { if (!(pm & 32)) { _Pragma("unroll") for (int d = 0; d < NDB; ++d) _Pragma("unroll") for (int sp = 0; sp < 2; ++sp) O[d] = __builtin_amdgcn_mfma_f32_32x32x16_bf16(src[2 * d + sp], pfk[sp], O[d], 0, 0, 0); } \
        else { _Pragma("unroll") for (int d = 0; d < NDB; ++d) O[d][0] += __builtin_bit_cast(float, (int)src[2 * d][0] + (int)pfk[0][0]); } } while (0)
#define ATT_SM(Sk, Sother, pfk) do { float mx = Sk[0]; _Pragma("unroll") for (int e = 1; e < 16; ++e) mx = fmaxf(mx, Sk[e]); \
            if (__any(mx > 8.f)) { mx = fmaxf(mx, __shfl_xor(mx, 32)); \
                const float dsh = fmaxf(mx, 0.f), alpha = __builtin_amdgcn_exp2f(-dsh); l_run *= alpha; \
                _Pragma("unroll") for (int e = 0; e < 16; ++e) { negm[e] -= dsh; Sk[e] -= dsh; Sother[e] -= dsh; } \
                _Pragma("unroll") for (int dd = 0; dd < NDB; ++dd) _Pragma("unroll") for (int e = 0; e < 16; ++e) O[dd][e] *= alpha; } \
            float ps = 0.f; \
            _Pragma("unroll") for (int sp = 0; sp < 2; ++sp) { float e8[8]; \
                if (pm & 16) { _Pragma("unroll") for (int jj = 0; jj < 8; ++jj) e8[jj] = Sk[8 * sp + jj]; } else { _Pragma("unroll") for (int jj = 0; jj < 8; ++jj) { e8[jj] = __builtin_amdgcn_exp2f(Sk[8 * sp + jj]); ps += e8[jj]; } } \
                u32x4 w; w.x = pg8::cvt_pk_bf16(e8[0], e8[1]); w.y = pg8::cvt_pk_bf16(e8[2], e8[3]); w.z = pg8::cvt_pk_bf16(e8[4], e8[5]); w.w = pg8::cvt_pk_bf16(e8[6], e8[7]); \
                pfk[sp] = __builtin_bit_cast(bf16x8, w); } \
            l_run += ps; } while (0)
#define ATT_COMPUTE(stg) do { LAS unsigned char* sb = lds + (stg) * L::STAGE; \
            bf16x8 kf[2][NKS]; \
            { const int koff_ = (pm & 64) ? 0 : koff; _Pragma("unroll") for (int kb = 0; kb < 2; ++kb) _Pragma("unroll") for (int s_ = 0; s_ < NKS; ++s_) kf[kb][s_] = *(const LAS bf16x8*)(sb + koff_ + kb * 32 * C::KRS + 32 * s_); } \
            __builtin_amdgcn_sched_barrier(0); \
            f32x16 S0 = negm, S1 = negm; __builtin_amdgcn_s_setprio(1); \
            if (!(pm & 32)) { _Pragma("unroll") for (int s_ = 0; s_ < NKS; ++s_) S0 = __builtin_amdgcn_mfma_f32_32x32x16_bf16(kf[0][s_], qf[s_], S0, 0, 0, 0); \
            _Pragma("unroll") for (int s_ = 0; s_ < NKS; ++s_) S1 = __builtin_amdgcn_mfma_f32_32x32x16_bf16(kf[1][s_], qf[s_], S1, 0, 0, 0); } \
            __builtin_amdgcn_s_setprio(0); bf16x8 vfa[2 * NDB], vfb[2 * NDB]; \
            ATT_VREAD(vfa, 0); \
            __builtin_amdgcn_sched_barrier(0); \
            bf16x8 pf0[2], pf1[2]; \
            ATT_SM(S0, S1, pf0); \
            __builtin_amdgcn_sched_barrier(0); \
            __builtin_amdgcn_s_setprio(1); ATT_PV(vfa, pf0); __builtin_amdgcn_s_setprio(0); \
            ATT_VREAD(vfb, 1); \
            __builtin_amdgcn_sched_barrier(0); \
            ATT_SM(S1, S0, pf1); \
            __builtin_amdgcn_sched_barrier(0); \
            __builtin_amdgcn_s_setprio(1); ATT_PV(vfb, pf1); __builtin_amdgcn_s_setprio(0); \
            } while (0)
    int adv = ntile - 1;
    ATT_LOAD(stA); ATT_LOAD(stB);
    ATT_WRITE(stA, 0);
    __syncthreads();
#pragma unroll 1
    for (int j = 0; j < ntile; j += 2) {
        if (!(pm & 1)) ATT_LOAD(stA);
        if (j < mytiles) ATT_COMPUTE(0);
        if (!(pm & 2)) ATT_WRITE(stB, 1);
        if (!(pm & 8)) __syncthreads();
        if (!(pm & 1)) ATT_LOAD(stB);
        if (j + 1 < mytiles) ATT_COMPUTE(1);
        if (!(pm & 2)) ATT_WRITE(stA, 0);
        if (!(pm & 8)) __syncthreads();
    }
#undef ATT_LOAD
#undef ATT_WRITE
#undef ATT_COMPUTE
#undef ATT_VREAD
#undef ATT_PV
#undef ATT_SM
    const float inv = 1.f / (l_run + __shfl_xor(l_run, 32));
    if (MODE == 0) {
        bf16* o = (bf16*)(p.ws + WS_OC) + trow * 1536 + (2 * hp + half) * 64 + 4 * h;
#pragma unroll
        for (int d = 0; d < NDB; ++d)
#pragma unroll
            for (int g4 = 0; g4 < 4; ++g4) { u32x2 w; w.x = pg8::cvt_pk_bf16(O[d][4 * g4] * inv, O[d][4 * g4 + 1] * inv); w.y = pg8::cvt_pk_bf16(O[d][4 * g4 + 2] * inv, O[d][4 * g4 + 3] * inv);
                *(u32x2*)(o + 32 * d + 8 * g4) = w; }
    } else {
        LAS unsigned char* xr = lds + (32 * (wid & 3) + r) * 264 + 8 * h;
        if (half == 1) {
#pragma unroll
            for (int d = 0; d < NDB; ++d)
#pragma unroll
                for (int g4 = 0; g4 < 4; ++g4) { u32x2 w; w.x = pg8::cvt_pk_bf16(O[d][4 * g4] * inv, O[d][4 * g4 + 1] * inv); w.y = pg8::cvt_pk_bf16(O[d][4 * g4 + 2] * inv, O[d][4 * g4 + 3] * inv);
                    *(LAS u32x2*)(xr + 64 * d + 16 * g4) = w; }
        }
        __syncthreads();
        if (half == 0) {
            float ss = 0.f;
#pragma unroll
            for (int d = 0; d < NDB; ++d)
#pragma unroll
                for (int g4 = 0; g4 < 4; ++g4) { const u32x2 w = *(const LAS u32x2*)(xr + 64 * d + 16 * g4);
                    O[d][4 * g4] = O[d][4 * g4] * inv - lam * bflo(w.x); O[d][4 * g4 + 1] = O[d][4 * g4 + 1] * inv - lam * bfhi(w.x);
                    O[d][4 * g4 + 2] = O[d][4 * g4 + 2] * inv - lam * bflo(w.y); O[d][4 * g4 + 3] = O[d][4 * g4 + 3] * inv - lam * bfhi(w.y);
                    ss += (O[d][4 * g4] * O[d][4 * g4] + O[d][4 * g4 + 1] * O[d][4 * g4 + 1]) + (O[d][4 * g4 + 2] * O[d][4 * g4 + 2] + O[d][4 * g4 + 3] * O[d][4 * g4 + 3]); }
            ss += __shfl_xor(ss, 32);
            const float rstd = rsqrtf(ss * (1.f / 128.f) + NORM_EPS) * (1.f - lam_init);
            const float* sg = p.in[11] + (size_t)l * 128 + 4 * h;
            bf16* o = (bf16*)(p.ws + WS_OC) + trow * 1536 + 512 + hp * 128 + 4 * h;
#pragma unroll
            for (int d = 0; d < NDB; ++d)
#pragma unroll
                for (int g4 = 0; g4 < 4; ++g4) { const f32x4 g = *(const f32x4*)(sg + 32 * d + 8 * g4);
                    u32x2 w; w.x = pg8::cvt_pk_bf16(O[d][4 * g4] * rstd * g.x, O[d][4 * g4 + 1] * rstd * g.y); w.y = pg8::cvt_pk_bf16(O[d][4 * g4 + 2] * rstd * g.z, O[d][4 * g4 + 3] * rstd * g.w);
                    *(u32x2*)(o + 32 * d + 8 * g4) = w; }
        }
        __syncthreads();
    }
}

__device__ __forceinline__ void sgu_unit(const Params& p, int l, int n, int g, LAS unsigned char* lds) {
    constexpr int VRS = 320;
    int tid = threadIdx.x; asm volatile("" : "+v"(tid));
    const int lane = tid & 63, wid = __builtin_amdgcn_readfirstlane(tid >> 6), r = lane & 31, h = lane >> 5, tb = wid & 3, ch = wid >> 2;
    const bf16* Z = (const bf16*)(p.ws + WS_Z) + (size_t)n * 128 * ZP;
#pragma unroll
    for (int i = 0; i < 4; ++i) { const int id = tid + 512 * i, row = id >> 4, c = id & 15; *(LAS u32x4*)(lds + row * VRS + c * 16) = *(const u32x4*)(Z + (size_t)row * ZP + ZC_SV + g * 128 + c * 8); }
    const bf16* W = (const bf16*)(p.ws + WS_W + (size_t)l * W_LAYER + WO_SGU) + ((size_t)g * 128 + tb * 32 + r) * 128 + 4 * h;
    u32x2 wf[8][2];
#pragma unroll
    for (int ks = 0; ks < 8; ++ks) { wf[ks][0] = *(const u32x2*)(W + 16 * ks); wf[ks][1] = *(const u32x2*)(W + 16 * ks + 8); }
    __syncthreads();
    f32x16 O[2];
#pragma unroll
    for (int d = 0; d < 2; ++d)
#pragma unroll
        for (int e = 0; e < 16; ++e) O[d][e] = 0.f;
    const int voff = (4 * h + ((lane & 15) >> 2)) * VRS + (((lane >> 4) & 1) * 16 + (lane & 3) * 4) * 2 + 128 * ch;
#pragma unroll
    for (int d = 0; d < 2; ++d)
#pragma unroll
        for (int ks = 0; ks < 8; ++ks) { const LAS unsigned char* va = lds + voff + (16 * ks) * VRS + 64 * d;
            const att::s16x4 t0 = att::lds_tr(va), t1 = att::lds_tr(va + 8 * VRS);
            const bf16x8 vf = {t0[0], t0[1], t0[2], t0[3], t1[0], t1[1], t1[2], t1[3]};
            const u32x4 pw = {wf[ks][0].x, wf[ks][0].y, wf[ks][1].x, wf[ks][1].y};
            O[d] = __builtin_amdgcn_mfma_f32_32x32x16_bf16(vf, __builtin_bit_cast(bf16x8, pw), O[d], 0, 0, 0); }
    const int t = tb * 32 + r; const size_t trow = (size_t)n * 128 + t;
    const float bias = p.in[14][(size_t)l * 512 + g * 128 + t];
    const bf16* up = (const bf16*)(p.ws + WS_Z) + trow * ZP + ZC_SU + g * 128 + 64 * ch + 4 * h;
    bf16* o = (bf16*)(p.ws + WS_OC) + trow * 1536 + 1024 + g * 128 + 64 * ch + 4 * h;
#pragma unroll
    for (int d = 0; d < 2; ++d)
#pragma unroll
        for (int g4 = 0; g4 < 4; ++g4) { const u32x2 uw = *(const u32x2*)(up + 32 * d + 8 * g4);
            u32x2 w; w.x = pg8::cvt_pk_bf16(bflo(uw.x) * (O[d][4 * g4] + bias), bfhi(uw.x) * (O[d][4 * g4 + 1] + bias)); w.y = pg8::cvt_pk_bf16(bflo(uw.y) * (O[d][4 * g4 + 2] + bias), bfhi(uw.y) * (O[d][4 * g4 + 3] + bias));
            *(u32x2*)(o + 32 * d + 8 * g4) = w; }
    __syncthreads();
}
}

#define XB_TMO      128
#define XB_XCNT(j)  (256  + 64 * (j))
#define XB_XSUB(j)  (1280 + 64 * (j))
#define XB_XGEN(j)  (2304 + 64 * (j))
#define XB_TOP      3328
#define XB_TOPGEN   3392
#define XCD_BAR_WORDS 3456
#define XB_SPIN_CAP (1u << 18)
__device__ __forceinline__ unsigned xb_ld(unsigned* p)              { return __hip_atomic_load(p, __ATOMIC_RELAXED, __HIP_MEMORY_SCOPE_AGENT); }
__device__ __forceinline__ unsigned xb_add(unsigned* p, unsigned v) { return __hip_atomic_fetch_add(p, v, __ATOMIC_RELAXED, __HIP_MEMORY_SCOPE_AGENT); }
__device__ __forceinline__ unsigned xb_xcc_id() { return (unsigned)__builtin_amdgcn_s_getreg((3 << 11) | 20) & 0xFu; }
#define XB_SPIN(cond, bar) do { unsigned _sp = 0; while (cond) { __builtin_amdgcn_s_sleep(1); \
    if ((++_sp & 255u) == 0u) { if (xb_ld(&(bar)[XB_TMO])) break; if (_sp > XB_SPIN_CAP) { atomicAdd(&(bar)[XB_TMO], 1u); break; } } } } while (0)
struct XcdBarrier { unsigned* bar; unsigned x; volatile LAS unsigned* st; };
__device__ __forceinline__ XcdBarrier xcd_barrier_post(unsigned* bar, volatile LAS unsigned* st) {
    XcdBarrier b; b.bar = bar; b.x = xb_xcc_id(); b.st = st;
    if (threadIdx.x == 0) (void)xb_add(&bar[XB_XCNT(b.x)], 1u);
    return b;
}
__device__ __forceinline__ void xcd_barrier_complete(unsigned* bar, unsigned x, unsigned& nloc, unsigned& nx) {
    const unsigned G = gridDim.x * gridDim.y * gridDim.z;
    unsigned sum, cnt, mine, sp = 0u;
    for (;;) {
        sum = 0u; cnt = 0u; mine = 0u;
#pragma unroll
        for (unsigned j = 0; j < 16; ++j) { const unsigned c = xb_ld(&bar[XB_XCNT(j)]); sum += c; cnt += (c > 0u) ? 1u : 0u; mine = (j == x) ? c : mine; }
        if (sum == G) break;
        __builtin_amdgcn_s_sleep(1);
        if ((++sp & 255u) == 0u) { if (xb_ld(&bar[XB_TMO])) break; if (sp > XB_SPIN_CAP) { atomicAdd(&bar[XB_TMO], 1u); break; } }
    }
    nloc = mine > 0u ? mine : 1u; nx = cnt > 0u ? cnt : 1u;
}
__device__ __forceinline__ void xcd_barrier(const XcdBarrier& b) {
    asm volatile("s_waitcnt vmcnt(0)" ::: "memory");
    __syncthreads();
    if (threadIdx.x == 0) {
        unsigned* bar = b.bar;
        __builtin_amdgcn_s_waitcnt(0);
        unsigned nloc = b.st[0], nx = b.st[1];
        if (nloc == 0u) { xcd_barrier_complete(bar, b.x, nloc, nx); b.st[0] = nloc; b.st[1] = nx; }
        const unsigned old = xb_add(&bar[XB_XSUB(b.x)], 1u);
        const unsigned gen = old / nloc;
        if (old + 1u == (gen + 1u) * nloc) {
            __builtin_amdgcn_fence(__ATOMIC_RELEASE, "agent");
            asm volatile("s_waitcnt vmcnt(0)" ::: "memory");
            const unsigned og = xb_add(&bar[XB_TOP], 1u);
            const unsigned tg = og / nx;
            if (og + 1u == (tg + 1u) * nx) xb_add(&bar[XB_TOPGEN], 1u);
            else XB_SPIN(xb_ld(&bar[XB_TOPGEN]) == tg, bar);
            __builtin_amdgcn_fence(__ATOMIC_ACQUIRE, "agent");
            xb_add(&bar[XB_XGEN(b.x)], 1u);
            asm volatile("s_waitcnt vmcnt(0)" ::: "memory");
        } else {
            XB_SPIN(xb_ld(&bar[XB_XGEN(b.x)]) == gen, bar);
            __builtin_amdgcn_fence(__ATOMIC_ACQUIRE, "agent");
            asm volatile("s_waitcnt vmcnt(0)" ::: "memory");
        }
    }
    __syncthreads();
}

constexpr int NPHASE = 1 + 11 * DEPTH;
constexpr int CW_BAR = 4096;
struct MArgs { Params p; int ph_lo, ph_hi, li, pad; };

__global__ void __launch_bounds__(512, 2) mega(MArgs a) {
    extern __shared__ __attribute__((aligned(16))) unsigned char lds_raw[];
    LAS unsigned char* lds = (LAS unsigned char*)lds_raw;
    volatile LAS unsigned* MISC = (volatile LAS unsigned*)(lds + MISC_OFF);
    const Params& p = a.p;
    const int tid = threadIdx.x, lane = tid & 63, wave = __builtin_amdgcn_readfirstlane(tid >> 6);
    const int G = gridDim.x, bx = blockIdx.x;
    const int vcu = (G % 8 == 0) ? (bx % 8) * (G / 8) + bx / 8 : bx;
    const int gw = vcu * 8 + wave, ngw = G * 8;
    unsigned char* ws = p.ws;
    for (int u = tid; u < (LDS_BYTES - RING_BYTES) / 4; u += 512) ((LAS unsigned*)(lds + RING_BYTES))[u] = 0u;
    __syncthreads();
    XcdBarrier bar = xcd_barrier_post((unsigned*)(ws + WS_CTL) + CW_BAR + a.li * XCD_BAR_WORDS, MISC + 8);
    const int lo = a.ph_lo, hi = a.ph_hi;
#ifndef PROBE_PM
#define PROBE_PM 0
#endif
#ifndef PROBE_K
#define PROBE_K (-1)
#endif
#ifndef PROBE_N
#define PROBE_N 0
#endif
#define NREP(j) ((PROBE_K == (j)) ? PROBE_N : 0)
#ifndef ENMASK
#define ENMASK 0xFFFFFFFFu
#endif
#define EN(j) ((ENMASK >> (j)) & 1u)
#define IN(k) (lo <= (k) && (k) < hi)
#define SEAM(k) do { if (IN(k) && IN((k) + 1)) xcd_barrier(bar); } while (0)

    if (EN(11) && IN(0)) for (int rep = 0; rep <= NREP(11); ++rep) {
        float* scr = (float*)lds_raw;
        __syncthreads();
        for (int r12 = 0; r12 <= NREP(12); ++r12)
        for (int l = 0; l < DEPTH; ++l) prologue_transposes(p, l, scr + wave * (64 * 33), gw, ngw, lane);
        prologue_rope(p, bx * 512 + tid, G * 512);
        __syncthreads();
        for (int r13 = 0; r13 <= NREP(13); ++r13)
        for (int it = bx; it < 2 * 256; it += G) fold_item(p, it >> 8, it & 255, scr, tid);
        __syncthreads();
        for (int r15 = 0; r15 <= NREP(15); ++r15)
        for (int t = gw; t < T; t += ngw) rms_row_to_bf16(p.in[0] + (size_t)t * DM, p.in[1], (bf16*)(ws + WS_HB) + (size_t)t * DM, lane, ws + WS_HB8 + (size_t)t * DM);
        for (int r14 = 0; r14 <= NREP(14); ++r14)
        for (int r = gw; r < 2 * DEPTH * NEXP; r += ngw) { const int tb = r / (DEPTH * NEXP), q = r % (DEPTH * NEXP);
            const size_t ro = (size_t)(q / NEXP) * NEXP * QROW + (size_t)(q % NEXP) * 128;
            if (tb) q4_row(p.in[23] + (size_t)q * DM, ws + WS_V8 + ro, (float*)(ws + WS_PS) + (size_t)DEPTH * NEXP + q, lane);
            else q4u_row(p.in[22] + (size_t)q * DM, ws + WS_U8 + ro, (float*)(ws + WS_PS) + q, lane); }
        { unsigned* gmax = (unsigned*)(ws + WS_CTL) + CW_GMAX;
          for (int m6 = 0; m6 < 3 * DEPTH; ++m6) { const f32x4* src = (const f32x4*)(p.in[15] + (size_t)m6 * DM * DM); float mx = 0.f;
              for (int i = gw * 64 + lane; i < DM * DM / 4; i += ngw * 64) { const f32x4 v = src[i]; mx = fmaxf(mx, fmaxf(fmaxf(fabsf(v.x), fabsf(v.y)), fmaxf(fabsf(v.z), fabsf(v.w)))); }
#pragma unroll
              for (int of = 1; of < 64; of <<= 1) mx = fmaxf(mx, __shfl_xor(mx, of));
              if (lane == 0) atomicMax(gmax + 64 * m6, __builtin_bit_cast(unsigned, mx)); } }
        xcd_barrier(bar);
        { unsigned* gmax = (unsigned*)(ws + WS_CTL) + CW_GMAX;
          for (int it = gw; it < DEPTH * 3 * 64 * 32; it += ngw) { const int m6 = it / 2048, q = it % 2048, cb = q / 32, kb = q % 32;
              transpose_item8(p.in[15] + (size_t)m6 * DM * DM, DM, cb * 32, kb * 64, DM, ws + WS_WG8, m6 * DM + cb * 32, scr + wave * (64 * 33), lane, gate_scale(gmax + 64 * m6)); } }
    }
    SEAM(0);
    { constexpr int l = 0;
        const int pb = 1 + 11 * l;
        unsigned char* wl = ws + WS_W + (size_t)l * W_LAYER;
        bf16* HB = (bf16*)(ws + WS_HB); bf16* Z = (bf16*)(ws + WS_Z); bf16* Gt = (bf16*)(ws + WS_G);
        if (EN(0) && IN(pb + 0)) for (int rep = 0; rep <= NREP(0); ++rep) {
            { pg8::ProbGen g{HB, (const bf16*)(wl + WO_CAT), DM, DM, DM}; pg8::StaticOrder S; S.init(T, ZP, G, bx);
              pg8::EpiZG E{Z, Gt, p.in[16] + (size_t)l * NGATE, 1};
              pg8::gemm_phase<pg8::EpiZG, pg8::ProbGen, pg8::StaticOrder>(lds, g, S, E); }
            {
              const unsigned* gmax = (const unsigned*)(ws + WS_CTL) + CW_GMAX + 64 * 3 * l;
              pg8::ProbGen g{(const bf16*)(ws + WS_HB8), (const bf16*)(ws + WS_WG8 + (size_t)l * NGATE * DM), DM / 2, DM / 2, DM / 2}; pg8::StaticOrder S; S.init(T, NGATE, G, bx);
              pg8::EpiG8 E{Gt, p.in[16] + (size_t)l * NGATE, gmax};
              pg8::gemm_phase<pg8::EpiG8, pg8::ProbGen, pg8::StaticOrder, true, true>(lds, g, S, E); }
        }
        SEAM(pb + 0);
        if (EN(1) && IN(pb + 1)) { int ln = lane; asm volatile("" : "+v"(ln)); for (int t = gw; t < T; t += ngw) prep1_row(p, l, t, ln); }
        SEAM(pb + 1);
        if (EN(2) && IN(pb + 2)) for (int rep = 0; rep <= NREP(2); ++rep) {
            pg8::ProbUp g{Z, (const bf16*)(wl + WO_UP), ZP, 512, 512}; pg8::StaticOrder S; S.init(T, 1792, G, bx);
            pg8::EpiUp E{(bf16*)(ws + WS_QR), (bf16*)(ws + WS_KVR)};
            pg8::gemm_phase<pg8::EpiUp, pg8::ProbUp, pg8::StaticOrder>(lds, g, S, E);
        }
        SEAM(pb + 2);
        if (EN(3) && IN(pb + 3)) for (int rep = 0; rep <= NREP(3); ++rep) { int ln = lane; asm volatile("" : "+v"(ln)); for (int t = gw; t < T; t += ngw) prep2_row(p, l, t, ln); }
        SEAM(pb + 3);
        if (EN(4) && IN(pb + 4)) for (int rep = 0; rep <= NREP(4); ++rep) {
            const float lam = diff_lambda(p, l, lane), lam_init = 0.8f - 0.6f * expf(-0.3f * (float)l);
            unsigned* qbase = (unsigned*)(ws + WS_CTL) + 64 * (1 + 8 * l + 16 * rep);
            int qs = 0;
            for (;;) {
                __syncthreads();
                if (tid == 0) { int u = 192, qx = 0;
                    while (qs < 8) { qx = (int)((bar.x + (unsigned)qs) & 7u); u = (int)atomicAdd(qbase + 64 * qx, 1u); if (u < 192) break; ++qs; }
                    MISC[16] = (unsigned)(qs < 8 ? u : 192); MISC[17] = (unsigned)qx; MISC[18] = (unsigned)qs; }
                __syncthreads();
                const int u = (int)MISC[16], qx = (int)MISC[17]; qs = (int)MISC[18];
                if (u >= 192) break;
                if (u < 128) { const int qb = 31 - (u >> 2), combo = qx + 8 * (u & 3);
                    if (combo < 16) att::attn_unit<1>(p, l, combo >> 2, combo & 3, qb, lds, lam, lam_init, rep < NREP(4) ? PROBE_PM : 0);
                    else att::attn_unit<0>(p, l, (combo - 16) >> 2, (combo - 16) & 3, qb, lds, 0.f, 0.f, rep < NREP(4) ? PROBE_PM : 0);
                } else { const int v = qx * 64 + (u - 128); att::sgu_unit(p, l, v >> 2, v & 3, lds); }
            }
        }
        SEAM(pb + 4);
        if (EN(5) && IN(pb + 5)) for (int rep = 0; rep <= NREP(5); ++rep) {
            const bool prb = rep < NREP(5);
            pg8::ProbGen g{(const bf16*)(ws + WS_OC), (const bf16*)(wl + WO_B), 1536, 1536, 1536}; pg8::StaticOrder S; S.init(T, DM, G, bx);
            if (prb && (PROBE_PM & 2)) { g.A = HB; g.lda = DM; }
            if (prb && (PROBE_PM & 4)) { g.Bt = (const bf16*)(wl + WO_CAT); g.ldb = DM; }
            pg8::EpiMG E{prb ? (bf16*)(ws + WS_QR) : (bf16*)(ws + WS_MG), Gt, (prb && (PROBE_PM & 1)) ? 1 : 0};
            if (prb && (PROBE_PM & 8)) { pg8::EpiDelta E2{(bf16*)(ws + WS_QR)}; pg8::gemm_phase<pg8::EpiDelta, pg8::ProbGen, pg8::StaticOrder>(lds, g, S, E2); }
            else pg8::gemm_phase<pg8::EpiMG, pg8::ProbGen, pg8::StaticOrder>(lds, g, S, E);
        }
        SEAM(pb + 5);
        if (EN(6) && IN(pb + 6)) for (int rep = 0; rep <= NREP(6); ++rep) {
            pg8::ProbGen g{(const bf16*)(ws + WS_MG), (const bf16*)(wl + WO_OUT), DM, DM, DM}; pg8::StaticOrder S; S.init(T, DM, G, bx);
            pg8::EpiDelta E{(bf16*)(ws + WS_QR)};
            pg8::gemm_phase<pg8::EpiDelta, pg8::ProbGen, pg8::StaticOrder>(lds, g, S, E);
        }
        SEAM(pb + 6);
        if (EN(7) && IN(pb + 7)) { int ln = lane; asm volatile("" : "+v"(ln));
            const float* xin = l == 0 ? p.in[0] : p.out;
            for (int t = gw; t < T; t += ngw) add_rms_row(xin + (size_t)t * DM, (const bf16*)(ws + WS_QR) + (size_t)t * DM, RESID_IN_PEER ? nullptr : p.out + (size_t)t * DM, p.in[19] + (size_t)l * DM, HB + (size_t)t * DM, (float*)(ws + WS_HS) + 2 * (size_t)t, ln); }
        SEAM(pb + 7);
        if (EN(8) && IN(pb + 8)) for (int rep = 0; rep <= NREP(8); ++rep) {
            pg8::ProbGen g{HB, (const bf16*)(wl + WO_PQ), DM, DM, DM}; pg8::StaticOrder S; S.init(T, DM, G, bx);
            pg8::EpiSC E{(float*)(ws + WS_SC)};
            pg8::gemm_phase<pg8::EpiSC, pg8::ProbGen, pg8::StaticOrder>(lds, g, S, E);
        }
        SEAM(pb + 8);
        if (EN(10) && IN(pb + 10)) { int ln = lane; asm volatile("" : "+v"(ln));
            const float* gn = l + 1 < DEPTH ? p.in[1] + (size_t)(l + 1) * DM : nullptr;
            __syncthreads();
            for (int rep = 0; rep <= NREP(10); ++rep) { if (rep < NREP(10)) peer_octets<PROBE_PM | 4>(p, l, gw, ngw, ln, nullptr, p.out, p.out, lds + wave * PEER_LDS_WAVE); else peer_octets(p, l, gw, ngw, ln, gn, p.out, p.out, lds + wave * PEER_LDS_WAVE); }
            __syncthreads(); }
        SEAM(pb + 10);
        }
    { constexpr int l = 1;
        const int pb = 1 + 11 * l;
        unsigned char* wl = ws + WS_W + (size_t)l * W_LAYER;
        bf16* HB = (bf16*)(ws + WS_HB); bf16* Z = (bf16*)(ws + WS_Z); bf16* Gt = (bf16*)(ws + WS_G);
        if (EN(0) && IN(pb + 0)) for (int rep = 0; rep <= NREP(0); ++rep) {
            { pg8::ProbGen g{HB, (const bf16*)(wl + WO_CAT), DM, DM, DM}; pg8::StaticOrder S; S.init(T, ZP, G, bx);
              pg8::EpiZG E{Z, Gt, p.in[16] + (size_t)l * NGATE, 1};
              pg8::gemm_phase<pg8::EpiZG, pg8::ProbGen, pg8::StaticOrder>(lds, g, S, E); }
            {
              const unsigned* gmax = (const unsigned*)(ws + WS_CTL) + CW_GMAX + 64 * 3 * l;
              pg8::ProbGen g{(const bf16*)(ws + WS_HB8), (const bf16*)(ws + WS_WG8 + (size_t)l * NGATE * DM), DM / 2, DM / 2, DM / 2}; pg8::StaticOrder S; S.init(T, NGATE, G, bx);
              pg8::EpiG8 E{Gt, p.in[16] + (size_t)l * NGATE, gmax};
              pg8::gemm_phase<pg8::EpiG8, pg8::ProbGen, pg8::StaticOrder, true, true>(lds, g, S, E); }
        }
        SEAM(pb + 0);
        if (EN(1) && IN(pb + 1)) { int ln = lane; asm volatile("" : "+v"(ln)); for (int t = gw; t < T; t += ngw) prep1_row(p, l, t, ln); }
        SEAM(pb + 1);
        if (EN(2) && IN(pb + 2)) for (int rep = 0; rep <= NREP(2); ++rep) {
            pg8::ProbUp g{Z, (const bf16*)(wl + WO_UP), ZP, 512, 512}; pg8::StaticOrder S; S.init(T, 1792, G, bx);
            pg8::EpiUp E{(bf16*)(ws + WS_QR), (bf16*)(ws + WS_KVR)};
            pg8::gemm_phase<pg8::EpiUp, pg8::ProbUp, pg8::StaticOrder>(lds, g, S, E);
        }
        SEAM(pb + 2);
        if (EN(3) && IN(pb + 3)) for (int rep = 0; rep <= NREP(3); ++rep) { int ln = lane; asm volatile("" : "+v"(ln)); for (int t = gw; t < T; t += ngw) prep2_row(p, l, t, ln); }
        SEAM(pb + 3);
        if (EN(4) && IN(pb + 4)) for (int rep = 0; rep <= NREP(4); ++rep) {
            const float lam = diff_lambda(p, l, lane), lam_init = 0.8f - 0.6f * expf(-0.3f * (float)l);
            unsigned* qbase = (unsigned*)(ws + WS_CTL) + 64 * (1 + 8 * l + 16 * rep);
            int qs = 0;
            for (;;) {
                __syncthreads();
                if (tid == 0) { int u = 192, qx = 0;
                    while (qs < 8) { qx = (int)((bar.x + (unsigned)qs) & 7u); u = (int)atomicAdd(qbase + 64 * qx, 1u); if (u < 192) break; ++qs; }
                    MISC[16] = (unsigned)(qs < 8 ? u : 192); MISC[17] = (unsigned)qx; MISC[18] = (unsigned)qs; }
                __syncthreads();
                const int u = (int)MISC[16], qx = (int)MISC[17]; qs = (int)MISC[18];
                if (u >= 192) break;
                if (u < 128) { const int qb = 31 - (u >> 2), combo = qx + 8 * (u & 3);
                    if (combo < 16) att::attn_unit<1>(p, l, combo >> 2, combo & 3, qb, lds, lam, lam_init, rep < NREP(4) ? PROBE_PM : 0);
                    else att::attn_unit<0>(p, l, (combo - 16) >> 2, (combo - 16) & 3, qb, lds, 0.f, 0.f, rep < NREP(4) ? PROBE_PM : 0);
                } else { const int v = qx * 64 + (u - 128); att::sgu_unit(p, l, v >> 2, v & 3, lds); }
            }
        }
        SEAM(pb + 4);
        if (EN(5) && IN(pb + 5)) for (int rep = 0; rep <= NREP(5); ++rep) {
            const bool prb = rep < NREP(5);
            pg8::ProbGen g{(const bf16*)(ws + WS_OC), (const bf16*)(wl + WO_B), 1536, 1536, 1536}; pg8::StaticOrder S; S.init(T, DM, G, bx);
            if (prb && (PROBE_PM & 2)) { g.A = HB; g.lda = DM; }
            if (prb && (PROBE_PM & 4)) { g.Bt = (const bf16*)(wl + WO_CAT); g.ldb = DM; }
            pg8::EpiMG E{prb ? (bf16*)(ws + WS_QR) : (bf16*)(ws + WS_MG), Gt, (prb && (PROBE_PM & 1)) ? 1 : 0};
            if (prb && (PROBE_PM & 8)) { pg8::EpiDelta E2{(bf16*)(ws + WS_QR)}; pg8::gemm_phase<pg8::EpiDelta, pg8::ProbGen, pg8::StaticOrder>(lds, g, S, E2); }
            else pg8::gemm_phase<pg8::EpiMG, pg8::ProbGen, pg8::StaticOrder>(lds, g, S, E);
        }
        SEAM(pb + 5);
        if (EN(6) && IN(pb + 6)) for (int rep = 0; rep <= NREP(6); ++rep) {
            pg8::ProbGen g{(const bf16*)(ws + WS_MG), (const bf16*)(wl + WO_OUT), DM, DM, DM}; pg8::StaticOrder S; S.init(T, DM, G, bx);
            pg8::EpiDelta E{(bf16*)(ws + WS_QR)};
            pg8::gemm_phase<pg8::EpiDelta, pg8::ProbGen, pg8::StaticOrder>(lds, g, S, E);
        }
        SEAM(pb + 6);
        if (EN(7) && IN(pb + 7)) { int ln = lane; asm volatile("" : "+v"(ln));
            const float* xin = l == 0 ? p.in[0] : p.out;
            for (int t = gw; t < T; t += ngw) add_rms_row(xin + (size_t)t * DM, (const bf16*)(ws + WS_QR) + (size_t)t * DM, RESID_IN_PEER ? nullptr : p.out + (size_t)t * DM, p.in[19] + (size_t)l * DM, HB + (size_t)t * DM, (float*)(ws + WS_HS) + 2 * (size_t)t, ln); }
        SEAM(pb + 7);
        if (EN(8) && IN(pb + 8)) for (int rep = 0; rep <= NREP(8); ++rep) {
            pg8::ProbGen g{HB, (const bf16*)(wl + WO_PQ), DM, DM, DM}; pg8::StaticOrder S; S.init(T, DM, G, bx);
            pg8::EpiSC E{(float*)(ws + WS_SC)};
            pg8::gemm_phase<pg8::EpiSC, pg8::ProbGen, pg8::StaticOrder>(lds, g, S, E);
        }
        SEAM(pb + 8);
        if (EN(10) && IN(pb + 10)) { int ln = lane; asm volatile("" : "+v"(ln));
            const float* gn = l + 1 < DEPTH ? p.in[1] + (size_t)(l + 1) * DM : nullptr;
            __syncthreads();
            for (int rep = 0; rep <= NREP(10); ++rep) { if (rep < NREP(10)) peer_octets<PROBE_PM | 4>(p, l, gw, ngw, ln, nullptr, p.out, p.out, lds + wave * PEER_LDS_WAVE); else peer_octets(p, l, gw, ngw, ln, gn, p.out, p.out, lds + wave * PEER_LDS_WAVE); }
            __syncthreads(); }
        SEAM(pb + 10);
        }
#undef IN
#undef SEAM
}

static int g_grid = 0;
static void launch_mega(const Params& p, int lo, int hi, int li, hipStream_t stream) {
    MArgs a{}; a.p = p; a.ph_lo = lo; a.ph_hi = hi; a.li = li; a.pad = 0;
    mega<<<g_grid, 512, LDS_BYTES, stream>>>(a);
}
extern "C" void kernel_launch(void* const* d_in, const int* in_sizes, int n_in, void* d_out, int out_size, void* d_ws, size_t ws_size, hipStream_t stream) {
    if (n_in != 24 || out_size != T * DM || ws_size < WS_END) { fprintf(stderr, "kernel_launch: unexpected shapes (n_in %d, out %d, ws %zu, need %zu)\n", n_in, out_size, ws_size, (size_t)WS_END); return; }
    if (g_grid == 0) {
        int dev = 0, cus = 0, per_cu = 0;
        if (hipGetDevice(&dev) != hipSuccess || hipDeviceGetAttribute(&cus, hipDeviceAttributeMultiprocessorCount, dev) != hipSuccess) { g_grid = -1; return; }
        if (hipFuncSetAttribute((const void*)mega, hipFuncAttributeMaxDynamicSharedMemorySize, LDS_BYTES) != hipSuccess) { fprintf(stderr, "kernel_launch: hipFuncSetAttribute failed\n"); g_grid = -1; return; }
        if (hipOccupancyMaxActiveBlocksPerMultiprocessor(&per_cu, (const void*)mega, 512, LDS_BYTES) != hipSuccess || per_cu < 1) { fprintf(stderr, "kernel_launch: occupancy query says %d\n", per_cu); }
        (void)hipGetLastError();
        g_grid = cus;
    }
    if (g_grid < 0) return;
    Params p{};
    for (int i = 0; i < 24; ++i) p.in[i] = (const float*)d_in[i];
    p.out = (float*)d_out; p.ws = (unsigned char*)d_ws;
    unsigned char* ws = p.ws;
    (void)hipMemsetAsync(ws + WS_CTL, 0, 1 * MiB, stream);
    launch_mega(p, 0, NPHASE, 0, stream);
}
```

```cpp
#include <hip/hip_runtime.h>
#include <cstdio>
#include <cstdint>
#ifndef RESID_IN_PEER
#define RESID_IN_PEER 0
#endif

constexpr int BATCH = 4, SEQ = 4096, DM = 2048, DEPTH = 2;
constexpr int T = BATCH * SEQ;
constexpr int ZP = 3840;
constexpr int NGATE = 3 * DM;
constexpr int N1 = ZP + NGATE;
constexpr int ZC_CQ = 0, ZC_CKV = 512, ZC_DQ = 1024, ZC_DK = 1536, ZC_DV = 2048, ZC_SU = 2560, ZC_SV = 3072, ZC_KR = 3584;
constexpr int DIN = 3616;
constexpr int NEXP = 16384;
constexpr float NORM_EPS = 1e-6f;
constexpr float LOG2E = 1.4426950408889634f;

typedef unsigned short bf16;
typedef unsigned u32x4 __attribute__((ext_vector_type(4)));
typedef unsigned u32x2 __attribute__((ext_vector_type(2)));
typedef float f32x4 __attribute__((ext_vector_type(4)));
typedef float f32x16 __attribute__((ext_vector_type(16)));
typedef short bf16x8 __attribute__((ext_vector_type(8)));
#define LAS __attribute__((address_space(3)))

constexpr size_t MiB = 1u << 20;
constexpr size_t WS_CTL = 0;
constexpr size_t WS_ROPE = 1 * MiB;
constexpr size_t WS_W = 2 * MiB;
constexpr size_t WO_CAT = 0;
constexpr size_t WO_UP = WO_CAT + (size_t)N1 * DM * 2;
constexpr size_t WO_B = WO_UP + (size_t)1792 * 512 * 2;
constexpr size_t WO_OUT = WO_B + (size_t)3 * DM * 512 * 2;
constexpr size_t WO_PQ = WO_OUT + (size_t)DM * DM * 2;
constexpr size_t WO_SGU = WO_PQ + (size_t)DM * DM * 2;
constexpr size_t W_LAYER = WO_SGU + (size_t)4 * 128 * 128 * 2;
constexpr size_t WS_ACT = WS_W + 2 * W_LAYER + (2 * MiB - (2 * W_LAYER) % (2 * MiB));
constexpr size_t WS_HB = WS_ACT;
constexpr size_t WS_Z = WS_HB + (size_t)T * DM * 2;
constexpr size_t WS_G = WS_Z + (size_t)T * ZP * 2;
constexpr size_t WS_SC = WS_G;
constexpr size_t WS_QR = WS_G + (size_t)T * NGATE * 2;
constexpr size_t WS_KVR = WS_QR + (size_t)T * 768 * 2;
constexpr size_t WS_QM = WS_KVR + (size_t)T * 1024 * 2;
constexpr size_t WS_KM = WS_QM + (size_t)T * 768 * 2;
constexpr size_t WS_OC = WS_KM + (size_t)T * 768 * 2;
constexpr size_t WS_MG = WS_OC + (size_t)3 * T * 512 * 2;
constexpr size_t WS_IDX = WS_MG + (size_t)T * DM * 2;
constexpr size_t WS_GW = WS_IDX + (size_t)T * 128 * 4;
constexpr int QROW = DM / 2;
constexpr size_t WS_U8 = WS_GW + (size_t)T * 128 * 4;
constexpr size_t WS_V8 = WS_U8 + (size_t)DEPTH * NEXP * QROW;
constexpr size_t WS_PS = WS_V8 + (size_t)DEPTH * NEXP * QROW;
constexpr size_t WS_HB8 = WS_PS + (size_t)2 * DEPTH * NEXP * 4;
constexpr size_t WS_WG8 = WS_HB8 + (size_t)T * DM;
constexpr size_t WS_HS = WS_WG8 + (size_t)DEPTH * NGATE * DM;
constexpr size_t WS_XB = WS_HS + (size_t)T * 8;
constexpr size_t WS_END = WS_XB + (size_t)T * DM * 2;
constexpr int CW_GMAX = 3072;

struct Params {
    const float* in[24];
    float* out;
    unsigned char* ws;
};

__device__ __forceinline__ unsigned f2bf(float f) { unsigned u = __builtin_bit_cast(unsigned, f); return (u + 0x7fffu + ((u >> 16) & 1u)) >> 16; }
__device__ __forceinline__ unsigned pk2(float lo, float hi) { return f2bf(lo) | (f2bf(hi) << 16); }
__device__ __forceinline__ float bf2f(unsigned b) { return __builtin_bit_cast(float, b << 16); }
__device__ __forceinline__ float bflo(unsigned w) { return __builtin_bit_cast(float, w << 16); }
__device__ __forceinline__ float bfhi(unsigned w) { return __builtin_bit_cast(float, w & 0xffff0000u); }
__device__ __forceinline__ unsigned pk4_fp8(float a, float b, float c, float d) { int w = __builtin_amdgcn_cvt_pk_fp8_f32(a, b, 0, false); w = __builtin_amdgcn_cvt_pk_fp8_f32(c, d, w, true); return (unsigned)w; }
__device__ __forceinline__ float wave_sum(float v) {
#pragma unroll
    for (int o = 1; o < 64; o <<= 1) v += __shfl_xor(v, o);
    return v;
}
__device__ __forceinline__ float gelu_tanh(float x) {
    const float u = 0.7978845608028654f * (x + 0.044715f * x * x * x);
    const float e = __expf(-2.0f * fabsf(u));
    float th = (1.0f - e) / (1.0f + e);
    th = u < 0.f ? -th : th;
    return 0.5f * x * (1.0f + th);
}
__device__ __forceinline__ void unpack8(const u32x4 w, float (&f)[8]) {
    f[0] = bflo(w.x); f[1] = bfhi(w.x); f[2] = bflo(w.y); f[3] = bfhi(w.y); f[4] = bflo(w.z); f[5] = bfhi(w.z); f[6] = bflo(w.w); f[7] = bfhi(w.w);
}
__device__ __forceinline__ u32x4 pack8(const float (&f)[8]) {
    u32x4 w; w.x = pk2(f[0], f[1]); w.y = pk2(f[2], f[3]); w.z = pk2(f[4], f[5]); w.w = pk2(f[6], f[7]); return w;
}

__device__ __forceinline__ void transpose_item(const float* __restrict__ W, int ldw, int scol0, int k0, int K, bf16* __restrict__ WT, int drow0, float* scr, int lane, int kd0 = -1) {
    if (kd0 < 0) kd0 = k0;
    float v[32];
    const float* src = W + (size_t)(k0 + (lane >> 5)) * ldw + scol0 + (lane & 31);
#pragma unroll
    for (int i = 0; i < 32; ++i) v[i] = src[(size_t)(2 * i) * ldw];
#pragma unroll
    for (int i = 0; i < 32; ++i) scr[(2 * i + (lane >> 5)) * 33 + (lane & 31)] = v[i];
    asm volatile("s_waitcnt lgkmcnt(0)" ::: "memory");
    const int c = lane & 7;
#pragma unroll
    for (int j = 0; j < 4; ++j) { const int n = (lane >> 3) + 8 * j; const float* s = scr + (8 * c) * 33 + n;
        u32x4 o; o.x = pk2(s[0 * 33], s[1 * 33]); o.y = pk2(s[2 * 33], s[3 * 33]); o.z = pk2(s[4 * 33], s[5 * 33]); o.w = pk2(s[6 * 33], s[7 * 33]);
        *(u32x4*)(WT + (size_t)(drow0 + n) * K + kd0 + 8 * c) = o; }
    asm volatile("s_waitcnt lgkmcnt(0)" ::: "memory");
}

__device__ __forceinline__ void transpose_item8(const float* __restrict__ W, int ldw, int scol0, int k0, int K, unsigned char* __restrict__ WT, int drow0, float* scr, int lane, float sc) {
    float v[32];
    const float* src = W + (size_t)(k0 + (lane >> 5)) * ldw + scol0 + (lane & 31);
#pragma unroll
    for (int i = 0; i < 32; ++i) v[i] = src[(size_t)(2 * i) * ldw];
#pragma unroll
    for (int i = 0; i < 32; ++i) scr[(2 * i + (lane >> 5)) * 33 + (lane & 31)] = v[i] * sc;
    asm volatile("s_waitcnt lgkmcnt(0)" ::: "memory");
    const int c = lane & 7;
#pragma unroll
    for (int j = 0; j < 4; ++j) { const int n = (lane >> 3) + 8 * j; const float* s = scr + (8 * c) * 33 + n;
        u32x2 o; o.x = pk4_fp8(s[0 * 33], s[1 * 33], s[2 * 33], s[3 * 33]); o.y = pk4_fp8(s[4 * 33], s[5 * 33], s[6 * 33], s[7 * 33]);
        *(u32x2*)(WT + (size_t)(drow0 + n) * K + k0 + 8 * c) = o; }
    asm volatile("s_waitcnt lgkmcnt(0)" ::: "memory");
}
__device__ __forceinline__ float gate_scale(const unsigned* w) { const unsigned b = __hip_atomic_load(w, __ATOMIC_RELAXED, __HIP_MEMORY_SCOPE_AGENT); const int e = (int)((b >> 23) & 255u) - 126;
    const int k = 8 - e, kc = k < -100 ? -100 : (k > 100 ? 100 : k); return __builtin_bit_cast(float, (unsigned)(kc + 127) << 23); }
__device__ __forceinline__ void prologue_transposes(const Params& p, int l, float* scr, int gw, int ngw, int lane) {
    unsigned char* wl = p.ws + WS_W + (size_t)l * W_LAYER;
    bf16* Wcat = (bf16*)(wl + WO_CAT); bf16* Wup = (bf16*)(wl + WO_UP); bf16* Wb = (bf16*)(wl + WO_B); bf16* Wout = (bf16*)(wl + WO_OUT);
    const float* w_in = p.in[2] + (size_t)l * DM * DIN;
    const float* w_gate = p.in[15] + (size_t)l * 3 * DM * DM;
    const float* w_uq = p.in[5] + (size_t)l * 512 * 768;
    const float* w_ukv = p.in[6] + (size_t)l * 512 * 1024;
    const float* w_br = p.in[17] + (size_t)l * 3 * 512 * DM;
    const float* w_out = p.in[18] + (size_t)l * DM * DM;
    constexpr int I1 = 113 * 32, I2 = 3 * 64 * 32, I3 = 24 * 8, I4 = 32 * 8, I5 = 3 * 64 * 8, I6 = 64 * 32;
    constexpr int NIT = I1 + I2 + I3 + I4 + I5 + I6;
    for (int it = gw; it < NIT; it += ngw) {
        int r = it;
        if (r < I1) { const int cb = r / 32, kb = r % 32; const int n0 = cb * 32;
            const int sc = n0 < 1024 ? n0 : (n0 < 3584 ? n0 + 32 : n0 - 3584 + 1024);
            transpose_item(w_in, DIN, sc, kb * 64, DM, Wcat, n0, scr, lane); continue; } r -= I1;
        if (r < I2) { continue; } r -= I2;
        if (r < I3) { const int cb = r / 8, kb = r % 8;
            int sc, dr; if (cb < 16) { const int h = cb >> 1, hf = cb & 1; sc = h * 96 + 32 * hf; dr = h * 64 + 32 * hf; } else { const int h = cb - 16; sc = h * 96 + 64; dr = 512 + h * 32; }
            transpose_item(w_uq, 768, sc, kb * 64, 512, Wup, dr, scr, lane); continue; } r -= I3;
        if (r < I4) { const int cb = r / 8, kb = r % 8;
            const int v = cb >> 4, h = (cb & 15) >> 1, hf = cb & 1; const int sc = h * 128 + 64 * v + 32 * hf, dr = 768 + 512 * v + h * 64 + 32 * hf;
            transpose_item(w_ukv, 1024, sc, kb * 64, 512, Wup, dr, scr, lane); continue; } r -= I4;
        if (r < I5) { const int n = r / 512, q = r % 512, cb = q / 8, kb = q % 8;
            transpose_item(w_br + (size_t)n * 512 * DM, DM, cb * 32, kb * 64, 1536, Wb, cb * 32, scr, lane, n * 512 + kb * 64); continue; } r -= I5;
        { const int cb = r / 32, kb = r % 32; transpose_item(w_out, DM, cb * 32, kb * 64, DM, Wout, cb * 32, scr, lane); }
    }
    for (int i = gw * 64 + lane; i < 224 * 256; i += ngw * 64) { ((u32x4*)(Wcat + (size_t)DIN * DM))[i] = (u32x4){0u, 0u, 0u, 0u}; }
    bf16* sg = (bf16*)(wl + WO_SGU); const float* sw = p.in[13] + (size_t)l * 4 * 128 * 128;
    for (int i = gw * 64 + lane; i < 4 * 128 * 128; i += ngw * 64) { const int s = i & 127, t = (i >> 7) & 127; const bool ok = (s >> 6) <= (t >> 6); sg[i] = (bf16)f2bf(ok ? sw[i] : 0.f); }
}

__device__ __forceinline__ void prologue_rope(const Params& p, int gtid, int nthr) {
    float* tab = (float*)(p.ws + WS_ROPE);
    for (int i = gtid; i < SEQ * 24; i += nthr) {
        const int pos = i / 24, j = i % 24;
        const int jj = j < 8 ? 2 * j : j - 8;
        float invf;
        switch (jj) { case 0: invf = 1.000000000e+00f; break; case 1: invf = 4.403665960e-01f; break; case 2: invf = 1.939227432e-01f; break; case 3: invf = 8.539710194e-02f; break;
            case 4: invf = 3.760603070e-02f; break; case 5: invf = 1.656044088e-02f; break; case 6: invf = 7.292664610e-03f; break; case 7: invf = 3.211446106e-03f; break;
            case 8: invf = 1.414213562e-03f; break; case 9: invf = 6.227724371e-04f; break; case 10: invf = 2.742481884e-04f; break; case 11: invf = 1.207697351e-04f; break;
            case 12: invf = 5.318295734e-05f; break; case 13: invf = 2.341999971e-05f; break; case 14: invf = 1.031338525e-05f; break; default: invf = 4.541670478e-06f; break; }
        int co, so; if (j < 8) { co = j; so = 8 + j; } else { co = 16 + (j - 8); so = 32 + (j - 8); }
        const float ang = (float)pos * invf; float sn, cs; sincosf(ang, &sn, &cs);
        tab[pos * 48 + co] = cs; tab[pos * 48 + so] = sn;
    }
}

__device__ __forceinline__ void fold_item(const Params& p, int l, int item, float* lds, int tid) {
    const int hc = item >> 4, mt = item & 15, c = hc & 1, m0 = mt * 128;
    const float* Wq = p.in[20] + (size_t)l * DM * DM; const float* keys = p.in[21] + (size_t)l * 2 * 128 * 128 + (size_t)c * 128 * 128;
    bf16* WPQ = (bf16*)(p.ws + WS_W + (size_t)l * W_LAYER + WO_PQ);
    float* As = lds; float* Bs = lds + 128 * 68;
    const int tn = tid & 31, tm = tid >> 5;
    float acc[4][8];
#pragma unroll
    for (int i = 0; i < 4; ++i)
#pragma unroll
        for (int j = 0; j < 8; ++j) acc[i][j] = 0.f;
    for (int dh = 0; dh < 2; ++dh) {
        __syncthreads();
        for (int i = tid; i < 128 * 16; i += 512) { const int r = i >> 4, q = i & 15;
            *(f32x4*)(As + r * 68 + 4 * q) = *(const f32x4*)(Wq + (size_t)(m0 + r) * DM + hc * 128 + dh * 64 + 4 * q);
            *(f32x4*)(Bs + r * 68 + 4 * q) = *(const f32x4*)(keys + r * 128 + dh * 64 + 4 * q); }
        __syncthreads();
#pragma unroll 2
        for (int d = 0; d < 64; d += 4) {
            f32x4 b4[4], a4[8];
#pragma unroll
            for (int i = 0; i < 4; ++i) b4[i] = *(const f32x4*)(Bs + (tn + 32 * i) * 68 + d);
#pragma unroll
            for (int j = 0; j < 8; ++j) a4[j] = *(const f32x4*)(As + (8 * tm + j) * 68 + d);
#pragma unroll
            for (int i = 0; i < 4; ++i)
#pragma unroll
                for (int j = 0; j < 8; ++j) acc[i][j] += (b4[i].x * a4[j].x + b4[i].y * a4[j].y) + (b4[i].z * a4[j].z + b4[i].w * a4[j].w);
        }
    }
#pragma unroll
    for (int i = 0; i < 4; ++i) *(u32x4*)(WPQ + (size_t)(hc * 128 + tn + 32 * i) * DM + m0 + 8 * tm) = pack8(acc[i]);
}

__device__ __forceinline__ void rms_row_to_bf16(const float* xrow, const float* gain, bf16* orow, int lane, unsigned char* o8 = nullptr) {
    f32x4 v[8]; float s = 0.f;
#pragma unroll
    for (int j = 0; j < 8; ++j) { v[j] = ((const f32x4*)xrow)[lane + 64 * j]; s += (v[j].x * v[j].x + v[j].y * v[j].y) + (v[j].z * v[j].z + v[j].w * v[j].w); }
    const float rstd = rsqrtf(wave_sum(s) * (1.f / DM) + NORM_EPS);
#pragma unroll
    for (int j = 0; j < 8; ++j) { const f32x4 g = ((const f32x4*)gain)[lane + 64 * j];
        u32x2 o; o.x = pk2(v[j].x * rstd * g.x, v[j].y * rstd * g.y); o.y = pk2(v[j].z * rstd * g.z, v[j].w * rstd * g.w);
        ((u32x2*)orow)[lane + 64 * j] = o;
        if (o8) ((unsigned*)o8)[lane + 64 * j] = pk4_fp8(v[j].x * rstd * g.x, v[j].y * rstd * g.y, v[j].z * rstd * g.z, v[j].w * rstd * g.w); }
}

template <bool XIN_BF16> __device__ __forceinline__ void add_rms_row(const void* xin, const bf16* dl, bf16* xout, const float* gain, bf16* orow, float* hs, int lane) {
    f32x4 v[8]; float s = 0.f;
#pragma unroll
    for (int j = 0; j < 8; ++j) { const u32x2 d = ((const u32x2*)dl)[lane + 64 * j];
        if (XIN_BF16) { const u32x2 xb = ((const u32x2*)xin)[lane + 64 * j]; v[j] = (f32x4){bflo(xb.x), bfhi(xb.x), bflo(xb.y), bfhi(xb.y)}; } else v[j] = ((const f32x4*)xin)[lane + 64 * j];
        v[j].x += bflo(d.x); v[j].y += bfhi(d.x); v[j].z += bflo(d.y); v[j].w += bfhi(d.y);
        { u32x2 xo; xo.x = pk2(v[j].x, v[j].y); xo.y = pk2(v[j].z, v[j].w); ((u32x2*)xout)[lane + 64 * j] = xo; }
        s += (v[j].x * v[j].x + v[j].y * v[j].y) + (v[j].z * v[j].z + v[j].w * v[j].w); }
    const float rstd = rsqrtf(wave_sum(s) * (1.f / DM) + NORM_EPS);
    float mx = 0.f;
#pragma unroll
    for (int j = 0; j < 8; ++j) { const f32x4 g = ((const f32x4*)gain)[lane + 64 * j];
        u32x2 o; o.x = pk2(v[j].x * rstd * g.x, v[j].y * rstd * g.y); o.y = pk2(v[j].z * rstd * g.z, v[j].w * rstd * g.w);
        ((u32x2*)orow)[lane + 64 * j] = o;
        v[j].x = bflo(o.x); v[j].y = bfhi(o.x); v[j].z = bflo(o.y); v[j].w = bfhi(o.y);
        mx = fmaxf(mx, fmaxf(fmaxf(fabsf(v[j].x), fabsf(v[j].y)), fmaxf(fabsf(v[j].z), fabsf(v[j].w)))); }
#pragma unroll
    for (int of = 1; of < 64; of <<= 1) mx = fmaxf(mx, __shfl_xor(mx, of));
    const float hscale = fmaxf(mx, 1e-30f) * (1.f / 127.f), ih = 1.f / hscale; int isum = 0;
#pragma unroll
    for (int j = 0; j < 8; ++j) isum += ((int)rintf(v[j].x * ih) + (int)rintf(v[j].y * ih)) + ((int)rintf(v[j].z * ih) + (int)rintf(v[j].w * ih));
    const float h8sum = wave_sum((float)isum);
    if (lane == 0) { hs[0] = hscale; hs[1] = h8sum; }
}

__device__ __forceinline__ void prep1_row(const Params& p, int l, int t, int lane) {
    bf16* z = (bf16*)(p.ws + WS_Z) + (size_t)t * ZP;
    const float* rope = (const float*)(p.ws + WS_ROPE) + (size_t)(t & (SEQ - 1)) * 48;
    float f[8];
#pragma unroll
    for (int seg = 0; seg < 2; ++seg) {
        const float* g = (seg == 0 ? p.in[3] : p.in[4]) + (size_t)l * 512;
        u32x4* ptr = (u32x4*)(z + (seg == 0 ? ZC_CQ : ZC_CKV)) + lane;
        unpack8(*ptr, f); float s = 0.f;
#pragma unroll
        for (int i = 0; i < 8; ++i) s += f[i] * f[i];
        const float rstd = rsqrtf(wave_sum(s) * (1.f / 512.f) + NORM_EPS);
#pragma unroll
        for (int i = 0; i < 8; ++i) f[i] = f[i] * rstd * g[lane * 8 + i];
        *ptr = pack8(f);
    }
#pragma unroll
    for (int seg = 0; seg < 2; ++seg) {
        const float* g = p.in[9] + (size_t)l * 128 + seg * 64;
        u32x4* ptr = (u32x4*)(z + (seg == 0 ? ZC_DQ : ZC_DK)) + lane;
        unpack8(*ptr, f); float s = 0.f;
#pragma unroll
        for (int i = 0; i < 8; ++i) s += f[i] * f[i];
        s += __shfl_xor(s, 1); s += __shfl_xor(s, 2); s += __shfl_xor(s, 4);
        const float rstd = rsqrtf(s * (1.f / 64.f) + NORM_EPS);
        const int d0 = (lane & 7) * 8;
#pragma unroll
        for (int i = 0; i < 8; ++i) f[i] = f[i] * rstd * g[d0 + i];
        float o[8];
#pragma unroll
        for (int i = 0; i < 8; ++i) o[i] = __shfl_xor(f[i], 1);
        if ((lane & 7) == 0) {
#pragma unroll
            for (int i = 0; i < 8; ++i) f[i] = f[i] * rope[i] - o[i] * rope[8 + i];
        } else if ((lane & 7) == 1) {
#pragma unroll
            for (int i = 0; i < 8; ++i) f[i] = f[i] * rope[i] + o[i] * rope[8 + i];
        }
        if (seg == 0) {
#pragma unroll
            for (int i = 0; i < 8; ++i) f[i] *= 0.125f * LOG2E;
        }
        *ptr = pack8(f);
    }
    {
        u32x4* ptr = (u32x4*)(z + ZC_SU) + lane;
        unpack8(*ptr, f);
#pragma unroll
        for (int i = 0; i < 8; ++i) f[i] = gelu_tanh(f[i]);
        *ptr = pack8(f);
    }
    {
        const float* g = p.in[12] + (size_t)l * 512;
        u32x4* ptr = (u32x4*)(z + ZC_SV) + lane;
        unpack8(*ptr, f); float s = 0.f;
#pragma unroll
        for (int i = 0; i < 8; ++i) { f[i] = gelu_tanh(f[i]); s += f[i] * f[i]; }
        const float rstd = rsqrtf(wave_sum(s) * (1.f / 512.f) + NORM_EPS);
#pragma unroll
        for (int i = 0; i < 8; ++i) f[i] = f[i] * rstd * g[lane * 8 + i];
        *ptr = pack8(f);
    }
    {
        const float* g = p.in[8] + (size_t)l * 64 + 32;
        const int ll = lane & 3;
        const u32x4 w = *((const u32x4*)(z + ZC_KR) + ll);
        unpack8(w, f); float s = 0.f;
#pragma unroll
        for (int i = 0; i < 8; ++i) s += f[i] * f[i];
        s += __shfl_xor(s, 1); s += __shfl_xor(s, 2);
        const float rstd = rsqrtf(s * (1.f / 32.f) + NORM_EPS);
#pragma unroll
        for (int i = 0; i < 8; ++i) f[i] = f[i] * rstd * g[ll * 8 + i];
        float o[8];
#pragma unroll
        for (int i = 0; i < 8; ++i) o[i] = __shfl_xor(f[i], 2);
        const int fi = (ll & 1) * 8;
        if (ll < 2) {
#pragma unroll
            for (int i = 0; i < 8; ++i) f[i] = f[i] * rope[16 + fi + i] - o[i] * rope[32 + fi + i];
        } else {
#pragma unroll
            for (int i = 0; i < 8; ++i) f[i] = f[i] * rope[16 + fi + i] + o[i] * rope[32 + fi + i];
        }
        if (lane < 32) { bf16* km = (bf16*)(p.ws + WS_KM) + (size_t)t * 768 + (lane >> 2) * 96 + 64 + ll * 8; *(u32x4*)km = pack8(f); }
    }
}

__device__ __forceinline__ void prep2_row(const Params& p, int l, int t, int lane) {
    const bf16* qr = (const bf16*)(p.ws + WS_QR) + (size_t)t * 768;
    const bf16* kvr = (const bf16*)(p.ws + WS_KVR) + (size_t)t * 1024;
    bf16* qm = (bf16*)(p.ws + WS_QM) + (size_t)t * 768;
    bf16* km = (bf16*)(p.ws + WS_KM) + (size_t)t * 768;
    const float* rope = (const float*)(p.ws + WS_ROPE) + (size_t)(t & (SEQ - 1)) * 48;
    const float* ng = p.in[7] + (size_t)l * 128;
    const float* rg = p.in[8] + (size_t)l * 64;
    const float qscale = 0.10206207261596577f * LOG2E;
    float f[8];
    const int h = lane >> 3, d0 = (lane & 7) * 8;
    {
        unpack8(*((const u32x4*)qr + lane), f); float s = 0.f;
#pragma unroll
        for (int i = 0; i < 8; ++i) s += f[i] * f[i];
        s += __shfl_xor(s, 1); s += __shfl_xor(s, 2); s += __shfl_xor(s, 4);
        const float rstd = rsqrtf(s * (1.f / 64.f) + NORM_EPS) * qscale;
#pragma unroll
        for (int i = 0; i < 8; ++i) f[i] = f[i] * rstd * ng[d0 + i];
        *(u32x4*)(qm + h * 96 + d0) = pack8(f);
    }
    {
        unpack8(*((const u32x4*)kvr + lane), f); float s = 0.f;
#pragma unroll
        for (int i = 0; i < 8; ++i) s += f[i] * f[i];
        s += __shfl_xor(s, 1); s += __shfl_xor(s, 2); s += __shfl_xor(s, 4);
        const float rstd = rsqrtf(s * (1.f / 64.f) + NORM_EPS);
#pragma unroll
        for (int i = 0; i < 8; ++i) f[i] = f[i] * rstd * ng[64 + d0 + i];
        *(u32x4*)(km + h * 96 + d0) = pack8(f);
    }
    {
        const int l5 = lane & 31, hh = l5 >> 2, ll = l5 & 3;
        unpack8(*((const u32x4*)(qr + 512) + l5), f); float s = 0.f;
#pragma unroll
        for (int i = 0; i < 8; ++i) s += f[i] * f[i];
        s += __shfl_xor(s, 1); s += __shfl_xor(s, 2);
        const float rstd = rsqrtf(s * (1.f / 32.f) + NORM_EPS);
#pragma unroll
        for (int i = 0; i < 8; ++i) f[i] = f[i] * rstd * rg[ll * 8 + i];
        float o[8];
#pragma unroll
        for (int i = 0; i < 8; ++i) o[i] = __shfl_xor(f[i], 2);
        const int fi = (ll & 1) * 8;
        if (ll < 2) {
#pragma unroll
            for (int i = 0; i < 8; ++i) f[i] = (f[i] * rope[16 + fi + i] - o[i] * rope[32 + fi + i]) * qscale;
        } else {
#pragma unroll
            for (int i = 0; i < 8; ++i) f[i] = (f[i] * rope[16 + fi + i] + o[i] * rope[32 + fi + i]) * qscale;
        }
        if (lane < 32) *(u32x4*)(qm + hh * 96 + 64 + ll * 8) = pack8(f);
    }
}

__device__ __forceinline__ float diff_lambda(const Params& p, int l, int lane) {
    const float* lv = p.in[10] + (size_t)l * 256;
    const float a = wave_sum(lv[lane] * lv[64 + lane]), b = wave_sum(lv[128 + lane] * lv[192 + lane]);
    const float lambda_init = 0.8f - 0.6f * expf(-0.3f * (float)l);
    return expf(a) - expf(b) + lambda_init;
}

typedef float f32x2 __attribute__((ext_vector_type(2)));
typedef _Float16 f16x32 __attribute__((ext_vector_type(32)));
typedef float f32x32 __attribute__((ext_vector_type(32)));
typedef unsigned u32x6 __attribute__((ext_vector_type(6)));
__device__ __forceinline__ void q4_row(const float* __restrict__ src, unsigned char* __restrict__ dst, float* scl, int lane) {
    f32x4 v[8]; float ss = 0.f;
#pragma unroll
    for (int j = 0; j < 8; ++j) { v[j] = *(const f32x4*)(src + 256 * (lane >> 3) + 32 * j + 4 * (lane & 7)); ss += (v[j].x * v[j].x + v[j].y * v[j].y) + (v[j].z * v[j].z + v[j].w * v[j].w); }
    const float sc = fmaxf(0.5f * sqrtf(wave_sum(ss) * (1.f / DM)), 1e-30f), is = 1.f / sc;
    u32x4 w;
#pragma unroll
    for (int d = 0; d < 4; ++d) { unsigned x = 0;
        const f32x4 a = v[2 * d], b = v[2 * d + 1];
        x = __builtin_amdgcn_cvt_scalef32_pk_fp4_f32(x, fminf(fmaxf(a.x * is, -6.f), 6.f), fminf(fmaxf(a.y * is, -6.f), 6.f), 1.0f, 0);
        x = __builtin_amdgcn_cvt_scalef32_pk_fp4_f32(x, fminf(fmaxf(a.z * is, -6.f), 6.f), fminf(fmaxf(a.w * is, -6.f), 6.f), 1.0f, 1);
        x = __builtin_amdgcn_cvt_scalef32_pk_fp4_f32(x, fminf(fmaxf(b.x * is, -6.f), 6.f), fminf(fmaxf(b.y * is, -6.f), 6.f), 1.0f, 2);
        x = __builtin_amdgcn_cvt_scalef32_pk_fp4_f32(x, fminf(fmaxf(b.z * is, -6.f), 6.f), fminf(fmaxf(b.w * is, -6.f), 6.f), 1.0f, 3);
        w[d] = x; }
    *(u32x4*)(dst + (size_t)(lane >> 3) * (NEXP * 128) + 16 * (lane & 7)) = w;
    if (lane == 0) *scl = sc;
}
__device__ __forceinline__ void q4u_row(const float* __restrict__ src, unsigned char* __restrict__ dst, float* scl, int lane) {
    f32x4 v[8]; float ss = 0.f;
#pragma unroll
    for (int j = 0; j < 8; ++j) { v[j] = *(const f32x4*)(src + 256 * (lane >> 3) + 32 * j + 4 * (lane & 7)); ss += (v[j].x * v[j].x + v[j].y * v[j].y) + (v[j].z * v[j].z + v[j].w * v[j].w); }
    const float step = fmaxf(0.35f * sqrtf(wave_sum(ss) * (1.f / DM)), 1e-30f), is = 1.f / step;
    u32x4 w;
#pragma unroll
    for (int d = 0; d < 4; ++d) { unsigned x = 0;
#pragma unroll
        for (int e = 0; e < 8; ++e) { const float f = v[2 * d + (e >> 2)][e & 3]; const int q = (int)fminf(fmaxf(rintf(f * is), -8.f), 7.f) + 8; x |= (unsigned)q << (4 * e); }
        w[d] = x; }
    *(u32x4*)(dst + (size_t)(lane >> 3) * (NEXP * 128) + 16 * (lane & 7)) = w;
    if (lane == 0) *scl = step;
}
__device__ __forceinline__ int f2key(float f) { const int b = __builtin_bit_cast(int, f); return b ^ ((b >> 31) & 0x7fffffff); }
__device__ __forceinline__ float key2f(int k) { const int b = k ^ ((k >> 31) & 0x7fffffff); return __builtin_bit_cast(float, b & ~127); }
__device__ __forceinline__ void topk_lane(const float* __restrict__ sc, int (&idxo)[16], float (&gwo)[16]) {
    float av[2][16]; int ai[2][16];
#pragma unroll
    for (int c = 0; c < 2; ++c) {
        int lst[16];
#pragma unroll
        for (int j = 0; j < 16; ++j) lst[j] = (int)0x80000000;
#pragma unroll 1
        for (int i0 = 0; i0 < 128; i0 += 32) {
            f32x4 v[8];
#pragma unroll
            for (int q = 0; q < 8; ++q) v[q] = *(const f32x4*)(sc + c * 128 + i0 + 4 * q);
#pragma unroll
            for (int q = 0; q < 8; ++q)
#pragma unroll
                for (int e = 0; e < 4; ++e) { int key = (f2key(v[q][e]) & ~127) | (127 - (i0 + 4 * q + e));
#pragma unroll
                    for (int j = 0; j < 16; ++j) { const int hi = max(lst[j], key); key = min(lst[j], key); lst[j] = hi; } }
        }
#pragma unroll
        for (int j = 0; j < 16; ++j) { av[c][j] = key2f(lst[j]); ai[c][j] = 127 - (lst[j] & 127); }
    }
    float lv[16]; int lp[16];
#pragma unroll
    for (int j = 0; j < 16; ++j) { lv[j] = -INFINITY; lp[j] = 0; }
#pragma unroll
    for (int i = 0; i < 16; ++i)
#pragma unroll
        for (int jj = 0; jj < 16; ++jj) if ((i + 1) * (jj + 1) <= 16) {
            float sv = av[0][i] + av[1][jj]; int pay = ai[0][i] * 128 + ai[1][jj];
#pragma unroll
            for (int j = 0; j < 16; ++j) { const bool gt = sv > lv[j]; const float nv = gt ? sv : lv[j]; const int np = gt ? pay : lp[j]; sv = gt ? lv[j] : sv; pay = gt ? lp[j] : pay; lv[j] = nv; lp[j] = np; }
        }
    float sum = 0.f; const float mx = lv[0];
#pragma unroll
    for (int j = 0; j < 16; ++j) { lv[j] = __expf(lv[j] - mx); sum += lv[j]; }
    const float inv = 1.f / sum;
#pragma unroll
    for (int j = 0; j < 16; ++j) { idxo[j] = lp[j]; gwo[j] = lv[j] * inv; }
}
__device__ __forceinline__ float dot_f4(const u32x4 a, const f32x2 (&h)[16]) {
    f32x2 s = {0.f, 0.f};
#pragma unroll
    for (int w = 0; w < 4; ++w) {
        s = __builtin_elementwise_fma(__builtin_amdgcn_cvt_scalef32_pk_f32_fp4(a[w], 1.0f, 0), h[4 * w], s); s = __builtin_elementwise_fma(__builtin_amdgcn_cvt_scalef32_pk_f32_fp4(a[w], 1.0f, 1), h[4 * w + 1], s);
        s = __builtin_elementwise_fma(__builtin_amdgcn_cvt_scalef32_pk_f32_fp4(a[w], 1.0f, 2), h[4 * w + 2], s); s = __builtin_elementwise_fma(__builtin_amdgcn_cvt_scalef32_pk_f32_fp4(a[w], 1.0f, 3), h[4 * w + 3], s); }
    return s.x + s.y;
}
__device__ __forceinline__ int dot_u4i(const u32x4 a, const int (&he)[4], const int (&ho)[4]) {
    int acc = 0;
#pragma unroll
    for (int w = 0; w < 4; ++w) { acc = __builtin_amdgcn_sdot4((int)(a[w] & 0x0F0F0F0Fu), he[w], acc, false); acc = __builtin_amdgcn_sdot4((int)((a[w] >> 4) & 0x0F0F0F0Fu), ho[w], acc, false); }
    return acc;
}
typedef _Float16 h16x2 __attribute__((ext_vector_type(2)));
__device__ __forceinline__ void axpy_h4(const u32x4 a, unsigned c2bits, h16x2 (&o)[16]) {
    const h16x2 c2 = __builtin_bit_cast(h16x2, c2bits);
#pragma unroll
    for (int w = 0; w < 4; ++w) {
#pragma unroll
        for (int b = 0; b < 4; ++b) { const h16x2 v = b == 0 ? __builtin_bit_cast(h16x2, __builtin_amdgcn_cvt_scalef32_pk_f16_fp4(a[w], 1.0f, 0)) : b == 1 ? __builtin_bit_cast(h16x2, __builtin_amdgcn_cvt_scalef32_pk_f16_fp4(a[w], 1.0f, 1))
                                                     : b == 2 ? __builtin_bit_cast(h16x2, __builtin_amdgcn_cvt_scalef32_pk_f16_fp4(a[w], 1.0f, 2)) : __builtin_bit_cast(h16x2, __builtin_amdgcn_cvt_scalef32_pk_f16_fp4(a[w], 1.0f, 3));
            o[4 * w + b] = __builtin_elementwise_fma(c2, v, o[4 * w + b]); } }
}
__device__ __forceinline__ int grp8_sum(int x) {
    x += __builtin_amdgcn_update_dpp(0, x, 0xB1, 0xF, 0xF, true);
    x += __builtin_amdgcn_update_dpp(0, x, 0x4E, 0xF, 0xF, true);
    x += __builtin_amdgcn_update_dpp(0, x, 0x141, 0xF, 0xF, true);
    return x;
}
__device__ __forceinline__ float grp8_sumf(float x) {
    x += __builtin_bit_cast(float, __builtin_amdgcn_update_dpp(0, __builtin_bit_cast(int, x), 0xB1, 0xF, 0xF, true));
    x += __builtin_bit_cast(float, __builtin_amdgcn_update_dpp(0, __builtin_bit_cast(int, x), 0x4E, 0xF, 0xF, true));
    x += __builtin_bit_cast(float, __builtin_amdgcn_update_dpp(0, __builtin_bit_cast(int, x), 0x141, 0xF, 0xF, true));
    return x;
}
constexpr int PEER_LDS_WAVE = 12288;
template <int MODE = 0, bool XOUT_F32 = false> __device__ __forceinline__ void peer_octets(const Params& p, int l, int gw, int ngw, int lane, const float* gain_next, const bf16* xin, void* xout, LAS unsigned char* wl) {
    const __amdgpu_buffer_rsrc_t RU = __builtin_amdgcn_make_buffer_rsrc((void*)(p.ws + WS_U8 + (size_t)l * NEXP * QROW), 0, NEXP * QROW, 0x00020000);
    const __amdgpu_buffer_rsrc_t RV = __builtin_amdgcn_make_buffer_rsrc((void*)(p.ws + WS_V8 + (size_t)l * NEXP * QROW), 0, NEXP * QROW, 0x00020000);
    const float* PSU = (const float*)(p.ws + WS_PS) + (size_t)l * NEXP; const float* PSV = PSU + (size_t)DEPTH * NEXP;
    const int tl = lane >> 3, c = lane & 7, c16 = 16 * c;
    LAS u32x4* pr4 = (LAS u32x4*)(wl + tl * 1024);
    LAS int* acc = (LAS int*)(wl + 8192 + tl * 512);
    for (int oc = gw; oc < T / 8; oc += ngw) {
        const int t = 8 * oc + tl;
        const bf16* hb = (const bf16*)(p.ws + WS_HB) + (size_t)t * DM + 4 * c;
        int myidx[16]; float mygw[16], mysu[16], mysv[16];
        topk_lane((const float*)(p.ws + WS_SC) + ((size_t)t * 8 + c) * 256, myidx, mygw);
#pragma unroll
        for (int i = 0; i < 16; ++i) { mysu[i] = PSU[myidx[i]]; mysv[i] = PSV[myidx[i]]; }
#pragma unroll
        for (int i = 0; i < 8; ++i) { pr4[8 * c + i] = (u32x4){(unsigned)myidx[2 * i] * 128u, 0u, (unsigned)myidx[2 * i + 1] * 128u, 0u}; }
#pragma unroll
        for (int i = 0; i < 4; ++i) *(LAS u32x4*)(acc + 16 * c + 4 * i) = (u32x4){0u, 0u, 0u, 0u};
        const f32x2 hs = *(const f32x2*)((const float*)(p.ws + WS_HS) + 2 * (size_t)t);
        const float hscale = hs.x, h8sum = hs.y, ih = 1.f / hscale;
        u32x4 bufA[8], bufB[8]; unsigned cfA[8], cfB[8];
#define PEER_ISSUE(buf, cf, R, b) do { const int j_ = (b) & 15; const int so_ = ((b) >> 4) * (NEXP * 128); \
            const u32x4 q0_ = pr4[4 * j_], q1_ = pr4[4 * j_ + 1], q2_ = pr4[4 * j_ + 2], q3_ = pr4[4 * j_ + 3]; \
            cf[0] = q0_.y; cf[1] = q0_.w; cf[2] = q1_.y; cf[3] = q1_.w; cf[4] = q2_.y; cf[5] = q2_.w; cf[6] = q3_.y; cf[7] = q3_.w; \
            buf[0] = __builtin_amdgcn_raw_buffer_load_b128(R, (int)q0_.x + c16, so_, 0); buf[1] = __builtin_amdgcn_raw_buffer_load_b128(R, (int)q0_.z + c16, so_, 0); \
            buf[2] = __builtin_amdgcn_raw_buffer_load_b128(R, (int)q1_.x + c16, so_, 0); buf[3] = __builtin_amdgcn_raw_buffer_load_b128(R, (int)q1_.z + c16, so_, 0); \
            buf[4] = __builtin_amdgcn_raw_buffer_load_b128(R, (int)q2_.x + c16, so_, 0); buf[5] = __builtin_amdgcn_raw_buffer_load_b128(R, (int)q2_.z + c16, so_, 0); \
            buf[6] = __builtin_amdgcn_raw_buffer_load_b128(R, (int)q3_.x + c16, so_, 0); buf[7] = __builtin_amdgcn_raw_buffer_load_b128(R, (int)q3_.z + c16, so_, 0); } while (0)
        int he[4], ho[4];
#define PEER_HLOAD(sl) do { float hf_[32]; \
            _Pragma("unroll") for (int q = 0; q < 8; ++q) { const u32x2 w_ = *(const u32x2*)(hb + 256 * (sl) + 32 * q); hf_[4 * q] = bflo(w_.x); hf_[4 * q + 1] = bfhi(w_.x); hf_[4 * q + 2] = bflo(w_.y); hf_[4 * q + 3] = bfhi(w_.y); } \
            _Pragma("unroll") for (int w = 0; w < 4; ++w) { unsigned e_ = 0, od_ = 0; \
                _Pragma("unroll") for (int j = 0; j < 4; ++j) { const int qe = (int)rintf(hf_[8 * w + 2 * j] * ih), qo = (int)rintf(hf_[8 * w + 2 * j + 1] * ih); e_ |= (unsigned)(qe & 255) << (8 * j); od_ |= (unsigned)(qo & 255) << (8 * j); } \
                he[w] = (int)e_; ho[w] = (int)od_; } } while (0)
#define PEER_CONSUME_U(buf, b) do { int mine_ = 0; \
            _Pragma("unroll") for (int i = 0; i < 8; ++i) { const int tot_ = grp8_sum(dot_u4i(buf[i], he, ho)); mine_ = (c == i) ? tot_ : mine_; } \
            __hip_atomic_fetch_add(acc + 8 * ((b) & 15) + c, mine_, __ATOMIC_RELAXED, __HIP_MEMORY_SCOPE_WAVEFRONT); } while (0)
        if (!(MODE & 1)) {
        PEER_ISSUE(bufA, cfA, RU, 0);
#pragma unroll 1
        for (int b = 0; b < 128; b += 2) {
            if ((b & 15) == 0) PEER_HLOAD(b >> 4);
            PEER_ISSUE(bufB, cfB, RU, b + 1);
            __builtin_amdgcn_sched_barrier(0);
            PEER_CONSUME_U(bufA, b);
            __builtin_amdgcn_sched_barrier(0);
            if (b + 2 < 128) PEER_ISSUE(bufA, cfA, RU, b + 2);
            __builtin_amdgcn_sched_barrier(0);
            PEER_CONSUME_U(bufB, b + 1);
            __builtin_amdgcn_sched_barrier(0);
        }
        }
#pragma unroll
        for (int i = 0; i < 16; ++i) { const float a = ((float)acc[16 * c + i] - 8.f * h8sum) * mysu[i] * hscale;
            const _Float16 ch = (_Float16)(mygw[i] * gelu_tanh(a) * mysv[i] * 256.f);
            ((LAS unsigned*)pr4)[2 * (16 * c + i) + 1] = __builtin_bit_cast(unsigned, (h16x2){ch, ch}); }
        h16x2 o[16]; u32x2 xr[8]; float ss = 0.f;
#pragma unroll
        for (int i = 0; i < 16; ++i) o[i] = (h16x2){(_Float16)0.f, (_Float16)0.f};
#pragma unroll
        for (int q = 0; q < 8; ++q) xr[q] = (u32x2){0u, 0u};
        const bf16* xrow = xin + (size_t)t * DM + 4 * c; float* xwf = (float*)xout + (size_t)t * DM + 4 * c; bf16* xwb = (bf16*)xout + (size_t)t * DM + 4 * c;
#define PEER_CONSUME_V(buf, cf) do { _Pragma("unroll") for (int i = 0; i < 8; ++i) axpy_h4(buf[i], cf[i], o); } while (0)
        if (!(MODE & 2)) {
        PEER_ISSUE(bufA, cfA, RV, 0);
#pragma unroll 1
        for (int b = 0; b < 128; b += 2) {
            if ((b & 15) == 12) {
#pragma unroll
                for (int q = 0; q < 8; ++q) xr[q] = *(const u32x2*)(xrow + 256 * (b >> 4) + 32 * q); }
            PEER_ISSUE(bufB, cfB, RV, b + 1);
            __builtin_amdgcn_sched_barrier(0);
            PEER_CONSUME_V(bufA, cfA);
            __builtin_amdgcn_sched_barrier(0);
            if (b + 2 < 128) PEER_ISSUE(bufA, cfA, RV, b + 2);
            __builtin_amdgcn_sched_barrier(0);
            PEER_CONSUME_V(bufB, cfB);
            __builtin_amdgcn_sched_barrier(0);
            if ((b & 15) == 14) {
#pragma unroll
                for (int q = 0; q < 8; ++q) { f32x4 x = {bflo(xr[q].x), bfhi(xr[q].x), bflo(xr[q].y), bfhi(xr[q].y)};
                    x.x += (float)o[2 * q].x * (1.f / 256.f); x.y += (float)o[2 * q].y * (1.f / 256.f); x.z += (float)o[2 * q + 1].x * (1.f / 256.f); x.w += (float)o[2 * q + 1].y * (1.f / 256.f);
                    if (!(MODE & 4)) { if (XOUT_F32) *(f32x4*)(xwf + 256 * (b >> 4) + 32 * q) = x; else { u32x2 xo; xo.x = pk2(x.x, x.y); xo.y = pk2(x.z, x.w); *(u32x2*)(xwb + 256 * (b >> 4) + 32 * q) = xo; } } ss += (x.x * x.x + x.y * x.y) + (x.z * x.z + x.w * x.w); }
#pragma unroll
                for (int i = 0; i < 16; ++i) o[i] = (h16x2){(_Float16)0.f, (_Float16)0.f};
            }
        }
        }
        if (gain_next) {
            const float rstd = rsqrtf(grp8_sumf(ss) * (1.f / DM) + NORM_EPS);
            bf16* hw = (bf16*)(p.ws + WS_HB) + (size_t)t * DM + 4 * c; unsigned char* h8w = p.ws + WS_HB8 + (size_t)t * DM + 4 * c;
#pragma unroll 1
            for (int sl = 0; sl < 8; ++sl) {
#pragma unroll
                for (int q = 0; q < 8; ++q) { const int e0 = 256 * sl + 32 * q; const u32x2 xb_ = *(const u32x2*)(xwb + e0); const f32x4 x = {bflo(xb_.x), bfhi(xb_.x), bflo(xb_.y), bfhi(xb_.y)}; const f32x4 g = *(const f32x4*)(gain_next + e0 + 4 * c);
                    u32x2 w; w.x = pk2(x.x * rstd * g.x, x.y * rstd * g.y); w.y = pk2(x.z * rstd * g.z, x.w * rstd * g.w);
                    *(u32x2*)(hw + e0) = w;
                    *(unsigned*)(h8w + e0) = pk4_fp8(x.x * rstd * g.x, x.y * rstd * g.y, x.z * rstd * g.z, x.w * rstd * g.w); }
            }
        }
    }
#undef PEER_ISSUE
#undef PEER_HLOAD
#undef PEER_CONSUME_U
#undef PEER_CONSUME_V
}

namespace pg8 {
#define PG8_LAS __attribute__((address_space(3)))
typedef int v4i32 __attribute__((ext_vector_type(4)));
typedef int v8i32 __attribute__((ext_vector_type(8)));
constexpr int BM = 256, BK = 64, HALF = 128, HTB = HALF * BK * 2, STAGE_BYTES = 8 * HTB, NXCD = 8, WGM = 8;
__host__ __device__ __forceinline__ int lds_byte(int r, int c) { const int st = (r >> 4) * 2 + (c >> 5), rr = r & 15, cc = c & 31, ob = rr * 64 + cc * 2; return st * 1024 + (ob ^ (((ob >> 9) & 1) << 5)); }
__host__ __device__ __forceinline__ void stage_rc(int b, int& R, int& C) { const int st = b / 1024, sb = b % 1024, swz = sb ^ (((sb >> 9) & 1) << 5); R = (st >> 1) * 16 + swz / 64; C = (st & 1) * 32 + (swz % 64) / 2; }
__host__ __device__ __forceinline__ int perm32(int rho) { const int n = rho >> 4, i = rho & 15; return 8 * (i >> 2) + 4 * n + (i & 3); }
struct Unit { int pm, pn; };
struct StaticOrder {
    int nM, nN, nwg, G, c;
    __host__ __device__ void init(int M, int N, int G_, int c_) { nM = M / BM; nN = N / BM; nwg = nM * nN; G = G_; c = c_; }
    __host__ __device__ bool next(int i, Unit& u) const {
        const long L = (long)i * G + c; if (L >= nwg) return false;
        int wgid = (int)L; { const int q = nwg / NXCD, r = nwg % NXCD, xcd = wgid % NXCD, off = wgid / NXCD; wgid = (xcd < r ? xcd * (q + 1) : r * (q + 1) + (xcd - r) * q) + off; }
        const int nig = WGM * nN, gid = wgid / nig, fm = gid * WGM, gsz = (nM - fm) < WGM ? (nM - fm) : WGM;
        u.pm = fm + ((wgid % nig) % gsz); u.pn = (wgid % nig) / gsz; return true;
    }
};
struct MergedOrder {
    StaticOrder base;
    __host__ __device__ bool next(int i, Unit& u) const { const int tile = i / 3, n = i - 3 * tile; Unit b; if (!base.next(tile, b)) return false; u.pm = n * 64 + b.pm; u.pn = n * 8 + b.pn; return true; }
};
struct ZGOrder {
    StaticOrder sz, sg;
    __host__ __device__ void init(int G, int c) { sz.init(T, ZP, G, c); sg.init(T, DM, G, c); }
    __host__ __device__ bool next(int i, Unit& u) const {
        const int nzu = sz.c < sz.nwg ? (sz.nwg - sz.c + sz.G - 1) / sz.G : 0;
        if (i < nzu) return sz.next(i, u);
        const int j = i - nzu, tile = j / 3, n = j - 3 * tile; Unit b; if (!sg.next(tile, b)) return false; u.pm = b.pm; u.pn = 15 + 8 * n + b.pn; return true; }
};
struct ProbGen { const bf16* A; const bf16* Bt; int lda, ldb, K;
    __device__ __forceinline__ const char* Aptr(const Unit& u) const { return (const char*)(A + (size_t)u.pm * BM * lda); }
    __device__ __forceinline__ const char* Bptr(const Unit& u) const { return (const char*)(Bt + (size_t)u.pn * BM * ldb); } };
struct ProbUp { const bf16* Z; const bf16* Wup; int lda, ldb, K;
    __device__ __forceinline__ const char* Aptr(const Unit& u) const { return (const char*)(Z + (size_t)u.pm * BM * ZP + (u.pn < 3 ? ZC_CQ : ZC_CKV)); }
    __device__ __forceinline__ const char* Bptr(const Unit& u) const { return (const char*)(Wup + (size_t)u.pn * BM * 512); } };

__device__ __forceinline__ unsigned cvt_pk_bf16(float lo, float hi) { unsigned r; asm volatile("v_cvt_pk_bf16_f32 %0, %1, %2" : "=v"(r) : "v"(lo), "v"(hi)); return r; }
struct EpiZG { static constexpr bool PERM = true; static constexpr bool HOOK = false; bf16* Z; bf16* G; const float* bg; int noratio;
    __device__ __forceinline__ void operator()(const f32x4 (&acc)[2][2][4][2], const Unit& u, int wr, int wc, int fr, int fq) const {
        const int row0 = u.pm * BM + wr * 64 + fr; const bool gate = u.pn >= 15;
        const int gi = u.pn - 15, n0_ = gi >> 3; const int n = n0_;  const bool rat = n0_ > 0 && !noratio;
        bf16* base = gate ? G + n * DM : Z; const int ld = gate ? NGATE : ZP; const int colt = gate ? (gi & 7) * BM : u.pn * BM; const int col0 = colt + wc * 32 + 8 * fq;
        f32x4 bv[2][2];
#pragma unroll
        for (int bj = 0; bj < 2; ++bj)
#pragma unroll
            for (int nn = 0; nn < 2; ++nn) bv[bj][nn] = gate ? *(const f32x4*)(bg + n * DM + col0 + bj * HALF + 4 * nn) : (f32x4){0.f, 0.f, 0.f, 0.f};
#pragma unroll
        for (int ai = 0; ai < 2; ++ai) {
            u32x4 pw[4][2];
            if (gate && rat) {
#pragma unroll
                for (int m = 0; m < 4; ++m)
#pragma unroll
                    for (int bj = 0; bj < 2; ++bj) pw[m][bj] = *(const u32x4*)(base + (size_t)(row0 + ai * HALF + m * 16) * ld + col0 + bj * HALF - DM);
                __builtin_amdgcn_sched_barrier(0);
            }
#pragma unroll
            for (int m = 0; m < 4; ++m) { bf16* rowp = base + (size_t)(row0 + ai * HALF + m * 16) * ld + col0;
#pragma unroll
                for (int bj = 0; bj < 2; ++bj) { f32x4 v0 = acc[ai][bj][m][0] + bv[bj][0], v1 = acc[ai][bj][m][1] + bv[bj][1];
                    if (gate) {
#pragma unroll
                        for (int j = 0; j < 4; ++j) { v0[j] = fmaxf(__builtin_amdgcn_rcpf(1.f + __builtin_amdgcn_exp2f(-LOG2E * v0[j])), 1e-6f); v1[j] = fmaxf(__builtin_amdgcn_rcpf(1.f + __builtin_amdgcn_exp2f(-LOG2E * v1[j])), 1e-6f); }
                        if (rat) { const u32x4 q = pw[m][bj];
                            const float p8[8] = {bflo(q.x), bfhi(q.x), bflo(q.y), bfhi(q.y), bflo(q.z), bfhi(q.z), bflo(q.w), bfhi(q.w)};
                            u32x4 rw; rw.x = cvt_pk_bf16(p8[0] * __builtin_amdgcn_rcpf(v0[0]), p8[1] * __builtin_amdgcn_rcpf(v0[1])); rw.y = cvt_pk_bf16(p8[2] * __builtin_amdgcn_rcpf(v0[2]), p8[3] * __builtin_amdgcn_rcpf(v0[3]));
                            rw.z = cvt_pk_bf16(p8[4] * __builtin_amdgcn_rcpf(v1[0]), p8[5] * __builtin_amdgcn_rcpf(v1[1])); rw.w = cvt_pk_bf16(p8[6] * __builtin_amdgcn_rcpf(v1[2]), p8[7] * __builtin_amdgcn_rcpf(v1[3]));
                            *(u32x4*)(rowp + bj * HALF - DM) = rw; } }
                    u32x4 w; w.x = cvt_pk_bf16(v0[0], v0[1]); w.y = cvt_pk_bf16(v0[2], v0[3]); w.z = cvt_pk_bf16(v1[0], v1[1]); w.w = cvt_pk_bf16(v1[2], v1[3]);
                    *(u32x4*)(rowp + bj * HALF) = w; } }
        }
    } };
struct EpiG8 { static constexpr bool PERM = true; static constexpr bool HOOK = false; bf16* G; const float* bg; const unsigned* gmax;
    __device__ __forceinline__ void operator()(const f32x4 (&acc)[2][2][4][2], const Unit& u, int wr, int wc, int fr, int fq) const {
        const int row0 = u.pm * BM + wr * 64 + fr, col0 = u.pn * BM + wc * 32 + 8 * fq; const int n = u.pn >> 3; const float is = 1.f / gate_scale(gmax + 64 * n);
        f32x4 bv[2][2];
#pragma unroll
        for (int bj = 0; bj < 2; ++bj)
#pragma unroll
            for (int nn = 0; nn < 2; ++nn) bv[bj][nn] = *(const f32x4*)(bg + col0 + bj * HALF + 4 * nn);
#pragma unroll
        for (int ai = 0; ai < 2; ++ai)
#pragma unroll
            for (int m = 0; m < 4; ++m) { unsigned char* rowp = (unsigned char*)G + (size_t)(row0 + ai * HALF + m * 16) * NGATE + col0;
#pragma unroll
                for (int bj = 0; bj < 2; ++bj) { f32x4 v0 = acc[ai][bj][m][0] * is + bv[bj][0], v1 = acc[ai][bj][m][1] * is + bv[bj][1];
#pragma unroll
                    for (int j = 0; j < 4; ++j) { v0[j] = 256.f * __builtin_amdgcn_rcpf(1.f + __builtin_amdgcn_exp2f(-LOG2E * v0[j])) - 0.5f; v1[j] = 256.f * __builtin_amdgcn_rcpf(1.f + __builtin_amdgcn_exp2f(-LOG2E * v1[j])) - 0.5f; }
                    u32x2 w = {0u, 0u};
                    w.x = __builtin_amdgcn_cvt_pk_u8_f32(v0[0], 0, w.x); w.x = __builtin_amdgcn_cvt_pk_u8_f32(v0[1], 1, w.x); w.x = __builtin_amdgcn_cvt_pk_u8_f32(v0[2], 2, w.x); w.x = __builtin_amdgcn_cvt_pk_u8_f32(v0[3], 3, w.x);
                    w.y = __builtin_amdgcn_cvt_pk_u8_f32(v1[0], 0, w.y); w.y = __builtin_amdgcn_cvt_pk_u8_f32(v1[1], 1, w.y); w.y = __builtin_amdgcn_cvt_pk_u8_f32(v1[2], 2, w.y); w.y = __builtin_amdgcn_cvt_pk_u8_f32(v1[3], 3, w.y);
                    *(u32x2*)(rowp + bj * HALF) = w; } }
    } };
struct EpiUp { static constexpr bool HOOK = false; static constexpr bool PERM = true; bf16* QR; bf16* KVR;
    __device__ __forceinline__ void operator()(const f32x4 (&acc)[2][2][4][2], const Unit& u, int wr, int wc, int fr, int fq) const {
        const int row0 = u.pm * BM + wr * 64 + fr; const bool kv = u.pn >= 3;
        bf16* base = kv ? KVR : QR; const int ld = kv ? 1024 : 768; const int col0 = (kv ? (u.pn - 3) : u.pn) * BM + wc * 32 + 8 * fq;
#pragma unroll
        for (int ai = 0; ai < 2; ++ai)
#pragma unroll
            for (int m = 0; m < 4; ++m) { bf16* rowp = base + (size_t)(row0 + ai * HALF + m * 16) * ld + col0;
#pragma unroll
                for (int bj = 0; bj < 2; ++bj) { const f32x4 v0 = acc[ai][bj][m][0], v1 = acc[ai][bj][m][1];
                    u32x4 w; w.x = cvt_pk_bf16(v0[0], v0[1]); w.y = cvt_pk_bf16(v0[2], v0[3]); w.z = cvt_pk_bf16(v1[0], v1[1]); w.w = cvt_pk_bf16(v1[2], v1[3]);
                    *(u32x4*)(rowp + bj * HALF) = w; } }
    } };
struct EpiMG { static constexpr bool PERM = true; static constexpr bool HOOK = true; bf16* MG; const bf16* R; int nohook;
    template <bool RATIO> __device__ __forceinline__ void scale(f32x4 (&acc)[2][2][4][2], const Unit& u, int wr, int wc, int fr, int fq, int slot) const {
        const __amdgpu_buffer_rsrc_t rs = __builtin_amdgcn_make_buffer_rsrc((void*)R, 0, (int)((size_t)T * NGATE), 0x00020000);
        const int voff = (u.pm * BM + wr * 64 + fr) * NGATE + slot * DM + u.pn * BM + wc * 32 + 8 * fq;
#define MG_DEC(w_, k_) ((float)(((w_) >> (8 * (k_))) & 0xFFu))
#pragma unroll
        for (int ai = 0; ai < 2; ++ai) {
            u32x2 ga[4][2], gb[4][2];
#pragma unroll
            for (int m = 0; m < 4; ++m)
#pragma unroll
                for (int bj = 0; bj < 2; ++bj) { ga[m][bj] = __builtin_amdgcn_raw_buffer_load_b64(rs, voff, (ai * HALF + m * 16) * NGATE + bj * HALF, 0);
                    if (RATIO) gb[m][bj] = __builtin_amdgcn_raw_buffer_load_b64(rs, voff, (ai * HALF + m * 16) * NGATE + DM + bj * HALF, 0); }
            __builtin_amdgcn_sched_barrier(0);
#pragma unroll
            for (int m = 0; m < 4; ++m)
#pragma unroll
                for (int bj = 0; bj < 2; ++bj) { const u32x2 a = ga[m][bj];
                    float f[8];
#pragma unroll
                    for (int j = 0; j < 8; ++j) f[j] = MG_DEC(j < 4 ? a.x : a.y, j & 3) * (1.f / 256.f) + (0.5f / 256.f);
                    if (RATIO) { const u32x2 b = gb[m][bj];
#pragma unroll
                        for (int j = 0; j < 8; ++j) f[j] *= __builtin_amdgcn_rcpf(MG_DEC(j < 4 ? b.x : b.y, j & 3) * (1.f / 256.f) + (0.5f / 256.f)); }
                    acc[ai][bj][m][0][0] *= f[0]; acc[ai][bj][m][0][1] *= f[1]; acc[ai][bj][m][0][2] *= f[2]; acc[ai][bj][m][0][3] *= f[3];
                    acc[ai][bj][m][1][0] *= f[4]; acc[ai][bj][m][1][1] *= f[5]; acc[ai][bj][m][1][2] *= f[6]; acc[ai][bj][m][1][3] *= f[7]; }
            __builtin_amdgcn_sched_barrier(0);
        }
    }
#undef MG_DEC
    __device__ __forceinline__ void hook(f32x4 (&acc)[2][2][4][2], const Unit& u, int wr, int wc, int fr, int fq, int seg) const { if (!nohook) scale<true>(acc, u, wr, wc, fr, fq, seg - 1); }
    __device__ __forceinline__ void operator()(f32x4 (&acc)[2][2][4][2], const Unit& u, int wr, int wc, int fr, int fq) const {
        scale<false>(acc, u, wr, wc, fr, fq, 2);
        const int row0 = u.pm * BM + wr * 64 + fr, col0 = u.pn * BM + wc * 32 + 8 * fq;
#pragma unroll
        for (int ai = 0; ai < 2; ++ai)
#pragma unroll
            for (int m = 0; m < 4; ++m) { bf16* rowp = MG + (size_t)(row0 + ai * HALF + m * 16) * DM + col0;
#pragma unroll
                for (int bj = 0; bj < 2; ++bj) { const f32x4 v0 = acc[ai][bj][m][0], v1 = acc[ai][bj][m][1];
                    u32x4 w; w.x = cvt_pk_bf16(v0[0], v0[1]); w.y = cvt_pk_bf16(v0[2], v0[3]); w.z = cvt_pk_bf16(v1[0], v1[1]); w.w = cvt_pk_bf16(v1[2], v1[3]);
                    *(u32x4*)(rowp + bj * HALF) = w; } }
    } };
struct EpiOut { static constexpr bool HOOK = false; static constexpr bool PERM = false; const float* Xin; float* X;
    __device__ __forceinline__ void operator()(const f32x4 (&acc)[2][2][4][2], const Unit& u, int wr, int wc, int fr, int fq) const {
        const int row0 = u.pm * BM + wr * 64 + fr, col0 = u.pn * BM + wc * 32 + 4 * fq;
#pragma unroll
        for (int ai = 0; ai < 2; ++ai)
#pragma unroll
            for (int m = 0; m < 4; ++m) { const size_t off = (size_t)(row0 + ai * HALF + m * 16) * DM + col0;
#pragma unroll
                for (int bj = 0; bj < 2; ++bj)
#pragma unroll
                    for (int n = 0; n < 2; ++n) { const f32x4 xi = *(const f32x4*)(Xin + off + bj * HALF + n * 16); *(f32x4*)(X + off + bj * HALF + n * 16) = xi + acc[ai][bj][m][n]; } }
    } };
struct EpiDelta { static constexpr bool HOOK = false; static constexpr bool PERM = true; bf16* D;
    __device__ __forceinline__ void operator()(const f32x4 (&acc)[2][2][4][2], const Unit& u, int wr, int wc, int fr, int fq) const {
        const int row0 = u.pm * BM + wr * 64 + fr, col0 = u.pn * BM + wc * 32 + 8 * fq;
#pragma unroll
        for (int ai = 0; ai < 2; ++ai)
#pragma unroll
            for (int m = 0; m < 4; ++m) { bf16* rowp = D + (size_t)(row0 + ai * HALF + m * 16) * DM + col0;
#pragma unroll
                for (int bj = 0; bj < 2; ++bj) { const f32x4 v0 = acc[ai][bj][m][0], v1 = acc[ai][bj][m][1];
                    u32x4 w; w.x = cvt_pk_bf16(v0[0], v0[1]); w.y = cvt_pk_bf16(v0[2], v0[3]); w.z = cvt_pk_bf16(v1[0], v1[1]); w.w = cvt_pk_bf16(v1[2], v1[3]);
                    *(u32x4*)(rowp + bj * HALF) = w; } }
    } };
struct EpiSC { static constexpr bool HOOK = false; static constexpr bool PERM = false; float* SC;
    __device__ __forceinline__ void operator()(const f32x4 (&acc)[2][2][4][2], const Unit& u, int wr, int wc, int fr, int fq) const {
        const int row0 = u.pm * BM + wr * 64 + fr, col0 = u.pn * BM + wc * 32 + 4 * fq;
#pragma unroll
        for (int ai = 0; ai < 2; ++ai)
#pragma unroll
            for (int m = 0; m < 4; ++m) { const size_t off = (size_t)(row0 + ai * HALF + m * 16) * DM + col0;
#pragma unroll
                for (int bj = 0; bj < 2; ++bj)
#pragma unroll
                    for (int n = 0; n < 2; ++n) *(f32x4*)(SC + off + bj * HALF + n * 16) = acc[ai][bj][m][n]; }
    } };

template <class Epi, class Prob, class Sched, bool ALIGN_EPI = true, bool FP8 = false>
__device__ __forceinline__ void gemm_phase(PG8_LAS unsigned char* lds, const Prob g, const Sched& S, const Epi& E) {
    int tid = threadIdx.x; asm volatile("" : "+v"(tid));
    const int wid = __builtin_amdgcn_readfirstlane(tid >> 6), lane = tid & 63, wr = wid >> 2, wc = wid & 3, fr = lane & 15, fq = lane >> 4;
    const int K = g.K, nt = K / BK;
    unsigned voffA[2], voffB[2];
#pragma unroll
    for (int i = 0; i < 2; ++i) { int R, C; stage_rc(tid * 16 + i * 8192, R, C); const int Rb = Epi::PERM ? ((R & ~31) + perm32(R & 31)) : R;
        voffA[i] = (unsigned)(R * g.lda + C) * 2u; voffB[i] = (unsigned)(Rb * g.ldb + C) * 2u; }
    const size_t kstep = (size_t)(BK * 2);
    const size_t hstepA = (size_t)HALF * g.lda * 2, hstepB = (size_t)HALF * g.ldb * 2;
    const unsigned ldsw = (unsigned)wid * 1024u;
    const int aoff = lds_byte(wr * 64 + fr, fq * 8), boff = lds_byte(wc * 32 + fr, fq * 8);
#define PG8_SA(b, h) (((b) * 2 + (h)) * HTB)
#define PG8_SB(b, h) ((4 + (b) * 2 + (h)) * HTB)
#define PG8_STAGE(bufoff, gbase, voff) do { _Pragma("unroll") for (int _i = 0; _i < 2; ++_i) \
        __builtin_amdgcn_global_load_lds((const unsigned*)((const char*)(gbase) + (voff)[_i]), (PG8_LAS unsigned*)(lds + (bufoff) + ldsw + _i * 8192), 16, 0, 0); } while (0)
#define PG8_CAT8(x0, x1) __builtin_shufflevector(__builtin_bit_cast(v4i32, x0), __builtin_bit_cast(v4i32, x1), 0, 1, 2, 3, 4, 5, 6, 7)
#define PG8_LDA(dst, b, h) do { _Pragma("unroll") for (int m = 0; m < 4; ++m) { const bf16x8 x0 = *(const PG8_LAS bf16x8*)(lds + PG8_SA(b, h) + aoff + m * 2048), x1 = *(const PG8_LAS bf16x8*)(lds + PG8_SA(b, h) + aoff + m * 2048 + 1024); \
        if constexpr (FP8) dst##8[m] = PG8_CAT8(x0, x1); else { dst[m][0] = x0; dst[m][1] = x1; } } } while (0)
#define PG8_LDB(dst, b, h) do { _Pragma("unroll") for (int n = 0; n < 2; ++n) { const bf16x8 x0 = *(const PG8_LAS bf16x8*)(lds + PG8_SB(b, h) + boff + n * 2048), x1 = *(const PG8_LAS bf16x8*)(lds + PG8_SB(b, h) + boff + n * 2048 + 1024); \
        if constexpr (FP8) dst##8[n] = PG8_CAT8(x0, x1); else { dst[n][0] = x0; dst[n][1] = x1; } } } while (0)
#define PG8_MMA(ai, bj, At, Bt) do { __builtin_amdgcn_s_setprio(1); _Pragma("unroll") for (int m = 0; m < 4; ++m) _Pragma("unroll") for (int n = 0; n < 2; ++n) { \
        if constexpr (FP8) asm volatile("v_mfma_f32_16x16x128_f8f6f4 %0, %1, %2, %0" : "+v"(acc[ai][bj][m][n]) : "v"(Bt##8[n]), "v"(At##8[m]));   \
        else { _Pragma("unroll") for (int k = 0; k < 2; ++k) acc[ai][bj][m][n] = __builtin_amdgcn_mfma_f32_16x16x32_bf16(Bt[n][k], At[m][k], acc[ai][bj][m][n], 0, 0, 0); } } \
        if constexpr (FP8) asm volatile("s_nop 7" ::: "memory");   \
        __builtin_amdgcn_s_setprio(0); } while (0)
#define PG8_WAIT_V(n) asm volatile("s_waitcnt vmcnt(" #n ")" ::: "memory")
#define PG8_WAIT_L(n) asm volatile("s_waitcnt lgkmcnt(" #n ")" ::: "memory")
#define PG8_BAR __builtin_amdgcn_s_barrier()
#define PG8_SCHED __builtin_amdgcn_sched_barrier(0)
    Unit cur, nxt; int ui = 0;
    if (!S.next(0, cur)) return;
    f32x4 acc[2][2][4][2];
#pragma unroll
    for (int a = 0; a < 2; ++a)
#pragma unroll
        for (int b = 0; b < 2; ++b)
#pragma unroll
            for (int m = 0; m < 4; ++m)
#pragma unroll
                for (int n = 0; n < 2; ++n) acc[a][b][m][n] = (f32x4){0.f, 0.f, 0.f, 0.f};
    bf16x8 At[4][2], B0[2][2], B1[2][2];
    v8i32 At8[4], B08[2], B18[2];
    const char* cA = g.Aptr(cur); const char* cB = g.Bptr(cur);
    PG8_STAGE(PG8_SB(0, 0), cB, voffB); PG8_STAGE(PG8_SB(0, 1), cB + hstepB, voffB); PG8_STAGE(PG8_SA(0, 0), cA, voffA); PG8_STAGE(PG8_SA(0, 1), cA + hstepA, voffA);
    if (wr == 1) PG8_BAR;
    PG8_WAIT_V(2); PG8_BAR;
    PG8_STAGE(PG8_SB(1, 0), cB + kstep, voffB); PG8_STAGE(PG8_SA(1, 0), cA + kstep, voffA); PG8_STAGE(PG8_SB(1, 1), cB + hstepB + kstep, voffB);
    PG8_WAIT_V(6); PG8_BAR;
    for (;;) {
        const bool has_next = S.next(ui + 1, nxt);
        const char* nA = has_next ? g.Aptr(nxt) : cA; const char* nB = has_next ? g.Bptr(nxt) : cB;
        for (int t = 0; t < nt; t += 2) {
            if constexpr (Epi::HOOK) { if (t == 8 || t == 16) E.hook(acc, cur, wr, wc, fr, fq, t >> 3); }
            const bool last = (t == nt - 2);
            const char* a1 = cA + (size_t)(t + 1) * kstep;
            const char* a2 = last ? nA : cA + (size_t)(t + 2) * kstep; const char* b2 = last ? nB : cB + (size_t)(t + 2) * kstep;
            const char* a3 = a2 + kstep; const char* b3 = b2 + kstep;
            PG8_LDB(B0, 0, 0); PG8_LDB(B1, 0, 1); PG8_SCHED; PG8_LDA(At, 0, 0); PG8_STAGE(PG8_SA(1, 1), a1 + hstepA, voffA);
            PG8_WAIT_V(8); PG8_WAIT_L(0); PG8_BAR; PG8_MMA(0, 0, At, B0); PG8_MMA(0, 1, At, B1); PG8_BAR; PG8_SCHED;
            PG8_LDA(At, 0, 1); PG8_STAGE(PG8_SB(0, 0), b2, voffB); PG8_STAGE(PG8_SB(0, 1), b2 + hstepB, voffB); PG8_STAGE(PG8_SA(0, 0), a2, voffA);
            PG8_WAIT_V(8); PG8_WAIT_L(0); PG8_BAR; PG8_MMA(1, 0, At, B0); PG8_MMA(1, 1, At, B1); PG8_BAR; PG8_SCHED;
            PG8_LDB(B0, 1, 0); PG8_LDB(B1, 1, 1); PG8_SCHED; PG8_LDA(At, 1, 0); PG8_STAGE(PG8_SA(0, 1), a2 + hstepA, voffA);
            PG8_WAIT_V(8); PG8_WAIT_L(0); PG8_BAR; PG8_MMA(0, 0, At, B0); PG8_MMA(0, 1, At, B1); PG8_BAR; PG8_SCHED;
            PG8_LDA(At, 1, 1); PG8_STAGE(PG8_SB(1, 0), b3, voffB); PG8_STAGE(PG8_SB(1, 1), b3 + hstepB, voffB); PG8_STAGE(PG8_SA(1, 0), a3, voffA);
            PG8_WAIT_V(8); PG8_WAIT_L(0); PG8_BAR; PG8_MMA(1, 0, At, B0); PG8_MMA(1, 1, At, B1); PG8_BAR; PG8_SCHED;
        }
        if constexpr (ALIGN_EPI) { if (wr == 0) PG8_BAR; }
        E(acc, cur, wr, wc, fr, fq);
        if (!has_next) break;
#pragma unroll
        for (int a = 0; a < 2; ++a)
#pragma unroll
            for (int b = 0; b < 2; ++b)
#pragma unroll
                for (int m = 0; m < 4; ++m)
#pragma unroll
                    for (int n = 0; n < 2; ++n) acc[a][b][m][n] = (f32x4){0.f, 0.f, 0.f, 0.f};
        cur = nxt; cA = nA; cB = nB; ++ui;
        if constexpr (ALIGN_EPI) { if (wr == 1) PG8_BAR; }
    }
    PG8_WAIT_V(0);
    if constexpr (!ALIGN_EPI) { if (wr == 0) PG8_BAR; }
    PG8_BAR;
#undef PG8_SA
#undef PG8_SB
#undef PG8_STAGE
#undef PG8_LDA
#undef PG8_CAT8
#undef PG8_LDB
#undef PG8_MMA
#undef PG8_WAIT_V
#undef PG8_WAIT_L
#undef PG8_BAR
#undef PG8_SCHED
}
}


constexpr int RING_BYTES = 131072, MISC_OFF = RING_BYTES + 320, LDS_BYTES = 147456;
namespace att {
typedef short s16x4 __attribute__((ext_vector_type(4)));
__device__ __forceinline__ s16x4 lds_tr(const LAS unsigned char* p) { return __builtin_bit_cast(s16x4, __builtin_amdgcn_ds_read_tr16_b64_v4i16((LAS s16x4*)p)); }
template <int MODE> struct Cfg;
template <> struct Cfg<0> { static constexpr int DQK = 96, DV = 64, KRS = 208, VRS = 192, NV = 2, NL = 5; };
template <> struct Cfg<1> { static constexpr int DQK = 64, DV = 128, KRS = 144, VRS = 320, NV = 1, NL = 4; };
template <int MODE> struct Lay { using C = Cfg<MODE>; static constexpr int KB = 64 * C::KRS, VB = 64 * C::VRS, STAGE = 2 * KB + C::NV * VB; };

template <int MODE>
__device__ __forceinline__ void attn_unit(const Params& p, int l, int b, int hp, int qb, LAS unsigned char* lds, float lam, float lam_init, int pm = 0) {
    using C = Cfg<MODE>; using L = Lay<MODE>;
    constexpr int DQK = C::DQK, DV = C::DV, NDB = DV / 32, NKS = DQK / 16;
    int tid = threadIdx.x; asm volatile("" : "+v"(tid));
    const int lane = tid & 63, wid = __builtin_amdgcn_readfirstlane(tid >> 6), half = wid >> 2, r = lane & 31, h = lane >> 5;
    const int q0 = qb * 128, qrow = q0 + 32 * (wid & 3) + r;
    const size_t trow = (size_t)b * SEQ + qrow;
    const int ntile = 2 * qb + 2, mytiles = 2 * qb + 1 + ((wid & 3) >> 1);
    const bf16* Qb; const bf16* Kg[2]; const bf16* Vg[2]; int kp, vp;
    if (MODE == 0) { const bf16* QM = (const bf16*)(p.ws + WS_QM); const bf16* KM = (const bf16*)(p.ws + WS_KM); const bf16* KVR = (const bf16*)(p.ws + WS_KVR);
        Qb = QM + trow * 768 + (2 * hp + half) * 96; kp = 768; vp = 1024;
        Kg[0] = KM + (size_t)b * SEQ * 768 + (2 * hp) * 96; Kg[1] = Kg[0] + 96; Vg[0] = KVR + (size_t)b * SEQ * 1024 + 512 + (2 * hp) * 64; Vg[1] = Vg[0] + 64;
    } else { const bf16* Z = (const bf16*)(p.ws + WS_Z);
        Qb = Z + trow * ZP + ZC_DQ + (2 * hp + half) * 64; kp = ZP; vp = ZP;
        Kg[0] = Z + (size_t)b * SEQ * ZP + ZC_DK + (2 * hp) * 64; Kg[1] = Kg[0] + 64; Vg[0] = Z + (size_t)b * SEQ * ZP + ZC_DV + hp * 128; Vg[1] = Vg[0]; }
    constexpr int KC = DQK / 8, VC = DV / 8;
    typedef const __attribute__((address_space(1))) bf16* gptr_t;
    gptr_t gp[C::NL]; int lo_[C::NL]; size_t gstep[C::NL];
#pragma unroll
    for (int i = 0; i < C::NL; ++i) { const int id = tid + 512 * i;
        if (id < 2 * 64 * KC) { const int sg = id / (64 * KC), q = id % (64 * KC), row = q / KC, c = q % KC; gp[i] = (gptr_t)(sg ? Kg[1] : Kg[0]) + (size_t)row * kp + c * 8; lo_[i] = sg * L::KB + row * C::KRS + c * 16; gstep[i] = (size_t)64 * kp; }
        else { const int q2 = id - 2 * 64 * KC, sg = q2 / (64 * VC), q = q2 % (64 * VC), row = q / VC, c = q % VC; gp[i] = (gptr_t)(sg ? Vg[1] : Vg[0]) + (size_t)row * vp + c * 8; lo_[i] = 2 * L::KB + sg * L::VB + row * C::VRS + c * 16; gstep[i] = (size_t)64 * vp; } }
    bf16x8 qf[NKS];
#pragma unroll
    for (int s_ = 0; s_ < NKS; ++s_) qf[s_] = *(const bf16x8*)(Qb + 16 * s_ + 8 * h);
    const int koff = half * L::KB + r * C::KRS + 16 * h;
    const int voff = 2 * L::KB + (C::NV == 2 ? half * L::VB : 0) + (4 * h + ((lane & 15) >> 2)) * C::VRS + (((lane >> 4) & 1) * 16 + (lane & 3) * 4) * 2;
    f32x16 O[NDB];
#pragma unroll
    for (int d = 0; d < NDB; ++d)
#pragma unroll
        for (int e = 0; e < 16; ++e) O[d][e] = 0.f;
    f32x16 negm;
#pragma unroll
    for (int e = 0; e < 16; ++e) negm[e] = 0.f;
    float l_run = 0.f;
    u32x4 stA[C::NL], stB[C::NL];
#define ATT_LOAD(R) do { const size_t _st = adv > 0 ? 1 : 0; --adv; _Pragma("unroll") for (int i = 0; i < C::NL; ++i) { R[i] = *(const __attribute__((address_space(1))) u32x4*)gp[i]; gp[i] += _st * gstep[i]; } } while (0)
#define ATT_WRITE(R, stg) do { _Pragma("unroll") for (int i = 0; i < C::NL; ++i) *(LAS u32x4*)(lds + (stg) * L::STAGE + lo_[i]) = R[i]; } while (0)
#define ATT_VREAD(dst, kb) do { const int voff_ = (pm & 64) ? 2 * L::KB : voff; _Pragma("unroll") for (int d = 0; d < NDB; ++d) _Pragma("unroll") for (int sp = 0; sp < 2; ++sp) { \
                const LAS unsigned char* va = sb + voff_ + (32 * (kb) + 16 * sp) * C::VRS + 64 * d; \
                const s16x4 t0 = lds_tr(va), t1 = lds_tr(va + 8 * C::VRS); \
                dst[2 * d + sp] = (bf16x8){t0[0], t0[1], t0[2], t0[3], t1[0], t1[1], t1[2], t1[3]}; } } while (0)
#define ATT_PV(src, pfk) do { if (!(pm & 32)) { _Pragma("unroll") for (int d = 0; d < NDB; ++d) _Pragma("unroll") for (int sp = 0; sp < 2; ++sp) O[d] = __builtin_amdgcn_mfma_f32_32x32x16_bf16(src[2 * d + sp], pfk[sp], O[d], 0, 0, 0); } \
        else { _Pragma("unroll") for (int d = 0; d < NDB; ++d) O[d][0] += __builtin_bit_cast(float, (int)src[2 * d][0] + (int)pfk[0][0]); } } while (0)
#define ATT_SM(Sk, Sother, pfk) do { float mx = Sk[0]; _Pragma("unroll") for (int e = 1; e < 16; ++e) mx = fmaxf(mx, Sk[e]); \
            if (__any(mx > 8.f)) { mx = fmaxf(mx, __shfl_xor(mx, 32)); \
                const float dsh = fmaxf(mx, 0.f), alpha = __builtin_amdgcn_exp2f(-dsh); l_run *= alpha; \
                _Pragma("unroll") for (int e = 0; e < 16; ++e) { negm[e] -= dsh; Sk[e] -= dsh; Sother[e] -= dsh; } \
                _Pragma("unroll") for (int dd = 0; dd < NDB; ++dd) _Pragma("unroll") for (int e = 0; e < 16; ++e) O[dd][e] *= alpha; } \
            float ps = 0.f; \
            _Pragma("unroll") for (int sp = 0; sp < 2; ++sp) { float e8[8]; \
                if (pm & 16) { _Pragma("unroll") for (int jj = 0; jj < 8; ++jj) e8[jj] = Sk[8 * sp + jj]; } else { _Pragma("unroll") for (int jj = 0; jj < 8; ++jj) { e8[jj] = __builtin_amdgcn_exp2f(Sk[8 * sp + jj]); ps += e8[jj]; } } \
                u32x4 w; w.x = pg8::cvt_pk_bf16(e8[0], e8[1]); w.y = pg8::cvt_pk_bf16(e8[2], e8[3]); w.z = pg8::cvt_pk_bf16(e8[4], e8[5]); w.w = pg8::cvt_pk_bf16(e8[6], e8[7]); \
                pfk[sp] = __builtin_bit_cast(bf16x8, w); } \
            l_run += ps; } while (0)
#define ATT_COMPUTE(stg) do { LAS unsigned char* sb = lds + (stg) * L::STAGE; \
            bf16x8 kf[2][NKS]; \
            { const int koff_ = (pm & 64) ? 0 : koff; _Pragma("unroll") for (int kb = 0; kb < 2; ++kb) _Pragma("unroll") for (int s_ = 0; s_ < NKS; ++s_) kf[kb][s_] = *(const LAS bf16x8*)(sb + koff_ + kb * 32 * C::KRS + 32 * s_); } \
            __builtin_amdgcn_sched_barrier(0); \
            f32x16 S0 = negm, S1 = negm; __builtin_amdgcn_s_setprio(1); \
            if (!(pm & 32)) { _Pragma("unroll") for (int s_ = 0; s_ < NKS; ++s_) S0 = __builtin_amdgcn_mfma_f32_32x32x16_bf16(kf[0][s_], qf[s_], S0, 0, 0, 0); \
            _Pragma("unroll") for (int s_ = 0; s_ < NKS; ++s_) S1 = __builtin_amdgcn_mfma_f32_32x32x16_bf16(kf[1][s_], qf[s_], S1, 0, 0, 0); } \
            __builtin_amdgcn_s_setprio(0); bf16x8 vfa[2 * NDB], vfb[2 * NDB]; \
            ATT_VREAD(vfa, 0); \
            __builtin_amdgcn_sched_barrier(0); \
            bf16x8 pf0[2], pf1[2]; \
            ATT_SM(S0, S1, pf0); \
            __builtin_amdgcn_sched_barrier(0); \
            __builtin_amdgcn_s_setprio(1); ATT_PV(vfa, pf0); __builtin_amdgcn_s_setprio(0); \
            ATT_VREAD(vfb, 1); \
            __builtin_amdgcn_sched_barrier(0); \
            ATT_SM(S1, S0, pf1); \
            __builtin_amdgcn_sched_barrier(0); \
            __builtin_amdgcn_s_setprio(1); ATT_PV(vfb, pf1); __builtin_amdgcn_s_setprio(0); \
            } while (0)
    int adv = ntile - 1;
    ATT_LOAD(stA); ATT_LOAD(stB);
    ATT_WRITE(stA, 0);
    __syncthreads();
#pragma unroll 1
    for (int j = 0; j < ntile; j += 2) {
        if (!(pm & 1)) ATT_LOAD(stA);
        if (j < mytiles) ATT_COMPUTE(0);
        if (!(pm & 2)) ATT_WRITE(stB, 1);
        if (!(pm & 8)) __syncthreads();
        if (!(pm & 1)) ATT_LOAD(stB);
        if (j + 1 < mytiles) ATT_COMPUTE(1);
        if (!(pm & 2)) ATT_WRITE(stA, 0);
        if (!(pm & 8)) __syncthreads();
    }
#undef ATT_LOAD
#undef ATT_WRITE
#undef ATT_COMPUTE
#undef ATT_VREAD
#undef ATT_PV
#undef ATT_SM
    const float inv = 1.f / (l_run + __shfl_xor(l_run, 32));
    if (MODE == 0) {
        bf16* o = (bf16*)(p.ws + WS_OC) + trow * 1536 + (2 * hp + half) * 64 + 4 * h;
#pragma unroll
        for (int d = 0; d < NDB; ++d)
#pragma unroll
            for (int g4 = 0; g4 < 4; ++g4) { u32x2 w; w.x = pg8::cvt_pk_bf16(O[d][4 * g4] * inv, O[d][4 * g4 + 1] * inv); w.y = pg8::cvt_pk_bf16(O[d][4 * g4 + 2] * inv, O[d][4 * g4 + 3] * inv);
                *(u32x2*)(o + 32 * d + 8 * g4) = w; }
    } else {
        LAS unsigned char* xr = lds + (32 * (wid & 3) + r) * 264 + 8 * h;
        if (half == 1) {
#pragma unroll
            for (int d = 0; d < NDB; ++d)
#pragma unroll
                for (int g4 = 0; g4 < 4; ++g4) { u32x2 w; w.x = pg8::cvt_pk_bf16(O[d][4 * g4] * inv, O[d][4 * g4 + 1] * inv); w.y = pg8::cvt_pk_bf16(O[d][4 * g4 + 2] * inv, O[d][4 * g4 + 3] * inv);
                    *(LAS u32x2*)(xr + 64 * d + 16 * g4) = w; }
        }
        __syncthreads();
        if (half == 0) {
            float ss = 0.f;
#pragma unroll
            for (int d = 0; d < NDB; ++d)
#pragma unroll
                for (int g4 = 0; g4 < 4; ++g4) { const u32x2 w = *(const LAS u32x2*)(xr + 64 * d + 16 * g4);
                    O[d][4 * g4] = O[d][4 * g4] * inv - lam * bflo(w.x); O[d][4 * g4 + 1] = O[d][4 * g4 + 1] * inv - lam * bfhi(w.x);
                    O[d][4 * g4 + 2] = O[d][4 * g4 + 2] * inv - lam * bflo(w.y); O[d][4 * g4 + 3] = O[d][4 * g4 + 3] * inv - lam * bfhi(w.y);
                    ss += (O[d][4 * g4] * O[d][4 * g4] + O[d][4 * g4 + 1] * O[d][4 * g4 + 1]) + (O[d][4 * g4 + 2] * O[d][4 * g4 + 2] + O[d][4 * g4 + 3] * O[d][4 * g4 + 3]); }
            ss += __shfl_xor(ss, 32);
            const float rstd = rsqrtf(ss * (1.f / 128.f) + NORM_EPS) * (1.f - lam_init);
            const float* sg = p.in[11] + (size_t)l * 128 + 4 * h;
            bf16* o = (bf16*)(p.ws + WS_OC) + trow * 1536 + 512 + hp * 128 + 4 * h;
#pragma unroll
            for (int d = 0; d < NDB; ++d)
#pragma unroll
                for (int g4 = 0; g4 < 4; ++g4) { const f32x4 g = *(const f32x4*)(sg + 32 * d + 8 * g4);
                    u32x2 w; w.x = pg8::cvt_pk_bf16(O[d][4 * g4] * rstd * g.x, O[d][4 * g4 + 1] * rstd * g.y); w.y = pg8::cvt_pk_bf16(O[d][4 * g4 + 2] * rstd * g.z, O[d][4 * g4 + 3] * rstd * g.w);
                    *(u32x2*)(o + 32 * d + 8 * g4) = w; }
        }
        __syncthreads();
    }
}

__device__ __forceinline__ void sgu_unit(const Params& p, int l, int n, int g, LAS unsigned char* lds) {
    constexpr int VRS = 320;
    int tid = threadIdx.x; asm volatile("" : "+v"(tid));
    const int lane = tid & 63, wid = __builtin_amdgcn_readfirstlane(tid >> 6), r = lane & 31, h = lane >> 5, tb = wid & 3, ch = wid >> 2;
    const bf16* Z = (const bf16*)(p.ws + WS_Z) + (size_t)n * 128 * ZP;
#pragma unroll
    for (int i = 0; i < 4; ++i) { const int id = tid + 512 * i, row = id >> 4, c = id & 15; *(LAS u32x4*)(lds + row * VRS + c * 16) = *(const u32x4*)(Z + (size_t)row * ZP + ZC_SV + g * 128 + c * 8); }
    const bf16* W = (const bf16*)(p.ws + WS_W + (size_t)l * W_LAYER + WO_SGU) + ((size_t)g * 128 + tb * 32 + r) * 128 + 4 * h;
    u32x2 wf[8][2];
#pragma unroll
    for (int ks = 0; ks < 8; ++ks) { wf[ks][0] = *(const u32x2*)(W + 16 * ks); wf[ks][1] = *(const u32x2*)(W + 16 * ks + 8); }
    __syncthreads();
    f32x16 O[2];
#pragma unroll
    for (int d = 0; d < 2; ++d)
#pragma unroll
        for (int e = 0; e < 16; ++e) O[d][e] = 0.f;
    const int voff = (4 * h + ((lane & 15) >> 2)) * VRS + (((lane >> 4) & 1) * 16 + (lane & 3) * 4) * 2 + 128 * ch;
#pragma unroll
    for (int d = 0; d < 2; ++d)
#pragma unroll
        for (int ks = 0; ks < 8; ++ks) { const LAS unsigned char* va = lds + voff + (16 * ks) * VRS + 64 * d;
            const att::s16x4 t0 = att::lds_tr(va), t1 = att::lds_tr(va + 8 * VRS);
            const bf16x8 vf = {t0[0], t0[1], t0[2], t0[3], t1[0], t1[1], t1[2], t1[3]};
            const u32x4 pw = {wf[ks][0].x, wf[ks][0].y, wf[ks][1].x, wf[ks][1].y};
            O[d] = __builtin_amdgcn_mfma_f32_32x32x16_bf16(vf, __builtin_bit_cast(bf16x8, pw), O[d], 0, 0, 0); }
    const int t = tb * 32 + r; const size_t trow = (size_t)n * 128 + t;
    const float bias = p.in[14][(size_t)l * 512 + g * 128 + t];
    const bf16* up = (const bf16*)(p.ws + WS_Z) + trow * ZP + ZC_SU + g * 128 + 64 * ch + 4 * h;
    bf16* o = (bf16*)(p.ws + WS_OC) + trow * 1536 + 1024 + g * 128 + 64 * ch + 4 * h;
#pragma unroll
    for (int d = 0; d < 2; ++d)
#pragma unroll
        for (int g4 = 0; g4 < 4; ++g4) { const u32x2 uw = *(const u32x2*)(up + 32 * d + 8 * g4);
            u32x2 w; w.x = pg8::cvt_pk_bf16(bflo(uw.x) * (O[d][4 * g4] + bias), bfhi(uw.x) * (O[d][4 * g4 + 1] + bias)); w.y = pg8::cvt_pk_bf16(bflo(uw.y) * (O[d][4 * g4 + 2] + bias), bfhi(uw.y) * (O[d][4 * g4 + 3] + bias));
            *(u32x2*)(o + 32 * d + 8 * g4) = w; }
    __syncthreads();
}
}

#define XB_TMO      128
#define XB_XCNT(j)  (256  + 64 * (j))
#define XB_XSUB(j)  (1280 + 64 * (j))
#define XB_XGEN(j)  (2304 + 64 * (j))
#define XB_TOP      3328
#define XB_TOPGEN   3392
#define XCD_BAR_WORDS 3456
#define XB_SPIN_CAP (1u << 18)
__device__ __forceinline__ unsigned xb_ld(unsigned* p)              { return __hip_atomic_load(p, __ATOMIC_RELAXED, __HIP_MEMORY_SCOPE_AGENT); }
__device__ __forceinline__ unsigned xb_add(unsigned* p, unsigned v) { return __hip_atomic_fetch_add(p, v, __ATOMIC_RELAXED, __HIP_MEMORY_SCOPE_AGENT); }
__device__ __forceinline__ unsigned xb_xcc_id() { return (unsigned)__builtin_amdgcn_s_getreg((3 << 11) | 20) & 0xFu; }
#define XB_SPIN(cond, bar) do { unsigned _sp = 0; while (cond) { __builtin_amdgcn_s_sleep(1); \
    if ((++_sp & 255u) == 0u) { if (xb_ld(&(bar)[XB_TMO])) break; if (_sp > XB_SPIN_CAP) { atomicAdd(&(bar)[XB_TMO], 1u); break; } } } } while (0)
struct XcdBarrier { unsigned* bar; unsigned x; volatile LAS unsigned* st; };
__device__ __forceinline__ XcdBarrier xcd_barrier_post(unsigned* bar, volatile LAS unsigned* st) {
    XcdBarrier b; b.bar = bar; b.x = xb_xcc_id(); b.st = st;
    if (threadIdx.x == 0) (void)xb_add(&bar[XB_XCNT(b.x)], 1u);
    return b;
}
__device__ __forceinline__ void xcd_barrier_complete(unsigned* bar, unsigned x, unsigned& nloc, unsigned& nx) {
    const unsigned G = gridDim.x * gridDim.y * gridDim.z;
    unsigned sum, cnt, mine, sp = 0u;
    for (;;) {
        sum = 0u; cnt = 0u; mine = 0u;
#pragma unroll
        for (unsigned j = 0; j < 16; ++j) { const unsigned c = xb_ld(&bar[XB_XCNT(j)]); sum += c; cnt += (c > 0u) ? 1u : 0u; mine = (j == x) ? c : mine; }
        if (sum == G) break;
        __builtin_amdgcn_s_sleep(1);
        if ((++sp & 255u) == 0u) { if (xb_ld(&bar[XB_TMO])) break; if (sp > XB_SPIN_CAP) { atomicAdd(&bar[XB_TMO], 1u); break; } }
    }
    nloc = mine > 0u ? mine : 1u; nx = cnt > 0u ? cnt : 1u;
}
__device__ __forceinline__ void xcd_barrier(const XcdBarrier& b) {
    asm volatile("s_waitcnt vmcnt(0)" ::: "memory");
    __syncthreads();
    if (threadIdx.x == 0) {
        unsigned* bar = b.bar;
        __builtin_amdgcn_s_waitcnt(0);
        unsigned nloc = b.st[0], nx = b.st[1];
        if (nloc == 0u) { xcd_barrier_complete(bar, b.x, nloc, nx); b.st[0] = nloc; b.st[1] = nx; }
        const unsigned old = xb_add(&bar[XB_XSUB(b.x)], 1u);
        const unsigned gen = old / nloc;
        if (old + 1u == (gen + 1u) * nloc) {
            __builtin_amdgcn_fence(__ATOMIC_RELEASE, "agent");
            asm volatile("s_waitcnt vmcnt(0)" ::: "memory");
            const unsigned og = xb_add(&bar[XB_TOP], 1u);
            const unsigned tg = og / nx;
            if (og + 1u == (tg + 1u) * nx) xb_add(&bar[XB_TOPGEN], 1u);
            else XB_SPIN(xb_ld(&bar[XB_TOPGEN]) == tg, bar);
            __builtin_amdgcn_fence(__ATOMIC_ACQUIRE, "agent");
            xb_add(&bar[XB_XGEN(b.x)], 1u);
            asm volatile("s_waitcnt vmcnt(0)" ::: "memory");
        } else {
            XB_SPIN(xb_ld(&bar[XB_XGEN(b.x)]) == gen, bar);
            __builtin_amdgcn_fence(__ATOMIC_ACQUIRE, "agent");
            asm volatile("s_waitcnt vmcnt(0)" ::: "memory");
        }
    }
    __syncthreads();
}

constexpr int NPHASE = 1 + 11 * DEPTH;
constexpr int CW_BAR = 4096;
struct MArgs { Params p; int ph_lo, ph_hi, li, pad; };

__global__ void __launch_bounds__(512, 2) mega(MArgs a) {
    extern __shared__ __attribute__((aligned(16))) unsigned char lds_raw[];
    LAS unsigned char* lds = (LAS unsigned char*)lds_raw;
    volatile LAS unsigned* MISC = (volatile LAS unsigned*)(lds + MISC_OFF);
    const Params& p = a.p;
    const int tid = threadIdx.x, lane = tid & 63, wave = __builtin_amdgcn_readfirstlane(tid >> 6);
    const int G = gridDim.x, bx = blockIdx.x;
    const int vcu = (G % 8 == 0) ? (bx % 8) * (G / 8) + bx / 8 : bx;
    const int gw = vcu * 8 + wave, ngw = G * 8;
    unsigned char* ws = p.ws;
    for (int u = tid; u < (LDS_BYTES - RING_BYTES) / 4; u += 512) ((LAS unsigned*)(lds + RING_BYTES))[u] = 0u;
    __syncthreads();
    XcdBarrier bar = xcd_barrier_post((unsigned*)(ws + WS_CTL) + CW_BAR + a.li * XCD_BAR_WORDS, MISC + 8);
    const int lo = a.ph_lo, hi = a.ph_hi;
#ifndef PROBE_PM
#define PROBE_PM 0
#endif
#ifndef PROBE_K
#define PROBE_K (-1)
#endif
#ifndef PROBE_N
#define PROBE_N 0
#endif
#define NREP(j) ((PROBE_K == (j)) ? PROBE_N : 0)
#ifndef ENMASK
#define ENMASK 0xFFFFFFFFu
#endif
#define EN(j) ((ENMASK >> (j)) & 1u)
#define IN(k) (lo <= (k) && (k) < hi)
#define SEAM(k) do { if (IN(k) && IN((k) + 1)) xcd_barrier(bar); } while (0)

    if (EN(11) && IN(0)) for (int rep = 0; rep <= NREP(11); ++rep) {
        float* scr = (float*)lds_raw;
        __syncthreads();
        for (int r12 = 0; r12 <= NREP(12); ++r12)
        for (int l = 0; l < DEPTH; ++l) prologue_transposes(p, l, scr + wave * (64 * 33), gw, ngw, lane);
        prologue_rope(p, bx * 512 + tid, G * 512);
        __syncthreads();
        for (int r13 = 0; r13 <= NREP(13); ++r13)
        for (int it = bx; it < 2 * 256; it += G) fold_item(p, it >> 8, it & 255, scr, tid);
        __syncthreads();
        for (int r15 = 0; r15 <= NREP(15); ++r15)
        for (int t = gw; t < T; t += ngw) rms_row_to_bf16(p.in[0] + (size_t)t * DM, p.in[1], (bf16*)(ws + WS_HB) + (size_t)t * DM, lane, ws + WS_HB8 + (size_t)t * DM);
        for (int r14 = 0; r14 <= NREP(14); ++r14)
        for (int r = gw; r < 2 * DEPTH * NEXP; r += ngw) { const int tb = r / (DEPTH * NEXP), q = r % (DEPTH * NEXP);
            const size_t ro = (size_t)(q / NEXP) * NEXP * QROW + (size_t)(q % NEXP) * 128;
            if (tb) q4_row(p.in[23] + (size_t)q * DM, ws + WS_V8 + ro, (float*)(ws + WS_PS) + (size_t)DEPTH * NEXP + q, lane);
            else q4u_row(p.in[22] + (size_t)q * DM, ws + WS_U8 + ro, (float*)(ws + WS_PS) + q, lane); }
        { unsigned* gmax = (unsigned*)(ws + WS_CTL) + CW_GMAX;
          for (int m6 = 0; m6 < 3 * DEPTH; ++m6) { const f32x4* src = (const f32x4*)(p.in[15] + (size_t)m6 * DM * DM); float mx = 0.f;
              for (int i = gw * 64 + lane; i < DM * DM / 4; i += ngw * 64) { const f32x4 v = src[i]; mx = fmaxf(mx, fmaxf(fmaxf(fabsf(v.x), fabsf(v.y)), fmaxf(fabsf(v.z), fabsf(v.w)))); }
#pragma unroll
              for (int of = 1; of < 64; of <<= 1) mx = fmaxf(mx, __shfl_xor(mx, of));
              if (lane == 0) atomicMax(gmax + 64 * m6, __builtin_bit_cast(unsigned, mx)); } }
        xcd_barrier(bar);
        { unsigned* gmax = (unsigned*)(ws + WS_CTL) + CW_GMAX;
          for (int it = gw; it < DEPTH * 3 * 64 * 32; it += ngw) { const int m6 = it / 2048, q = it % 2048, cb = q / 32, kb = q % 32;
              transpose_item8(p.in[15] + (size_t)m6 * DM * DM, DM, cb * 32, kb * 64, DM, ws + WS_WG8, m6 * DM + cb * 32, scr + wave * (64 * 33), lane, gate_scale(gmax + 64 * m6)); } }
    }
    SEAM(0);
    { constexpr int l = 0;
        const int pb = 1 + 11 * l;
        unsigned char* wl = ws + WS_W + (size_t)l * W_LAYER;
        bf16* HB = (bf16*)(ws + WS_HB); bf16* Z = (bf16*)(ws + WS_Z); bf16* Gt = (bf16*)(ws + WS_G);
        if (EN(0) && IN(pb + 0)) for (int rep = 0; rep <= NREP(0); ++rep) {
            { pg8::ProbGen g{HB, (const bf16*)(wl + WO_CAT), DM, DM, DM}; pg8::StaticOrder S; S.init(T, ZP, G, bx);
              pg8::EpiZG E{Z, Gt, p.in[16] + (size_t)l * NGATE, 1};
              pg8::gemm_phase<pg8::EpiZG, pg8::ProbGen, pg8::StaticOrder>(lds, g, S, E); }
            {
              const unsigned* gmax = (const unsigned*)(ws + WS_CTL) + CW_GMAX + 64 * 3 * l;
              pg8::ProbGen g{(const bf16*)(ws + WS_HB8), (const bf16*)(ws + WS_WG8 + (size_t)l * NGATE * DM), DM / 2, DM / 2, DM / 2}; pg8::StaticOrder S; S.init(T, NGATE, G, bx);
              pg8::EpiG8 E{Gt, p.in[16] + (size_t)l * NGATE, gmax};
              pg8::gemm_phase<pg8::EpiG8, pg8::ProbGen, pg8::StaticOrder, true, true>(lds, g, S, E); }
        }
        SEAM(pb + 0);
        if (EN(1) && IN(pb + 1)) { int ln = lane; asm volatile("" : "+v"(ln)); for (int t = gw; t < T; t += ngw) prep1_row(p, l, t, ln); }
        SEAM(pb + 1);
        if (EN(2) && IN(pb + 2)) for (int rep = 0; rep <= NREP(2); ++rep) {
            pg8::ProbUp g{Z, (const bf16*)(wl + WO_UP), ZP, 512, 512}; pg8::StaticOrder S; S.init(T, 1792, G, bx);
            pg8::EpiUp E{(bf16*)(ws + WS_QR), (bf16*)(ws + WS_KVR)};
            pg8::gemm_phase<pg8::EpiUp, pg8::ProbUp, pg8::StaticOrder>(lds, g, S, E);
        }
        SEAM(pb + 2);
        if (EN(3) && IN(pb + 3)) for (int rep = 0; rep <= NREP(3); ++rep) { int ln = lane; asm volatile("" : "+v"(ln)); for (int t = gw; t < T; t += ngw) prep2_row(p, l, t, ln); }
        SEAM(pb + 3);
        if (EN(4) && IN(pb + 4)) for (int rep = 0; rep <= NREP(4); ++rep) {
            const float lam = diff_lambda(p, l, lane), lam_init = 0.8f - 0.6f * expf(-0.3f * (float)l);
            unsigned* qbase = (unsigned*)(ws + WS_CTL) + 64 * (1 + 8 * l + 16 * rep);
            int qs = 0;
            for (;;) {
                __syncthreads();
                if (tid == 0) { int u = 192, qx = 0;
                    while (qs < 8) { qx = (int)((bar.x + (unsigned)qs) & 7u); u = (int)atomicAdd(qbase + 64 * qx, 1u); if (u < 192) break; ++qs; }
                    MISC[16] = (unsigned)(qs < 8 ? u : 192); MISC[17] = (unsigned)qx; MISC[18] = (unsigned)qs; }
                __syncthreads();
                const int u = (int)MISC[16], qx = (int)MISC[17]; qs = (int)MISC[18];
                if (u >= 192) break;
                if (u < 128) { const int qb = 31 - (u >> 2), combo = qx + 8 * (u & 3);
                    if (combo < 16) att::attn_unit<1>(p, l, combo >> 2, combo & 3, qb, lds, lam, lam_init, rep < NREP(4) ? PROBE_PM : 0);
                    else att::attn_unit<0>(p, l, (combo - 16) >> 2, (combo - 16) & 3, qb, lds, 0.f, 0.f, rep < NREP(4) ? PROBE_PM : 0);
                } else { const int v = qx * 64 + (u - 128); att::sgu_unit(p, l, v >> 2, v & 3, lds); }
            }
        }
        SEAM(pb + 4);
        if (EN(5) && IN(pb + 5)) for (int rep = 0; rep <= NREP(5); ++rep) {
            const bool prb = rep < NREP(5);
            pg8::ProbGen g{(const bf16*)(ws + WS_OC), (const bf16*)(wl + WO_B), 1536, 1536, 1536}; pg8::StaticOrder S; S.init(T, DM, G, bx);
            if (prb && (PROBE_PM & 2)) { g.A = HB; g.lda = DM; }
            if (prb && (PROBE_PM & 4)) { g.Bt = (const bf16*)(wl + WO_CAT); g.ldb = DM; }
            pg8::EpiMG E{prb ? (bf16*)(ws + WS_QR) : (bf16*)(ws + WS_MG), Gt, (prb && (PROBE_PM & 1)) ? 1 : 0};
            if (prb && (PROBE_PM & 8)) { pg8::EpiDelta E2{(bf16*)(ws + WS_QR)}; pg8::gemm_phase<pg8::EpiDelta, pg8::ProbGen, pg8::StaticOrder>(lds, g, S, E2); }
            else pg8::gemm_phase<pg8::EpiMG, pg8::ProbGen, pg8::StaticOrder>(lds, g, S, E);
        }
        SEAM(pb + 5);
        if (EN(6) && IN(pb + 6)) for (int rep = 0; rep <= NREP(6); ++rep) {
            pg8::ProbGen g{(const bf16*)(ws + WS_MG), (const bf16*)(wl + WO_OUT), DM, DM, DM}; pg8::StaticOrder S; S.init(T, DM, G, bx);
            pg8::EpiDelta E{(bf16*)(ws + WS_QR)};
            pg8::gemm_phase<pg8::EpiDelta, pg8::ProbGen, pg8::StaticOrder>(lds, g, S, E);
        }
        SEAM(pb + 6);
        if (EN(7) && IN(pb + 7)) { int ln = lane; asm volatile("" : "+v"(ln));
            bf16* XB = (bf16*)(ws + WS_XB);
            for (int t = gw; t < T; t += ngw) {
                if (l == 0) add_rms_row<false>(p.in[0] + (size_t)t * DM, (const bf16*)(ws + WS_QR) + (size_t)t * DM, XB + (size_t)t * DM, p.in[19] + (size_t)l * DM, HB + (size_t)t * DM, (float*)(ws + WS_HS) + 2 * (size_t)t, ln);
                else add_rms_row<true>(XB + (size_t)t * DM, (const bf16*)(ws + WS_QR) + (size_t)t * DM, XB + (size_t)t * DM, p.in[19] + (size_t)l * DM, HB + (size_t)t * DM, (float*)(ws + WS_HS) + 2 * (size_t)t, ln); } }
        SEAM(pb + 7);
        if (EN(8) && IN(pb + 8)) for (int rep = 0; rep <= NREP(8); ++rep) {
            pg8::ProbGen g{HB, (const bf16*)(wl + WO_PQ), DM, DM, DM}; pg8::StaticOrder S; S.init(T, DM, G, bx);
            pg8::EpiSC E{(float*)(ws + WS_SC)};
            pg8::gemm_phase<pg8::EpiSC, pg8::ProbGen, pg8::StaticOrder>(lds, g, S, E);
        }
        SEAM(pb + 8);
        if (EN(10) && IN(pb + 10)) { int ln = lane; asm volatile("" : "+v"(ln));
            const float* gn = l + 1 < DEPTH ? p.in[1] + (size_t)(l + 1) * DM : nullptr;
            __syncthreads();
            for (int rep = 0; rep <= NREP(10); ++rep) { bf16* XB = (bf16*)(ws + WS_XB);
                if (rep < NREP(10)) peer_octets<PROBE_PM | 4>(p, l, gw, ngw, ln, nullptr, XB, XB, lds + wave * PEER_LDS_WAVE);
                else if (l + 1 < DEPTH) peer_octets<0, false>(p, l, gw, ngw, ln, gn, XB, XB, lds + wave * PEER_LDS_WAVE);
                else peer_octets<0, true>(p, l, gw, ngw, ln, nullptr, XB, p.out, lds + wave * PEER_LDS_WAVE); }
            __syncthreads(); }
        SEAM(pb + 10);
        }
    { constexpr int l = 1;
        const int pb = 1 + 11 * l;
        unsigned char* wl = ws + WS_W + (size_t)l * W_LAYER;
        bf16* HB = (bf16*)(ws + WS_HB); bf16* Z = (bf16*)(ws + WS_Z); bf16* Gt = (bf16*)(ws + WS_G);
        if (EN(0) && IN(pb + 0)) for (int rep = 0; rep <= NREP(0); ++rep) {
            { pg8::ProbGen g{HB, (const bf16*)(wl + WO_CAT), DM, DM, DM}; pg8::StaticOrder S; S.init(T, ZP, G, bx);
              pg8::EpiZG E{Z, Gt, p.in[16] + (size_t)l * NGATE, 1};
              pg8::gemm_phase<pg8::EpiZG, pg8::ProbGen, pg8::StaticOrder>(lds, g, S, E); }
            {
              const unsigned* gmax = (const unsigned*)(ws + WS_CTL) + CW_GMAX + 64 * 3 * l;
              pg8::ProbGen g{(const bf16*)(ws + WS_HB8), (const bf16*)(ws + WS_WG8 + (size_t)l * NGATE * DM), DM / 2, DM / 2, DM / 2}; pg8::StaticOrder S; S.init(T, NGATE, G, bx);
              pg8::EpiG8 E{Gt, p.in[16] + (size_t)l * NGATE, gmax};
              pg8::gemm_phase<pg8::EpiG8, pg8::ProbGen, pg8::StaticOrder, true, true>(lds, g, S, E); }
        }
        SEAM(pb + 0);
        if (EN(1) && IN(pb + 1)) { int ln = lane; asm volatile("" : "+v"(ln)); for (int t = gw; t < T; t += ngw) prep1_row(p, l, t, ln); }
        SEAM(pb + 1);
        if (EN(2) && IN(pb + 2)) for (int rep = 0; rep <= NREP(2); ++rep) {
            pg8::ProbUp g{Z, (const bf16*)(wl + WO_UP), ZP, 512, 512}; pg8::StaticOrder S; S.init(T, 1792, G, bx);
            pg8::EpiUp E{(bf16*)(ws + WS_QR), (bf16*)(ws + WS_KVR)};
            pg8::gemm_phase<pg8::EpiUp, pg8::ProbUp, pg8::StaticOrder>(lds, g, S, E);
        }
        SEAM(pb + 2);
        if (EN(3) && IN(pb + 3)) for (int rep = 0; rep <= NREP(3); ++rep) { int ln = lane; asm volatile("" : "+v"(ln)); for (int t = gw; t < T; t += ngw) prep2_row(p, l, t, ln); }
        SEAM(pb + 3);
        if (EN(4) && IN(pb + 4)) for (int rep = 0; rep <= NREP(4); ++rep) {
            const float lam = diff_lambda(p, l, lane), lam_init = 0.8f - 0.6f * expf(-0.3f * (float)l);
            unsigned* qbase = (unsigned*)(ws + WS_CTL) + 64 * (1 + 8 * l + 16 * rep);
            int qs = 0;
            for (;;) {
                __syncthreads();
                if (tid == 0) { int u = 192, qx = 0;
                    while (qs < 8) { qx = (int)((bar.x + (unsigned)qs) & 7u); u = (int)atomicAdd(qbase + 64 * qx, 1u); if (u < 192) break; ++qs; }
                    MISC[16] = (unsigned)(qs < 8 ? u : 192); MISC[17] = (unsigned)qx; MISC[18] = (unsigned)qs; }
                __syncthreads();
                const int u = (int)MISC[16], qx = (int)MISC[17]; qs = (int)MISC[18];
                if (u >= 192) break;
                if (u < 128) { const int qb = 31 - (u >> 2), combo = qx + 8 * (u & 3);
                    if (combo < 16) att::attn_unit<1>(p, l, combo >> 2, combo & 3, qb, lds, lam, lam_init, rep < NREP(4) ? PROBE_PM : 0);
                    else att::attn_unit<0>(p, l, (combo - 16) >> 2, (combo - 16) & 3, qb, lds, 0.f, 0.f, rep < NREP(4) ? PROBE_PM : 0);
                } else { const int v = qx * 64 + (u - 128); att::sgu_unit(p, l, v >> 2, v & 3, lds); }
            }
        }
        SEAM(pb + 4);
        if (EN(5) && IN(pb + 5)) for (int rep = 0; rep <= NREP(5); ++rep) {
            const bool prb = rep < NREP(5);
            pg8::ProbGen g{(const bf16*)(ws + WS_OC), (const bf16*)(wl + WO_B), 1536, 1536, 1536}; pg8::StaticOrder S; S.init(T, DM, G, bx);
            if (prb && (PROBE_PM & 2)) { g.A = HB; g.lda = DM; }
            if (prb && (PROBE_PM & 4)) { g.Bt = (const bf16*)(wl + WO_CAT); g.ldb = DM; }
            pg8::EpiMG E{prb ? (bf16*)(ws + WS_QR) : (bf16*)(ws + WS_MG), Gt, (prb && (PROBE_PM & 1)) ? 1 : 0};
            if (prb && (PROBE_PM & 8)) { pg8::EpiDelta E2{(bf16*)(ws + WS_QR)}; pg8::gemm_phase<pg8::EpiDelta, pg8::ProbGen, pg8::StaticOrder>(lds, g, S, E2); }
            else pg8::gemm_phase<pg8::EpiMG, pg8::ProbGen, pg8::StaticOrder>(lds, g, S, E);
        }
        SEAM(pb + 5);
        if (EN(6) && IN(pb + 6)) for (int rep = 0; rep <= NREP(6); ++rep) {
            pg8::ProbGen g{(const bf16*)(ws + WS_MG), (const bf16*)(wl + WO_OUT), DM, DM, DM}; pg8::StaticOrder S; S.init(T, DM, G, bx);
            pg8::EpiDelta E{(bf16*)(ws + WS_QR)};
            pg8::gemm_phase<pg8::EpiDelta, pg8::ProbGen, pg8::StaticOrder>(lds, g, S, E);
        }
        SEAM(pb + 6);
        if (EN(7) && IN(pb + 7)) { int ln = lane; asm volatile("" : "+v"(ln));
            bf16* XB = (bf16*)(ws + WS_XB);
            for (int t = gw; t < T; t += ngw) {
                if (l == 0) add_rms_row<false>(p.in[0] + (size_t)t * DM, (const bf16*)(ws + WS_QR) + (size_t)t * DM, XB + (size_t)t * DM, p.in[19] + (size_t)l * DM, HB + (size_t)t * DM, (float*)(ws + WS_HS) + 2 * (size_t)t, ln);
                else add_rms_row<true>(XB + (size_t)t * DM, (const bf16*)(ws + WS_QR) + (size_t)t * DM, XB + (size_t)t * DM, p.in[19] + (size_t)l * DM, HB + (size_t)t * DM, (float*)(ws + WS_HS) + 2 * (size_t)t, ln); } }
        SEAM(pb + 7);
        if (EN(8) && IN(pb + 8)) for (int rep = 0; rep <= NREP(8); ++rep) {
            pg8::ProbGen g{HB, (const bf16*)(wl + WO_PQ), DM, DM, DM}; pg8::StaticOrder S; S.init(T, DM, G, bx);
            pg8::EpiSC E{(float*)(ws + WS_SC)};
            pg8::gemm_phase<pg8::EpiSC, pg8::ProbGen, pg8::StaticOrder>(lds, g, S, E);
        }
        SEAM(pb + 8);
        if (EN(10) && IN(pb + 10)) { int ln = lane; asm volatile("" : "+v"(ln));
            const float* gn = l + 1 < DEPTH ? p.in[1] + (size_t)(l + 1) * DM : nullptr;
            __syncthreads();
            for (int rep = 0; rep <= NREP(10); ++rep) { bf16* XB = (bf16*)(ws + WS_XB);
                if (rep < NREP(10)) peer_octets<PROBE_PM | 4>(p, l, gw, ngw, ln, nullptr, XB, XB, lds + wave * PEER_LDS_WAVE);
                else if (l + 1 < DEPTH) peer_octets<0, false>(p, l, gw, ngw, ln, gn, XB, XB, lds + wave * PEER_LDS_WAVE);
                else peer_octets<0, true>(p, l, gw, ngw, ln, nullptr, XB, p.out, lds + wave * PEER_LDS_WAVE); }
            __syncthreads(); }
        SEAM(pb + 10);
        }
#undef IN
#undef SEAM
}

static int g_grid = 0;
static void launch_mega(const Params& p, int lo, int hi, int li, hipStream_t stream) {
    MArgs a{}; a.p = p; a.ph_lo = lo; a.ph_hi = hi; a.li = li; a.pad = 0;
    mega<<<g_grid, 512, LDS_BYTES, stream>>>(a);
}
extern "C" void kernel_launch(void* const* d_in, const int* in_sizes, int n_in, void* d_out, int out_size, void* d_ws, size_t ws_size, hipStream_t stream) {
    if (n_in != 24 || out_size != T * DM || ws_size < WS_END) { fprintf(stderr, "kernel_launch: unexpected shapes (n_in %d, out %d, ws %zu, need %zu)\n", n_in, out_size, ws_size, (size_t)WS_END); return; }
    if (g_grid == 0) {
        int dev = 0, cus = 0, per_cu = 0;
        if (hipGetDevice(&dev) != hipSuccess || hipDeviceGetAttribute(&cus, hipDeviceAttributeMultiprocessorCount, dev) != hipSuccess) { g_grid = -1; return; }
        if (hipFuncSetAttribute((const void*)mega, hipFuncAttributeMaxDynamicSharedMemorySize, LDS_BYTES) != hipSuccess) { fprintf(stderr, "kernel_launch: hipFuncSetAttribute failed\n"); g_grid = -1; return; }
        if (hipOccupancyMaxActiveBlocksPerMultiprocessor(&per_cu, (const void*)mega, 512, LDS_BYTES) != hipSuccess || per_cu < 1) { fprintf(stderr, "kernel_launch: occupancy query says %d\n", per_cu); }
        (void)hipGetLastError();
        g_grid = cus;
    }
    if (g_grid < 0) return;
    Params p{};
    for (int i = 0; i < 24; ++i) p.in[i] = (const float*)d_in[i];
    p.out = (float*)d_out; p.ws = (unsigned char*)d_ws;
    unsigned char* ws = p.ws;
    (void)hipMemsetAsync(ws + WS_CTL, 0, 1 * MiB, stream);
    launch_mega(p, 0, NPHASE, 0, stream);
}
```
